# Optimizing an MI355X kernel written in HIP

```python
import math
import jax
import jax.numpy as jnp
from jax import lax
import numpy as np

D_MODEL = 1024
BATCH = 1
SEQ = 16384
DEPTH = 2

N_EVEN = (DEPTH + 1) // 2
N_ODD = DEPTH // 2
D_FF = 2816
NORM_EPS = 1e-6
MIX_W = D_MODEL // 2

RET_HEADS = 4
RET_DK = MIX_W // RET_HEADS
RET_CHUNK = 128
ROPE_BASE = 10000.0
HEAD_NORM_EPS = 1e-6

SSM_HEAD_DIM = 64
SSM_HEADS = MIX_W // SSM_HEAD_DIM
SSM_GROUPS = 2
SSM_STATE = 64
SSM_CONV = 4
SSM_CHUNK = 128
SSM_XBC = MIX_W + 2 * SSM_GROUPS * SSM_STATE
SSM_NORM_EPS = 1e-5
DT_MIN = 1e-3
DT_MAX = 1e-1

LRU_BLOCKS = 4
LRU_BLOCK = MIX_W // LRU_BLOCKS
LRU_CONV = 4
LRU_C = 8.0

RWKV_HEAD_DIM = 64
RWKV_HEADS = MIX_W // RWKV_HEAD_DIM
DECAY_LORA = 64
ICL_LORA = 64
GATE_LORA = 160
RWKV_COLS = 3 * MIX_W + DECAY_LORA + ICL_LORA + GATE_LORA
RWKV_LN_EPS = 64e-5

AB_IN = 4 * MIX_W + MIX_W + SSM_XBC + SSM_HEADS
AB_SPLITS = (MIX_W, 2 * MIX_W, 3 * MIX_W, 4 * MIX_W, 5 * MIX_W, 5 * MIX_W + SSM_XBC)
CD_IN = 2 * MIX_W + RWKV_COLS
CD_SPLITS = (MIX_W, 2 * MIX_W)
RWKV_SPLITS = (MIX_W, 2 * MIX_W, 3 * MIX_W, 3 * MIX_W + DECAY_LORA, 3 * MIX_W + DECAY_LORA + ICL_LORA)

kernel_name = 'hybrid_macaron_retnet_mamba2_rglru_rwkv7'

F32 = jnp.float32


def rms_norm(x, g, eps=NORM_EPS):
    xf = x.astype(F32)
    y = xf * lax.rsqrt(jnp.mean(xf * xf, axis=-1, keepdims=True) + eps)
    return (y * g.astype(F32)).astype(x.dtype)


def swiglu_ffn(h, wg, wu, wd):
    return (jax.nn.silu(h @ wg) * (h @ wu)) @ wd


def causal_dwconv(x, w, b):
    k_width, ch = w.shape
    y = lax.conv_general_dilated(x, w[:, None, :].astype(x.dtype), window_strides=(1,),
                                 padding=[(k_width - 1, 0)],
                                 dimension_numbers=('NWC', 'WIO', 'NWC'),
                                 feature_group_count=ch)
    return y + b


def token_shift(p, mu):
    prev = jnp.pad(p, ((0, 0), (1, 0), (0, 0)))[:, :-1]
    return p + (prev - p) * mu


def rotary(x):
    t_len, d = x.shape[1], x.shape[-1]
    inv_freq = ROPE_BASE ** (-jnp.arange(0, d, 2, dtype=F32) / d)
    ang = jnp.arange(t_len, dtype=F32)[:, None] * inv_freq[None, :]
    cos = jnp.cos(ang)[None, :, None, :]
    sin = jnp.sin(ang)[None, :, None, :]
    x1, x2 = jnp.split(x.astype(F32), 2, axis=-1)
    return jnp.concatenate([x1 * cos - x2 * sin, x2 * cos + x1 * sin], axis=-1)


def retention_chunked(q, k, v):
    bsz, t_len, nh, dk = q.shape
    dv = v.shape[-1]
    c = RET_CHUNK
    nc = t_len // c
    log_g = jnp.log1p(-(2.0 ** (-5.0 - jnp.arange(nh, dtype=F32))))
    q = q.reshape(bsz, nc, c, nh, dk)
    k = k.reshape(bsz, nc, c, nh, dk)
    v = v.reshape(bsz, nc, c, nh, dv)
    pos = jnp.arange(c, dtype=F32)
    rel = pos[:, None] - pos[None, :]
    decay_in = jnp.where(rel >= 0, jnp.exp(jnp.maximum(rel, 0.0)[None] * log_g[:, None, None]), 0.0)
    scores = jnp.einsum('bnihd,bnjhd->bnhij', q, k) * decay_in
    o = jnp.einsum('bnhij,bnjhe->bnihe', scores, v)
    k_to_end = jnp.exp((c - 1 - pos)[:, None] * log_g[None, :])
    kv = jnp.einsum('bnjhd,jh,bnjhe->nbhde', k, k_to_end, v)
    chunk_decay = jnp.exp(c * log_g)[None, :, None, None]

    def step(s, kv_n):
        return s * chunk_decay + kv_n, s

    _, s_prev = lax.scan(step, jnp.zeros((bsz, nh, dk, dv), F32), kv)
    q_from_start = jnp.exp((pos + 1.0)[:, None] * log_g[None, :])
    o = o + jnp.einsum('bnihd,ih,nbhde->bnihe', q, q_from_start, s_prev)
    return o.reshape(bsz, t_len, nh, dv)


def ssd_chunked(xdt, a_dt, bm, cm):
    bsz, t_len, nh, hp = xdt.shape
    ng, ns = bm.shape[-2:]
    hg = nh // ng
    l = SSM_CHUNK
    nc = t_len // l
    x = xdt.reshape(bsz, nc, l, ng, hg, hp)
    bm = bm.reshape(bsz, nc, l, ng, ns)
    cm = cm.reshape(bsz, nc, l, ng, ns)
    a = a_dt.reshape(bsz, nc, l, ng, hg).transpose(0, 3, 4, 1, 2)
    a_cs = jnp.cumsum(a, axis=-1)
    causal = jnp.tril(jnp.ones((l, l), dtype=bool))
    seg = a_cs[..., :, None] - a_cs[..., None, :]
    decay_in = jnp.exp(jnp.where(causal, seg, -jnp.inf))
    cb = jnp.einsum('bclgn,bcsgn->bgcls', cm, bm)
    y_diag = jnp.einsum('bgcls,bghcls,bcsghp->bclghp', cb, decay_in, x)
    decay_to_end = jnp.exp(a_cs[..., -1:] - a_cs)
    chunk_states = jnp.einsum('bclgn,bghcl,bclghp->cbghpn', bm, decay_to_end, x)
    chunk_decay = jnp.exp(a_cs[..., -1]).transpose(3, 0, 1, 2)

    def step(s, inp):
        st, dec = inp
        return s * dec[..., None, None] + st, s

    s0 = jnp.zeros(chunk_states.shape[1:], F32)
    _, s_prev = lax.scan(step, s0, (chunk_states, chunk_decay))
    y_off = jnp.einsum('bclgn,cbghpn,bghcl->bclghp', cm, s_prev, jnp.exp(a_cs))
    return (y_diag + y_off).reshape(bsz, t_len, nh, hp)


def mamba2_mix(z, xbc, dt, conv_w, conv_b, dt_bias, a_log, d_skip, norm_g):
    bsz, t_len, _ = z.shape
    xbc = jax.nn.silu(causal_dwconv(xbc, conv_w, conv_b))
    xs, bm, cm = jnp.split(xbc, (MIX_W, MIX_W + SSM_GROUPS * SSM_STATE), axis=-1)
    dt = jax.nn.softplus(dt + dt_bias.astype(F32))
    a = -jnp.exp(a_log.astype(F32))
    xs = xs.reshape(bsz, t_len, SSM_HEADS, SSM_HEAD_DIM)
    y = ssd_chunked(xs * dt[..., None], dt * a,
                    bm.reshape(bsz, t_len, SSM_GROUPS, SSM_STATE),
                    cm.reshape(bsz, t_len, SSM_GROUPS, SSM_STATE))
    y = y + d_skip.astype(F32)[:, None] * xs
    y = (y.reshape(bsz, t_len, MIX_W) * jax.nn.silu(z)).reshape(bsz, t_len, SSM_GROUPS, MIX_W // SSM_GROUPS)
    y = y * lax.rsqrt(jnp.mean(y * y, axis=-1, keepdims=True) + SSM_NORM_EPS)
    return y.reshape(bsz, t_len, MIX_W) * norm_g.astype(F32)


def mix_ab(h, w_in, conv_w, conv_b, dt_bias, a_log, d_skip, norm_g, w_out):
    bsz, t_len, _ = h.shape
    p = (h @ w_in).astype(F32)
    q, k, v, g, z, xbc, dt = jnp.split(p, AB_SPLITS, axis=-1)
    q = rotary(q.reshape(bsz, t_len, RET_HEADS, RET_DK))
    k = rotary(k.reshape(bsz, t_len, RET_HEADS, RET_DK)) * (RET_DK ** -0.5)
    o = retention_chunked(q, k, v.reshape(bsz, t_len, RET_HEADS, RET_DK))
    o = o * lax.rsqrt(jnp.mean(o * o, axis=-1, keepdims=True) + HEAD_NORM_EPS)
    y_ret = jax.nn.silu(g) * o.reshape(bsz, t_len, MIX_W)
    y_ssm = mamba2_mix(z, xbc, dt, conv_w, conv_b, dt_bias, a_log, d_skip, norm_g)
    y = jnp.concatenate([y_ret, y_ssm], axis=-1).astype(h.dtype)
    return y @ w_out


def rglru_mix(xb, gb, conv_w, conv_b, wa, ba, wx, bx, lam):
    bsz, t_len, _ = xb.shape
    xb = causal_dwconv(xb, conv_w, conv_b)
    xh = xb.reshape(bsz, t_len, LRU_BLOCKS, LRU_BLOCK)
    r = jax.nn.sigmoid(jnp.einsum('btnd,nde->btne', xh, wa) + ba).reshape(bsz, t_len, MIX_W)
    i = jax.nn.sigmoid(jnp.einsum('btnd,nde->btne', xh, wx) + bx).reshape(bsz, t_len, MIX_W)
    log_a = -LRU_C * r * jax.nn.softplus(-lam.astype(F32))
    a = jnp.exp(log_a)
    u = jnp.sqrt(-jnp.expm1(2.0 * log_a)) * (i * xb)

    def combine(left, right):
        a_l, h_l = left
        a_r, h_r = right
        return a_l * a_r, a_r * h_l + h_r

    _, hs = lax.associative_scan(combine, (a, u), axis=1)
    return hs * jax.nn.gelu(gb)


def rwkv7_recurrence(r, w, k, v, kk, b):
    bsz, _, nh, nd = r.shape

    def step(s, inp):
        r_t, w_t, k_t, v_t, kk_t, b_t = inp
        s_kk = jnp.einsum('bhvk,bhk->bhv', s, kk_t)
        s = s * w_t[:, :, None, :] - s_kk[..., None] * b_t[:, :, None, :] + v_t[..., None] * k_t[:, :, None, :]
        return s, jnp.einsum('bhvk,bhk->bhv', s, r_t)

    seq = (r.transpose(1, 0, 2, 3), w.transpose(1, 0, 2, 3), k.transpose(1, 0, 2, 3),
           v.transpose(1, 0, 2, 3), kk.transpose(1, 0, 2, 3), b.transpose(1, 0, 2, 3))
    _, y = lax.scan(step, jnp.zeros((bsz, nh, nd, nd), F32), seq)
    return y.transpose(1, 0, 2, 3)


def rwkv7_mix(p, mu, w0, w2, a0, a2, g2, k_k, k_a, r_k, ln_g, ln_b):
    bsz, t_len, _ = p.shape
    p = token_shift(p, mu)
    r, k, v, wl, al, gl = jnp.split(p, RWKV_SPLITS, axis=-1)
    w = -jax.nn.softplus(-(w0 + jnp.tanh(wl) @ w2)) - 0.5
    decay = jnp.exp(-jnp.exp(w))
    a = jax.nn.sigmoid(a0 + al @ a2)
    g = jax.nn.sigmoid(gl) @ g2

    def heads(t):
        return t.reshape(bsz, t_len, RWKV_HEADS, RWKV_HEAD_DIM)

    kk = heads(k * k_k)
    kk = kk / jnp.maximum(jnp.sqrt(jnp.sum(kk * kk, axis=-1, keepdims=True)), 1e-12)
    k = k * (1.0 + (a - 1.0) * k_a)
    rh, kh, vh = heads(r), heads(k), heads(v)
    y = rwkv7_recurrence(rh, heads(decay), kh, vh, kk, kk * heads(a))
    mean = jnp.mean(y, axis=-1, keepdims=True)
    var = jnp.mean(jnp.square(y - mean), axis=-1, keepdims=True)
    y = ((y - mean) * lax.rsqrt(var + RWKV_LN_EPS)).reshape(bsz, t_len, MIX_W) * ln_g + ln_b
    bonus = jnp.sum(rh * kh * r_k, axis=-1, keepdims=True) * vh
    y = y + bonus.reshape(bsz, t_len, MIX_W)
    return y * g


def mix_cd(h, w_in, lru_conv_w, lru_conv_b, lru_wa, lru_ba, lru_wx, lru_bx, lru_lambda,
           mu, w0, w2, a0, a2, g2, k_k, k_a, r_k, ln_g, ln_b, w_out):
    p = (h @ w_in).astype(F32)
    xb, gb, pr = jnp.split(p, CD_SPLITS, axis=-1)
    y_lru = rglru_mix(xb, gb, lru_conv_w, lru_conv_b, lru_wa, lru_ba, lru_wx, lru_bx, lru_lambda)
    y_rwkv = rwkv7_mix(pr, mu, w0, w2, a0, a2, g2, k_k, k_a, r_k, ln_g, ln_b)
    y = jnp.concatenate([y_lru, y_rwkv], axis=-1).astype(h.dtype)
    return y @ w_out


def setup_inputs(seed: int = 0) -> dict:
    key = jax.random.key(seed)
    keys = iter(jax.random.split(key, 64))

    def normal(shape, scale):
        return scale * jax.random.normal(next(keys), shape, F32)

    def uniform(shape, lo, hi):
        return jax.random.uniform(next(keys), shape, F32, lo, hi)

    def gain(shape):
        return 1.0 + 0.02 * jax.random.normal(next(keys), shape, F32)

    d = D_MODEL
    x = normal((BATCH, SEQ, d), 1.0)
    dt0 = jnp.exp(uniform((N_EVEN, SSM_HEADS), math.log(DT_MIN), math.log(DT_MAX)))
    lru_a = uniform((N_ODD, MIX_W), 0.9, 0.999) ** (1.0 / LRU_C)
    ratio = jnp.arange(MIX_W, dtype=F32) / (MIX_W - 1)
    return {
        'x': x,
        'ffn1_norm': gain((DEPTH, d)),
        'ffn1_wg': normal((DEPTH, d, D_FF), d ** -0.5),
        'ffn1_wu': normal((DEPTH, d, D_FF), d ** -0.5),
        'ffn1_wd': normal((DEPTH, D_FF, d), D_FF ** -0.5),
        'mix_norm': gain((DEPTH, d)),
        'ffn2_norm': gain((DEPTH, d)),
        'ffn2_wg': normal((DEPTH, d, D_FF), d ** -0.5),
        'ffn2_wu': normal((DEPTH, d, D_FF), d ** -0.5),
        'ffn2_wd': normal((DEPTH, D_FF, d), D_FF ** -0.5),
        'ab_w_in': normal((N_EVEN, d, AB_IN), d ** -0.5),
        'ab_w_out': normal((N_EVEN, 2 * MIX_W, d), (2 * MIX_W) ** -0.5),
        'ssm_conv_w': normal((N_EVEN, SSM_CONV, SSM_XBC), SSM_CONV ** -0.5),
        'ssm_conv_b': normal((N_EVEN, SSM_XBC), 0.01),
        'ssm_dt_bias': dt0 + jnp.log(-jnp.expm1(-dt0)),
        'ssm_a_log': jnp.log(uniform((N_EVEN, SSM_HEADS), 1.0, 16.0)),
        'ssm_d': gain((N_EVEN, SSM_HEADS)),
        'ssm_norm': gain((N_EVEN, MIX_W)),
        'cd_w_in': normal((N_ODD, d, CD_IN), d ** -0.5),
        'cd_w_out': normal((N_ODD, 2 * MIX_W, d), (2 * MIX_W) ** -0.5),
        'lru_conv_w': normal((N_ODD, LRU_CONV, MIX_W), LRU_CONV ** -0.5),
        'lru_conv_b': normal((N_ODD, MIX_W), 0.01),
        'lru_wa': normal((N_ODD, LRU_BLOCKS, LRU_BLOCK, LRU_BLOCK), LRU_BLOCK ** -0.5),
        'lru_ba': normal((N_ODD, LRU_BLOCKS, LRU_BLOCK), 0.01),
        'lru_wx': normal((N_ODD, LRU_BLOCKS, LRU_BLOCK, LRU_BLOCK), LRU_BLOCK ** -0.5),
        'lru_bx': normal((N_ODD, LRU_BLOCKS, LRU_BLOCK), 0.01),
        'lru_lambda': jnp.log(lru_a) - jnp.log1p(-lru_a),
        'rwkv_mu': uniform((N_ODD, RWKV_COLS), 0.0, 1.0),
        'rwkv_w0': -6.5 + 5.0 * ratio ** 0.85 + normal((N_ODD, MIX_W), 0.1),
        'rwkv_w2': normal((N_ODD, DECAY_LORA, MIX_W), 0.1),
        'rwkv_a0': normal((N_ODD, MIX_W), 0.1),
        'rwkv_a2': normal((N_ODD, ICL_LORA, MIX_W), 0.1),
        'rwkv_g2': normal((N_ODD, GATE_LORA, MIX_W), GATE_LORA ** -0.5),
        'rwkv_kk': 0.85 + normal((N_ODD, MIX_W), 0.05),
        'rwkv_ka': 1.0 + normal((N_ODD, MIX_W), 0.05),
        'rwkv_rk': normal((N_ODD, RWKV_HEADS, RWKV_HEAD_DIM), 0.1),
        'rwkv_ln_g': gain((N_ODD, MIX_W)),
        'rwkv_ln_b': normal((N_ODD, MIX_W), 0.01),
        'final_norm': gain((d,)),
    }


def reference(x, ffn1_norm, ffn1_wg, ffn1_wu, ffn1_wd, mix_norm, ffn2_norm, ffn2_wg, ffn2_wu, ffn2_wd,
              ab_w_in, ab_w_out, ssm_conv_w, ssm_conv_b, ssm_dt_bias, ssm_a_log, ssm_d, ssm_norm,
              cd_w_in, cd_w_out, lru_conv_w, lru_conv_b, lru_wa, lru_ba, lru_wx, lru_bx, lru_lambda,
              rwkv_mu, rwkv_w0, rwkv_w2, rwkv_a0, rwkv_a2, rwkv_g2, rwkv_kk, rwkv_ka, rwkv_rk,
              rwkv_ln_g, rwkv_ln_b, final_norm):
    for layer in range(DEPTH):
        j = layer // 2
        x = x + 0.5 * swiglu_ffn(rms_norm(x, ffn1_norm[layer]), ffn1_wg[layer], ffn1_wu[layer],
                                 ffn1_wd[layer]).astype(x.dtype)
        h = rms_norm(x, mix_norm[layer])
        if layer % 2 == 0:
            y = mix_ab(h, ab_w_in[j], ssm_conv_w[j], ssm_conv_b[j], ssm_dt_bias[j], ssm_a_log[j],
                       ssm_d[j], ssm_norm[j], ab_w_out[j])
        else:
            y = mix_cd(h, cd_w_in[j], lru_conv_w[j], lru_conv_b[j], lru_wa[j], lru_ba[j], lru_wx[j],
                       lru_bx[j], lru_lambda[j], rwkv_mu[j], rwkv_w0[j], rwkv_w2[j], rwkv_a0[j],
                       rwkv_a2[j], rwkv_g2[j], rwkv_kk[j], rwkv_ka[j], rwkv_rk[j], rwkv_ln_g[j],
                       rwkv_ln_b[j], cd_w_out[j])
        x = x + y.astype(x.dtype)
        x = x + 0.5 * swiglu_ffn(rms_norm(x, ffn2_norm[layer]), ffn2_wg[layer], ffn2_wu[layer],
                                 ffn2_wd[layer]).astype(x.dtype)
    return rms_norm(x, final_norm)
```

```cpp
#include <hip/hip_runtime.h>
#include <hip/hip_cooperative_groups.h>
#include <cstdio>
#include <cstdint>
namespace cg = cooperative_groups;
namespace pg8 {
#define PG8_LAS __attribute__((address_space(3)))
typedef unsigned short bf16_t;
typedef short bf16x8 __attribute__((ext_vector_type(8)));
typedef float f32x4 __attribute__((ext_vector_type(4)));
typedef unsigned u32x4 __attribute__((ext_vector_type(4)));
constexpr int BM = 256, BK = 64, HALF = 128, HTB = HALF * BK * 2  , STAGE_BYTES = 8 * HTB, NXCD = 8, WGM = 8;

__host__ __device__ __forceinline__ int lds_byte(int r, int c) { const int st = (r >> 4) * 2 + (c >> 5), rr = r & 15, cc = c & 31, ob = rr * 64 + cc * 2; return st * 1024 + (ob ^ (((ob >> 9) & 1) << 5)); }
__host__ __device__ __forceinline__ void stage_rc(int b, int& R, int& C) { const int st = b / 1024, sb = b % 1024, swz = sb ^ (((sb >> 9) & 1) << 5); R = (st >> 1) * 16 + swz / 64; C = (st & 1) * 32 + (swz % 64) / 2; }
__host__ __device__ __forceinline__ int perm32(int rho) { const int n = rho >> 4, i = rho & 15; return 8 * (i >> 2) + 4 * n + (i & 3); }

struct Unit { int pm, pn; };
struct Gemm { const bf16_t* A; const bf16_t* Bt; int M, N, K; };

struct StaticOrder {
    int nM, nN, nwg, G, c;
    __host__ __device__ void init(int M, int N, int G_, int c_) { nM = M / BM; nN = N / BM; nwg = nM * nN; G = G_; c = c_; }
    __host__ __device__ bool next(int i, Unit& u) const {
        const long L = (long)i * G + c; if (L >= nwg) return false;
        int wgid = (int)L; { const int q = nwg / NXCD, r = nwg % NXCD, xcd = wgid % NXCD, off = wgid / NXCD; wgid = (xcd < r ? xcd * (q + 1) : r * (q + 1) + (xcd - r) * q) + off; }
        const int nig = WGM * nN, gid = wgid / nig, fm = gid * WGM, gsz = (nM - fm) < WGM ? (nM - fm) : WGM;
        u.pm = fm + ((wgid % nig) % gsz); u.pn = (wgid % nig) / gsz; return true;
    }
    __device__ __forceinline__ void a_ready(const Unit&) const {}
    __device__ __forceinline__ void done(const Unit&) const {}
};
__device__ __forceinline__ unsigned cvt_pk_bf16(float lo, float hi) { unsigned r; asm volatile("v_cvt_pk_bf16_f32 %0, %1, %2" : "=v"(r) : "v"(lo), "v"(hi)); return r; }
template <class Epi, class Sched, bool ALIGN_EPI = false, bool SP2 = false>
__device__ __forceinline__ void gemm_phase(PG8_LAS unsigned char* lds, const Gemm g, const Sched& S, const Epi& E) {
    const int tid = threadIdx.x, wid = __builtin_amdgcn_readfirstlane(tid >> 6), lane = tid & 63, wr = wid >> 2, wc = wid & 3, fr = lane & 15, fq = lane >> 4;
    const int K = g.K, nt = K / BK;
    unsigned voffA[2], voffB[2];
#pragma unroll
    for (int i = 0; i < 2; ++i) { int R, C; stage_rc(tid * 16 + i * 8192, R, C); const int Rb = Epi::PERM ? ((R & ~31) + perm32(R & 31)) : R;
        voffA[i] = (unsigned)(R * K + C) * 2u; voffB[i] = (unsigned)(Rb * K + C) * 2u; }
    const size_t kstep = (size_t)(BK * 2);
    const size_t hstep = (size_t)HALF * K * 2;
    const size_t tstep = 2 * hstep;
    const unsigned ldsw = (unsigned)wid * 1024u;
    const int aoff = lds_byte(wr * 64 + fr, fq * 8), boff = lds_byte(wc * 32 + fr, fq * 8);
#define PG8_SA(b, h) (((b) * 2 + (h)) * HTB)
#define PG8_SB(b, h) ((4 + (b) * 2 + (h)) * HTB)
#define PG8_STAGE(bufoff, gbase, voff) do { _Pragma("unroll") for (int _i = 0; _i < 2; ++_i) \
        __builtin_amdgcn_global_load_lds((const unsigned*)((const char*)(gbase) + (voff)[_i]), (PG8_LAS unsigned*)(lds + (bufoff) + ldsw + _i * 8192), 16, 0, 0); } while (0)
#define PG8_LDA(dst, b, h) do { _Pragma("unroll") for (int m = 0; m < 4; ++m) _Pragma("unroll") for (int k = 0; k < 2; ++k) dst[m][k] = *(const PG8_LAS bf16x8*)(lds + PG8_SA(b, h) + aoff + m * 2048 + k * 1024); } while (0)
#define PG8_LDB(dst, b, h) do { _Pragma("unroll") for (int n = 0; n < 2; ++n) _Pragma("unroll") for (int k = 0; k < 2; ++k) dst[n][k] = *(const PG8_LAS bf16x8*)(lds + PG8_SB(b, h) + boff + n * 2048 + k * 1024); } while (0)
#define PG8_MMA(ai, bj, At, Bt) do { __builtin_amdgcn_s_setprio(1); _Pragma("unroll") for (int m = 0; m < 4; ++m) _Pragma("unroll") for (int n = 0; n < 2; ++n) _Pragma("unroll") for (int k = 0; k < 2; ++k) \
        acc[ai][bj][m][n] = __builtin_amdgcn_mfma_f32_16x16x32_bf16(Bt[n][k], At[m][k], acc[ai][bj][m][n], 0, 0, 0); __builtin_amdgcn_s_setprio(0); } while (0)
#define PG8_WAIT_V(n) asm volatile("s_waitcnt vmcnt(" #n ")" ::: "memory")
#define PG8_WAIT_L(n) asm volatile("s_waitcnt lgkmcnt(" #n ")" ::: "memory")
#define PG8_BAR __builtin_amdgcn_s_barrier()
#define PG8_SCHED __builtin_amdgcn_sched_barrier(0)
    Unit cur, nxt; int ui = 0;
    if (!S.next(0, cur)) return;
    f32x4 acc[2][2][4][2];
#pragma unroll
    for (int a = 0; a < 2; ++a)
#pragma unroll
        for (int b = 0; b < 2; ++b)
#pragma unroll
            for (int m = 0; m < 4; ++m)
#pragma unroll
                for (int n = 0; n < 2; ++n) acc[a][b][m][n] = (f32x4){0.f, 0.f, 0.f, 0.f};
    bf16x8 At[4][2], B0[2][2], B1[2][2];
    const char* cA = (const char*)g.A + (size_t)cur.pm * tstep; const char* cB = (const char*)g.Bt + (size_t)cur.pn * tstep;
    S.a_ready(cur);
    if constexpr (SP2) {
        PG8_STAGE(PG8_SB(0, 0), cB, voffB); PG8_STAGE(PG8_SB(0, 1), cB + hstep, voffB); PG8_STAGE(PG8_SA(0, 0), cA, voffA); PG8_STAGE(PG8_SA(0, 1), cA + hstep, voffA);
        if (wr == 1) PG8_BAR;
        PG8_WAIT_V(2); PG8_BAR;
        PG8_STAGE(PG8_SB(1, 0), cB + kstep, voffB); PG8_STAGE(PG8_SA(1, 0), cA + kstep, voffA); PG8_STAGE(PG8_SB(1, 1), cB + hstep + kstep, voffB);
        PG8_WAIT_V(6); PG8_BAR;
    } else {
        PG8_STAGE(PG8_SB(0, 0), cB, voffB); PG8_STAGE(PG8_SA(0, 0), cA, voffA); PG8_STAGE(PG8_SB(0, 1), cB + hstep, voffB); PG8_STAGE(PG8_SA(0, 1), cA + hstep, voffA);
        if (wr == 1) PG8_BAR;
        PG8_WAIT_V(4); PG8_BAR;
        PG8_STAGE(PG8_SB(1, 0), cB + kstep, voffB); PG8_STAGE(PG8_SA(1, 0), cA + kstep, voffA); PG8_STAGE(PG8_SB(1, 1), cB + hstep + kstep, voffB);
        PG8_WAIT_V(6); PG8_BAR;
    }
    for (;;) {
        const bool has_next = S.next(ui + 1, nxt);
        const char* nA = has_next ? (const char*)g.A + (size_t)nxt.pm * tstep : cA; const char* nB = has_next ? (const char*)g.Bt + (size_t)nxt.pn * tstep : cB;
        for (int t = 0; t < nt; t += 2) {
            const bool last = (t == nt - 2);
            const char* a1 = cA + (size_t)(t + 1) * kstep;
            const char* a2 = last ? nA : cA + (size_t)(t + 2) * kstep; const char* b2 = last ? nB : cB + (size_t)(t + 2) * kstep;
            const char* a3 = a2 + kstep; const char* b3 = b2 + kstep;
            if (last && has_next) S.a_ready(nxt);
            if constexpr (SP2) {
            PG8_LDB(B0, 0, 0); PG8_LDB(B1, 0, 1); PG8_SCHED; PG8_LDA(At, 0, 0); PG8_STAGE(PG8_SA(1, 1), a1 + hstep, voffA);
            PG8_WAIT_V(8); PG8_WAIT_L(0); PG8_BAR; PG8_MMA(0, 0, At, B0); PG8_MMA(0, 1, At, B1); PG8_BAR; PG8_SCHED;
            PG8_LDA(At, 0, 1); PG8_STAGE(PG8_SB(0, 0), b2, voffB); PG8_STAGE(PG8_SB(0, 1), b2 + hstep, voffB); PG8_STAGE(PG8_SA(0, 0), a2, voffA);
            PG8_WAIT_V(8); PG8_WAIT_L(0); PG8_BAR; PG8_MMA(1, 0, At, B0); PG8_MMA(1, 1, At, B1); PG8_BAR; PG8_SCHED;
            PG8_LDB(B0, 1, 0); PG8_LDB(B1, 1, 1); PG8_SCHED; PG8_LDA(At, 1, 0); PG8_STAGE(PG8_SA(0, 1), a2 + hstep, voffA);
            PG8_WAIT_V(8); PG8_WAIT_L(0); PG8_BAR; PG8_MMA(0, 0, At, B0); PG8_MMA(0, 1, At, B1); PG8_BAR; PG8_SCHED;
            PG8_LDA(At, 1, 1); PG8_STAGE(PG8_SB(1, 0), b3, voffB); PG8_STAGE(PG8_SB(1, 1), b3 + hstep, voffB); PG8_STAGE(PG8_SA(1, 0), a3, voffA);
            PG8_WAIT_V(8); PG8_WAIT_L(0); PG8_BAR; PG8_MMA(1, 0, At, B0); PG8_MMA(1, 1, At, B1); PG8_BAR; PG8_SCHED;
            } else {
            PG8_LDB(B0, 0, 0); PG8_SCHED; PG8_LDA(At, 0, 0); PG8_STAGE(PG8_SA(1, 1), a1 + hstep, voffA);
            PG8_WAIT_L(8); PG8_BAR; PG8_WAIT_L(0); PG8_MMA(0, 0, At, B0); PG8_BAR; PG8_SCHED;
            PG8_LDB(B1, 0, 1); PG8_STAGE(PG8_SB(0, 0), b2, voffB);
            PG8_BAR; PG8_WAIT_L(0); PG8_MMA(0, 1, At, B1); PG8_BAR;
            PG8_LDA(At, 0, 1); PG8_STAGE(PG8_SA(0, 0), a2, voffA);
            PG8_BAR; PG8_WAIT_L(0); PG8_MMA(1, 0, At, B0); PG8_BAR; PG8_SCHED;
            PG8_STAGE(PG8_SB(0, 1), b2 + hstep, voffB);
            PG8_WAIT_V(6); PG8_BAR; PG8_MMA(1, 1, At, B1); PG8_BAR;
            PG8_LDB(B0, 1, 0); PG8_SCHED; PG8_LDA(At, 1, 0); PG8_STAGE(PG8_SA(0, 1), a2 + hstep, voffA);
            PG8_WAIT_L(8); PG8_BAR; PG8_WAIT_L(0); PG8_MMA(0, 0, At, B0); PG8_BAR; PG8_SCHED;
            PG8_LDB(B1, 1, 1); PG8_STAGE(PG8_SB(1, 0), b3, voffB);
            PG8_BAR; PG8_WAIT_L(0); PG8_MMA(0, 1, At, B1); PG8_BAR;
            PG8_LDA(At, 1, 1); PG8_STAGE(PG8_SA(1, 0), a3, voffA);
            PG8_BAR; PG8_WAIT_L(0); PG8_MMA(1, 0, At, B0); PG8_BAR; PG8_SCHED;
            PG8_STAGE(PG8_SB(1, 1), b3 + hstep, voffB);
            PG8_WAIT_V(6); PG8_BAR; PG8_MMA(1, 1, At, B1); PG8_BAR;
            }
        }
        if constexpr (ALIGN_EPI) { if (wr == 0) PG8_BAR; }
        if constexpr (!Epi::AFTER_DRAIN) { E(acc, cur, wr, wc, fr, fq); S.done(cur); }
        if (!has_next) break;
#pragma unroll
        for (int a = 0; a < 2; ++a)
#pragma unroll
            for (int b = 0; b < 2; ++b)
#pragma unroll
                for (int m = 0; m < 4; ++m)
#pragma unroll
                    for (int n = 0; n < 2; ++n) acc[a][b][m][n] = (f32x4){0.f, 0.f, 0.f, 0.f};
        cur = nxt; cA = nA; cB = nB; ++ui;
        if constexpr (ALIGN_EPI) { if (wr == 1) PG8_BAR; }
    }
    PG8_WAIT_V(0);
    if constexpr (!ALIGN_EPI) { if (wr == 0) PG8_BAR; }
    PG8_BAR;
    if constexpr (Epi::AFTER_DRAIN) { E.fused(acc, cur, wr, wc, fr, fq, lds, wid, lane); S.done(cur); }
#undef PG8_SA
#undef PG8_SB
#undef PG8_STAGE
#undef PG8_LDA
#undef PG8_LDB
#undef PG8_MMA
#undef PG8_WAIT_V
#undef PG8_WAIT_L
#undef PG8_BAR
#undef PG8_SCHED
}
}

#define LAS __attribute__((address_space(3)))
typedef unsigned short bf16_t;
typedef short bf16x8 __attribute__((ext_vector_type(8)));
typedef float f32x4 __attribute__((ext_vector_type(4)));
typedef float f32x2 __attribute__((ext_vector_type(2)));
typedef unsigned u32x4 __attribute__((ext_vector_type(4)));
typedef unsigned u32x2 __attribute__((ext_vector_type(2)));

constexpr int T = 16384, D = 1024, FF = 2816;
constexpr int P0LD = 3328, P1LD = 2880;
constexpr int C_Q = 0, C_K = 512, C_V = 1024, C_G = 1536, C_Z = 2048, C_XBC = 2560;
constexpr size_t MiB = 1u << 20;
constexpr size_t WS_SSQ = 247 * MiB, WS_DT = 512 * 1024, WS_LRUC = 1 * MiB, WS_CHD = 2 * MiB + 512 * 1024, WS_SMALLW = 3 * MiB;
constexpr size_t WS_WGU1 = 4 * MiB, WS_WD1 = 15 * MiB, WS_WIN = 21 * MiB, WS_WOUT = 28 * MiB, WS_WGU2 = 30 * MiB, WS_WD2 = 41 * MiB;
constexpr size_t WS_XB = 47 * MiB, WS_Y = 79 * MiB, WS_HP = 111 * MiB, WS_ST = 215 * MiB, WS_END = 255 * MiB;
constexpr int LDS_BYTES = 163840;

typedef float f32x2_t __attribute__((ext_vector_type(2)));
typedef __bf16 bf16x2_t __attribute__((ext_vector_type(2)));
__device__ __forceinline__ unsigned pk2(float lo, float hi) { f32x2_t v = {lo, hi}; bf16x2_t b = __builtin_convertvector(v, bf16x2_t); return __builtin_bit_cast(unsigned, b); }
__device__ __forceinline__ unsigned short f2bf(float f) { return (unsigned short)(pk2(f, 0.f) & 0xffffu); }
__device__ __forceinline__ float bflo(unsigned w) { return __uint_as_float(w << 16); }
__device__ __forceinline__ float bfhi(unsigned w) { return __uint_as_float(w & 0xffff0000u); }
__device__ __forceinline__ float bf2f(unsigned short h) { return __uint_as_float(((unsigned)h) << 16); }
__device__ __forceinline__ float frcp(float x) { return __builtin_amdgcn_rcpf(x); }
__device__ __forceinline__ float sigmoidf_(float x) { return frcp(1.f + __expf(-x)); }
__device__ __forceinline__ float siluf_(float x) { return x * frcp(1.f + __expf(-x)); }
__device__ __forceinline__ float softplusf_(float x) { return x > 20.f ? x : log1pf(__expf(x)); }
__device__ __forceinline__ float wave_sum(float v) {
#pragma unroll
    for (int o = 1; o < 64; o <<= 1) v += __shfl_xor(v, o);
    return v;
}
__device__ __forceinline__ f32x4 mma(f32x4 acc, bf16x8 nfrag, bf16x8 mfrag) { return __builtin_amdgcn_mfma_f32_16x16x32_bf16(nfrag, mfrag, acc, 0, 0, 0); }
__device__ __forceinline__ bf16x8 ldf(const LAS bf16_t* base, int stride, int row0, int k0, int lane) { return *(const LAS bf16x8*)(base + (row0 + (lane & 15)) * stride + k0 + 8 * (lane >> 4)); }
__device__ __forceinline__ bf16x8 ldfg(const bf16_t* base, int stride, int row0, int k0, int lane) { return *(const bf16x8*)(base + (size_t)(row0 + (lane & 15)) * stride + k0 + 8 * (lane >> 4)); }
#define F4Z ((f32x4){0.f, 0.f, 0.f, 0.f})
__device__ __forceinline__ float ssq_row(const float* ssq, int row) {
    float s = 0.f;
#pragma unroll
    for (int k = 0; k < 16; ++k) s += ssq[(size_t)k * T + row];
    return s;
}

struct Ctx {
    const float* const* in; float* X; unsigned char* ws; LAS unsigned char* lds;
    int tid, lane, wave, G, bid;
};

__device__ __forceinline__ void tr_item(const float* W, int K, int N, bf16_t* WT, const float* gain, int k0, int n0, int drow0, LAS float* scr, int lane) {
    const int nn = n0 + (lane & 31);
#pragma unroll 8
    for (int i = 0; i < 32; ++i) { const int kk = 2 * i + (lane >> 5); float v = (nn < N) ? W[(size_t)(k0 + kk) * N + nn] : 0.f; if (gain) v *= gain[k0 + kk]; scr[kk * 33 + (lane & 31)] = v; }
    asm volatile("s_waitcnt lgkmcnt(0)" ::: "memory");
    const int c = lane & 7;
#pragma unroll
    for (int j = 0; j < 4; ++j) { const int n = (lane >> 3) + 8 * j; const LAS float* s = scr + (8 * c) * 33 + n;
        u32x4 o; o.x = pk2(s[0 * 33], s[1 * 33]); o.y = pk2(s[2 * 33], s[3 * 33]); o.z = pk2(s[4 * 33], s[5 * 33]); o.w = pk2(s[6 * 33], s[7 * 33]);
        if (n0 + n < N) *(u32x4*)(WT + (size_t)(drow0 + n) * K + k0 + 8 * c) = o; }
    asm volatile("s_waitcnt lgkmcnt(0)" ::: "memory");
}
__device__ __forceinline__ void tr_matrix(const Ctx& C, const float* W, int K, int N, bf16_t* WT, const float* gain, int mode, int& base) {
    LAS float* scr = (LAS float*)(C.lds + C.wave * 8448);
    const int nblk = (N + 31) / 32, nitems = (K / 64) * nblk, gw = C.bid * 8 + C.wave, ngw = C.G * 8;
    int first = (gw - (base % ngw) + ngw) % ngw;
    for (int it = first; it < nitems; it += ngw) {
        const int kb = it / nblk, nb = it % nblk, n0 = 32 * nb;
        const int drow0 = mode == 0 ? n0 : ((n0 >> 7) * 256 + (n0 & 127) + (mode == 2 ? 128 : 0));
        tr_item(W, K, N, WT, gain, 64 * kb, n0, drow0, scr, C.lane);
    }
    base += nitems;
}
__device__ __forceinline__ void convert_weights(const Ctx& C, int layer, int which) {
    int base = 0; unsigned char* ws = C.ws;
    if (which & 1) {
        tr_matrix(C, C.in[2] + (size_t)layer * D * FF, D, FF, (bf16_t*)(ws + WS_WGU1), C.in[1] + layer * D, 1, base);
        tr_matrix(C, C.in[3] + (size_t)layer * D * FF, D, FF, (bf16_t*)(ws + WS_WGU1), C.in[1] + layer * D, 2, base);
        tr_matrix(C, C.in[4] + (size_t)layer * D * FF, FF, D, (bf16_t*)(ws + WS_WD1), nullptr, 0, base);
    }
    if (which & 2) {
        if (layer == 0) { tr_matrix(C, C.in[10], D, 3336, (bf16_t*)(ws + WS_WIN), C.in[5], 0, base); tr_matrix(C, C.in[11], D, D, (bf16_t*)(ws + WS_WOUT), nullptr, 0, base); }
        else            { tr_matrix(C, C.in[18], D, 2848, (bf16_t*)(ws + WS_WIN), C.in[5] + D, 0, base); tr_matrix(C, C.in[19], D, D, (bf16_t*)(ws + WS_WOUT), nullptr, 0, base); }
    }
    if (which & 4) {
        tr_matrix(C, C.in[7] + (size_t)layer * D * FF, D, FF, (bf16_t*)(ws + WS_WGU2), C.in[6] + layer * D, 1, base);
        tr_matrix(C, C.in[8] + (size_t)layer * D * FF, D, FF, (bf16_t*)(ws + WS_WGU2), C.in[6] + layer * D, 2, base);
        tr_matrix(C, C.in[9] + (size_t)layer * D * FF, FF, D, (bf16_t*)(ws + WS_WD2), nullptr, 0, base);
    }
}
__device__ __forceinline__ void tr_small(const Ctx& C, const float* W, int K, int N, bf16_t* WT) {
    for (int idx = C.bid * 512 + C.tid; idx < K * N; idx += C.G * 512) { const int n = idx / K, k = idx % K; WT[idx] = f2bf(W[(size_t)k * N + n]); }
}

struct EpiSwiglu {
    static constexpr bool PERM = true, AFTER_DRAIN = false;
    bf16_t* H; const float* ssq;
    __device__ __forceinline__ void operator()(const f32x4 (&acc)[2][2][4][2], const pg8::Unit& u, int wr, int wc, int fr, int fq) const {
        const int row0 = u.pm * 256 + wr * 64 + fr, col0 = u.pn * 128 + wc * 32 + 8 * fq;
#pragma unroll
        for (int ai = 0; ai < 2; ++ai)
#pragma unroll
            for (int m = 0; m < 4; ++m) {
                const int row = row0 + ai * 128 + m * 16; const float r = rsqrtf(ssq_row(ssq, row) * (1.f / D) + 1e-6f);
                float h[8];
#pragma unroll
                for (int n = 0; n < 2; ++n)
#pragma unroll
                    for (int v = 0; v < 4; ++v) { const float g = acc[ai][0][m][n][v] * r, up = acc[ai][1][m][n][v] * r; h[4 * n + v] = siluf_(g) * up; }
                u32x4 w; w.x = pk2(h[0], h[1]); w.y = pk2(h[2], h[3]); w.z = pk2(h[4], h[5]); w.w = pk2(h[6], h[7]);
                *(u32x4*)(H + (size_t)row * FF + col0) = w;
            }
    }
};
struct EpiResid {
    static constexpr bool PERM = false, AFTER_DRAIN = false;
    float* X; bf16_t* XB; float* ssq_out; float alpha;
    __device__ __forceinline__ void operator()(const f32x4 (&acc)[2][2][4][2], const pg8::Unit& u, int wr, int wc, int fr, int fq) const {
        const int row0 = u.pm * 256 + wr * 64 + fr, col0 = u.pn * 256 + wc * 32 + 4 * fq;
#pragma unroll
        for (int ai = 0; ai < 2; ++ai)
#pragma unroll
            for (int m = 0; m < 4; ++m) {
                const int row = row0 + ai * 128 + m * 16; float s = 0.f;
#pragma unroll
                for (int bj = 0; bj < 2; ++bj)
#pragma unroll
                    for (int n = 0; n < 2; ++n) {
                        const size_t off = (size_t)row * D + col0 + bj * 128 + n * 16;
                        f32x4 x = *(const f32x4*)(X + off); x = x + acc[ai][bj][m][n] * alpha;
                        *(f32x4*)(X + off) = x; u32x2 b; b.x = pk2(x[0], x[1]); b.y = pk2(x[2], x[3]); *(u32x2*)(XB + off) = b;
                        s += (x[0] * x[0] + x[1] * x[1]) + (x[2] * x[2] + x[3] * x[3]);
                    }
                s += __shfl_xor(s, 16); s += __shfl_xor(s, 32);
                if (fq == 0) ssq_out[(size_t)(u.pn * 4 + wc) * T + row] = s;
            }
    }
};
struct EpiProj {
    static constexpr bool PERM = true, AFTER_DRAIN = false;
    bf16_t* P; int ldp, ncols; const float* ssq; float* DT; int dt_col0;
    __device__ __forceinline__ void operator()(const f32x4 (&acc)[2][2][4][2], const pg8::Unit& u, int wr, int wc, int fr, int fq) const {
        const int row0 = u.pm * 256 + wr * 64 + fr, col0 = u.pn * 256 + wc * 32 + 8 * fq;
#pragma unroll
        for (int ai = 0; ai < 2; ++ai)
#pragma unroll
            for (int m = 0; m < 4; ++m) {
                const int row = row0 + ai * 128 + m * 16; const float r = rsqrtf(ssq_row(ssq, row) * (1.f / D) + 1e-6f);
#pragma unroll
                for (int bj = 0; bj < 2; ++bj) {
                    const int c = col0 + bj * 128; const f32x4 v0 = acc[ai][bj][m][0] * r, v1 = acc[ai][bj][m][1] * r;
                    if (c + 8 <= ncols) { u32x4 w; w.x = pk2(v0[0], v0[1]); w.y = pk2(v0[2], v0[3]); w.z = pk2(v1[0], v1[1]); w.w = pk2(v1[2], v1[3]); *(u32x4*)(P + (size_t)row * ldp + c) = w; }
                    else if (DT && c == dt_col0) { *(f32x4*)(DT + (size_t)row * 8) = v0; *(f32x4*)(DT + (size_t)row * 8 + 4) = v1; }
                }
            }
    }
};

__device__ __forceinline__ void prologue_x(const Ctx& C) {
    const float* x = C.in[0]; bf16_t* XB = (bf16_t*)(C.ws + WS_XB); float* ssq = (float*)(C.ws + WS_SSQ);
    const int gw = C.bid * 8 + C.wave, ngw = C.G * 8;
    for (int m = gw; m < T; m += ngw) {
        const f32x4* xr = (const f32x4*)(x + (size_t)m * D) + C.lane; f32x4* orow = (f32x4*)(C.X + (size_t)m * D) + C.lane; u32x2* brow = (u32x2*)(XB + (size_t)m * D) + C.lane;
        float s = 0.f;
#pragma unroll
        for (int j = 0; j < 4; ++j) { const f32x4 v = xr[64 * j]; orow[64 * j] = v; u32x2 b; b.x = pk2(v[0], v[1]); b.y = pk2(v[2], v[3]); brow[64 * j] = b; s += (v[0] * v[0] + v[1] * v[1]) + (v[2] * v[2] + v[3] * v[3]); }
        s = wave_sum(s);
        if (C.lane == 0) ssq[m] = s;
    }
    for (int i = C.bid * 512 + C.tid; i < 15 * T; i += C.G * 512) ssq[T + i] = 0.f;
}
__device__ __forceinline__ void final_norm(const Ctx& C) {
    const float* ssq = (const float*)(C.ws + WS_SSQ) + (size_t)6 * T * 16; const float* g = C.in[38];
    const int gw = C.bid * 8 + C.wave, ngw = C.G * 8;
    f32x4 gv[4];
#pragma unroll
    for (int j = 0; j < 4; ++j) gv[j] = ((const f32x4*)g)[C.lane + 64 * j];
    for (int m = gw; m < T; m += ngw) {
        f32x4* xr = (f32x4*)(C.X + (size_t)m * D) + C.lane; const float r = rsqrtf(ssq_row(ssq, m) * (1.f / D) + 1e-6f);
#pragma unroll
        for (int j = 0; j < 4; ++j) { f32x4 v = xr[64 * j]; v = v * r * gv[j];
#ifdef SANITIZE
#pragma unroll
            for (int q = 0; q < 4; ++q) v[q] = (fabsf(v[q]) < 1e30f) ? v[q] : 0.f;
#endif
            xr[64 * j] = v; }
    }
}

__device__ __forceinline__ float ret_log_gamma(int h) { return logf(1.f - exp2f(-5.f - (float)h)); }

template <bool TR>
__device__ __forceinline__ void stage_rot(const bf16_t* P, int t0, int col0, LAS bf16_t* dst, int stride, float scale, float lg, bool kte, int nrows, int tl, int nth) {
    for (int it = tl; it < nrows * 8; it += nth) {
        const int row = it >> 3, d0 = (it & 7) * 8, t = t0 + row;
        const bf16_t* src = P + (size_t)t * P0LD + col0 + d0;
        const u32x4 a = *(const u32x4*)src, b = *(const u32x4*)(src + 64);
        const float rs = scale * (kte ? __expf(lg * (float)(127 - row)) : 1.f);
        float o1[8], o2[8];
#pragma unroll
        for (int i = 0; i < 8; ++i) {
            const unsigned wa = a[i >> 1], wb = b[i >> 1];
            const float x1 = (i & 1) ? bfhi(wa) : bflo(wa), x2 = (i & 1) ? bfhi(wb) : bflo(wb);
            const float invf = exp2f(-(float)(d0 + i) * (13.287712379549449f / 64.f));
            const float ang = (float)t * invf, n = rintf(ang * 0.15915494309189535f);
            float r = fmaf(-n, 6.2831854820251465f, ang); r = fmaf(-n, -1.7484556e-7f, r);
            const float s = __sinf(r), c = __cosf(r);
            o1[i] = (x1 * c - x2 * s) * rs; o2[i] = (x2 * c + x1 * s) * rs;
        }
        if (TR) {
#pragma unroll
            for (int i = 0; i < 8; ++i) { dst[(d0 + i) * stride + row] = f2bf(o1[i]); dst[(64 + d0 + i) * stride + row] = f2bf(o2[i]); }
        } else {
            u32x4 w1, w2; w1.x = pk2(o1[0], o1[1]); w1.y = pk2(o1[2], o1[3]); w1.z = pk2(o1[4], o1[5]); w1.w = pk2(o1[6], o1[7]);
            w2.x = pk2(o2[0], o2[1]); w2.y = pk2(o2[2], o2[3]); w2.z = pk2(o2[4], o2[5]); w2.w = pk2(o2[6], o2[7]);
            *(LAS u32x4*)(dst + row * stride + d0) = w1; *(LAS u32x4*)(dst + row * stride + 64 + d0) = w2;
        }
    }
}
__device__ __forceinline__ void stage_vT(const bf16_t* P, int t0, int col0, LAS bf16_t* dst, int stride, int tid) {
    for (int it = tid; it < 128 * 16; it += 512) {
        const int row = it >> 4, e0 = (it & 15) * 8;
        const u32x4 a = *(const u32x4*)(P + (size_t)(t0 + row) * P0LD + col0 + e0);
#pragma unroll
        for (int i = 0; i < 8; ++i) { const unsigned w = a[i >> 1]; dst[(e0 + i) * stride + row] = (unsigned short)((i & 1) ? (w >> 16) : (w & 0xffffu)); }
    }
}

__device__ __forceinline__ void stage_dt(const Ctx& C, int t0, int g, LAS float* DTS, LAS float* AS, LAS float* ACS) {
    const int l = C.tid & 127, hh = C.tid >> 7, h = 4 * g + hh;
    const float* DT = (const float*)(C.ws + WS_DT);
    const float dtv = softplusf_(DT[(size_t)(t0 + l) * 8 + h] + C.in[14][h]);
    DTS[hh * 128 + l] = dtv; AS[hh * 128 + l] = -dtv * __expf(C.in[15][h]);
    __syncthreads();
    float s = 0.f;
    for (int i = 0; i <= l; ++i) s += AS[hh * 128 + i];
    ACS[hh * 128 + l] = s;
    __syncthreads();
}

template <int NGRP, int MODE>
__device__ __forceinline__ void stage_conv(const Ctx& C, int t0, int g, LAS bf16_t* XT, LAS bf16_t* BB, LAS bf16_t* CC, const LAS float* DTS, const LAS float* ACS) {
    constexpr int NSEG = 512 / NGRP, RP = (128 + NSEG - 1) / NSEG;
    if (C.tid >= NGRP * NSEG) return;
    const bf16_t* P = (const bf16_t*)(C.ws + WS_HP);
    const int grp = C.tid % NGRP, seg = C.tid / NGRP;
    const int ch0 = grp < 32 ? 256 * g + 8 * grp : (grp < 40 ? 512 + 64 * g + 8 * (grp - 32) : 640 + 64 * g + 8 * (grp - 40));
    const float* cw = C.in[12]; const float* cb = C.in[13];
    float w0[8], w1[8], w2[8], w3[8], bb[8], x0[8], x1[8], x2[8];
#pragma unroll
    for (int i = 0; i < 8; ++i) { w0[i] = cw[ch0 + i]; w1[i] = cw[768 + ch0 + i]; w2[i] = cw[1536 + ch0 + i]; w3[i] = cw[2304 + ch0 + i]; bb[i] = cb[ch0 + i]; }
    const int r0 = seg * RP, r1 = (r0 + RP < 128) ? r0 + RP : 128;
    auto ldrow = [&](int t, float (&x)[8]) {
        if (t < 0) {
#pragma unroll
            for (int i = 0; i < 8; ++i) x[i] = 0.f;
        } else {
            const u32x4 a = *(const u32x4*)(P + (size_t)t * P0LD + C_XBC + ch0);
#pragma unroll
            for (int i = 0; i < 4; ++i) { x[2 * i] = bflo(a[i]); x[2 * i + 1] = bfhi(a[i]); }
        }
    };
    ldrow(t0 + r0 - 3, x0); ldrow(t0 + r0 - 2, x1); ldrow(t0 + r0 - 1, x2);
    for (int row = r0; row < r1; ++row) {
        float x3[8], v[8]; ldrow(t0 + row, x3);
#pragma unroll
        for (int i = 0; i < 8; ++i) { float s = bb[i] + w0[i] * x0[i] + w1[i] * x1[i] + w2[i] * x2[i] + w3[i] * x3[i]; v[i] = siluf_(s); x0[i] = x1[i]; x1[i] = x2[i]; x2[i] = x3[i]; }
        if (grp < 32) {
            const int hh = grp >> 3;
            float sc = DTS[hh * 128 + row]; if (MODE == 0) sc *= __expf(ACS[hh * 128 + 127] - ACS[hh * 128 + row]);
#pragma unroll
            for (int i = 0; i < 8; ++i) XT[(8 * grp + i) * 136 + row] = f2bf(v[i] * sc);
        } else if (MODE == 0) {
#pragma unroll
            for (int i = 0; i < 8; ++i) BB[(8 * (grp - 32) + i) * 136 + row] = f2bf(v[i]);
        } else {
            u32x4 w; w.x = pk2(v[0], v[1]); w.y = pk2(v[2], v[3]); w.z = pk2(v[4], v[5]); w.w = pk2(v[6], v[7]);
            if (grp < 40) *(LAS u32x4*)(BB + row * 72 + 8 * (grp - 32)) = w; else *(LAS u32x4*)(CC + row * 72 + 8 * (grp - 40)) = w;
        }
    }
}

__device__ __forceinline__ void ret_state_unit(const Ctx& C, int c, int h) {
    const bf16_t* P = (const bf16_t*)(C.ws + WS_HP); float* SR = (float*)(C.ws + WS_ST);
    LAS bf16_t* KT = (LAS bf16_t*)C.lds; LAS bf16_t* VT = KT + 128 * 136;
    const int t0 = c * 128, lane = C.lane, fr = lane & 15, fq = lane >> 4;
    stage_rot<true>(P, t0, C_K + h * 128, KT, 136, 0.08838834764831845f, ret_log_gamma(h), true, 128, C.tid, 512);
    stage_vT(P, t0, C_V + h * 128, VT, 136, C.tid);
    __syncthreads();
    const int e0 = 16 * C.wave; bf16x8 mf[4];
#pragma unroll
    for (int k = 0; k < 4; ++k) mf[k] = ldf(VT, 136, e0, 32 * k, lane);
    float* out = SR + ((size_t)(c * 4 + h) * 128 + e0 + fr) * 128 + 4 * fq;
#pragma unroll
    for (int dt = 0; dt < 8; ++dt) { f32x4 acc = F4Z;
#pragma unroll
        for (int k = 0; k < 4; ++k) acc = mma(acc, ldf(KT, 136, 16 * dt, 32 * k, lane), mf[k]);
        *(f32x4*)(out + 16 * dt) = acc; }
    __syncthreads();
}
__device__ __forceinline__ void mamba_state_unit(const Ctx& C, int c, int g) {
    LAS bf16_t* XT = (LAS bf16_t*)C.lds; LAS bf16_t* BT = XT + 256 * 136;
    LAS float* DTS = (LAS float*)(C.lds + 150528); LAS float* ACS = DTS + 512; LAS float* AS = ACS + 512;
    float* SM = (float*)(C.ws + WS_XB); float* CHD = (float*)(C.ws + WS_CHD);
    const int t0 = c * 128, lane = C.lane, fr = lane & 15, fq = lane >> 4;
    stage_dt(C, t0, g, DTS, AS, ACS);
    stage_conv<40, 0>(C, t0, g, XT, BT, nullptr, DTS, ACS);
    if (C.tid < 4) CHD[(c * 2 + g) * 32 + C.tid] = __expf(ACS[C.tid * 128 + 127]);
    __syncthreads();
    const int hh = C.wave >> 1, ph = C.wave & 1;
#pragma unroll
    for (int pt = 0; pt < 2; ++pt) {
        const int p0 = ph * 32 + 16 * pt; bf16x8 mf[4];
#pragma unroll
        for (int k = 0; k < 4; ++k) mf[k] = ldf(XT, 136, hh * 64 + p0, 32 * k, lane);
        float* out = SM + ((size_t)(c * 8 + 4 * g + hh) * 64 + p0 + fr) * 64 + 4 * fq;
#pragma unroll
        for (int nt = 0; nt < 4; ++nt) { f32x4 acc = F4Z;
#pragma unroll
            for (int k = 0; k < 4; ++k) acc = mma(acc, ldf(BT, 136, 16 * nt, 32 * k, lane), mf[k]);
            *(f32x4*)(out + 16 * nt) = acc; }
    }
    __syncthreads();
}
__device__ __forceinline__ void l0_states(const Ctx& C) {
    for (int u = C.bid; u < 256; u += C.G) mamba_state_unit(C, u >> 1, u & 1);
    for (int u = C.bid; u < 512; u += C.G) ret_state_unit(C, u >> 2, u & 3);
}

__device__ __forceinline__ void l0_scan(const Ctx& C) {
    float* SR = (float*)(C.ws + WS_ST); float* SM = (float*)(C.ws + WS_XB); const float* CHD = (const float*)(C.ws + WS_CHD);
    for (int idx = C.bid * 512 + C.tid; idx < 65536 + 32768; idx += C.G * 512) {
        if (idx < 65536) {
            const float dec = __expf(128.f * ret_log_gamma(idx >> 14)); float s = 0.f; float* p = SR + idx;
            for (int c0 = 0; c0 < 128; c0 += 8) { float kv[8];
#pragma unroll
                for (int j = 0; j < 8; ++j) kv[j] = p[(size_t)(c0 + j) * 65536];
#pragma unroll
                for (int j = 0; j < 8; ++j) { p[(size_t)(c0 + j) * 65536] = s; s = s * dec + kv[j]; } }
        } else {
            const int e = idx - 65536, head = e >> 12; float s = 0.f; float* p = SM + e;
            for (int c0 = 0; c0 < 128; c0 += 8) { float kv[8], dc[8];
#pragma unroll
                for (int j = 0; j < 8; ++j) { kv[j] = p[(size_t)(c0 + j) * 32768]; dc[j] = CHD[((c0 + j) * 2 + (head >> 2)) * 32 + (head & 3)]; }
#pragma unroll
                for (int j = 0; j < 8; ++j) { p[(size_t)(c0 + j) * 32768] = s; s = s * dc[j] + kv[j]; } }
        }
    }
}

__device__ __forceinline__ void mamba_out_unit(const Ctx& C, int c, int g) {
    LAS bf16_t* XT = (LAS bf16_t*)C.lds; LAS bf16_t* BM = (LAS bf16_t*)(C.lds + 69632); LAS bf16_t* CM = (LAS bf16_t*)(C.lds + 88064);
    LAS bf16_t* SP = (LAS bf16_t*)(C.lds + 106496); LAS bf16_t* STR = (LAS bf16_t*)(C.lds + 115712) + C.wave * (16 * 136);
    LAS float* DTS = (LAS float*)(C.lds + 150528); LAS float* ACS = DTS + 512; LAS float* AS = ACS + 512;
    const bf16_t* P = (const bf16_t*)(C.ws + WS_HP); const float* SM = (const float*)(C.ws + WS_XB); bf16_t* Y = (bf16_t*)(C.ws + WS_Y);
    const int t0 = c * 128, lane = C.lane, fr = lane & 15, fq = lane >> 4, w = C.wave, l0 = 16 * w, l = l0 + fr;
    stage_dt(C, t0, g, DTS, AS, ACS);
    stage_conv<48, 1>(C, t0, g, XT, BM, CM, DTS, ACS);
    __syncthreads();
    bf16x8 cmA[2]; cmA[0] = ldf(CM, 72, l0, 0, lane); cmA[1] = ldf(CM, 72, l0, 32, lane);
    f32x4 cb[8];
#pragma unroll
    for (int st = 0; st < 8; ++st) { cb[st] = F4Z; if (st <= w) { cb[st] = mma(cb[st], ldf(BM, 72, 16 * st, 0, lane), cmA[0]); cb[st] = mma(cb[st], ldf(BM, 72, 16 * st, 32, lane), cmA[1]); } }
    float ssq = 0.f;
#pragma unroll 1
    for (int hh = 0; hh < 4; ++hh) {
        const int h = 4 * g + hh;
        __syncthreads();
        {
            const float* src = SM + (size_t)(c * 8 + h) * 4096;
#pragma unroll
            for (int i = 0; i < 2; ++i) { const int e = (C.tid + 512 * i) * 4; const f32x4 v = *(const f32x4*)(src + e); u32x2 b; b.x = pk2(v[0], v[1]); b.y = pk2(v[2], v[3]); *(LAS u32x2*)(SP + (e >> 6) * 72 + (e & 63)) = b; }
        }
        const float al = ACS[hh * 128 + l];
#pragma unroll
        for (int st = 0; st < 8; ++st) {
            const f32x4 as4 = *(const LAS f32x4*)(ACS + hh * 128 + 16 * st + 4 * fq); float sc[4];
#pragma unroll
            for (int v = 0; v < 4; ++v) { const int s = 16 * st + 4 * fq + v; sc[v] = (st <= w && s <= l) ? cb[st][v] * __expf(al - as4[v]) : 0.f; }
            u32x2 b; b.x = pk2(sc[0], sc[1]); b.y = pk2(sc[2], sc[3]); *(LAS u32x2*)(STR + fr * 136 + 16 * st + 4 * fq) = b;
        }
        __syncthreads();
        bf16x8 sA[4];
#pragma unroll
        for (int k = 0; k < 4; ++k) sA[k] = ldf(STR, 136, 0, 32 * k, lane);
        const float eal = __expf(al), dsk = C.in[16][h], rdt = frcp(DTS[hh * 128 + l]);
#pragma unroll
        for (int pt = 0; pt < 4; ++pt) {
            f32x4 ya = F4Z, yo = F4Z;
#pragma unroll
            for (int k = 0; k < 4; ++k) ya = mma(ya, ldf(XT, 136, hh * 64 + 16 * pt, 32 * k, lane), sA[k]);
#pragma unroll
            for (int k = 0; k < 2; ++k) yo = mma(yo, ldf(SP, 72, 16 * pt, 32 * k, lane), cmA[k]);
            const int p = 16 * pt + 4 * fq;
            const u32x2 zz = *(const u32x2*)(P + (size_t)(t0 + l) * P0LD + C_Z + 256 * g + hh * 64 + p);
            const float z[4] = {bflo(zz.x), bfhi(zz.x), bflo(zz.y), bfhi(zz.y)};
            float y[4];
#pragma unroll
            for (int v = 0; v < 4; ++v) {
                const float xs = bf2f(XT[(hh * 64 + p + v) * 136 + l]) * rdt;
                y[v] = (ya[v] + yo[v] * eal + dsk * xs) * siluf_(z[v]); ssq += y[v] * y[v];
            }
            u32x2 b; b.x = pk2(y[0], y[1]); b.y = pk2(y[2], y[3]);
            *(u32x2*)(Y + (size_t)(t0 + l) * D + 512 + 256 * g + hh * 64 + p) = b;
        }
    }
    ssq += __shfl_xor(ssq, 16); ssq += __shfl_xor(ssq, 32);
    const float rinv = rsqrtf(ssq * (1.f / 256.f) + 1e-5f);
#pragma unroll 4
    for (int q = 0; q < 16; ++q) {
        const int ch = 256 * g + 16 * q + 4 * fq; const f32x4 ng = *(const f32x4*)(C.in[17] + ch);
        u32x2* yp = (u32x2*)(Y + (size_t)(t0 + l) * D + 512 + ch); const u32x2 yy = *yp;
        u32x2 b; b.x = pk2(bflo(yy.x) * rinv * ng[0], bfhi(yy.x) * rinv * ng[1]); b.y = pk2(bflo(yy.y) * rinv * ng[2], bfhi(yy.y) * rinv * ng[3]);
        *yp = b;
    }
    __syncthreads();
}
__device__ __forceinline__ void ret_out_unit(const Ctx& C, int c, int h) {
    LAS bf16_t* KN = (LAS bf16_t*)C.lds; LAS bf16_t* VT = KN + 128 * 136; LAS bf16_t* ST = VT + 128 * 136; LAS bf16_t* STR = ST + 128 * 136 + C.wave * (16 * 136);
    const bf16_t* P = (const bf16_t*)(C.ws + WS_HP); const float* SR = (const float*)(C.ws + WS_ST); bf16_t* Y = (bf16_t*)(C.ws + WS_Y);
    const int t0 = c * 128, lane = C.lane, fr = lane & 15, fq = lane >> 4, w = C.wave, i0 = 16 * w, ii = i0 + fr;
    const float lg = ret_log_gamma(h);
    stage_rot<false>(P, t0, C_K + h * 128, KN, 136, 0.08838834764831845f, 0.f, false, 128, C.tid, 512);
    stage_vT(P, t0, C_V + h * 128, VT, 136, C.tid);
    {
        const float* src = SR + (size_t)(c * 4 + h) * 16384;
#pragma unroll
        for (int i = 0; i < 8; ++i) { const int e = (C.tid + 512 * i) * 4; const f32x4 v = *(const f32x4*)(src + e); u32x2 b; b.x = pk2(v[0], v[1]); b.y = pk2(v[2], v[3]); *(LAS u32x2*)(ST + (e >> 7) * 136 + (e & 127)) = b; }
    }
    stage_rot<false>(P, t0 + i0, C_Q + h * 128, STR, 136, 1.f, 0.f, false, 16, lane, 64);
    __syncthreads();
    bf16x8 qA[4];
#pragma unroll
    for (int k = 0; k < 4; ++k) qA[k] = ldf(STR, 136, 0, 32 * k, lane);
    __syncthreads();
#pragma unroll
    for (int jt = 0; jt < 8; ++jt) {
        f32x4 sa = F4Z;
        if (jt <= w) {
#pragma unroll
            for (int k = 0; k < 4; ++k) sa = mma(sa, ldf(KN, 136, 16 * jt, 32 * k, lane), qA[k]);
        }
        float sc[4];
#pragma unroll
        for (int v = 0; v < 4; ++v) { const int j = 16 * jt + 4 * fq + v; sc[v] = (jt <= w && j <= ii) ? sa[v] * __expf(lg * (float)(ii - j)) : 0.f; }
        u32x2 b; b.x = pk2(sc[0], sc[1]); b.y = pk2(sc[2], sc[3]); *(LAS u32x2*)(STR + fr * 136 + 16 * jt + 4 * fq) = b;
    }
    __syncthreads();
    bf16x8 sA[4];
#pragma unroll
    for (int k = 0; k < 4; ++k) sA[k] = ldf(STR, 136, 0, 32 * k, lane);
    const float qfs = __expf(lg * (float)(ii + 1));
    f32x4 o[8]; float ssq = 0.f;
#pragma unroll
    for (int et = 0; et < 8; ++et) {
        f32x4 a = F4Z, a2 = F4Z;
#pragma unroll
        for (int k = 0; k < 4; ++k) { a = mma(a, ldf(VT, 136, 16 * et, 32 * k, lane), sA[k]); a2 = mma(a2, ldf(ST, 136, 16 * et, 32 * k, lane), qA[k]); }
        o[et] = a + a2 * qfs;
        ssq += (o[et][0] * o[et][0] + o[et][1] * o[et][1]) + (o[et][2] * o[et][2] + o[et][3] * o[et][3]);
    }
    ssq += __shfl_xor(ssq, 16); ssq += __shfl_xor(ssq, 32);
    const float rinv = rsqrtf(ssq * (1.f / 128.f) + 1e-6f);
#pragma unroll
    for (int et = 0; et < 8; ++et) {
        const int ch = h * 128 + 16 * et + 4 * fq;
        const u32x2 gg = *(const u32x2*)(P + (size_t)(t0 + ii) * P0LD + C_G + ch);
        u32x2 b; b.x = pk2(o[et][0] * rinv * siluf_(bflo(gg.x)), o[et][1] * rinv * siluf_(bfhi(gg.x))); b.y = pk2(o[et][2] * rinv * siluf_(bflo(gg.y)), o[et][3] * rinv * siluf_(bfhi(gg.y)));
        *(u32x2*)(Y + (size_t)(t0 + ii) * D + ch) = b;
    }
    __syncthreads();
}
__device__ __forceinline__ void l0_output(const Ctx& C) {
    for (int u = C.bid; u < 256; u += C.G) mamba_out_unit(C, u >> 1, u & 1);
    for (int u = C.bid; u < 512; u += C.G) ret_out_unit(C, u >> 2, u & 3);
}

constexpr size_t WS_WLOG = WS_ST, WS_AA = WS_ST + 16 * MiB, WS_GG = WS_WGU1, WS_PC = WS_Y, WS_UC = WS_XB;
constexpr size_t WS_LA = WS_LRUC, WS_HC = WS_LRUC + 512 * 1024, WS_HIN = WS_LRUC + 1024 * 1024;
constexpr int SW_WAT = 0, SW_WXT = 65536, SW_W2T = 131072, SW_A2T = 163840, SW_G2T = 196608;
__device__ __forceinline__ bf16_t* gg_row(unsigned char* ws, int t) { return (bf16_t*)(ws + WS_GG) + (size_t)t * 512; }
__device__ __forceinline__ float tanhf_(float x) { return 1.f - 2.f * frcp(1.f + __expf(2.f * x)); }

__device__ __forceinline__ void rwkv_prep(const Ctx& C, int c) {
    const bf16_t* P = (const bf16_t*)(C.ws + WS_HP); const bf16_t* SW = (const bf16_t*)(C.ws + WS_SMALLW);
    bf16_t* WLOG = (bf16_t*)(C.ws + WS_WLOG); bf16_t* AA = (bf16_t*)(C.ws + WS_AA);
    LAS bf16_t* TW = (LAS bf16_t*)C.lds; LAS bf16_t* AL = TW + 64 * 72; LAS bf16_t* SG = AL + 64 * 72;
    const float* mu = C.in[27];
    const int t0 = 64 * c, lane = C.lane, fr = lane & 15, fq = lane >> 4;
    for (int idx = C.tid; idx < 64 * 288; idx += 512) {
        const int tok = idx / 288, cc = idx % 288, col = 2560 + cc, t = t0 + tok;
        const float cur = bf2f(P[(size_t)t * P1LD + col]), prev = t > 0 ? bf2f(P[(size_t)(t - 1) * P1LD + col]) : 0.f;
        const float s = cur + (prev - cur) * mu[col - 1024];
        if (cc < 64) TW[tok * 72 + cc] = f2bf(tanhf_(s)); else if (cc < 128) AL[tok * 72 + cc - 64] = f2bf(s); else SG[tok * 168 + cc - 128] = f2bf(sigmoidf_(s));
    }
    __syncthreads();
    const int n0 = 64 * C.wave;
#pragma unroll 1
    for (int which = 0; which < 2; ++which) {
        const bf16_t* BT = SW + (which == 0 ? SW_W2T : SW_A2T); const LAS bf16_t* AM = which == 0 ? TW : AL;
        const float* bias = which == 0 ? C.in[28] : C.in[30]; bf16_t* O = which == 0 ? WLOG : AA;
#pragma unroll 1
        for (int nt = 0; nt < 4; ++nt) {
            const bf16x8 nf0 = ldfg(BT, 64, n0 + 16 * nt, 0, lane), nf1 = ldfg(BT, 64, n0 + 16 * nt, 32, lane);
            const int n = n0 + 16 * nt + 4 * fq; const f32x4 bv = *(const f32x4*)(bias + n);
#pragma unroll
            for (int mt = 0; mt < 4; ++mt) {
                f32x4 acc = F4Z; acc = mma(acc, nf0, ldf(AM, 72, 16 * mt, 0, lane)); acc = mma(acc, nf1, ldf(AM, 72, 16 * mt, 32, lane));
                float o[4];
#pragma unroll
                for (int v = 0; v < 4; ++v) { const float x = acc[v] + bv[v]; o[v] = which == 0 ? -__expf(-softplusf_(-x) - 0.5f) : sigmoidf_(x); }
                u32x2 b; b.x = pk2(o[0], o[1]); b.y = pk2(o[2], o[3]);
                *(u32x2*)(O + (size_t)(t0 + 16 * mt + fr) * 512 + n) = b;
            }
        }
    }
#pragma unroll 1
    for (int nt = 0; nt < 4; ++nt) {
        bf16x8 nf[5];
#pragma unroll
        for (int k = 0; k < 5; ++k) nf[k] = ldfg(SW + SW_G2T, 160, n0 + 16 * nt, 32 * k, lane);
        const int n = n0 + 16 * nt + 4 * fq;
#pragma unroll
        for (int mt = 0; mt < 4; ++mt) {
            f32x4 acc = F4Z;
#pragma unroll
            for (int k = 0; k < 5; ++k) acc = mma(acc, nf[k], ldf(SG, 168, 16 * mt, 32 * k, lane));
#ifdef GG_CONSTVAL
            acc = (f32x4){0.5f, 0.25f, -0.5f, 1.f};
#endif
            u32x2 b; b.x = pk2(acc[0], acc[1]); b.y = pk2(acc[2], acc[3]);
            *(u32x2*)(gg_row(C.ws, t0 + 16 * mt + fr) + n) = b;
        }
    }
    asm volatile("s_waitcnt vmcnt(0)" ::: "memory");
    __threadfence_block();
    __syncthreads();
}

template <int PASS>
__device__ __forceinline__ void rwkv_chunk(const Ctx& C, int c) {
    const bf16_t* P = (const bf16_t*)(C.ws + WS_HP);
    const bf16_t* WLOG = (const bf16_t*)(C.ws + WS_WLOG); const bf16_t* AA = (const bf16_t*)(C.ws + WS_AA);
    float* PC = (float*)(C.ws + WS_PC); float* UC = (float*)(C.ws + WS_UC); bf16_t* Y = (bf16_t*)(C.ws + WS_Y);
    LAS float* VW = (LAS float*)(C.lds + 40960); LAS float* VKK = VW + 4096; LAS float* VB = VKK + 4096; LAS float* VK = VB + 4096; LAS float* VR = VK + 4096; LAS float* VV = VR + 4096; LAS float* VG = VV + 4096; LAS float* VBON = VG + 4096;
    const int t0 = 64 * c, lane = C.lane, head = C.wave, ch = C.tid;
    const float* mu = C.in[27];
    float SU[64], SP[64];
    if (PASS == 1) {
#pragma unroll
        for (int k = 0; k < 64; ++k) { SU[k] = 0.f; SP[k] = (k == lane) ? 1.f : 0.f; }
    } else {
        const f32x4* src = (const f32x4*)(UC + ((size_t)(c * 8 + head) * 64 + lane) * 64);
#pragma unroll
        for (int k4 = 0; k4 < 16; ++k4) { f32x4 v = src[k4];
#ifdef RW3_ZERO
            v = F4Z;
#endif
            SU[4 * k4] = v[0]; SU[4 * k4 + 1] = v[1]; SU[4 * k4 + 2] = v[2]; SU[4 * k4 + 3] = v[3]; }
    }
    float pr = 0.f, pk = 0.f, pv = 0.f;
    if (t0 > 0) { const bf16_t* row = P + (size_t)(t0 - 1) * P1LD; pr = bf2f(row[1024 + ch]); pk = bf2f(row[1536 + ch]); pv = bf2f(row[2048 + ch]); }
#pragma unroll 1
    for (int sb = 0; sb < 8; ++sb) {
        const float mu_r = mu[ch], mu_k = mu[512 + ch], mu_v = mu[1024 + ch], kkc = C.in[33][ch], kac = C.in[34][ch], rkc = C.in[35][ch];
#pragma unroll 2
        for (int j = 0; j < 8; ++j) {
            const int t = t0 + 8 * sb + j; const bf16_t* row = P + (size_t)t * P1LD;
            const float cr = bf2f(row[1024 + ch]), ck = bf2f(row[1536 + ch]), cv = bf2f(row[2048 + ch]);
            const float rs = cr + (pr - cr) * mu_r, ks = ck + (pk - ck) * mu_k, vs = cv + (pv - cv) * mu_v;
            pr = cr; pk = ck; pv = cv;
#if defined(RW3_CONST) || defined(RW3_CONST_AW)
            const float a = 0.5f, wl = -0.05f;
#else
            const float a = bf2f(AA[(size_t)t * 512 + ch]), wl = bf2f(WLOG[(size_t)t * 512 + ch]);
#endif
            const float kkr = ks * kkc, nrm = wave_sum(kkr * kkr), kk = kkr * rsqrtf(fmaxf(nrm, 1e-24f));
            const float kp = ks * (1.f + (a - 1.f) * kac);
            VW[j * 512 + ch] = __expf(wl); VKK[j * 512 + ch] = kk; VB[j * 512 + ch] = kk * a; VK[j * 512 + ch] = kp;
            VV[j * 512 + ch] = vs;
            if (PASS == 3) { VR[j * 512 + ch] = rs; const float bon = wave_sum(rs * kp * rkc); if (lane == 0) VBON[j * 8 + head] = bon;
#if defined(RW3_CONST) || defined(RW3_CONST_G)
                VG[j * 512 + ch] = 1.f; }
#else
                VG[j * 512 + ch] = bf2f(gg_row(C.ws, t)[ch]); }
#endif
        }
        __syncthreads();
#pragma unroll 1
        for (int j = 0; j < 8; ++j) {
            const LAS f32x4* pw = (const LAS f32x4*)(VW + j * 512 + head * 64); const LAS f32x4* pkk = (const LAS f32x4*)(VKK + j * 512 + head * 64);
            const LAS f32x4* pb = (const LAS f32x4*)(VB + j * 512 + head * 64); const LAS f32x4* pkp = (const LAS f32x4*)(VK + j * 512 + head * 64);
            const LAS f32x4* prr = (const LAS f32x4*)(VR + j * 512 + head * 64);
            float skU = 0.f, skP = 0.f;
            {
                f32x4 q = pkk[0];
#pragma unroll
                for (int k4 = 0; k4 < 16; ++k4) {
                    f32x4 qn = q; if (k4 + 1 < 16) qn = pkk[k4 + 1];
#pragma unroll
                    for (int i = 0; i < 4; ++i) { skU = fmaf(SU[4 * k4 + i], q[i], skU); if (PASS == 1) skP = fmaf(SP[4 * k4 + i], q[i], skP); }
                    q = qn;
                    __builtin_amdgcn_sched_barrier(0);
                }
            }
            const float vv = VV[j * 512 + ch]; float y = 0.f;
            {
                f32x4 w4 = pw[0], b4 = pb[0], k4v = pkp[0], r4 = F4Z; if (PASS == 3) r4 = prr[0];
#pragma unroll
                for (int k4 = 0; k4 < 16; ++k4) {
                    f32x4 nw = w4, nb = b4, nk = k4v, nr = r4;
                    if (k4 + 1 < 16) { nw = pw[k4 + 1]; nb = pb[k4 + 1]; nk = pkp[k4 + 1]; if (PASS == 3) nr = prr[k4 + 1]; }
#pragma unroll
                    for (int i = 0; i < 4; ++i) {
                        const float tt = fmaf(-skU, b4[i], vv * k4v[i]); SU[4 * k4 + i] = fmaf(SU[4 * k4 + i], w4[i], tt);
                        if (PASS == 1) SP[4 * k4 + i] = fmaf(SP[4 * k4 + i], w4[i], -skP * b4[i]);
                        if (PASS == 3) y = fmaf(SU[4 * k4 + i], r4[i], y);
                    }
                    w4 = nw; b4 = nb; k4v = nk; r4 = nr;
                    __builtin_amdgcn_sched_barrier(0);
                }
            }
            if (PASS == 3) {
                const float mean = wave_sum(y) * (1.f / 64.f), d = y - mean, var = wave_sum(d * d) * (1.f / 64.f);
                const float yn = d * rsqrtf(var + 64e-5f) * C.in[36][ch] + C.in[37][ch];
                Y[(size_t)(t0 + 8 * sb + j) * D + 512 + ch] = f2bf((yn + VBON[j * 8 + head] * vv) * VG[j * 512 + ch]);
            }
        }
        __syncthreads();
    }
    if (PASS == 1) {
        f32x4* du = (f32x4*)(UC + ((size_t)(c * 8 + head) * 64 + lane) * 64); f32x4* dp = (f32x4*)(PC + ((size_t)(c * 8 + head) * 64 + lane) * 64);
#pragma unroll
        for (int k4 = 0; k4 < 16; ++k4) { du[k4] = (f32x4){SU[4 * k4], SU[4 * k4 + 1], SU[4 * k4 + 2], SU[4 * k4 + 3]}; dp[k4] = (f32x4){SP[4 * k4], SP[4 * k4 + 1], SP[4 * k4 + 2], SP[4 * k4 + 3]}; }
    }
}

template <int PASS>
__device__ __forceinline__ void lru_chunk(const Ctx& C, int c) {
    const bf16_t* P = (const bf16_t*)(C.ws + WS_HP); const bf16_t* SW = (const bf16_t*)(C.ws + WS_SMALLW); bf16_t* Y = (bf16_t*)(C.ws + WS_Y);
    LAS bf16_t* XC = (LAS bf16_t*)C.lds; LAS bf16_t* LAB = (LAS bf16_t*)(C.lds + 66560);
    const int t0 = 64 * c, lane = C.lane, fr = lane & 15, fq = lane >> 4;
    {
        const int grp = C.tid & 63, seg = C.tid >> 6, ch0 = 8 * grp, r0 = 8 * seg;
        const float* cw = C.in[20]; const float* cb = C.in[21];
        float w0[8], w1[8], w2[8], w3[8], bb[8], x0[8], x1[8], x2[8];
#pragma unroll
        for (int i = 0; i < 8; ++i) { w0[i] = cw[ch0 + i]; w1[i] = cw[512 + ch0 + i]; w2[i] = cw[1024 + ch0 + i]; w3[i] = cw[1536 + ch0 + i]; bb[i] = cb[ch0 + i]; }
        auto ldrow = [&](int t, float (&x)[8]) {
            if (t < 0) {
#pragma unroll
                for (int i = 0; i < 8; ++i) x[i] = 0.f;
            } else {
                const u32x4 a = *(const u32x4*)(P + (size_t)t * P1LD + ch0);
#pragma unroll
                for (int i = 0; i < 4; ++i) { x[2 * i] = bflo(a[i]); x[2 * i + 1] = bfhi(a[i]); }
            }
        };
        ldrow(t0 + r0 - 3, x0); ldrow(t0 + r0 - 2, x1); ldrow(t0 + r0 - 1, x2);
#pragma unroll 1
        for (int row = r0; row < r0 + 8; ++row) {
            float x3[8], v[8]; ldrow(t0 + row, x3);
#pragma unroll
            for (int i = 0; i < 8; ++i) { v[i] = bb[i] + w0[i] * x0[i] + w1[i] * x1[i] + w2[i] * x2[i] + w3[i] * x3[i]; x0[i] = x1[i]; x1[i] = x2[i]; x2[i] = x3[i]; }
            u32x4 w; w.x = pk2(v[0], v[1]); w.y = pk2(v[2], v[3]); w.z = pk2(v[4], v[5]); w.w = pk2(v[6], v[7]);
            *(LAS u32x4*)(XC + row * 520 + ch0) = w;
        }
    }
    __syncthreads();
    const int nb = C.wave >> 1, eh = C.wave & 1, cbase = nb * 128 + 64 * eh;
#pragma unroll 1
    for (int mt = 0; mt < 4; ++mt) {
        bf16x8 mf[4];
#pragma unroll
        for (int k = 0; k < 4; ++k) mf[k] = ldf(XC, 520, 16 * mt, nb * 128 + 32 * k, lane);
        unsigned ur[4][2];
#pragma unroll
        for (int nt = 0; nt < 4; ++nt) {
            f32x4 aa = F4Z, ax = F4Z;
#pragma unroll
            for (int k = 0; k < 4; ++k) {
                aa = mma(aa, ldfg(SW + SW_WAT + nb * 16384, 128, 64 * eh + 16 * nt, 32 * k, lane), mf[k]);
                ax = mma(ax, ldfg(SW + SW_WXT + nb * 16384, 128, 64 * eh + 16 * nt, 32 * k, lane), mf[k]);
            }
            const int chn = cbase + 16 * nt + 4 * fq;
            const f32x4 bav = *(const f32x4*)(C.in[23] + chn), bxv = *(const f32x4*)(C.in[25] + chn), lam = *(const f32x4*)(C.in[26] + chn);
            const u32x2 xw = *(const LAS u32x2*)(XC + (16 * mt + fr) * 520 + chn);
            const float xc[4] = {bflo(xw.x), bfhi(xw.x), bflo(xw.y), bfhi(xw.y)};
            float la[4], uu[4];
#pragma unroll
            for (int v = 0; v < 4; ++v) { const float r = sigmoidf_(aa[v] + bav[v]), ig = sigmoidf_(ax[v] + bxv[v]); la[v] = -8.f * softplusf_(-lam[v]) * r; uu[v] = sqrtf(fmaxf(-expm1f(2.f * la[v]), 0.f)) * ig * xc[v]; }
            *(LAS u32x2*)(LAB + (16 * mt + fr) * 512 + chn) = (u32x2){pk2(la[0], la[1]), pk2(la[2], la[3])};
            ur[nt][0] = pk2(uu[0], uu[1]); ur[nt][1] = pk2(uu[2], uu[3]);
        }
        __syncthreads();
#pragma unroll
        for (int nt = 0; nt < 4; ++nt) *(LAS u32x2*)(XC + (16 * mt + fr) * 520 + cbase + 16 * nt + 4 * fq) = (u32x2){ur[nt][0], ur[nt][1]};
    }
    __syncthreads();
    {
        const int ch = C.tid;
        float* LA = (float*)(C.ws + WS_LA); float* HC = (float*)(C.ws + WS_HC); const float* HIN = (const float*)(C.ws + WS_HIN);
        float h = PASS == 3 ? HIN[c * 512 + ch] : 0.f, sla = 0.f;
#pragma unroll 4
        for (int tok = 0; tok < 64; ++tok) {
            const float la = bf2f(LAB[tok * 512 + ch]), u = bf2f(XC[tok * 520 + ch]);
            h = fmaf(__expf(la), h, u); sla += la;
            if (PASS == 3) {
                const float gb = bf2f(P[(size_t)(t0 + tok) * P1LD + 512 + ch]);
                const float ge = 0.5f * gb * (1.f + tanhf_(0.7978845608028654f * (gb + 0.044715f * gb * gb * gb)));
                Y[(size_t)(t0 + tok) * D + ch] = f2bf(h * ge);
            }
        }
        if (PASS == 1) { LA[c * 512 + ch] = sla; HC[c * 512 + ch] = h; }
    }
    __syncthreads();
}

__device__ __forceinline__ void l1_pass_a(const Ctx& C) {
#ifndef SKIP_PREP
    for (int c = C.bid; c < 256; c += C.G) rwkv_prep(C, c);
#endif
#ifndef SKIP_RW1
    for (int c = C.bid; c < 256; c += C.G) rwkv_chunk<1>(C, c);
#endif
#ifndef SKIP_LRU1
    for (int c = C.bid; c < 256; c += C.G) lru_chunk<1>(C, c);
#endif
}
__device__ __forceinline__ void l1_pass_c(const Ctx& C) {
#ifndef SKIP_RW3
    for (int c = C.bid; c < 256; c += C.G) rwkv_chunk<3>(C, c);
#endif
#ifndef SKIP_LRU3
    for (int c = C.bid; c < 256; c += C.G) lru_chunk<3>(C, c);
#endif
}

__device__ __forceinline__ void l1_middle(const Ctx& C) {
    const float* PC = (const float*)(C.ws + WS_PC); float* UC = (float*)(C.ws + WS_UC);
    const int lane = C.lane;
#ifndef SKIP_MID
    for (int gw = C.bid * 8 + C.wave; gw < 512; gw += C.G * 8) {
        const int head = gw >> 6, row = gw & 63;
        LAS float* SR = (LAS float*)(C.lds + C.wave * 256);
        float s = 0.f; SR[lane] = 0.f;
        float pa[64], pb[64];
#pragma unroll
        for (int i = 0; i < 64; ++i) pa[i] = PC[((size_t)(0 * 8 + head) * 64 + i) * 64 + lane];
#pragma unroll 1
        for (int c = 0; c < 256; c += 2) {
            {
                float* up = UC + ((size_t)(c * 8 + head) * 64 + row) * 64 + lane; const float u = *up; *up = s;
#pragma unroll
                for (int i = 0; i < 64; ++i) pb[i] = PC[((size_t)((c + 1) * 8 + head) * 64 + i) * 64 + lane];
                float acc = u;
#pragma unroll
                for (int i4 = 0; i4 < 16; ++i4) { const f32x4 s4 = *(const LAS f32x4*)(SR + 4 * i4); acc = fmaf(s4[0], pa[4 * i4], acc); acc = fmaf(s4[1], pa[4 * i4 + 1], acc); acc = fmaf(s4[2], pa[4 * i4 + 2], acc); acc = fmaf(s4[3], pa[4 * i4 + 3], acc); }
                s = acc; SR[lane] = s;
            }
            {
                float* up = UC + ((size_t)((c + 1) * 8 + head) * 64 + row) * 64 + lane; const float u = *up; *up = s;
                const int cn = (c + 2 < 256) ? c + 2 : 255;
#pragma unroll
                for (int i = 0; i < 64; ++i) pa[i] = PC[((size_t)(cn * 8 + head) * 64 + i) * 64 + lane];
                float acc = u;
#pragma unroll
                for (int i4 = 0; i4 < 16; ++i4) { const f32x4 s4 = *(const LAS f32x4*)(SR + 4 * i4); acc = fmaf(s4[0], pb[4 * i4], acc); acc = fmaf(s4[1], pb[4 * i4 + 1], acc); acc = fmaf(s4[2], pb[4 * i4 + 2], acc); acc = fmaf(s4[3], pb[4 * i4 + 3], acc); }
                s = acc; SR[lane] = s;
            }
        }
    }
#endif
    if (C.bid == (C.G > 64 ? 64 : 0)) {
        const float* LA = (const float*)(C.ws + WS_LA); const float* HC = (const float*)(C.ws + WS_HC); float* HIN = (float*)(C.ws + WS_HIN);
        const int ch = C.tid; float h = 0.f;
        for (int c0 = 0; c0 < 256; c0 += 8) { float la[8], hc[8];
#pragma unroll
            for (int j = 0; j < 8; ++j) { la[j] = LA[(c0 + j) * 512 + ch]; hc[j] = HC[(c0 + j) * 512 + ch]; }
#pragma unroll
            for (int j = 0; j < 8; ++j) { HIN[(c0 + j) * 512 + ch] = h; h = fmaf(__expf(la[j]), h, hc[j]); } }
    }
}

struct Args { const float* in[39]; float* out; unsigned char* ws; int ph_lo, ph_hi; };
constexpr int N_PHASES = 20;

__device__ __forceinline__ void ffn_gu(const Ctx& C, LAS unsigned char* lds, size_t wgu, int site) {
    pg8::Gemm g{(const bf16_t*)(C.ws + WS_XB), (const bf16_t*)(C.ws + wgu), T, 2 * FF, D}; pg8::StaticOrder S; S.init(T, 2 * FF, C.G, C.bid);
    EpiSwiglu E{(bf16_t*)(C.ws + WS_HP), (const float*)(C.ws + WS_SSQ) + (size_t)site * T * 16};
    pg8::gemm_phase<EpiSwiglu, pg8::StaticOrder, true, true>(lds, g, S, E);
}
__device__ __forceinline__ void ffn_down(const Ctx& C, LAS unsigned char* lds, size_t wd, int site_out) {
    pg8::Gemm g{(const bf16_t*)(C.ws + WS_HP), (const bf16_t*)(C.ws + wd), T, D, FF}; pg8::StaticOrder S; S.init(T, D, C.G, C.bid);
    EpiResid E{C.X, (bf16_t*)(C.ws + WS_XB), (float*)(C.ws + WS_SSQ) + (size_t)site_out * T * 16, 0.5f};
    pg8::gemm_phase<EpiResid, pg8::StaticOrder, true, true>(lds, g, S, E);
}
__device__ __forceinline__ void out_proj(const Ctx& C, LAS unsigned char* lds, int site_out) {
    pg8::Gemm g{(const bf16_t*)(C.ws + WS_Y), (const bf16_t*)(C.ws + WS_WOUT), T, D, D}; pg8::StaticOrder S; S.init(T, D, C.G, C.bid);
    EpiResid E{C.X, (bf16_t*)(C.ws + WS_XB), (float*)(C.ws + WS_SSQ) + (size_t)site_out * T * 16, 1.0f};
    pg8::gemm_phase<EpiResid, pg8::StaticOrder, true, true>(lds, g, S, E);
}

__global__ void __launch_bounds__(512) mk_fwd(Args args) {
    extern __shared__ __attribute__((aligned(16))) unsigned char lds_raw[];
    cg::grid_group grid = cg::this_grid();
    Ctx C; C.in = args.in; C.X = args.out; C.ws = args.ws; C.lds = (LAS unsigned char*)lds_raw;
    C.tid = threadIdx.x; C.lane = C.tid & 63; C.wave = __builtin_amdgcn_readfirstlane(C.tid >> 6); C.G = gridDim.x; C.bid = blockIdx.x;
    LAS unsigned char* lds = C.lds;
    const int lo = args.ph_lo, hi = args.ph_hi;
#define IN(k) (lo <= (k) && (k) < hi)
#define SEAM(k) do { if (IN(k) && IN((k) + 1)) { asm volatile("s_waitcnt vmcnt(0)" ::: "memory"); __builtin_amdgcn_fence(__ATOMIC_RELEASE, "agent"); asm volatile("s_waitcnt vmcnt(0)" ::: "memory"); \
    grid.sync(); __builtin_amdgcn_fence(__ATOMIC_ACQUIRE, "agent"); asm volatile("s_waitcnt vmcnt(0)" ::: "memory"); } } while (0)

    if (IN(0)) {
        convert_weights(C, 0, 7);
        bf16_t* sw = (bf16_t*)(C.ws + WS_SMALLW);
        for (int n = 0; n < 4; ++n) { tr_small(C, C.in[22] + n * 16384, 128, 128, sw + n * 16384); tr_small(C, C.in[24] + n * 16384, 128, 128, sw + 65536 + n * 16384); }
        tr_small(C, C.in[29], 64, 512, sw + 131072); tr_small(C, C.in[31], 64, 512, sw + 163840); tr_small(C, C.in[32], 160, 512, sw + 196608);
        prologue_x(C);
    }
    SEAM(0);
    if (IN(1)) ffn_gu(C, lds, WS_WGU1, 0);
    SEAM(1);
    if (IN(2)) ffn_down(C, lds, WS_WD1, 1);
    SEAM(2);
    if (IN(3)) {
        pg8::Gemm g{(const bf16_t*)(C.ws + WS_XB), (const bf16_t*)(C.ws + WS_WIN), T, 3584, D}; pg8::StaticOrder S; S.init(T, 3584, C.G, C.bid);
        EpiProj E{(bf16_t*)(C.ws + WS_HP), P0LD, 3328, (const float*)(C.ws + WS_SSQ) + (size_t)1 * T * 16, (float*)(C.ws + WS_DT), 3328};
        pg8::gemm_phase<EpiProj, pg8::StaticOrder, true, true>(lds, g, S, E);
    }
    SEAM(3);
    #ifndef SKIP4
    if (IN(4)) l0_states(C);
#endif
    SEAM(4);
    #ifndef SKIP5
    if (IN(5)) { l0_scan(C); __syncthreads(); convert_weights(C, 1, 1); }
#endif
    SEAM(5);
    #ifndef SKIP6
    if (IN(6)) l0_output(C);
#endif
    SEAM(6);
    if (IN(7)) out_proj(C, lds, 2);
    SEAM(7);
    if (IN(8)) { convert_weights(C, 1, 2); __syncthreads(); ffn_gu(C, lds, WS_WGU2, 2); }
    SEAM(8);
    if (IN(9)) ffn_down(C, lds, WS_WD2, 3);
    SEAM(9);
    if (IN(10)) ffn_gu(C, lds, WS_WGU1, 3);
    SEAM(10);
    if (IN(11)) ffn_down(C, lds, WS_WD1, 4);
    SEAM(11);
    if (IN(12)) {
        pg8::Gemm g{(const bf16_t*)(C.ws + WS_XB), (const bf16_t*)(C.ws + WS_WIN), T, 3072, D}; pg8::StaticOrder S; S.init(T, 3072, C.G, C.bid);
        EpiProj E{(bf16_t*)(C.ws + WS_HP), P1LD, 2848, (const float*)(C.ws + WS_SSQ) + (size_t)4 * T * 16, nullptr, -1};
        pg8::gemm_phase<EpiProj, pg8::StaticOrder, true, true>(lds, g, S, E);
    }
    SEAM(12);
    if (IN(13)) l1_pass_a(C);
    SEAM(13);
    if (IN(14)) { l1_middle(C); __syncthreads(); convert_weights(C, 1, 4); }
    SEAM(14);
    if (IN(15)) l1_pass_c(C);
    SEAM(15);
    if (IN(16)) out_proj(C, lds, 5);
    SEAM(16);
    if (IN(17)) ffn_gu(C, lds, WS_WGU2, 5);
    SEAM(17);
    if (IN(18)) ffn_down(C, lds, WS_WD2, 6);
    SEAM(18);
    if (IN(19)) final_norm(C);
#undef IN
#undef SEAM
}

extern "C" void kernel_launch(void* const* d_in, const int* in_sizes, int n_in, void* d_out, int out_size, void* d_ws, size_t ws_size, hipStream_t stream) {
    static int grid = 0;
    if (grid == 0) {
        if (n_in != 39 || out_size != T * D || ws_size < WS_END) { fprintf(stderr, "kernel_launch: unexpected problem: n_in %d out %d ws %zu\n", n_in, out_size, ws_size); grid = -1; return; }
        int dev = 0, cus = 0, per_cu = 0;
        hipGetDevice(&dev); hipDeviceGetAttribute(&cus, hipDeviceAttributeMultiprocessorCount, dev);
        if (hipFuncSetAttribute((const void*)mk_fwd, hipFuncAttributeMaxDynamicSharedMemorySize, LDS_BYTES) != hipSuccess) { fprintf(stderr, "kernel_launch: hipFuncSetAttribute failed\n"); grid = -1; return; }
        if (hipOccupancyMaxActiveBlocksPerMultiprocessor(&per_cu, (const void*)mk_fwd, 512, LDS_BYTES) != hipSuccess || per_cu < 1) { fprintf(stderr, "kernel_launch: occupancy query says %d\n", per_cu); per_cu = 1; (void)hipGetLastError(); }
        grid = cus * (per_cu > 1 ? 1 : per_cu);
    }
    if (grid < 0) return;
    Args a{};
    for (int i = 0; i < 39; ++i) a.in[i] = (const float*)d_in[i];
    a.out = (float*)d_out; a.ws = (unsigned char*)d_ws; a.ph_lo = 0; a.ph_hi = N_PHASES;
    void* kargs[] = {&a};
    hipError_t e = hipLaunchCooperativeKernel((const void*)mk_fwd, dim3(grid), dim3(512), kargs, LDS_BYTES, stream);
    if (e != hipSuccess) fprintf(stderr, "kernel_launch: cooperative launch failed: %s (grid %d)\n", hipGetErrorString(e), grid);
}
```

```cpp
#include <hip/hip_runtime.h>
#include <hip/hip_cooperative_groups.h>
#include <cstdio>
#include <cstdint>
namespace cg = cooperative_groups;
namespace pg8 {
#define PG8_LAS __attribute__((address_space(3)))
typedef unsigned short bf16_t;
typedef short bf16x8 __attribute__((ext_vector_type(8)));
typedef float f32x4 __attribute__((ext_vector_type(4)));
typedef unsigned u32x4 __attribute__((ext_vector_type(4)));
constexpr int BM = 256, BK = 64, HALF = 128, HTB = HALF * BK * 2  , STAGE_BYTES = 8 * HTB, NXCD = 8, WGM = 8;

__host__ __device__ __forceinline__ int lds_byte(int r, int c) { const int st = (r >> 4) * 2 + (c >> 5), rr = r & 15, cc = c & 31, ob = rr * 64 + cc * 2; return st * 1024 + (ob ^ (((ob >> 9) & 1) << 5)); }
__host__ __device__ __forceinline__ void stage_rc(int b, int& R, int& C) { const int st = b / 1024, sb = b % 1024, swz = sb ^ (((sb >> 9) & 1) << 5); R = (st >> 1) * 16 + swz / 64; C = (st & 1) * 32 + (swz % 64) / 2; }
__host__ __device__ __forceinline__ int perm32(int rho) { const int n = rho >> 4, i = rho & 15; return 8 * (i >> 2) + 4 * n + (i & 3); }

struct Unit { int pm, pn; };
struct Gemm { const bf16_t* A; const bf16_t* Bt; int M, N, K; };

struct StaticOrder {
    int nM, nN, nwg, G, c;
    __host__ __device__ void init(int M, int N, int G_, int c_) { nM = M / BM; nN = N / BM; nwg = nM * nN; G = G_; c = c_; }
    __host__ __device__ bool next(int i, Unit& u) const {
        const long L = (long)i * G + c; if (L >= nwg) return false;
        int wgid = (int)L; { const int q = nwg / NXCD, r = nwg % NXCD, xcd = wgid % NXCD, off = wgid / NXCD; wgid = (xcd < r ? xcd * (q + 1) : r * (q + 1) + (xcd - r) * q) + off; }
        const int nig = WGM * nN, gid = wgid / nig, fm = gid * WGM, gsz = (nM - fm) < WGM ? (nM - fm) : WGM;
        u.pm = fm + ((wgid % nig) % gsz); u.pn = (wgid % nig) / gsz; return true;
    }
    __device__ __forceinline__ void a_ready(const Unit&) const {}
    __device__ __forceinline__ void done(const Unit&) const {}
};
__device__ __forceinline__ unsigned cvt_pk_bf16(float lo, float hi) { unsigned r; asm volatile("v_cvt_pk_bf16_f32 %0, %1, %2" : "=v"(r) : "v"(lo), "v"(hi)); return r; }
template <class Epi, class Sched, bool ALIGN_EPI = false, bool SP2 = false>
__device__ __forceinline__ void gemm_phase(PG8_LAS unsigned char* lds, const Gemm g, const Sched& S, const Epi& E) {
    const int tid = threadIdx.x, wid = __builtin_amdgcn_readfirstlane(tid >> 6), lane = tid & 63, wr = wid >> 2, wc = wid & 3, fr = lane & 15, fq = lane >> 4;
    const int K = g.K, nt = K / BK;
    unsigned voffA[2], voffB[2];
#pragma unroll
    for (int i = 0; i < 2; ++i) { int R, C; stage_rc(tid * 16 + i * 8192, R, C); const int Rb = Epi::PERM ? ((R & ~31) + perm32(R & 31)) : R;
        voffA[i] = (unsigned)(R * K + C) * 2u; voffB[i] = (unsigned)(Rb * K + C) * 2u; }
    const size_t kstep = (size_t)(BK * 2);
    const size_t hstep = (size_t)HALF * K * 2;
    const size_t tstep = 2 * hstep;
    const unsigned ldsw = (unsigned)wid * 1024u;
    const int aoff = lds_byte(wr * 64 + fr, fq * 8), boff = lds_byte(wc * 32 + fr, fq * 8);
#define PG8_SA(b, h) (((b) * 2 + (h)) * HTB)
#define PG8_SB(b, h) ((4 + (b) * 2 + (h)) * HTB)
#define PG8_STAGE(bufoff, gbase, voff) do { _Pragma("unroll") for (int _i = 0; _i < 2; ++_i) \
        __builtin_amdgcn_global_load_lds((const unsigned*)((const char*)(gbase) + (voff)[_i]), (PG8_LAS unsigned*)(lds + (bufoff) + ldsw + _i * 8192), 16, 0, 0); } while (0)
#define PG8_LDA(dst, b, h) do { _Pragma("unroll") for (int m = 0; m < 4; ++m) _Pragma("unroll") for (int k = 0; k < 2; ++k) dst[m][k] = *(const PG8_LAS bf16x8*)(lds + PG8_SA(b, h) + aoff + m * 2048 + k * 1024); } while (0)
#define PG8_LDB(dst, b, h) do { _Pragma("unroll") for (int n = 0; n < 2; ++n) _Pragma("unroll") for (int k = 0; k < 2; ++k) dst[n][k] = *(const PG8_LAS bf16x8*)(lds + PG8_SB(b, h) + boff + n * 2048 + k * 1024); } while (0)
#define PG8_MMA(ai, bj, At, Bt) do { __builtin_amdgcn_s_setprio(1); _Pragma("unroll") for (int m = 0; m < 4; ++m) _Pragma("unroll") for (int n = 0; n < 2; ++n) _Pragma("unroll") for (int k = 0; k < 2; ++k) \
        acc[ai][bj][m][n] = __builtin_amdgcn_mfma_f32_16x16x32_bf16(Bt[n][k], At[m][k], acc[ai][bj][m][n], 0, 0, 0); __builtin_amdgcn_s_setprio(0); } while (0)
#define PG8_WAIT_V(n) asm volatile("s_waitcnt vmcnt(" #n ")" ::: "memory")
#define PG8_WAIT_L(n) asm volatile("s_waitcnt lgkmcnt(" #n ")" ::: "memory")
#define PG8_BAR __builtin_amdgcn_s_barrier()
#define PG8_SCHED __builtin_amdgcn_sched_barrier(0)
    Unit cur, nxt; int ui = 0;
    if (!S.next(0, cur)) return;
    f32x4 acc[2][2][4][2];
#pragma unroll
    for (int a = 0; a < 2; ++a)
#pragma unroll
        for (int b = 0; b < 2; ++b)
#pragma unroll
            for (int m = 0; m < 4; ++m)
#pragma unroll
                for (int n = 0; n < 2; ++n) acc[a][b][m][n] = (f32x4){0.f, 0.f, 0.f, 0.f};
    bf16x8 At[4][2], B0[2][2], B1[2][2];
    const char* cA = (const char*)g.A + (size_t)cur.pm * tstep; const char* cB = (const char*)g.Bt + (size_t)cur.pn * tstep;
    S.a_ready(cur);
    if constexpr (SP2) {
        PG8_STAGE(PG8_SB(0, 0), cB, voffB); PG8_STAGE(PG8_SB(0, 1), cB + hstep, voffB); PG8_STAGE(PG8_SA(0, 0), cA, voffA); PG8_STAGE(PG8_SA(0, 1), cA + hstep, voffA);
        if (wr == 1) PG8_BAR;
        PG8_WAIT_V(2); PG8_BAR;
        PG8_STAGE(PG8_SB(1, 0), cB + kstep, voffB); PG8_STAGE(PG8_SA(1, 0), cA + kstep, voffA); PG8_STAGE(PG8_SB(1, 1), cB + hstep + kstep, voffB);
        PG8_WAIT_V(6); PG8_BAR;
    } else {
        PG8_STAGE(PG8_SB(0, 0), cB, voffB); PG8_STAGE(PG8_SA(0, 0), cA, voffA); PG8_STAGE(PG8_SB(0, 1), cB + hstep, voffB); PG8_STAGE(PG8_SA(0, 1), cA + hstep, voffA);
        if (wr == 1) PG8_BAR;
        PG8_WAIT_V(4); PG8_BAR;
        PG8_STAGE(PG8_SB(1, 0), cB + kstep, voffB); PG8_STAGE(PG8_SA(1, 0), cA + kstep, voffA); PG8_STAGE(PG8_SB(1, 1), cB + hstep + kstep, voffB);
        PG8_WAIT_V(6); PG8_BAR;
    }
    for (;;) {
        const bool has_next = S.next(ui + 1, nxt);
        const char* nA = has_next ? (const char*)g.A + (size_t)nxt.pm * tstep : cA; const char* nB = has_next ? (const char*)g.Bt + (size_t)nxt.pn * tstep : cB;
        for (int t = 0; t < nt; t += 2) {
            const bool last = (t == nt - 2);
            const char* a1 = cA + (size_t)(t + 1) * kstep;
            const char* a2 = last ? nA : cA + (size_t)(t + 2) * kstep; const char* b2 = last ? nB : cB + (size_t)(t + 2) * kstep;
            const char* a3 = a2 + kstep; const char* b3 = b2 + kstep;
            if (last && has_next) S.a_ready(nxt);
            if constexpr (SP2) {
            PG8_LDB(B0, 0, 0); PG8_LDB(B1, 0, 1); PG8_SCHED; PG8_LDA(At, 0, 0); PG8_STAGE(PG8_SA(1, 1), a1 + hstep, voffA);
            PG8_WAIT_V(8); PG8_WAIT_L(0); PG8_BAR; PG8_MMA(0, 0, At, B0); PG8_MMA(0, 1, At, B1); PG8_BAR; PG8_SCHED;
            PG8_LDA(At, 0, 1); PG8_STAGE(PG8_SB(0, 0), b2, voffB); PG8_STAGE(PG8_SB(0, 1), b2 + hstep, voffB); PG8_STAGE(PG8_SA(0, 0), a2, voffA);
            PG8_WAIT_V(8); PG8_WAIT_L(0); PG8_BAR; PG8_MMA(1, 0, At, B0); PG8_MMA(1, 1, At, B1); PG8_BAR; PG8_SCHED;
            PG8_LDB(B0, 1, 0); PG8_LDB(B1, 1, 1); PG8_SCHED; PG8_LDA(At, 1, 0); PG8_STAGE(PG8_SA(0, 1), a2 + hstep, voffA);
            PG8_WAIT_V(8); PG8_WAIT_L(0); PG8_BAR; PG8_MMA(0, 0, At, B0); PG8_MMA(0, 1, At, B1); PG8_BAR; PG8_SCHED;
            PG8_LDA(At, 1, 1); PG8_STAGE(PG8_SB(1, 0), b3, voffB); PG8_STAGE(PG8_SB(1, 1), b3 + hstep, voffB); PG8_STAGE(PG8_SA(1, 0), a3, voffA);
            PG8_WAIT_V(8); PG8_WAIT_L(0); PG8_BAR; PG8_MMA(1, 0, At, B0); PG8_MMA(1, 1, At, B1); PG8_BAR; PG8_SCHED;
            } else {
            PG8_LDB(B0, 0, 0); PG8_SCHED; PG8_LDA(At, 0, 0); PG8_STAGE(PG8_SA(1, 1), a1 + hstep, voffA);
            PG8_WAIT_L(8); PG8_BAR; PG8_WAIT_L(0); PG8_MMA(0, 0, At, B0); PG8_BAR; PG8_SCHED;
            PG8_LDB(B1, 0, 1); PG8_STAGE(PG8_SB(0, 0), b2, voffB);
            PG8_BAR; PG8_WAIT_L(0); PG8_MMA(0, 1, At, B1); PG8_BAR;
            PG8_LDA(At, 0, 1); PG8_STAGE(PG8_SA(0, 0), a2, voffA);
            PG8_BAR; PG8_WAIT_L(0); PG8_MMA(1, 0, At, B0); PG8_BAR; PG8_SCHED;
            PG8_STAGE(PG8_SB(0, 1), b2 + hstep, voffB);
            PG8_WAIT_V(6); PG8_BAR; PG8_MMA(1, 1, At, B1); PG8_BAR;
            PG8_LDB(B0, 1, 0); PG8_SCHED; PG8_LDA(At, 1, 0); PG8_STAGE(PG8_SA(0, 1), a2 + hstep, voffA);
            PG8_WAIT_L(8); PG8_BAR; PG8_WAIT_L(0); PG8_MMA(0, 0, At, B0); PG8_BAR; PG8_SCHED;
            PG8_LDB(B1, 1, 1); PG8_STAGE(PG8_SB(1, 0), b3, voffB);
            PG8_BAR; PG8_WAIT_L(0); PG8_MMA(0, 1, At, B1); PG8_BAR;
            PG8_LDA(At, 1, 1); PG8_STAGE(PG8_SA(1, 0), a3, voffA);
            PG8_BAR; PG8_WAIT_L(0); PG8_MMA(1, 0, At, B0); PG8_BAR; PG8_SCHED;
            PG8_STAGE(PG8_SB(1, 1), b3 + hstep, voffB);
            PG8_WAIT_V(6); PG8_BAR; PG8_MMA(1, 1, At, B1); PG8_BAR;
            }
        }
        if constexpr (ALIGN_EPI) { if (wr == 0) PG8_BAR; }
        if constexpr (!Epi::AFTER_DRAIN) { E(acc, cur, wr, wc, fr, fq); S.done(cur); }
        if (!has_next) break;
#pragma unroll
        for (int a = 0; a < 2; ++a)
#pragma unroll
            for (int b = 0; b < 2; ++b)
#pragma unroll
                for (int m = 0; m < 4; ++m)
#pragma unroll
                    for (int n = 0; n < 2; ++n) acc[a][b][m][n] = (f32x4){0.f, 0.f, 0.f, 0.f};
        cur = nxt; cA = nA; cB = nB; ++ui;
        if constexpr (ALIGN_EPI) { if (wr == 1) PG8_BAR; }
    }
    PG8_WAIT_V(0);
    if constexpr (!ALIGN_EPI) { if (wr == 0) PG8_BAR; }
    PG8_BAR;
    if constexpr (Epi::AFTER_DRAIN) { E.fused(acc, cur, wr, wc, fr, fq, lds, wid, lane); S.done(cur); }
#undef PG8_SA
#undef PG8_SB
#undef PG8_STAGE
#undef PG8_LDA
#undef PG8_LDB
#undef PG8_MMA
#undef PG8_WAIT_V
#undef PG8_WAIT_L
#undef PG8_BAR
#undef PG8_SCHED
}
}

#define LAS __attribute__((address_space(3)))
typedef unsigned short bf16_t;
typedef short bf16x8 __attribute__((ext_vector_type(8)));
typedef float f32x4 __attribute__((ext_vector_type(4)));
typedef float f32x2 __attribute__((ext_vector_type(2)));
typedef unsigned u32x4 __attribute__((ext_vector_type(4)));
typedef unsigned u32x2 __attribute__((ext_vector_type(2)));

constexpr int T = 16384, D = 1024, FF = 2816;
constexpr int P0LD = 3328, P1LD = 2880;
constexpr int C_Q = 0, C_K = 512, C_V = 1024, C_G = 1536, C_Z = 2048, C_XBC = 2560;
constexpr size_t MiB = 1u << 20;
constexpr size_t WS_SSQ = 247 * MiB, WS_DT = 512 * 1024, WS_LRUC = 1 * MiB, WS_CHD = 2 * MiB + 512 * 1024, WS_SMALLW = 3 * MiB;
constexpr size_t WS_WGU1 = 4 * MiB, WS_WD1 = 15 * MiB, WS_WIN = 21 * MiB, WS_WOUT = 28 * MiB, WS_WGU2 = 30 * MiB, WS_WD2 = 41 * MiB;
constexpr size_t WS_XB = 47 * MiB, WS_Y = 79 * MiB, WS_HP = 111 * MiB, WS_ST = 215 * MiB, WS_END = 255 * MiB;
constexpr int LDS_BYTES = 163840;

typedef float f32x2_t __attribute__((ext_vector_type(2)));
typedef __bf16 bf16x2_t __attribute__((ext_vector_type(2)));
__device__ __forceinline__ unsigned pk2(float lo, float hi) { f32x2_t v = {lo, hi}; bf16x2_t b = __builtin_convertvector(v, bf16x2_t); return __builtin_bit_cast(unsigned, b); }
__device__ __forceinline__ unsigned short f2bf(float f) { return (unsigned short)(pk2(f, 0.f) & 0xffffu); }
__device__ __forceinline__ float bflo(unsigned w) { return __uint_as_float(w << 16); }
__device__ __forceinline__ float bfhi(unsigned w) { return __uint_as_float(w & 0xffff0000u); }
__device__ __forceinline__ float bf2f(unsigned short h) { return __uint_as_float(((unsigned)h) << 16); }
__device__ __forceinline__ float frcp(float x) { return __builtin_amdgcn_rcpf(x); }
__device__ __forceinline__ float sigmoidf_(float x) { return frcp(1.f + __expf(-x)); }
__device__ __forceinline__ float siluf_(float x) { return x * frcp(1.f + __expf(-x)); }
__device__ __forceinline__ float softplusf_(float x) { return x > 20.f ? x : log1pf(__expf(x)); }
__device__ __forceinline__ float wave_sum(float v) {
#pragma unroll
    for (int o = 1; o < 64; o <<= 1) v += __shfl_xor(v, o);
    return v;
}
__device__ __forceinline__ f32x4 mma(f32x4 acc, bf16x8 nfrag, bf16x8 mfrag) { return __builtin_amdgcn_mfma_f32_16x16x32_bf16(nfrag, mfrag, acc, 0, 0, 0); }
__device__ __forceinline__ bf16x8 ldf(const LAS bf16_t* base, int stride, int row0, int k0, int lane) { return *(const LAS bf16x8*)(base + (row0 + (lane & 15)) * stride + k0 + 8 * (lane >> 4)); }
__device__ __forceinline__ bf16x8 ldfg(const bf16_t* base, int stride, int row0, int k0, int lane) { return *(const bf16x8*)(base + (size_t)(row0 + (lane & 15)) * stride + k0 + 8 * (lane >> 4)); }
#define F4Z ((f32x4){0.f, 0.f, 0.f, 0.f})
__device__ __forceinline__ float ssq_row(const float* ssq, int row) {
    float s = 0.f;
#pragma unroll
    for (int k = 0; k < 16; ++k) s += ssq[(size_t)k * T + row];
    return s;
}

struct Ctx {
    const float* const* in; float* X; unsigned char* ws; LAS unsigned char* lds;
    int tid, lane, wave, G, bid;
};

__device__ __forceinline__ void tr_item(const float* W, int K, int N, bf16_t* WT, const float* gain, int k0, int n0, int drow0, LAS float* scr, int lane) {
    const int nn = n0 + (lane & 31);
#pragma unroll 8
    for (int i = 0; i < 32; ++i) { const int kk = 2 * i + (lane >> 5); float v = (nn < N) ? W[(size_t)(k0 + kk) * N + nn] : 0.f; if (gain) v *= gain[k0 + kk]; scr[kk * 33 + (lane & 31)] = v; }
    asm volatile("s_waitcnt lgkmcnt(0)" ::: "memory");
    const int c = lane & 7;
#pragma unroll
    for (int j = 0; j < 4; ++j) { const int n = (lane >> 3) + 8 * j; const LAS float* s = scr + (8 * c) * 33 + n;
        u32x4 o; o.x = pk2(s[0 * 33], s[1 * 33]); o.y = pk2(s[2 * 33], s[3 * 33]); o.z = pk2(s[4 * 33], s[5 * 33]); o.w = pk2(s[6 * 33], s[7 * 33]);
        if (n0 + n < N) *(u32x4*)(WT + (size_t)(drow0 + n) * K + k0 + 8 * c) = o; }
    asm volatile("s_waitcnt lgkmcnt(0)" ::: "memory");
}
__device__ __forceinline__ void tr_matrix(const Ctx& C, const float* W, int K, int N, bf16_t* WT, const float* gain, int mode, int& base) {
    LAS float* scr = (LAS float*)(C.lds + C.wave * 8448);
    const int nblk = (N + 31) / 32, nitems = (K / 64) * nblk, gw = C.bid * 8 + C.wave, ngw = C.G * 8;
    int first = (gw - (base % ngw) + ngw) % ngw;
    for (int it = first; it < nitems; it += ngw) {
        const int kb = it / nblk, nb = it % nblk, n0 = 32 * nb;
        const int drow0 = mode == 0 ? n0 : ((n0 >> 7) * 256 + (n0 & 127) + (mode == 2 ? 128 : 0));
        tr_item(W, K, N, WT, gain, 64 * kb, n0, drow0, scr, C.lane);
    }
    base += nitems;
}
__device__ __forceinline__ void convert_weights(const Ctx& C, int layer, int which) {
    int base = 0; unsigned char* ws = C.ws;
    if (which & 1) {
        tr_matrix(C, C.in[2] + (size_t)layer * D * FF, D, FF, (bf16_t*)(ws + WS_WGU1), C.in[1] + layer * D, 1, base);
        tr_matrix(C, C.in[3] + (size_t)layer * D * FF, D, FF, (bf16_t*)(ws + WS_WGU1), C.in[1] + layer * D, 2, base);
        tr_matrix(C, C.in[4] + (size_t)layer * D * FF, FF, D, (bf16_t*)(ws + WS_WD1), nullptr, 0, base);
    }
    if (which & 2) {
        if (layer == 0) { tr_matrix(C, C.in[10], D, 3336, (bf16_t*)(ws + WS_WIN), C.in[5], 0, base); tr_matrix(C, C.in[11], D, D, (bf16_t*)(ws + WS_WOUT), nullptr, 0, base); }
        else            { tr_matrix(C, C.in[18], D, 2848, (bf16_t*)(ws + WS_WIN), C.in[5] + D, 0, base); tr_matrix(C, C.in[19], D, D, (bf16_t*)(ws + WS_WOUT), nullptr, 0, base); }
    }
    if (which & 4) {
        tr_matrix(C, C.in[7] + (size_t)layer * D * FF, D, FF, (bf16_t*)(ws + WS_WGU2), C.in[6] + layer * D, 1, base);
        tr_matrix(C, C.in[8] + (size_t)layer * D * FF, D, FF, (bf16_t*)(ws + WS_WGU2), C.in[6] + layer * D, 2, base);
        tr_matrix(C, C.in[9] + (size_t)layer * D * FF, FF, D, (bf16_t*)(ws + WS_WD2), nullptr, 0, base);
    }
}
__device__ __forceinline__ void tr_small(const Ctx& C, const float* W, int K, int N, bf16_t* WT) {
    for (int idx = C.bid * 512 + C.tid; idx < K * N; idx += C.G * 512) { const int n = idx / K, k = idx % K; WT[idx] = f2bf(W[(size_t)k * N + n]); }
}

struct EpiSwiglu {
    static constexpr bool PERM = true, AFTER_DRAIN = false;
    bf16_t* H; const float* ssq;
    __device__ __forceinline__ void operator()(const f32x4 (&acc)[2][2][4][2], const pg8::Unit& u, int wr, int wc, int fr, int fq) const {
        const int row0 = u.pm * 256 + wr * 64 + fr, col0 = u.pn * 128 + wc * 32 + 8 * fq;
#pragma unroll
        for (int ai = 0; ai < 2; ++ai)
#pragma unroll
            for (int m = 0; m < 4; ++m) {
                const int row = row0 + ai * 128 + m * 16; const float r = rsqrtf(ssq_row(ssq, row) * (1.f / D) + 1e-6f);
                float h[8];
#pragma unroll
                for (int n = 0; n < 2; ++n)
#pragma unroll
                    for (int v = 0; v < 4; ++v) { const float g = acc[ai][0][m][n][v] * r, up = acc[ai][1][m][n][v] * r; h[4 * n + v] = siluf_(g) * up; }
                u32x4 w; w.x = pk2(h[0], h[1]); w.y = pk2(h[2], h[3]); w.z = pk2(h[4], h[5]); w.w = pk2(h[6], h[7]);
                *(u32x4*)(H + (size_t)row * FF + col0) = w;
            }
    }
};
struct EpiResid {
    static constexpr bool PERM = false, AFTER_DRAIN = false;
    float* X; bf16_t* XB; float* ssq_out; float alpha;
    __device__ __forceinline__ void operator()(const f32x4 (&acc)[2][2][4][2], const pg8::Unit& u, int wr, int wc, int fr, int fq) const {
        const int row0 = u.pm * 256 + wr * 64 + fr, col0 = u.pn * 256 + wc * 32 + 4 * fq;
#pragma unroll
        for (int ai = 0; ai < 2; ++ai)
#pragma unroll
            for (int m = 0; m < 4; ++m) {
                const int row = row0 + ai * 128 + m * 16; float s = 0.f;
#pragma unroll
                for (int bj = 0; bj < 2; ++bj)
#pragma unroll
                    for (int n = 0; n < 2; ++n) {
                        const size_t off = (size_t)row * D + col0 + bj * 128 + n * 16;
                        f32x4 x = *(const f32x4*)(X + off); x = x + acc[ai][bj][m][n] * alpha;
                        *(f32x4*)(X + off) = x; u32x2 b; b.x = pk2(x[0], x[1]); b.y = pk2(x[2], x[3]); *(u32x2*)(XB + off) = b;
                        s += (x[0] * x[0] + x[1] * x[1]) + (x[2] * x[2] + x[3] * x[3]);
                    }
                s += __shfl_xor(s, 16); s += __shfl_xor(s, 32);
                if (fq == 0) ssq_out[(size_t)(u.pn * 4 + wc) * T + row] = s;
            }
    }
};
struct EpiProj {
    static constexpr bool PERM = true, AFTER_DRAIN = false;
    bf16_t* P; int ldp, ncols; const float* ssq; float* DT; int dt_col0;
    __device__ __forceinline__ void operator()(const f32x4 (&acc)[2][2][4][2], const pg8::Unit& u, int wr, int wc, int fr, int fq) const {
        const int row0 = u.pm * 256 + wr * 64 + fr, col0 = u.pn * 256 + wc * 32 + 8 * fq;
#pragma unroll
        for (int ai = 0; ai < 2; ++ai)
#pragma unroll
            for (int m = 0; m < 4; ++m) {
                const int row = row0 + ai * 128 + m * 16; const float r = rsqrtf(ssq_row(ssq, row) * (1.f / D) + 1e-6f);
#pragma unroll
                for (int bj = 0; bj < 2; ++bj) {
                    const int c = col0 + bj * 128; const f32x4 v0 = acc[ai][bj][m][0] * r, v1 = acc[ai][bj][m][1] * r;
                    if (c + 8 <= ncols) { u32x4 w; w.x = pk2(v0[0], v0[1]); w.y = pk2(v0[2], v0[3]); w.z = pk2(v1[0], v1[1]); w.w = pk2(v1[2], v1[3]); *(u32x4*)(P + (size_t)row * ldp + c) = w; }
                    else if (DT && c == dt_col0) { *(f32x4*)(DT + (size_t)row * 8) = v0; *(f32x4*)(DT + (size_t)row * 8 + 4) = v1; }
                }
            }
    }
};

__device__ __forceinline__ void prologue_x(const Ctx& C) {
    const float* x = C.in[0]; bf16_t* XB = (bf16_t*)(C.ws + WS_XB); float* ssq = (float*)(C.ws + WS_SSQ);
    const int gw = C.bid * 8 + C.wave, ngw = C.G * 8;
    for (int m = gw; m < T; m += ngw) {
        const f32x4* xr = (const f32x4*)(x + (size_t)m * D) + C.lane; f32x4* orow = (f32x4*)(C.X + (size_t)m * D) + C.lane; u32x2* brow = (u32x2*)(XB + (size_t)m * D) + C.lane;
        float s = 0.f;
#pragma unroll
        for (int j = 0; j < 4; ++j) { const f32x4 v = xr[64 * j]; orow[64 * j] = v; u32x2 b; b.x = pk2(v[0], v[1]); b.y = pk2(v[2], v[3]); brow[64 * j] = b; s += (v[0] * v[0] + v[1] * v[1]) + (v[2] * v[2] + v[3] * v[3]); }
        s = wave_sum(s);
        if (C.lane == 0) ssq[m] = s;
    }
    for (int i = C.bid * 512 + C.tid; i < 15 * T; i += C.G * 512) ssq[T + i] = 0.f;
}
__device__ __forceinline__ void final_norm(const Ctx& C) {
    const float* ssq = (const float*)(C.ws + WS_SSQ) + (size_t)6 * T * 16; const float* g = C.in[38];
    const int gw = C.bid * 8 + C.wave, ngw = C.G * 8;
    f32x4 gv[4];
#pragma unroll
    for (int j = 0; j < 4; ++j) gv[j] = ((const f32x4*)g)[C.lane + 64 * j];
    for (int m = gw; m < T; m += ngw) {
        f32x4* xr = (f32x4*)(C.X + (size_t)m * D) + C.lane; const float r = rsqrtf(ssq_row(ssq, m) * (1.f / D) + 1e-6f);
#pragma unroll
        for (int j = 0; j < 4; ++j) { f32x4 v = xr[64 * j]; v = v * r * gv[j];
#ifdef SANITIZE
#pragma unroll
            for (int q = 0; q < 4; ++q) v[q] = (fabsf(v[q]) < 1e30f) ? v[q] : 0.f;
#endif
            xr[64 * j] = v; }
    }
}

__device__ __forceinline__ float ret_log_gamma(int h) { return logf(1.f - exp2f(-5.f - (float)h)); }

template <bool TR>
__device__ __forceinline__ void stage_rot(const bf16_t* P, int t0, int col0, LAS bf16_t* dst, int stride, float scale, float lg, bool kte, int nrows, int tl, int nth) {
    for (int it = tl; it < nrows * 8; it += nth) {
        const int row = it >> 3, d0 = (it & 7) * 8, t = t0 + row;
        const bf16_t* src = P + (size_t)t * P0LD + col0 + d0;
        const u32x4 a = *(const u32x4*)src, b = *(const u32x4*)(src + 64);
        const float rs = scale * (kte ? __expf(lg * (float)(127 - row)) : 1.f);
        float o1[8], o2[8];
#pragma unroll
        for (int i = 0; i < 8; ++i) {
            const unsigned wa = a[i >> 1], wb = b[i >> 1];
            const float x1 = (i & 1) ? bfhi(wa) : bflo(wa), x2 = (i & 1) ? bfhi(wb) : bflo(wb);
            const float invf = exp2f(-(float)(d0 + i) * (13.287712379549449f / 64.f));
            const float ang = (float)t * invf, n = rintf(ang * 0.15915494309189535f);
            float r = fmaf(-n, 6.2831854820251465f, ang); r = fmaf(-n, -1.7484556e-7f, r);
            const float s = __sinf(r), c = __cosf(r);
            o1[i] = (x1 * c - x2 * s) * rs; o2[i] = (x2 * c + x1 * s) * rs;
        }
        if (TR) {
#pragma unroll
            for (int i = 0; i < 8; ++i) { dst[(d0 + i) * stride + row] = f2bf(o1[i]); dst[(64 + d0 + i) * stride + row] = f2bf(o2[i]); }
        } else {
            u32x4 w1, w2; w1.x = pk2(o1[0], o1[1]); w1.y = pk2(o1[2], o1[3]); w1.z = pk2(o1[4], o1[5]); w1.w = pk2(o1[6], o1[7]);
            w2.x = pk2(o2[0], o2[1]); w2.y = pk2(o2[2], o2[3]); w2.z = pk2(o2[4], o2[5]); w2.w = pk2(o2[6], o2[7]);
            *(LAS u32x4*)(dst + row * stride + d0) = w1; *(LAS u32x4*)(dst + row * stride + 64 + d0) = w2;
        }
    }
}
__device__ __forceinline__ void stage_vT(const bf16_t* P, int t0, int col0, LAS bf16_t* dst, int stride, int tid) {
    for (int it = tid; it < 128 * 16; it += 512) {
        const int row = it >> 4, e0 = (it & 15) * 8;
        const u32x4 a = *(const u32x4*)(P + (size_t)(t0 + row) * P0LD + col0 + e0);
#pragma unroll
        for (int i = 0; i < 8; ++i) { const unsigned w = a[i >> 1]; dst[(e0 + i) * stride + row] = (unsigned short)((i & 1) ? (w >> 16) : (w & 0xffffu)); }
    }
}

__device__ __forceinline__ void stage_dt(const Ctx& C, int t0, int g, LAS float* DTS, LAS float* AS, LAS float* ACS) {
    const int l = C.tid & 127, hh = C.tid >> 7, h = 4 * g + hh;
    const float* DT = (const float*)(C.ws + WS_DT);
    const float dtv = softplusf_(DT[(size_t)(t0 + l) * 8 + h] + C.in[14][h]);
    DTS[hh * 128 + l] = dtv; AS[hh * 128 + l] = -dtv * __expf(C.in[15][h]);
    __syncthreads();
    float s = 0.f;
    for (int i = 0; i <= l; ++i) s += AS[hh * 128 + i];
    ACS[hh * 128 + l] = s;
    __syncthreads();
}

template <int NGRP, int MODE>
__device__ __forceinline__ void stage_conv(const Ctx& C, int t0, int g, LAS bf16_t* XT, LAS bf16_t* BB, LAS bf16_t* CC, const LAS float* DTS, const LAS float* ACS) {
    constexpr int NSEG = 512 / NGRP, RP = (128 + NSEG - 1) / NSEG;
    if (C.tid >= NGRP * NSEG) return;
    const bf16_t* P = (const bf16_t*)(C.ws + WS_HP);
    const int grp = C.tid % NGRP, seg = C.tid / NGRP;
    const int ch0 = grp < 32 ? 256 * g + 8 * grp : (grp < 40 ? 512 + 64 * g + 8 * (grp - 32) : 640 + 64 * g + 8 * (grp - 40));
    const float* cw = C.in[12]; const float* cb = C.in[13];
    float w0[8], w1[8], w2[8], w3[8], bb[8], x0[8], x1[8], x2[8];
#pragma unroll
    for (int i = 0; i < 8; ++i) { w0[i] = cw[ch0 + i]; w1[i] = cw[768 + ch0 + i]; w2[i] = cw[1536 + ch0 + i]; w3[i] = cw[2304 + ch0 + i]; bb[i] = cb[ch0 + i]; }
    const int r0 = seg * RP, r1 = (r0 + RP < 128) ? r0 + RP : 128;
    auto ldrow = [&](int t, float (&x)[8]) {
        if (t < 0) {
#pragma unroll
            for (int i = 0; i < 8; ++i) x[i] = 0.f;
        } else {
            const u32x4 a = *(const u32x4*)(P + (size_t)t * P0LD + C_XBC + ch0);
#pragma unroll
            for (int i = 0; i < 4; ++i) { x[2 * i] = bflo(a[i]); x[2 * i + 1] = bfhi(a[i]); }
        }
    };
    ldrow(t0 + r0 - 3, x0); ldrow(t0 + r0 - 2, x1); ldrow(t0 + r0 - 1, x2);
    for (int row = r0; row < r1; ++row) {
        float x3[8], v[8]; ldrow(t0 + row, x3);
#pragma unroll
        for (int i = 0; i < 8; ++i) { float s = bb[i] + w0[i] * x0[i] + w1[i] * x1[i] + w2[i] * x2[i] + w3[i] * x3[i]; v[i] = siluf_(s); x0[i] = x1[i]; x1[i] = x2[i]; x2[i] = x3[i]; }
        if (grp < 32) {
            const int hh = grp >> 3;
            float sc = DTS[hh * 128 + row]; if (MODE == 0) sc *= __expf(ACS[hh * 128 + 127] - ACS[hh * 128 + row]);
#pragma unroll
            for (int i = 0; i < 8; ++i) XT[(8 * grp + i) * 136 + row] = f2bf(v[i] * sc);
        } else if (MODE == 0) {
#pragma unroll
            for (int i = 0; i < 8; ++i) BB[(8 * (grp - 32) + i) * 136 + row] = f2bf(v[i]);
        } else {
            u32x4 w; w.x = pk2(v[0], v[1]); w.y = pk2(v[2], v[3]); w.z = pk2(v[4], v[5]); w.w = pk2(v[6], v[7]);
            if (grp < 40) *(LAS u32x4*)(BB + row * 72 + 8 * (grp - 32)) = w; else *(LAS u32x4*)(CC + row * 72 + 8 * (grp - 40)) = w;
        }
    }
}

__device__ __forceinline__ void ret_state_unit(const Ctx& C, int c, int h) {
    const bf16_t* P = (const bf16_t*)(C.ws + WS_HP); float* SR = (float*)(C.ws + WS_ST);
    LAS bf16_t* KT = (LAS bf16_t*)C.lds; LAS bf16_t* VT = KT + 128 * 136;
    const int t0 = c * 128, lane = C.lane, fr = lane & 15, fq = lane >> 4;
    stage_rot<true>(P, t0, C_K + h * 128, KT, 136, 0.08838834764831845f, ret_log_gamma(h), true, 128, C.tid, 512);
    stage_vT(P, t0, C_V + h * 128, VT, 136, C.tid);
    __syncthreads();
    const int e0 = 16 * C.wave; bf16x8 mf[4];
#pragma unroll
    for (int k = 0; k < 4; ++k) mf[k] = ldf(VT, 136, e0, 32 * k, lane);
    float* out = SR + ((size_t)(c * 4 + h) * 128 + e0 + fr) * 128 + 4 * fq;
#pragma unroll
    for (int dt = 0; dt < 8; ++dt) { f32x4 acc = F4Z;
#pragma unroll
        for (int k = 0; k < 4; ++k) acc = mma(acc, ldf(KT, 136, 16 * dt, 32 * k, lane), mf[k]);
        *(f32x4*)(out + 16 * dt) = acc; }
    __syncthreads();
}
__device__ __forceinline__ void mamba_state_unit(const Ctx& C, int c, int g) {
    LAS bf16_t* XT = (LAS bf16_t*)C.lds; LAS bf16_t* BT = XT + 256 * 136;
    LAS float* DTS = (LAS float*)(C.lds + 150528); LAS float* ACS = DTS + 512; LAS float* AS = ACS + 512;
    float* SM = (float*)(C.ws + WS_XB); float* CHD = (float*)(C.ws + WS_CHD);
    const int t0 = c * 128, lane = C.lane, fr = lane & 15, fq = lane >> 4;
    stage_dt(C, t0, g, DTS, AS, ACS);
    stage_conv<40, 0>(C, t0, g, XT, BT, nullptr, DTS, ACS);
    if (C.tid < 4) CHD[(c * 2 + g) * 32 + C.tid] = __expf(ACS[C.tid * 128 + 127]);
    __syncthreads();
    const int hh = C.wave >> 1, ph = C.wave & 1;
#pragma unroll
    for (int pt = 0; pt < 2; ++pt) {
        const int p0 = ph * 32 + 16 * pt; bf16x8 mf[4];
#pragma unroll
        for (int k = 0; k < 4; ++k) mf[k] = ldf(XT, 136, hh * 64 + p0, 32 * k, lane);
        float* out = SM + ((size_t)(c * 8 + 4 * g + hh) * 64 + p0 + fr) * 64 + 4 * fq;
#pragma unroll
        for (int nt = 0; nt < 4; ++nt) { f32x4 acc = F4Z;
#pragma unroll
            for (int k = 0; k < 4; ++k) acc = mma(acc, ldf(BT, 136, 16 * nt, 32 * k, lane), mf[k]);
            *(f32x4*)(out + 16 * nt) = acc; }
    }
    __syncthreads();
}
__device__ __forceinline__ void l0_states(const Ctx& C) {
    for (int u = C.bid; u < 256; u += C.G) mamba_state_unit(C, u >> 1, u & 1);
    for (int u = C.bid; u < 512; u += C.G) ret_state_unit(C, u >> 2, u & 3);
}

__device__ __forceinline__ void l0_scan(const Ctx& C) {
    float* SR = (float*)(C.ws + WS_ST); float* SM = (float*)(C.ws + WS_XB); const float* CHD = (const float*)(C.ws + WS_CHD);
    for (int idx = C.bid * 512 + C.tid; idx < 65536 + 32768; idx += C.G * 512) {
        if (idx < 65536) {
            const float dec = __expf(128.f * ret_log_gamma(idx >> 14)); float s = 0.f; float* p = SR + idx;
            for (int c0 = 0; c0 < 128; c0 += 8) { float kv[8];
#pragma unroll
                for (int j = 0; j < 8; ++j) kv[j] = p[(size_t)(c0 + j) * 65536];
#pragma unroll
                for (int j = 0; j < 8; ++j) { p[(size_t)(c0 + j) * 65536] = s; s = s * dec + kv[j]; } }
        } else {
            const int e = idx - 65536, head = e >> 12; float s = 0.f; float* p = SM + e;
            for (int c0 = 0; c0 < 128; c0 += 8) { float kv[8], dc[8];
#pragma unroll
                for (int j = 0; j < 8; ++j) { kv[j] = p[(size_t)(c0 + j) * 32768]; dc[j] = CHD[((c0 + j) * 2 + (head >> 2)) * 32 + (head & 3)]; }
#pragma unroll
                for (int j = 0; j < 8; ++j) { p[(size_t)(c0 + j) * 32768] = s; s = s * dc[j] + kv[j]; } }
        }
    }
}

__device__ __forceinline__ void mamba_out_unit(const Ctx& C, int c, int g) {
    LAS bf16_t* XT = (LAS bf16_t*)C.lds; LAS bf16_t* BM = (LAS bf16_t*)(C.lds + 69632); LAS bf16_t* CM = (LAS bf16_t*)(C.lds + 88064);
    LAS bf16_t* SP = (LAS bf16_t*)(C.lds + 106496); LAS bf16_t* STR = (LAS bf16_t*)(C.lds + 115712) + C.wave * (16 * 136);
    LAS float* DTS = (LAS float*)(C.lds + 150528); LAS float* ACS = DTS + 512; LAS float* AS = ACS + 512;
    const bf16_t* P = (const bf16_t*)(C.ws + WS_HP); const float* SM = (const float*)(C.ws + WS_XB); bf16_t* Y = (bf16_t*)(C.ws + WS_Y);
    const int t0 = c * 128, lane = C.lane, fr = lane & 15, fq = lane >> 4, w = C.wave, l0 = 16 * w, l = l0 + fr;
    stage_dt(C, t0, g, DTS, AS, ACS);
    stage_conv<48, 1>(C, t0, g, XT, BM, CM, DTS, ACS);
    __syncthreads();
    bf16x8 cmA[2]; cmA[0] = ldf(CM, 72, l0, 0, lane); cmA[1] = ldf(CM, 72, l0, 32, lane);
    f32x4 cb[8];
#pragma unroll
    for (int st = 0; st < 8; ++st) { cb[st] = F4Z; if (st <= w) { cb[st] = mma(cb[st], ldf(BM, 72, 16 * st, 0, lane), cmA[0]); cb[st] = mma(cb[st], ldf(BM, 72, 16 * st, 32, lane), cmA[1]); } }
    float ssq = 0.f;
#pragma unroll 1
    for (int hh = 0; hh < 4; ++hh) {
        const int h = 4 * g + hh;
        __syncthreads();
        {
            const float* src = SM + (size_t)(c * 8 + h) * 4096;
#pragma unroll
            for (int i = 0; i < 2; ++i) { const int e = (C.tid + 512 * i) * 4; const f32x4 v = *(const f32x4*)(src + e); u32x2 b; b.x = pk2(v[0], v[1]); b.y = pk2(v[2], v[3]); *(LAS u32x2*)(SP + (e >> 6) * 72 + (e & 63)) = b; }
        }
        const float al = ACS[hh * 128 + l];
#pragma unroll
        for (int st = 0; st < 8; ++st) {
            const f32x4 as4 = *(const LAS f32x4*)(ACS + hh * 128 + 16 * st + 4 * fq); float sc[4];
#pragma unroll
            for (int v = 0; v < 4; ++v) { const int s = 16 * st + 4 * fq + v; sc[v] = (st <= w && s <= l) ? cb[st][v] * __expf(al - as4[v]) : 0.f; }
            u32x2 b; b.x = pk2(sc[0], sc[1]); b.y = pk2(sc[2], sc[3]); *(LAS u32x2*)(STR + fr * 136 + 16 * st + 4 * fq) = b;
        }
        __syncthreads();
        bf16x8 sA[4];
#pragma unroll
        for (int k = 0; k < 4; ++k) sA[k] = ldf(STR, 136, 0, 32 * k, lane);
        const float eal = __expf(al), dsk = C.in[16][h], rdt = frcp(DTS[hh * 128 + l]);
#pragma unroll
        for (int pt = 0; pt < 4; ++pt) {
            f32x4 ya = F4Z, yo = F4Z;
#pragma unroll
            for (int k = 0; k < 4; ++k) ya = mma(ya, ldf(XT, 136, hh * 64 + 16 * pt, 32 * k, lane), sA[k]);
#pragma unroll
            for (int k = 0; k < 2; ++k) yo = mma(yo, ldf(SP, 72, 16 * pt, 32 * k, lane), cmA[k]);
            const int p = 16 * pt + 4 * fq;
            const u32x2 zz = *(const u32x2*)(P + (size_t)(t0 + l) * P0LD + C_Z + 256 * g + hh * 64 + p);
            const float z[4] = {bflo(zz.x), bfhi(zz.x), bflo(zz.y), bfhi(zz.y)};
            float y[4];
#pragma unroll
            for (int v = 0; v < 4; ++v) {
                const float xs = bf2f(XT[(hh * 64 + p + v) * 136 + l]) * rdt;
                y[v] = (ya[v] + yo[v] * eal + dsk * xs) * siluf_(z[v]); ssq += y[v] * y[v];
            }
            u32x2 b; b.x = pk2(y[0], y[1]); b.y = pk2(y[2], y[3]);
            *(u32x2*)(Y + (size_t)(t0 + l) * D + 512 + 256 * g + hh * 64 + p) = b;
        }
    }
    ssq += __shfl_xor(ssq, 16); ssq += __shfl_xor(ssq, 32);
    const float rinv = rsqrtf(ssq * (1.f / 256.f) + 1e-5f);
#pragma unroll 4
    for (int q = 0; q < 16; ++q) {
        const int ch = 256 * g + 16 * q + 4 * fq; const f32x4 ng = *(const f32x4*)(C.in[17] + ch);
        u32x2* yp = (u32x2*)(Y + (size_t)(t0 + l) * D + 512 + ch); const u32x2 yy = *yp;
        u32x2 b; b.x = pk2(bflo(yy.x) * rinv * ng[0], bfhi(yy.x) * rinv * ng[1]); b.y = pk2(bflo(yy.y) * rinv * ng[2], bfhi(yy.y) * rinv * ng[3]);
        *yp = b;
    }
    __syncthreads();
}
__device__ __forceinline__ void ret_out_unit(const Ctx& C, int c, int h) {
    LAS bf16_t* KN = (LAS bf16_t*)C.lds; LAS bf16_t* VT = KN + 128 * 136; LAS bf16_t* ST = VT + 128 * 136; LAS bf16_t* STR = ST + 128 * 136 + C.wave * (16 * 136);
    const bf16_t* P = (const bf16_t*)(C.ws + WS_HP); const float* SR = (const float*)(C.ws + WS_ST); bf16_t* Y = (bf16_t*)(C.ws + WS_Y);
    const int t0 = c * 128, lane = C.lane, fr = lane & 15, fq = lane >> 4, w = C.wave, i0 = 16 * w, ii = i0 + fr;
    const float lg = ret_log_gamma(h);
    stage_rot<false>(P, t0, C_K + h * 128, KN, 136, 0.08838834764831845f, 0.f, false, 128, C.tid, 512);
    stage_vT(P, t0, C_V + h * 128, VT, 136, C.tid);
    {
        const float* src = SR + (size_t)(c * 4 + h) * 16384;
#pragma unroll
        for (int i = 0; i < 8; ++i) { const int e = (C.tid + 512 * i) * 4; const f32x4 v = *(const f32x4*)(src + e); u32x2 b; b.x = pk2(v[0], v[1]); b.y = pk2(v[2], v[3]); *(LAS u32x2*)(ST + (e >> 7) * 136 + (e & 127)) = b; }
    }
    stage_rot<false>(P, t0 + i0, C_Q + h * 128, STR, 136, 1.f, 0.f, false, 16, lane, 64);
    __syncthreads();
    bf16x8 qA[4];
#pragma unroll
    for (int k = 0; k < 4; ++k) qA[k] = ldf(STR, 136, 0, 32 * k, lane);
    __syncthreads();
#pragma unroll
    for (int jt = 0; jt < 8; ++jt) {
        f32x4 sa = F4Z;
        if (jt <= w) {
#pragma unroll
            for (int k = 0; k < 4; ++k) sa = mma(sa, ldf(KN, 136, 16 * jt, 32 * k, lane), qA[k]);
        }
        float sc[4];
#pragma unroll
        for (int v = 0; v < 4; ++v) { const int j = 16 * jt + 4 * fq + v; sc[v] = (jt <= w && j <= ii) ? sa[v] * __expf(lg * (float)(ii - j)) : 0.f; }
        u32x2 b; b.x = pk2(sc[0], sc[1]); b.y = pk2(sc[2], sc[3]); *(LAS u32x2*)(STR + fr * 136 + 16 * jt + 4 * fq) = b;
    }
    __syncthreads();
    bf16x8 sA[4];
#pragma unroll
    for (int k = 0; k < 4; ++k) sA[k] = ldf(STR, 136, 0, 32 * k, lane);
    const float qfs = __expf(lg * (float)(ii + 1));
    f32x4 o[8]; float ssq = 0.f;
#pragma unroll
    for (int et = 0; et < 8; ++et) {
        f32x4 a = F4Z, a2 = F4Z;
#pragma unroll
        for (int k = 0; k < 4; ++k) { a = mma(a, ldf(VT, 136, 16 * et, 32 * k, lane), sA[k]); a2 = mma(a2, ldf(ST, 136, 16 * et, 32 * k, lane), qA[k]); }
        o[et] = a + a2 * qfs;
        ssq += (o[et][0] * o[et][0] + o[et][1] * o[et][1]) + (o[et][2] * o[et][2] + o[et][3] * o[et][3]);
    }
    ssq += __shfl_xor(ssq, 16); ssq += __shfl_xor(ssq, 32);
    const float rinv = rsqrtf(ssq * (1.f / 128.f) + 1e-6f);
#pragma unroll
    for (int et = 0; et < 8; ++et) {
        const int ch = h * 128 + 16 * et + 4 * fq;
        const u32x2 gg = *(const u32x2*)(P + (size_t)(t0 + ii) * P0LD + C_G + ch);
        u32x2 b; b.x = pk2(o[et][0] * rinv * siluf_(bflo(gg.x)), o[et][1] * rinv * siluf_(bfhi(gg.x))); b.y = pk2(o[et][2] * rinv * siluf_(bflo(gg.y)), o[et][3] * rinv * siluf_(bfhi(gg.y)));
        *(u32x2*)(Y + (size_t)(t0 + ii) * D + ch) = b;
    }
    __syncthreads();
}
__device__ __forceinline__ void l0_output(const Ctx& C) {
    for (int u = C.bid; u < 256; u += C.G) mamba_out_unit(C, u >> 1, u & 1);
    for (int u = C.bid; u < 512; u += C.G) ret_out_unit(C, u >> 2, u & 3);
}

constexpr size_t WS_WLOG = WS_ST, WS_AA = WS_ST + 16 * MiB, WS_GG = WS_WGU1, WS_PC = WS_Y, WS_UC = WS_XB;
constexpr size_t WS_LA = WS_LRUC, WS_HC = WS_LRUC + 512 * 1024, WS_HIN = WS_LRUC + 1024 * 1024;
constexpr int SW_WAT = 0, SW_WXT = 65536, SW_W2T = 131072, SW_A2T = 163840, SW_G2T = 196608;
__device__ __forceinline__ bf16_t* gg_row(unsigned char* ws, int t) { return (bf16_t*)(ws + WS_GG) + (size_t)t * 512; }
__device__ __forceinline__ float tanhf_(float x) { return 1.f - 2.f * frcp(1.f + __expf(2.f * x)); }

__device__ __forceinline__ void rwkv_prep(const Ctx& C, int c) {
    const bf16_t* P = (const bf16_t*)(C.ws + WS_HP); const bf16_t* SW = (const bf16_t*)(C.ws + WS_SMALLW);
    bf16_t* WLOG = (bf16_t*)(C.ws + WS_WLOG); bf16_t* AA = (bf16_t*)(C.ws + WS_AA);
    LAS bf16_t* TW = (LAS bf16_t*)C.lds; LAS bf16_t* AL = TW + 64 * 72; LAS bf16_t* SG = AL + 64 * 72;
    const float* mu = C.in[27];
    const int t0 = 64 * c, lane = C.lane, fr = lane & 15, fq = lane >> 4;
    for (int idx = C.tid; idx < 64 * 288; idx += 512) {
        const int tok = idx / 288, cc = idx % 288, col = 2560 + cc, t = t0 + tok;
        const float cur = bf2f(P[(size_t)t * P1LD + col]), prev = t > 0 ? bf2f(P[(size_t)(t - 1) * P1LD + col]) : 0.f;
        const float s = cur + (prev - cur) * mu[col - 1024];
        if (cc < 64) TW[tok * 72 + cc] = f2bf(tanhf_(s)); else if (cc < 128) AL[tok * 72 + cc - 64] = f2bf(s); else SG[tok * 168 + cc - 128] = f2bf(sigmoidf_(s));
    }
    __syncthreads();
    const int n0 = 64 * C.wave;
#pragma unroll 1
    for (int which = 0; which < 2; ++which) {
        const bf16_t* BT = SW + (which == 0 ? SW_W2T : SW_A2T); const LAS bf16_t* AM = which == 0 ? TW : AL;
        const float* bias = which == 0 ? C.in[28] : C.in[30]; bf16_t* O = which == 0 ? WLOG : AA;
#pragma unroll 1
        for (int nt = 0; nt < 4; ++nt) {
            const bf16x8 nf0 = ldfg(BT, 64, n0 + 16 * nt, 0, lane), nf1 = ldfg(BT, 64, n0 + 16 * nt, 32, lane);
            const int n = n0 + 16 * nt + 4 * fq; const f32x4 bv = *(const f32x4*)(bias + n);
#pragma unroll
            for (int mt = 0; mt < 4; ++mt) {
                f32x4 acc = F4Z; acc = mma(acc, nf0, ldf(AM, 72, 16 * mt, 0, lane)); acc = mma(acc, nf1, ldf(AM, 72, 16 * mt, 32, lane));
                float o[4];
#pragma unroll
                for (int v = 0; v < 4; ++v) { const float x = acc[v] + bv[v]; o[v] = which == 0 ? -__expf(-softplusf_(-x) - 0.5f) : sigmoidf_(x); }
                u32x2 b; b.x = pk2(o[0], o[1]); b.y = pk2(o[2], o[3]);
                *(u32x2*)(O + (size_t)(t0 + 16 * mt + fr) * 512 + n) = b;
            }
        }
    }
#pragma unroll 1
    for (int nt = 0; nt < 4; ++nt) {
        bf16x8 nf[5];
#pragma unroll
        for (int k = 0; k < 5; ++k) nf[k] = ldfg(SW + SW_G2T, 160, n0 + 16 * nt, 32 * k, lane);
        const int n = n0 + 16 * nt + 4 * fq;
#pragma unroll
        for (int mt = 0; mt < 4; ++mt) {
            f32x4 acc = F4Z;
#pragma unroll
            for (int k = 0; k < 5; ++k) acc = mma(acc, nf[k], ldf(SG, 168, 16 * mt, 32 * k, lane));
#ifdef GG_CONSTVAL
            acc = (f32x4){0.5f, 0.25f, -0.5f, 1.f};
#endif
            u32x2 b; b.x = pk2(acc[0], acc[1]); b.y = pk2(acc[2], acc[3]);
            *(u32x2*)(gg_row(C.ws, t0 + 16 * mt + fr) + n) = b;
        }
    }
    asm volatile("s_waitcnt vmcnt(0)" ::: "memory");
    __threadfence_block();
    __syncthreads();
}

template <int PASS>
__device__ __forceinline__ void rwkv_chunk(const Ctx& C, int c) {
    const bf16_t* P = (const bf16_t*)(C.ws + WS_HP);
    const bf16_t* WLOG = (const bf16_t*)(C.ws + WS_WLOG); const bf16_t* AA = (const bf16_t*)(C.ws + WS_AA);
    float* PC = (float*)(C.ws + WS_PC); float* UC = (float*)(C.ws + WS_UC); bf16_t* Y = (bf16_t*)(C.ws + WS_Y);
    LAS float* VW = (LAS float*)(C.lds + 40960); LAS float* VKK = VW + 4096; LAS float* VB = VKK + 4096; LAS float* VK = VB + 4096; LAS float* VR = VK + 4096; LAS float* VV = VR + 4096; LAS float* VG = VV + 4096; LAS float* VBON = VG + 4096;
    const int t0 = 64 * c, lane = C.lane, head = C.wave, ch = C.tid;
    const float* mu = C.in[27];
    float SU[64], SP[64];
    if (PASS == 1) {
#pragma unroll
        for (int k = 0; k < 64; ++k) { SU[k] = 0.f; SP[k] = (k == lane) ? 1.f : 0.f; }
    } else {
        const f32x4* src = (const f32x4*)(UC + ((size_t)(c * 8 + head) * 64 + lane) * 64);
#pragma unroll
        for (int k4 = 0; k4 < 16; ++k4) { f32x4 v = src[k4];
#ifdef RW3_ZERO
            v = F4Z;
#endif
            SU[4 * k4] = v[0]; SU[4 * k4 + 1] = v[1]; SU[4 * k4 + 2] = v[2]; SU[4 * k4 + 3] = v[3]; }
    }
    float pr = 0.f, pk = 0.f, pv = 0.f;
    if (t0 > 0) { const bf16_t* row = P + (size_t)(t0 - 1) * P1LD; pr = bf2f(row[1024 + ch]); pk = bf2f(row[1536 + ch]); pv = bf2f(row[2048 + ch]); }
#pragma unroll 1
    for (int sb = 0; sb < 8; ++sb) {
        const float mu_r = mu[ch], mu_k = mu[512 + ch], mu_v = mu[1024 + ch], kkc = C.in[33][ch], kac = C.in[34][ch], rkc = C.in[35][ch];
#pragma unroll 2
        for (int j = 0; j < 8; ++j) {
            const int t = t0 + 8 * sb + j; const bf16_t* row = P + (size_t)t * P1LD;
            const float cr = bf2f(row[1024 + ch]), ck = bf2f(row[1536 + ch]), cv = bf2f(row[2048 + ch]);
            const float rs = cr + (pr - cr) * mu_r, ks = ck + (pk - ck) * mu_k, vs = cv + (pv - cv) * mu_v;
            pr = cr; pk = ck; pv = cv;
#if defined(RW3_CONST) || defined(RW3_CONST_AW)
            const float a = 0.5f, wl = -0.05f;
#else
            const float a = bf2f(AA[(size_t)t * 512 + ch]), wl = bf2f(WLOG[(size_t)t * 512 + ch]);
#endif
            const float kkr = ks * kkc, nrm = wave_sum(kkr * kkr), kk = kkr * rsqrtf(fmaxf(nrm, 1e-24f));
            const float kp = ks * (1.f + (a - 1.f) * kac);
            VW[j * 512 + ch] = __expf(wl); VKK[j * 512 + ch] = kk; VB[j * 512 + ch] = kk * a; VK[j * 512 + ch] = kp;
            VV[j * 512 + ch] = vs;
            if (PASS == 3) { VR[j * 512 + ch] = rs; const float bon = wave_sum(rs * kp * rkc); if (lane == 0) VBON[j * 8 + head] = bon;
#if defined(RW3_CONST) || defined(RW3_CONST_G)
                VG[j * 512 + ch] = 1.f; }
#else
                VG[j * 512 + ch] = bf2f(gg_row(C.ws, t)[ch]); }
#endif
        }
        __syncthreads();
#pragma unroll 1
        for (int j = 0; j < 8; ++j) {
            const LAS f32x4* pw = (const LAS f32x4*)(VW + j * 512 + head * 64); const LAS f32x4* pkk = (const LAS f32x4*)(VKK + j * 512 + head * 64);
            const LAS f32x4* pb = (const LAS f32x4*)(VB + j * 512 + head * 64); const LAS f32x4* pkp = (const LAS f32x4*)(VK + j * 512 + head * 64);
            const LAS f32x4* prr = (const LAS f32x4*)(VR + j * 512 + head * 64);
            float skU = 0.f, skP = 0.f;
            {
                f32x4 q = pkk[0];
#pragma unroll
                for (int k4 = 0; k4 < 16; ++k4) {
                    f32x4 qn = q; if (k4 + 1 < 16) qn = pkk[k4 + 1];
#pragma unroll
                    for (int i = 0; i < 4; ++i) { skU = fmaf(SU[4 * k4 + i], q[i], skU); if (PASS == 1) skP = fmaf(SP[4 * k4 + i], q[i], skP); }
                    q = qn;
                    __builtin_amdgcn_sched_barrier(0);
                }
            }
            const float vv = VV[j * 512 + ch]; float y = 0.f;
            {
                f32x4 w4 = pw[0], b4 = pb[0], k4v = pkp[0], r4 = F4Z; if (PASS == 3) r4 = prr[0];
#pragma unroll
                for (int k4 = 0; k4 < 16; ++k4) {
                    f32x4 nw = w4, nb = b4, nk = k4v, nr = r4;
                    if (k4 + 1 < 16) { nw = pw[k4 + 1]; nb = pb[k4 + 1]; nk = pkp[k4 + 1]; if (PASS == 3) nr = prr[k4 + 1]; }
#pragma unroll
                    for (int i = 0; i < 4; ++i) {
                        const float tt = fmaf(-skU, b4[i], vv * k4v[i]); SU[4 * k4 + i] = fmaf(SU[4 * k4 + i], w4[i], tt);
                        if (PASS == 1) SP[4 * k4 + i] = fmaf(SP[4 * k4 + i], w4[i], -skP * b4[i]);
                        if (PASS == 3) y = fmaf(SU[4 * k4 + i], r4[i], y);
                    }
                    w4 = nw; b4 = nb; k4v = nk; r4 = nr;
                    __builtin_amdgcn_sched_barrier(0);
                }
            }
            if (PASS == 3) {
                const float mean = wave_sum(y) * (1.f / 64.f), d = y - mean, var = wave_sum(d * d) * (1.f / 64.f);
                const float yn = d * rsqrtf(var + 64e-5f) * C.in[36][ch] + C.in[37][ch];
                Y[(size_t)(t0 + 8 * sb + j) * D + 512 + ch] = f2bf((yn + VBON[j * 8 + head] * vv) * VG[j * 512 + ch]);
            }
        }
        __syncthreads();
    }
    if (PASS == 1) {
        f32x4* du = (f32x4*)(UC + ((size_t)(c * 8 + head) * 64 + lane) * 64); f32x4* dp = (f32x4*)(PC + ((size_t)(c * 8 + head) * 64 + lane) * 64);
#pragma unroll
        for (int k4 = 0; k4 < 16; ++k4) { du[k4] = (f32x4){SU[4 * k4], SU[4 * k4 + 1], SU[4 * k4 + 2], SU[4 * k4 + 3]}; dp[k4] = (f32x4){SP[4 * k4], SP[4 * k4 + 1], SP[4 * k4 + 2], SP[4 * k4 + 3]}; }
    }
}

template <int PASS>
__device__ __forceinline__ void lru_chunk(const Ctx& C, int c) {
    const bf16_t* P = (const bf16_t*)(C.ws + WS_HP); const bf16_t* SW = (const bf16_t*)(C.ws + WS_SMALLW); bf16_t* Y = (bf16_t*)(C.ws + WS_Y);
    LAS bf16_t* XC = (LAS bf16_t*)C.lds; LAS bf16_t* LAB = (LAS bf16_t*)(C.lds + 66560);
    const int t0 = 64 * c, lane = C.lane, fr = lane & 15, fq = lane >> 4;
    {
        const int grp = C.tid & 63, seg = C.tid >> 6, ch0 = 8 * grp, r0 = 8 * seg;
        const float* cw = C.in[20]; const float* cb = C.in[21];
        float w0[8], w1[8], w2[8], w3[8], bb[8], x0[8], x1[8], x2[8];
#pragma unroll
        for (int i = 0; i < 8; ++i) { w0[i] = cw[ch0 + i]; w1[i] = cw[512 + ch0 + i]; w2[i] = cw[1024 + ch0 + i]; w3[i] = cw[1536 + ch0 + i]; bb[i] = cb[ch0 + i]; }
        auto ldrow = [&](int t, float (&x)[8]) {
            if (t < 0) {
#pragma unroll
                for (int i = 0; i < 8; ++i) x[i] = 0.f;
            } else {
                const u32x4 a = *(const u32x4*)(P + (size_t)t * P1LD + ch0);
#pragma unroll
                for (int i = 0; i < 4; ++i) { x[2 * i] = bflo(a[i]); x[2 * i + 1] = bfhi(a[i]); }
            }
        };
        ldrow(t0 + r0 - 3, x0); ldrow(t0 + r0 - 2, x1); ldrow(t0 + r0 - 1, x2);
#pragma unroll 1
        for (int row = r0; row < r0 + 8; ++row) {
            float x3[8], v[8]; ldrow(t0 + row, x3);
#pragma unroll
            for (int i = 0; i < 8; ++i) { v[i] = bb[i] + w0[i] * x0[i] + w1[i] * x1[i] + w2[i] * x2[i] + w3[i] * x3[i]; x0[i] = x1[i]; x1[i] = x2[i]; x2[i] = x3[i]; }
            u32x4 w; w.x = pk2(v[0], v[1]); w.y = pk2(v[2], v[3]); w.z = pk2(v[4], v[5]); w.w = pk2(v[6], v[7]);
            *(LAS u32x4*)(XC + row * 520 + ch0) = w;
        }
    }
    __syncthreads();
    const int nb = C.wave >> 1, eh = C.wave & 1, cbase = nb * 128 + 64 * eh;
#pragma unroll 1
    for (int mt = 0; mt < 4; ++mt) {
        bf16x8 mf[4];
#pragma unroll
        for (int k = 0; k < 4; ++k) mf[k] = ldf(XC, 520, 16 * mt, nb * 128 + 32 * k, lane);
        unsigned ur[4][2];
#pragma unroll
        for (int nt = 0; nt < 4; ++nt) {
            f32x4 aa = F4Z, ax = F4Z;
#pragma unroll
            for (int k = 0; k < 4; ++k) {
                aa = mma(aa, ldfg(SW + SW_WAT + nb * 16384, 128, 64 * eh + 16 * nt, 32 * k, lane), mf[k]);
                ax = mma(ax, ldfg(SW + SW_WXT + nb * 16384, 128, 64 * eh + 16 * nt, 32 * k, lane), mf[k]);
            }
            const int chn = cbase + 16 * nt + 4 * fq;
            const f32x4 bav = *(const f32x4*)(C.in[23] + chn), bxv = *(const f32x4*)(C.in[25] + chn), lam = *(const f32x4*)(C.in[26] + chn);
            const u32x2 xw = *(const LAS u32x2*)(XC + (16 * mt + fr) * 520 + chn);
            const float xc[4] = {bflo(xw.x), bfhi(xw.x), bflo(xw.y), bfhi(xw.y)};
            float la[4], uu[4];
#pragma unroll
            for (int v = 0; v < 4; ++v) { const float r = sigmoidf_(aa[v] + bav[v]), ig = sigmoidf_(ax[v] + bxv[v]); la[v] = -8.f * softplusf_(-lam[v]) * r; uu[v] = sqrtf(fmaxf(-expm1f(2.f * la[v]), 0.f)) * ig * xc[v]; }
            *(LAS u32x2*)(LAB + (16 * mt + fr) * 512 + chn) = (u32x2){pk2(la[0], la[1]), pk2(la[2], la[3])};
            ur[nt][0] = pk2(uu[0], uu[1]); ur[nt][1] = pk2(uu[2], uu[3]);
        }
        __syncthreads();
#pragma unroll
        for (int nt = 0; nt < 4; ++nt) *(LAS u32x2*)(XC + (16 * mt + fr) * 520 + cbase + 16 * nt + 4 * fq) = (u32x2){ur[nt][0], ur[nt][1]};
    }
    __syncthreads();
    {
        const int ch = C.tid;
        float* LA = (float*)(C.ws + WS_LA); float* HC = (float*)(C.ws + WS_HC); const float* HIN = (const float*)(C.ws + WS_HIN);
        float h = PASS == 3 ? HIN[c * 512 + ch] : 0.f, sla = 0.f;
#pragma unroll 4
        for (int tok = 0; tok < 64; ++tok) {
            const float la = bf2f(LAB[tok * 512 + ch]), u = bf2f(XC[tok * 520 + ch]);
            h = fmaf(__expf(la), h, u); sla += la;
            if (PASS == 3) {
                const float gb = bf2f(P[(size_t)(t0 + tok) * P1LD + 512 + ch]);
                const float ge = 0.5f * gb * (1.f + tanhf_(0.7978845608028654f * (gb + 0.044715f * gb * gb * gb)));
                Y[(size_t)(t0 + tok) * D + ch] = f2bf(h * ge);
            }
        }
        if (PASS == 1) { LA[c * 512 + ch] = sla; HC[c * 512 + ch] = h; }
    }
    __syncthreads();
}

__device__ __forceinline__ void l1_pass_a(const Ctx& C) {
#ifndef SKIP_PREP
    for (int c = C.bid; c < 256; c += C.G) rwkv_prep(C, c);
#endif
#ifndef SKIP_RW1
    for (int c = C.bid; c < 256; c += C.G) rwkv_chunk<1>(C, c);
#endif
#ifndef SKIP_LRU1
    for (int c = C.bid; c < 256; c += C.G) lru_chunk<1>(C, c);
#endif
}
__device__ __forceinline__ void l1_pass_c(const Ctx& C) {
#ifndef SKIP_RW3
    for (int c = C.bid; c < 256; c += C.G) rwkv_chunk<3>(C, c);
#endif
#ifndef SKIP_LRU3
    for (int c = C.bid; c < 256; c += C.G) lru_chunk<3>(C, c);
#endif
}

__device__ __forceinline__ void l1_middle(const Ctx& C) {
    const float* PC = (const float*)(C.ws + WS_PC); float* UC = (float*)(C.ws + WS_UC);
    const int lane = C.lane;
#ifndef SKIP_MID
    for (int gw = C.bid * 8 + C.wave; gw < 512; gw += C.G * 8) {
        const int head = gw >> 6, row = gw & 63;
        LAS float* SR = (LAS float*)(C.lds + C.wave * 256);
        float s = 0.f; SR[lane] = 0.f;
        float pa[64], pb[64];
#pragma unroll
        for (int i = 0; i < 64; ++i) pa[i] = PC[((size_t)(0 * 8 + head) * 64 + i) * 64 + lane];
        float* ub = UC + ((size_t)head * 64 + row) * 64 + lane;
        float u_cur = ub[0];
#pragma unroll 1
        for (int c = 0; c < 256; c += 2) {
            {
                const float u_nxt = ub[(size_t)(c + 1) * 32768];
#pragma unroll
                for (int i = 0; i < 64; ++i) pb[i] = PC[((size_t)((c + 1) * 8 + head) * 64 + i) * 64 + lane];
                ub[(size_t)c * 32768] = s;
                float a0 = 0.f, a1 = 0.f, a2 = 0.f, a3 = 0.f;
#pragma unroll
                for (int i4 = 0; i4 < 16; ++i4) { const f32x4 s4 = *(const LAS f32x4*)(SR + 4 * i4); a0 = fmaf(s4[0], pa[4 * i4], a0); a1 = fmaf(s4[1], pa[4 * i4 + 1], a1); a2 = fmaf(s4[2], pa[4 * i4 + 2], a2); a3 = fmaf(s4[3], pa[4 * i4 + 3], a3); }
                s = u_cur + ((a0 + a1) + (a2 + a3)); SR[lane] = s; u_cur = u_nxt;
            }
            {
                const int cn = (c + 2 < 256) ? c + 2 : 255;
                const float u_nxt = ub[(size_t)cn * 32768];
#pragma unroll
                for (int i = 0; i < 64; ++i) pa[i] = PC[((size_t)(cn * 8 + head) * 64 + i) * 64 + lane];
                ub[(size_t)(c + 1) * 32768] = s;
                float a0 = 0.f, a1 = 0.f, a2 = 0.f, a3 = 0.f;
#pragma unroll
                for (int i4 = 0; i4 < 16; ++i4) { const f32x4 s4 = *(const LAS f32x4*)(SR + 4 * i4); a0 = fmaf(s4[0], pb[4 * i4], a0); a1 = fmaf(s4[1], pb[4 * i4 + 1], a1); a2 = fmaf(s4[2], pb[4 * i4 + 2], a2); a3 = fmaf(s4[3], pb[4 * i4 + 3], a3); }
                s = u_cur + ((a0 + a1) + (a2 + a3)); SR[lane] = s; u_cur = u_nxt;
            }
        }
    }
#endif
    if (C.bid == (C.G > 64 ? 64 : 0)) {
        const float* LA = (const float*)(C.ws + WS_LA); const float* HC = (const float*)(C.ws + WS_HC); float* HIN = (float*)(C.ws + WS_HIN);
        const int ch = C.tid; float h = 0.f;
        for (int c0 = 0; c0 < 256; c0 += 8) { float la[8], hc[8];
#pragma unroll
            for (int j = 0; j < 8; ++j) { la[j] = LA[(c0 + j) * 512 + ch]; hc[j] = HC[(c0 + j) * 512 + ch]; }
#pragma unroll
            for (int j = 0; j < 8; ++j) { HIN[(c0 + j) * 512 + ch] = h; h = fmaf(__expf(la[j]), h, hc[j]); } }
    }
}

struct Args { const float* in[39]; float* out; unsigned char* ws; int ph_lo, ph_hi; };
constexpr int N_PHASES = 20;

__device__ __forceinline__ void ffn_gu(const Ctx& C, LAS unsigned char* lds, size_t wgu, int site) {
    pg8::Gemm g{(const bf16_t*)(C.ws + WS_XB), (const bf16_t*)(C.ws + wgu), T, 2 * FF, D}; pg8::StaticOrder S; S.init(T, 2 * FF, C.G, C.bid);
    EpiSwiglu E{(bf16_t*)(C.ws + WS_HP), (const float*)(C.ws + WS_SSQ) + (size_t)site * T * 16};
    pg8::gemm_phase<EpiSwiglu, pg8::StaticOrder, true, true>(lds, g, S, E);
}
__device__ __forceinline__ void ffn_down(const Ctx& C, LAS unsigned char* lds, size_t wd, int site_out, float alpha = 0.5f) {
    pg8::Gemm g{(const bf16_t*)(C.ws + WS_HP), (const bf16_t*)(C.ws + wd), T, D, FF}; pg8::StaticOrder S; S.init(T, D, C.G, C.bid);
    EpiResid E{C.X, (bf16_t*)(C.ws + WS_XB), (float*)(C.ws + WS_SSQ) + (size_t)site_out * T * 16, alpha};
    pg8::gemm_phase<EpiResid, pg8::StaticOrder, true, true>(lds, g, S, E);
}
__device__ __forceinline__ void out_proj(const Ctx& C, LAS unsigned char* lds, int site_out) {
    pg8::Gemm g{(const bf16_t*)(C.ws + WS_Y), (const bf16_t*)(C.ws + WS_WOUT), T, D, D}; pg8::StaticOrder S; S.init(T, D, C.G, C.bid);
    EpiResid E{C.X, (bf16_t*)(C.ws + WS_XB), (float*)(C.ws + WS_SSQ) + (size_t)site_out * T * 16, 1.0f};
    pg8::gemm_phase<EpiResid, pg8::StaticOrder, true, true>(lds, g, S, E);
}

__global__ void __launch_bounds__(512) mk_fwd(Args args) {
    extern __shared__ __attribute__((aligned(16))) unsigned char lds_raw[];
    cg::grid_group grid = cg::this_grid();
    Ctx C; C.in = args.in; C.X = args.out; C.ws = args.ws; C.lds = (LAS unsigned char*)lds_raw;
    C.tid = threadIdx.x; C.lane = C.tid & 63; C.wave = __builtin_amdgcn_readfirstlane(C.tid >> 6); C.G = gridDim.x; C.bid = blockIdx.x;
    LAS unsigned char* lds = C.lds;
    const int lo = args.ph_lo, hi = args.ph_hi;
#define IN(k) (lo <= (k) && (k) < hi)
#ifndef REP_MASK
#define REP_MASK 0
#endif
#define REPS(k) (((REP_MASK >> (k)) & 1) ? 2 : 1)
#define SEAM(k) do { if (IN(k) && IN((k) + 1)) { asm volatile("s_waitcnt vmcnt(0)" ::: "memory");     \
    grid.sync(); if (C.wave == 0) { __builtin_amdgcn_fence(__ATOMIC_ACQUIRE, "agent"); asm volatile("s_waitcnt vmcnt(0)" ::: "memory"); } __syncthreads(); } } while (0)

    if (IN(0)) {
        convert_weights(C, 0, 7);
        bf16_t* sw = (bf16_t*)(C.ws + WS_SMALLW);
        for (int n = 0; n < 4; ++n) { tr_small(C, C.in[22] + n * 16384, 128, 128, sw + n * 16384); tr_small(C, C.in[24] + n * 16384, 128, 128, sw + 65536 + n * 16384); }
        tr_small(C, C.in[29], 64, 512, sw + 131072); tr_small(C, C.in[31], 64, 512, sw + 163840); tr_small(C, C.in[32], 160, 512, sw + 196608);
        prologue_x(C);
    }
    SEAM(0);
    if (IN(1)) { ffn_gu(C, lds, WS_WGU1, 0); if (REPS(1) == 2) ffn_gu(C, lds, WS_WGU1, 0); }
    SEAM(1);
    if (IN(2)) { ffn_down(C, lds, WS_WD1, 1, 0.5f); if (REPS(2) == 2) ffn_down(C, lds, WS_WD1, 1, 0.f); }
    SEAM(2);
    if (IN(3)) {
        pg8::Gemm g{(const bf16_t*)(C.ws + WS_XB), (const bf16_t*)(C.ws + WS_WIN), T, 3584, D}; pg8::StaticOrder S; S.init(T, 3584, C.G, C.bid);
        EpiProj E{(bf16_t*)(C.ws + WS_HP), P0LD, 3328, (const float*)(C.ws + WS_SSQ) + (size_t)1 * T * 16, (float*)(C.ws + WS_DT), 3328};
        pg8::gemm_phase<EpiProj, pg8::StaticOrder, true, true>(lds, g, S, E);
    }
    SEAM(3);
    #ifndef SKIP4
    if (IN(4)) { l0_states(C); if (REPS(4) == 2) l0_states(C); }
#endif
    SEAM(4);
    #ifndef SKIP5
    if (IN(5)) { l0_scan(C); __syncthreads(); convert_weights(C, 1, 1); }
#endif
    SEAM(5);
    #ifndef SKIP6
    if (IN(6)) { l0_output(C); if (REPS(6) == 2) l0_output(C); }
#endif
    SEAM(6);
    if (IN(7)) out_proj(C, lds, 2);
    SEAM(7);
    if (IN(8)) { convert_weights(C, 1, 2); __syncthreads(); ffn_gu(C, lds, WS_WGU2, 2); }
    SEAM(8);
    if (IN(9)) ffn_down(C, lds, WS_WD2, 3);
    SEAM(9);
    if (IN(10)) ffn_gu(C, lds, WS_WGU1, 3);
    SEAM(10);
    if (IN(11)) ffn_down(C, lds, WS_WD1, 4);
    SEAM(11);
    if (IN(12)) {
        pg8::Gemm g{(const bf16_t*)(C.ws + WS_XB), (const bf16_t*)(C.ws + WS_WIN), T, 3072, D}; pg8::StaticOrder S; S.init(T, 3072, C.G, C.bid);
        EpiProj E{(bf16_t*)(C.ws + WS_HP), P1LD, 2848, (const float*)(C.ws + WS_SSQ) + (size_t)4 * T * 16, nullptr, -1};
        pg8::gemm_phase<EpiProj, pg8::StaticOrder, true, true>(lds, g, S, E);
    }
    SEAM(12);
    if (IN(13)) { l1_pass_a(C); if (REPS(13) == 2) l1_pass_a(C); }
    SEAM(13);
    if (IN(14)) { l1_middle(C); __syncthreads(); convert_weights(C, 1, 4); }
    SEAM(14);
    if (IN(15)) { l1_pass_c(C); if (REPS(15) == 2) l1_pass_c(C); }
    SEAM(15);
    if (IN(16)) out_proj(C, lds, 5);
    SEAM(16);
    if (IN(17)) ffn_gu(C, lds, WS_WGU2, 5);
    SEAM(17);
    if (IN(18)) ffn_down(C, lds, WS_WD2, 6);
    SEAM(18);
    if (IN(19)) final_norm(C);
#undef IN
#undef SEAM
}

extern "C" void kernel_launch(void* const* d_in, const int* in_sizes, int n_in, void* d_out, int out_size, void* d_ws, size_t ws_size, hipStream_t stream) {
    static int grid = 0;
    if (grid == 0) {
        if (n_in != 39 || out_size != T * D || ws_size < WS_END) { fprintf(stderr, "kernel_launch: unexpected problem: n_in %d out %d ws %zu\n", n_in, out_size, ws_size); grid = -1; return; }
        int dev = 0, cus = 0, per_cu = 0;
        hipGetDevice(&dev); hipDeviceGetAttribute(&cus, hipDeviceAttributeMultiprocessorCount, dev);
        if (hipFuncSetAttribute((const void*)mk_fwd, hipFuncAttributeMaxDynamicSharedMemorySize, LDS_BYTES) != hipSuccess) { fprintf(stderr, "kernel_launch: hipFuncSetAttribute failed\n"); grid = -1; return; }
        if (hipOccupancyMaxActiveBlocksPerMultiprocessor(&per_cu, (const void*)mk_fwd, 512, LDS_BYTES) != hipSuccess || per_cu < 1) { fprintf(stderr, "kernel_launch: occupancy query says %d\n", per_cu); per_cu = 1; (void)hipGetLastError(); }
        grid = cus * (per_cu > 1 ? 1 : per_cu);
    }
    if (grid < 0) return;
    Args a{};
    for (int i = 0; i < 39; ++i) a.in[i] = (const float*)d_in[i];
    a.out = (float*)d_out; a.ws = (unsigned char*)d_ws; a.ph_lo = 0; a.ph_hi = N_PHASES;
    void* kargs[] = {&a};
    hipError_t e = hipLaunchCooperativeKernel((const void*)mk_fwd, dim3(grid), dim3(512), kargs, LDS_BYTES, stream);
    if (e != hipSuccess) fprintf(stderr, "kernel_launch: cooperative launch failed: %s (grid %d)\n", hipGetErrorString(e), grid);
}
```

```cpp
#include <hip/hip_runtime.h>
#include <hip/hip_cooperative_groups.h>
#include <cstdio>
#include <cstdint>
namespace cg = cooperative_groups;
namespace pg8 {
#define PG8_LAS __attribute__((address_space(3)))
typedef unsigned short bf16_t;
typedef short bf16x8 __attribute__((ext_vector_type(8)));
typedef float f32x4 __attribute__((ext_vector_type(4)));
typedef unsigned u32x4 __attribute__((ext_vector_type(4)));
constexpr int BM = 256, BK = 64, HALF = 128, HTB = HALF * BK * 2  , STAGE_BYTES = 8 * HTB, NXCD = 8, WGM = 8;

__host__ __device__ __forceinline__ int lds_byte(int r, int c) { const int st = (r >> 4) * 2 + (c >> 5), rr = r & 15, cc = c & 31, ob = rr * 64 + cc * 2; return st * 1024 + (ob ^ (((ob >> 9) & 1) << 5)); }
__host__ __device__ __forceinline__ void stage_rc(int b, int& R, int& C) { const int st = b / 1024, sb = b % 1024, swz = sb ^ (((sb >> 9) & 1) << 5); R = (st >> 1) * 16 + swz / 64; C = (st & 1) * 32 + (swz % 64) / 2; }
__host__ __device__ __forceinline__ int perm32(int rho) { const int n = rho >> 4, i = rho & 15; return 8 * (i >> 2) + 4 * n + (i & 3); }

struct Unit { int pm, pn; };
struct Gemm { const bf16_t* A; const bf16_t* Bt; int M, N, K; };

struct StaticOrder {
    int nM, nN, nwg, G, c;
    __host__ __device__ void init(int M, int N, int G_, int c_) { nM = M / BM; nN = N / BM; nwg = nM * nN; G = G_; c = c_; }
    __host__ __device__ bool next(int i, Unit& u) const {
        const long L = (long)i * G + c; if (L >= nwg) return false;
        int wgid = (int)L; { const int q = nwg / NXCD, r = nwg % NXCD, xcd = wgid % NXCD, off = wgid / NXCD; wgid = (xcd < r ? xcd * (q + 1) : r * (q + 1) + (xcd - r) * q) + off; }
        const int nig = WGM * nN, gid = wgid / nig, fm = gid * WGM, gsz = (nM - fm) < WGM ? (nM - fm) : WGM;
        u.pm = fm + ((wgid % nig) % gsz); u.pn = (wgid % nig) / gsz; return true;
    }
    __device__ __forceinline__ void a_ready(const Unit&) const {}
    __device__ __forceinline__ void done(const Unit&) const {}
};
__device__ __forceinline__ unsigned cvt_pk_bf16(float lo, float hi) { unsigned r; asm volatile("v_cvt_pk_bf16_f32 %0, %1, %2" : "=v"(r) : "v"(lo), "v"(hi)); return r; }
template <class Epi, class Sched, bool ALIGN_EPI = false, bool SP2 = false>
__device__ __forceinline__ void gemm_phase(PG8_LAS unsigned char* lds, const Gemm g, const Sched& S, const Epi& E) {
    const int tid = threadIdx.x, wid = __builtin_amdgcn_readfirstlane(tid >> 6), lane = tid & 63, wr = wid >> 2, wc = wid & 3, fr = lane & 15, fq = lane >> 4;
    const int K = g.K, nt = K / BK;
    unsigned voffA[2], voffB[2];
#pragma unroll
    for (int i = 0; i < 2; ++i) { int R, C; stage_rc(tid * 16 + i * 8192, R, C); const int Rb = Epi::PERM ? ((R & ~31) + perm32(R & 31)) : R;
        voffA[i] = (unsigned)(R * K + C) * 2u; voffB[i] = (unsigned)(Rb * K + C) * 2u; }
    const size_t kstep = (size_t)(BK * 2);
    const size_t hstep = (size_t)HALF * K * 2;
    const size_t tstep = 2 * hstep;
    const unsigned ldsw = (unsigned)wid * 1024u;
    const int aoff = lds_byte(wr * 64 + fr, fq * 8), boff = lds_byte(wc * 32 + fr, fq * 8);
#define PG8_SA(b, h) (((b) * 2 + (h)) * HTB)
#define PG8_SB(b, h) ((4 + (b) * 2 + (h)) * HTB)
#define PG8_STAGE(bufoff, gbase, voff) do { _Pragma("unroll") for (int _i = 0; _i < 2; ++_i) \
        __builtin_amdgcn_global_load_lds((const unsigned*)((const char*)(gbase) + (voff)[_i]), (PG8_LAS unsigned*)(lds + (bufoff) + ldsw + _i * 8192), 16, 0, 0); } while (0)
#define PG8_LDA(dst, b, h) do { _Pragma("unroll") for (int m = 0; m < 4; ++m) _Pragma("unroll") for (int k = 0; k < 2; ++k) dst[m][k] = *(const PG8_LAS bf16x8*)(lds + PG8_SA(b, h) + aoff + m * 2048 + k * 1024); } while (0)
#define PG8_LDB(dst, b, h) do { _Pragma("unroll") for (int n = 0; n < 2; ++n) _Pragma("unroll") for (int k = 0; k < 2; ++k) dst[n][k] = *(const PG8_LAS bf16x8*)(lds + PG8_SB(b, h) + boff + n * 2048 + k * 1024); } while (0)
#define PG8_MMA(ai, bj, At, Bt) do { __builtin_amdgcn_s_setprio(1); _Pragma("unroll") for (int m = 0; m < 4; ++m) _Pragma("unroll") for (int n = 0; n < 2; ++n) _Pragma("unroll") for (int k = 0; k < 2; ++k) \
        acc[ai][bj][m][n] = __builtin_amdgcn_mfma_f32_16x16x32_bf16(Bt[n][k], At[m][k], acc[ai][bj][m][n], 0, 0, 0); __builtin_amdgcn_s_setprio(0); } while (0)
#define PG8_WAIT_V(n) asm volatile("s_waitcnt vmcnt(" #n ")" ::: "memory")
#define PG8_WAIT_L(n) asm volatile("s_waitcnt lgkmcnt(" #n ")" ::: "memory")
#define PG8_BAR __builtin_amdgcn_s_barrier()
#define PG8_SCHED __builtin_amdgcn_sched_barrier(0)
    Unit cur, nxt; int ui = 0;
    if (!S.next(0, cur)) return;
    f32x4 acc[2][2][4][2];
#pragma unroll
    for (int a = 0; a < 2; ++a)
#pragma unroll
        for (int b = 0; b < 2; ++b)
#pragma unroll
            for (int m = 0; m < 4; ++m)
#pragma unroll
                for (int n = 0; n < 2; ++n) acc[a][b][m][n] = (f32x4){0.f, 0.f, 0.f, 0.f};
    bf16x8 At[4][2], B0[2][2], B1[2][2];
    const char* cA = (const char*)g.A + (size_t)cur.pm * tstep; const char* cB = (const char*)g.Bt + (size_t)cur.pn * tstep;
    S.a_ready(cur);
    if constexpr (SP2) {
        PG8_STAGE(PG8_SB(0, 0), cB, voffB); PG8_STAGE(PG8_SB(0, 1), cB + hstep, voffB); PG8_STAGE(PG8_SA(0, 0), cA, voffA); PG8_STAGE(PG8_SA(0, 1), cA + hstep, voffA);
        if (wr == 1) PG8_BAR;
        PG8_WAIT_V(2); PG8_BAR;
        PG8_STAGE(PG8_SB(1, 0), cB + kstep, voffB); PG8_STAGE(PG8_SA(1, 0), cA + kstep, voffA); PG8_STAGE(PG8_SB(1, 1), cB + hstep + kstep, voffB);
        PG8_WAIT_V(6); PG8_BAR;
    } else {
        PG8_STAGE(PG8_SB(0, 0), cB, voffB); PG8_STAGE(PG8_SA(0, 0), cA, voffA); PG8_STAGE(PG8_SB(0, 1), cB + hstep, voffB); PG8_STAGE(PG8_SA(0, 1), cA + hstep, voffA);
        if (wr == 1) PG8_BAR;
        PG8_WAIT_V(4); PG8_BAR;
        PG8_STAGE(PG8_SB(1, 0), cB + kstep, voffB); PG8_STAGE(PG8_SA(1, 0), cA + kstep, voffA); PG8_STAGE(PG8_SB(1, 1), cB + hstep + kstep, voffB);
        PG8_WAIT_V(6); PG8_BAR;
    }
    for (;;) {
        const bool has_next = S.next(ui + 1, nxt);
        const char* nA = has_next ? (const char*)g.A + (size_t)nxt.pm * tstep : cA; const char* nB = has_next ? (const char*)g.Bt + (size_t)nxt.pn * tstep : cB;
        for (int t = 0; t < nt; t += 2) {
            const bool last = (t == nt - 2);
            const char* a1 = cA + (size_t)(t + 1) * kstep;
            const char* a2 = last ? nA : cA + (size_t)(t + 2) * kstep; const char* b2 = last ? nB : cB + (size_t)(t + 2) * kstep;
            const char* a3 = a2 + kstep; const char* b3 = b2 + kstep;
            if (last && has_next) S.a_ready(nxt);
            if constexpr (SP2) {
            PG8_LDB(B0, 0, 0); PG8_LDB(B1, 0, 1); PG8_SCHED; PG8_LDA(At, 0, 0); PG8_STAGE(PG8_SA(1, 1), a1 + hstep, voffA);
            PG8_WAIT_V(8); PG8_WAIT_L(0); PG8_BAR; PG8_MMA(0, 0, At, B0); PG8_MMA(0, 1, At, B1); PG8_BAR; PG8_SCHED;
            PG8_LDA(At, 0, 1); PG8_STAGE(PG8_SB(0, 0), b2, voffB); PG8_STAGE(PG8_SB(0, 1), b2 + hstep, voffB); PG8_STAGE(PG8_SA(0, 0), a2, voffA);
            PG8_WAIT_V(8); PG8_WAIT_L(0); PG8_BAR; PG8_MMA(1, 0, At, B0); PG8_MMA(1, 1, At, B1); PG8_BAR; PG8_SCHED;
            PG8_LDB(B0, 1, 0); PG8_LDB(B1, 1, 1); PG8_SCHED; PG8_LDA(At, 1, 0); PG8_STAGE(PG8_SA(0, 1), a2 + hstep, voffA);
            PG8_WAIT_V(8); PG8_WAIT_L(0); PG8_BAR; PG8_MMA(0, 0, At, B0); PG8_MMA(0, 1, At, B1); PG8_BAR; PG8_SCHED;
            PG8_LDA(At, 1, 1); PG8_STAGE(PG8_SB(1, 0), b3, voffB); PG8_STAGE(PG8_SB(1, 1), b3 + hstep, voffB); PG8_STAGE(PG8_SA(1, 0), a3, voffA);
            PG8_WAIT_V(8); PG8_WAIT_L(0); PG8_BAR; PG8_MMA(1, 0, At, B0); PG8_MMA(1, 1, At, B1); PG8_BAR; PG8_SCHED;
            } else {
            PG8_LDB(B0, 0, 0); PG8_SCHED; PG8_LDA(At, 0, 0); PG8_STAGE(PG8_SA(1, 1), a1 + hstep, voffA);
            PG8_WAIT_L(8); PG8_BAR; PG8_WAIT_L(0); PG8_MMA(0, 0, At, B0); PG8_BAR; PG8_SCHED;
            PG8_LDB(B1, 0, 1); PG8_STAGE(PG8_SB(0, 0), b2, voffB);
            PG8_BAR; PG8_WAIT_L(0); PG8_MMA(0, 1, At, B1); PG8_BAR;
            PG8_LDA(At, 0, 1); PG8_STAGE(PG8_SA(0, 0), a2, voffA);
            PG8_BAR; PG8_WAIT_L(0); PG8_MMA(1, 0, At, B0); PG8_BAR; PG8_SCHED;
            PG8_STAGE(PG8_SB(0, 1), b2 + hstep, voffB);
            PG8_WAIT_V(6); PG8_BAR; PG8_MMA(1, 1, At, B1); PG8_BAR;
            PG8_LDB(B0, 1, 0); PG8_SCHED; PG8_LDA(At, 1, 0); PG8_STAGE(PG8_SA(0, 1), a2 + hstep, voffA);
            PG8_WAIT_L(8); PG8_BAR; PG8_WAIT_L(0); PG8_MMA(0, 0, At, B0); PG8_BAR; PG8_SCHED;
            PG8_LDB(B1, 1, 1); PG8_STAGE(PG8_SB(1, 0), b3, voffB);
            PG8_BAR; PG8_WAIT_L(0); PG8_MMA(0, 1, At, B1); PG8_BAR;
            PG8_LDA(At, 1, 1); PG8_STAGE(PG8_SA(1, 0), a3, voffA);
            PG8_BAR; PG8_WAIT_L(0); PG8_MMA(1, 0, At, B0); PG8_BAR; PG8_SCHED;
            PG8_STAGE(PG8_SB(1, 1), b3 + hstep, voffB);
            PG8_WAIT_V(6); PG8_BAR; PG8_MMA(1, 1, At, B1); PG8_BAR;
            }
        }
        if constexpr (ALIGN_EPI) { if (wr == 0) PG8_BAR; }
        if constexpr (!Epi::AFTER_DRAIN) { E(acc, cur, wr, wc, fr, fq); S.done(cur); }
        if (!has_next) break;
#pragma unroll
        for (int a = 0; a < 2; ++a)
#pragma unroll
            for (int b = 0; b < 2; ++b)
#pragma unroll
                for (int m = 0; m < 4; ++m)
#pragma unroll
                    for (int n = 0; n < 2; ++n) acc[a][b][m][n] = (f32x4){0.f, 0.f, 0.f, 0.f};
        cur = nxt; cA = nA; cB = nB; ++ui;
        if constexpr (ALIGN_EPI) { if (wr == 1) PG8_BAR; }
    }
    PG8_WAIT_V(0);
    if constexpr (!ALIGN_EPI) { if (wr == 0) PG8_BAR; }
    PG8_BAR;
    if constexpr (Epi::AFTER_DRAIN) { E.fused(acc, cur, wr, wc, fr, fq, lds, wid, lane); S.done(cur); }
#undef PG8_SA
#undef PG8_SB
#undef PG8_STAGE
#undef PG8_LDA
#undef PG8_LDB
#undef PG8_MMA
#undef PG8_WAIT_V
#undef PG8_WAIT_L
#undef PG8_BAR
#undef PG8_SCHED
}
}

#define LAS __attribute__((address_space(3)))
typedef unsigned short bf16_t;
typedef short bf16x8 __attribute__((ext_vector_type(8)));
typedef float f32x4 __attribute__((ext_vector_type(4)));
typedef float f32x2 __attribute__((ext_vector_type(2)));
typedef unsigned u32x4 __attribute__((ext_vector_type(4)));
typedef unsigned u32x2 __attribute__((ext_vector_type(2)));

constexpr int T = 16384, D = 1024, FF = 2816;
constexpr int P0LD = 3328, P1LD = 2880;
constexpr int C_Q = 0, C_K = 512, C_V = 1024, C_G = 1536, C_Z = 2048, C_XBC = 2560;
constexpr size_t MiB = 1u << 20;
constexpr size_t WS_SSQ = 247 * MiB, WS_DT = 512 * 1024, WS_LRUC = 1 * MiB, WS_CHD = 2 * MiB + 512 * 1024, WS_SMALLW = 3 * MiB;
constexpr size_t WS_WGU1 = 4 * MiB, WS_WD1 = 15 * MiB, WS_WIN = 21 * MiB, WS_WOUT = 28 * MiB, WS_WGU2 = 30 * MiB, WS_WD2 = 41 * MiB;
constexpr size_t WS_XB = 47 * MiB, WS_Y = 79 * MiB, WS_HP = 111 * MiB, WS_ST = 215 * MiB, WS_END = 255 * MiB;
constexpr int LDS_BYTES = 163840;

typedef float f32x2_t __attribute__((ext_vector_type(2)));
typedef __bf16 bf16x2_t __attribute__((ext_vector_type(2)));
__device__ __forceinline__ unsigned pk2(float lo, float hi) { f32x2_t v = {lo, hi}; bf16x2_t b = __builtin_convertvector(v, bf16x2_t); return __builtin_bit_cast(unsigned, b); }
__device__ __forceinline__ unsigned short f2bf(float f) { return (unsigned short)(pk2(f, 0.f) & 0xffffu); }
__device__ __forceinline__ float bflo(unsigned w) { return __uint_as_float(w << 16); }
__device__ __forceinline__ float bfhi(unsigned w) { return __uint_as_float(w & 0xffff0000u); }
__device__ __forceinline__ float bf2f(unsigned short h) { return __uint_as_float(((unsigned)h) << 16); }
__device__ __forceinline__ float frcp(float x) { return __builtin_amdgcn_rcpf(x); }
__device__ __forceinline__ float sigmoidf_(float x) { return frcp(1.f + __expf(-x)); }
__device__ __forceinline__ float siluf_(float x) { return x * frcp(1.f + __expf(-x)); }
__device__ __forceinline__ float softplusf_(float x) { return x > 20.f ? x : log1pf(__expf(x)); }
__device__ __forceinline__ float wave_sum(float v) {
#pragma unroll
    for (int o = 1; o < 64; o <<= 1) v += __shfl_xor(v, o);
    return v;
}
__device__ __forceinline__ f32x4 mma(f32x4 acc, bf16x8 nfrag, bf16x8 mfrag) { return __builtin_amdgcn_mfma_f32_16x16x32_bf16(nfrag, mfrag, acc, 0, 0, 0); }
__device__ __forceinline__ bf16x8 ldf(const LAS bf16_t* base, int stride, int row0, int k0, int lane) { return *(const LAS bf16x8*)(base + (row0 + (lane & 15)) * stride + k0 + 8 * (lane >> 4)); }
__device__ __forceinline__ bf16x8 ldfg(const bf16_t* base, int stride, int row0, int k0, int lane) { return *(const bf16x8*)(base + (size_t)(row0 + (lane & 15)) * stride + k0 + 8 * (lane >> 4)); }
#define F4Z ((f32x4){0.f, 0.f, 0.f, 0.f})
__device__ __forceinline__ float ssq_row(const float* ssq, int row) {
    float s = 0.f;
#pragma unroll
    for (int k = 0; k < 16; ++k) s += ssq[(size_t)k * T + row];
    return s;
}

struct Ctx {
    const float* const* in; float* X; unsigned char* ws; LAS unsigned char* lds;
    int tid, lane, wave, G, bid;
};

__device__ __forceinline__ void tr_item(const float* W, int K, int N, bf16_t* WT, const float* gain, int k0, int n0, int drow0, LAS float* scr, int lane) {
    const int nn = n0 + (lane & 31);
    float wv[32];
#pragma unroll
    for (int i = 0; i < 32; ++i) { const int kk = 2 * i + (lane >> 5); wv[i] = (nn < N) ? W[(size_t)(k0 + kk) * N + nn] : 0.f; }
#pragma unroll
    for (int i = 0; i < 32; ++i) { const int kk = 2 * i + (lane >> 5); float v = wv[i]; if (gain) v *= gain[k0 + kk]; scr[kk * 33 + (lane & 31)] = v; }
    asm volatile("s_waitcnt lgkmcnt(0)" ::: "memory");
    const int c = lane & 7;
#pragma unroll
    for (int j = 0; j < 4; ++j) { const int n = (lane >> 3) + 8 * j; const LAS float* s = scr + (8 * c) * 33 + n;
        u32x4 o; o.x = pk2(s[0 * 33], s[1 * 33]); o.y = pk2(s[2 * 33], s[3 * 33]); o.z = pk2(s[4 * 33], s[5 * 33]); o.w = pk2(s[6 * 33], s[7 * 33]);
        if (n0 + n < N) *(u32x4*)(WT + (size_t)(drow0 + n) * K + k0 + 8 * c) = o; }
    asm volatile("s_waitcnt lgkmcnt(0)" ::: "memory");
}
__device__ __forceinline__ void tr_matrix(const Ctx& C, const float* W, int K, int N, bf16_t* WT, const float* gain, int mode, int& base) {
    LAS float* scr = (LAS float*)(C.lds + C.wave * 8448);
    const int nblk = (N + 31) / 32, nitems = (K / 64) * nblk, gw = C.bid * 8 + C.wave, ngw = C.G * 8;
    int first = (gw - (base % ngw) + ngw) % ngw;
    for (int it = first; it < nitems; it += ngw) {
        const int kb = it / nblk, nb = it % nblk, n0 = 32 * nb;
        const int drow0 = mode == 0 ? n0 : ((n0 >> 7) * 256 + (n0 & 127) + (mode == 2 ? 128 : 0));
        tr_item(W, K, N, WT, gain, 64 * kb, n0, drow0, scr, C.lane);
    }
    base += nitems;
}
__device__ __forceinline__ void convert_weights(const Ctx& C, int layer, int which) {
    int base = 0; unsigned char* ws = C.ws;
    if (which & 1) {
        tr_matrix(C, C.in[2] + (size_t)layer * D * FF, D, FF, (bf16_t*)(ws + WS_WGU1), C.in[1] + layer * D, 1, base);
        tr_matrix(C, C.in[3] + (size_t)layer * D * FF, D, FF, (bf16_t*)(ws + WS_WGU1), C.in[1] + layer * D, 2, base);
        tr_matrix(C, C.in[4] + (size_t)layer * D * FF, FF, D, (bf16_t*)(ws + WS_WD1), nullptr, 0, base);
    }
    if (which & 2) {
        if (layer == 0) { tr_matrix(C, C.in[10], D, 3336, (bf16_t*)(ws + WS_WIN), C.in[5], 0, base); tr_matrix(C, C.in[11], D, D, (bf16_t*)(ws + WS_WOUT), nullptr, 0, base); }
        else            { tr_matrix(C, C.in[18], D, 2848, (bf16_t*)(ws + WS_WIN), C.in[5] + D, 0, base); tr_matrix(C, C.in[19], D, D, (bf16_t*)(ws + WS_WOUT), nullptr, 0, base); }
    }
    if (which & 4) {
        tr_matrix(C, C.in[7] + (size_t)layer * D * FF, D, FF, (bf16_t*)(ws + WS_WGU2), C.in[6] + layer * D, 1, base);
        tr_matrix(C, C.in[8] + (size_t)layer * D * FF, D, FF, (bf16_t*)(ws + WS_WGU2), C.in[6] + layer * D, 2, base);
        tr_matrix(C, C.in[9] + (size_t)layer * D * FF, FF, D, (bf16_t*)(ws + WS_WD2), nullptr, 0, base);
    }
}
__device__ __forceinline__ void tr_small(const Ctx& C, const float* W, int K, int N, bf16_t* WT) {
    for (int idx = C.bid * 512 + C.tid; idx < K * N; idx += C.G * 512) { const int n = idx / K, k = idx % K; WT[idx] = f2bf(W[(size_t)k * N + n]); }
}

struct EpiSwiglu {
    static constexpr bool PERM = true, AFTER_DRAIN = false;
    bf16_t* H; const float* ssq;
    __device__ __forceinline__ void operator()(const f32x4 (&acc)[2][2][4][2], const pg8::Unit& u, int wr, int wc, int fr, int fq) const {
        const int row0 = u.pm * 256 + wr * 64 + fr, col0 = u.pn * 128 + wc * 32 + 8 * fq;
#pragma unroll
        for (int ai = 0; ai < 2; ++ai)
#pragma unroll
            for (int m = 0; m < 4; ++m) {
                const int row = row0 + ai * 128 + m * 16; const float r = rsqrtf(ssq_row(ssq, row) * (1.f / D) + 1e-6f);
                float h[8];
#pragma unroll
                for (int n = 0; n < 2; ++n)
#pragma unroll
                    for (int v = 0; v < 4; ++v) { const float g = acc[ai][0][m][n][v] * r, up = acc[ai][1][m][n][v] * r; h[4 * n + v] = siluf_(g) * up; }
                u32x4 w; w.x = pk2(h[0], h[1]); w.y = pk2(h[2], h[3]); w.z = pk2(h[4], h[5]); w.w = pk2(h[6], h[7]);
                *(u32x4*)(H + (size_t)row * FF + col0) = w;
            }
    }
};
struct EpiResid {
    static constexpr bool PERM = false, AFTER_DRAIN = false;
    float* X; bf16_t* XB; float* ssq_out; float alpha;
    __device__ __forceinline__ void operator()(const f32x4 (&acc)[2][2][4][2], const pg8::Unit& u, int wr, int wc, int fr, int fq) const {
        const int row0 = u.pm * 256 + wr * 64 + fr, col0 = u.pn * 256 + wc * 32 + 4 * fq;
#pragma unroll
        for (int ai = 0; ai < 2; ++ai)
#pragma unroll
            for (int m = 0; m < 4; ++m) {
                const int row = row0 + ai * 128 + m * 16; float s = 0.f;
#pragma unroll
                for (int bj = 0; bj < 2; ++bj)
#pragma unroll
                    for (int n = 0; n < 2; ++n) {
                        const size_t off = (size_t)row * D + col0 + bj * 128 + n * 16;
                        f32x4 x = *(const f32x4*)(X + off); x = x + acc[ai][bj][m][n] * alpha;
                        *(f32x4*)(X + off) = x; u32x2 b; b.x = pk2(x[0], x[1]); b.y = pk2(x[2], x[3]); *(u32x2*)(XB + off) = b;
                        s += (x[0] * x[0] + x[1] * x[1]) + (x[2] * x[2] + x[3] * x[3]);
                    }
                s += __shfl_xor(s, 16); s += __shfl_xor(s, 32);
                if (fq == 0) ssq_out[(size_t)(u.pn * 4 + wc) * T + row] = s;
            }
    }
};
struct EpiProj {
    static constexpr bool PERM = true, AFTER_DRAIN = false;
    bf16_t* P; int ldp, ncols; const float* ssq; float* DT; int dt_col0;
    __device__ __forceinline__ void operator()(const f32x4 (&acc)[2][2][4][2], const pg8::Unit& u, int wr, int wc, int fr, int fq) const {
        const int row0 = u.pm * 256 + wr * 64 + fr, col0 = u.pn * 256 + wc * 32 + 8 * fq;
#pragma unroll
        for (int ai = 0; ai < 2; ++ai)
#pragma unroll
            for (int m = 0; m < 4; ++m) {
                const int row = row0 + ai * 128 + m * 16; const float r = rsqrtf(ssq_row(ssq, row) * (1.f / D) + 1e-6f);
#pragma unroll
                for (int bj = 0; bj < 2; ++bj) {
                    const int c = col0 + bj * 128; const f32x4 v0 = acc[ai][bj][m][0] * r, v1 = acc[ai][bj][m][1] * r;
                    if (c + 8 <= ncols) { u32x4 w; w.x = pk2(v0[0], v0[1]); w.y = pk2(v0[2], v0[3]); w.z = pk2(v1[0], v1[1]); w.w = pk2(v1[2], v1[3]); *(u32x4*)(P + (size_t)row * ldp + c) = w; }
                    else if (DT && c == dt_col0) { *(f32x4*)(DT + (size_t)row * 8) = v0; *(f32x4*)(DT + (size_t)row * 8 + 4) = v1; }
                }
            }
    }
};

__device__ __forceinline__ void prologue_x(const Ctx& C) {
    const float* x = C.in[0]; bf16_t* XB = (bf16_t*)(C.ws + WS_XB); float* ssq = (float*)(C.ws + WS_SSQ);
    const int gw = C.bid * 8 + C.wave, ngw = C.G * 8;
    for (int m = gw; m < T; m += ngw) {
        const f32x4* xr = (const f32x4*)(x + (size_t)m * D) + C.lane; f32x4* orow = (f32x4*)(C.X + (size_t)m * D) + C.lane; u32x2* brow = (u32x2*)(XB + (size_t)m * D) + C.lane;
        float s = 0.f;
#pragma unroll
        for (int j = 0; j < 4; ++j) { const f32x4 v = xr[64 * j]; orow[64 * j] = v; u32x2 b; b.x = pk2(v[0], v[1]); b.y = pk2(v[2], v[3]); brow[64 * j] = b; s += (v[0] * v[0] + v[1] * v[1]) + (v[2] * v[2] + v[3] * v[3]); }
        s = wave_sum(s);
        if (C.lane == 0) ssq[m] = s;
    }
    for (int i = C.bid * 512 + C.tid; i < 15 * T; i += C.G * 512) ssq[T + i] = 0.f;
}
__device__ __forceinline__ void final_norm(const Ctx& C) {
    const float* ssq = (const float*)(C.ws + WS_SSQ) + (size_t)6 * T * 16; const float* g = C.in[38];
    const int gw = C.bid * 8 + C.wave, ngw = C.G * 8;
    f32x4 gv[4];
#pragma unroll
    for (int j = 0; j < 4; ++j) gv[j] = ((const f32x4*)g)[C.lane + 64 * j];
    for (int m = gw; m < T; m += ngw) {
        f32x4* xr = (f32x4*)(C.X + (size_t)m * D) + C.lane; const float r = rsqrtf(ssq_row(ssq, m) * (1.f / D) + 1e-6f);
#pragma unroll
        for (int j = 0; j < 4; ++j) { f32x4 v = xr[64 * j]; v = v * r * gv[j];
#ifdef SANITIZE
#pragma unroll
            for (int q = 0; q < 4; ++q) v[q] = (fabsf(v[q]) < 1e30f) ? v[q] : 0.f;
#endif
            xr[64 * j] = v; }
    }
}

__device__ __forceinline__ float ret_log_gamma(int h) { return logf(1.f - exp2f(-5.f - (float)h)); }

template <bool TR>
__device__ __forceinline__ void stage_rot(const bf16_t* P, int t0, int col0, LAS bf16_t* dst, int stride, float scale, float lg, bool kte, int nrows, int tl, int nth) {
    for (int it = tl; it < nrows * 8; it += nth) {
        const int row = it >> 3, d0 = (it & 7) * 8, t = t0 + row;
        const bf16_t* src = P + (size_t)t * P0LD + col0 + d0;
        const u32x4 a = *(const u32x4*)src, b = *(const u32x4*)(src + 64);
        const float rs = scale * (kte ? __expf(lg * (float)(127 - row)) : 1.f);
        float o1[8], o2[8];
#pragma unroll
        for (int i = 0; i < 8; ++i) {
            const unsigned wa = a[i >> 1], wb = b[i >> 1];
            const float x1 = (i & 1) ? bfhi(wa) : bflo(wa), x2 = (i & 1) ? bfhi(wb) : bflo(wb);
            const float invf = exp2f(-(float)(d0 + i) * (13.287712379549449f / 64.f));
            const float ang = (float)t * invf, n = rintf(ang * 0.15915494309189535f);
            float r = fmaf(-n, 6.2831854820251465f, ang); r = fmaf(-n, -1.7484556e-7f, r);
            const float s = __sinf(r), c = __cosf(r);
            o1[i] = (x1 * c - x2 * s) * rs; o2[i] = (x2 * c + x1 * s) * rs;
        }
        if (TR) {
#pragma unroll
            for (int i = 0; i < 8; ++i) { dst[(d0 + i) * stride + row] = f2bf(o1[i]); dst[(64 + d0 + i) * stride + row] = f2bf(o2[i]); }
        } else {
            u32x4 w1, w2; w1.x = pk2(o1[0], o1[1]); w1.y = pk2(o1[2], o1[3]); w1.z = pk2(o1[4], o1[5]); w1.w = pk2(o1[6], o1[7]);
            w2.x = pk2(o2[0], o2[1]); w2.y = pk2(o2[2], o2[3]); w2.z = pk2(o2[4], o2[5]); w2.w = pk2(o2[6], o2[7]);
            *(LAS u32x4*)(dst + row * stride + d0) = w1; *(LAS u32x4*)(dst + row * stride + 64 + d0) = w2;
        }
    }
}
__device__ __forceinline__ void stage_vT(const bf16_t* P, int t0, int col0, LAS bf16_t* dst, int stride, int tid) {
    for (int it = tid; it < 128 * 16; it += 512) {
        const int row = it >> 4, e0 = (it & 15) * 8;
        const u32x4 a = *(const u32x4*)(P + (size_t)(t0 + row) * P0LD + col0 + e0);
#pragma unroll
        for (int i = 0; i < 8; ++i) { const unsigned w = a[i >> 1]; dst[(e0 + i) * stride + row] = (unsigned short)((i & 1) ? (w >> 16) : (w & 0xffffu)); }
    }
}

__device__ __forceinline__ void stage_dt(const Ctx& C, int t0, int g, LAS float* DTS, LAS float* AS, LAS float* ACS) {
    const int l = C.tid & 127, hh = C.tid >> 7, h = 4 * g + hh;
    const float* DT = (const float*)(C.ws + WS_DT);
    const float dtv = softplusf_(DT[(size_t)(t0 + l) * 8 + h] + C.in[14][h]);
    DTS[hh * 128 + l] = dtv; AS[hh * 128 + l] = -dtv * __expf(C.in[15][h]);
    __syncthreads();
    float s = 0.f;
    for (int i = 0; i <= l; ++i) s += AS[hh * 128 + i];
    ACS[hh * 128 + l] = s;
    __syncthreads();
}

template <int NGRP, int MODE>
__device__ __forceinline__ void stage_conv(const Ctx& C, int t0, int g, LAS bf16_t* XT, LAS bf16_t* BB, LAS bf16_t* CC, const LAS float* DTS, const LAS float* ACS) {
    constexpr int NSEG = 512 / NGRP, RP = (128 + NSEG - 1) / NSEG;
    if (C.tid >= NGRP * NSEG) return;
    const bf16_t* P = (const bf16_t*)(C.ws + WS_HP);
    const int grp = C.tid % NGRP, seg = C.tid / NGRP;
    const int ch0 = grp < 32 ? 256 * g + 8 * grp : (grp < 40 ? 512 + 64 * g + 8 * (grp - 32) : 640 + 64 * g + 8 * (grp - 40));
    const float* cw = C.in[12]; const float* cb = C.in[13];
    float w0[8], w1[8], w2[8], w3[8], bb[8], x0[8], x1[8], x2[8];
#pragma unroll
    for (int i = 0; i < 8; ++i) { w0[i] = cw[ch0 + i]; w1[i] = cw[768 + ch0 + i]; w2[i] = cw[1536 + ch0 + i]; w3[i] = cw[2304 + ch0 + i]; bb[i] = cb[ch0 + i]; }
    const int r0 = seg * RP, r1 = (r0 + RP < 128) ? r0 + RP : 128;
    auto ldrow = [&](int t, float (&x)[8]) {
        if (t < 0) {
#pragma unroll
            for (int i = 0; i < 8; ++i) x[i] = 0.f;
        } else {
            const u32x4 a = *(const u32x4*)(P + (size_t)t * P0LD + C_XBC + ch0);
#pragma unroll
            for (int i = 0; i < 4; ++i) { x[2 * i] = bflo(a[i]); x[2 * i + 1] = bfhi(a[i]); }
        }
    };
    ldrow(t0 + r0 - 3, x0); ldrow(t0 + r0 - 2, x1); ldrow(t0 + r0 - 1, x2);
    for (int row = r0; row < r1; ++row) {
        float x3[8], v[8]; ldrow(t0 + row, x3);
#pragma unroll
        for (int i = 0; i < 8; ++i) { float s = bb[i] + w0[i] * x0[i] + w1[i] * x1[i] + w2[i] * x2[i] + w3[i] * x3[i]; v[i] = siluf_(s); x0[i] = x1[i]; x1[i] = x2[i]; x2[i] = x3[i]; }
        if (grp < 32) {
            const int hh = grp >> 3;
            float sc = DTS[hh * 128 + row]; if (MODE == 0) sc *= __expf(ACS[hh * 128 + 127] - ACS[hh * 128 + row]);
#pragma unroll
            for (int i = 0; i < 8; ++i) XT[(8 * grp + i) * 136 + row] = f2bf(v[i] * sc);
        } else if (MODE == 0) {
#pragma unroll
            for (int i = 0; i < 8; ++i) BB[(8 * (grp - 32) + i) * 136 + row] = f2bf(v[i]);
        } else {
            u32x4 w; w.x = pk2(v[0], v[1]); w.y = pk2(v[2], v[3]); w.z = pk2(v[4], v[5]); w.w = pk2(v[6], v[7]);
            if (grp < 40) *(LAS u32x4*)(BB + row * 72 + 8 * (grp - 32)) = w; else *(LAS u32x4*)(CC + row * 72 + 8 * (grp - 40)) = w;
        }
    }
}

__device__ __forceinline__ void ret_state_unit(const Ctx& C, int c, int h) {
    const bf16_t* P = (const bf16_t*)(C.ws + WS_HP); float* SR = (float*)(C.ws + WS_ST);
    LAS bf16_t* KT = (LAS bf16_t*)C.lds; LAS bf16_t* VT = KT + 128 * 136;
    const int t0 = c * 128, lane = C.lane, fr = lane & 15, fq = lane >> 4;
    stage_rot<true>(P, t0, C_K + h * 128, KT, 136, 0.08838834764831845f, ret_log_gamma(h), true, 128, C.tid, 512);
    stage_vT(P, t0, C_V + h * 128, VT, 136, C.tid);
    __syncthreads();
    const int e0 = 16 * C.wave; bf16x8 mf[4];
#pragma unroll
    for (int k = 0; k < 4; ++k) mf[k] = ldf(VT, 136, e0, 32 * k, lane);
    float* out = SR + ((size_t)(c * 4 + h) * 128 + e0 + fr) * 128 + 4 * fq;
#pragma unroll
    for (int dt = 0; dt < 8; ++dt) { f32x4 acc = F4Z;
#pragma unroll
        for (int k = 0; k < 4; ++k) acc = mma(acc, ldf(KT, 136, 16 * dt, 32 * k, lane), mf[k]);
        *(f32x4*)(out + 16 * dt) = acc; }
    __syncthreads();
}
__device__ __forceinline__ void mamba_state_unit(const Ctx& C, int c, int g) {
    LAS bf16_t* XT = (LAS bf16_t*)C.lds; LAS bf16_t* BT = XT + 256 * 136;
    LAS float* DTS = (LAS float*)(C.lds + 150528); LAS float* ACS = DTS + 512; LAS float* AS = ACS + 512;
    float* SM = (float*)(C.ws + WS_XB); float* CHD = (float*)(C.ws + WS_CHD);
    const int t0 = c * 128, lane = C.lane, fr = lane & 15, fq = lane >> 4;
    stage_dt(C, t0, g, DTS, AS, ACS);
    stage_conv<40, 0>(C, t0, g, XT, BT, nullptr, DTS, ACS);
    if (C.tid < 4) CHD[(c * 2 + g) * 32 + C.tid] = __expf(ACS[C.tid * 128 + 127]);
    __syncthreads();
    const int hh = C.wave >> 1, ph = C.wave & 1;
#pragma unroll
    for (int pt = 0; pt < 2; ++pt) {
        const int p0 = ph * 32 + 16 * pt; bf16x8 mf[4];
#pragma unroll
        for (int k = 0; k < 4; ++k) mf[k] = ldf(XT, 136, hh * 64 + p0, 32 * k, lane);
        float* out = SM + ((size_t)(c * 8 + 4 * g + hh) * 64 + p0 + fr) * 64 + 4 * fq;
#pragma unroll
        for (int nt = 0; nt < 4; ++nt) { f32x4 acc = F4Z;
#pragma unroll
            for (int k = 0; k < 4; ++k) acc = mma(acc, ldf(BT, 136, 16 * nt, 32 * k, lane), mf[k]);
            *(f32x4*)(out + 16 * nt) = acc; }
    }
    __syncthreads();
}
__device__ __forceinline__ void l0_states(const Ctx& C) {
    for (int u = C.bid; u < 256; u += C.G) mamba_state_unit(C, u >> 1, u & 1);
    for (int u = C.bid; u < 512; u += C.G) ret_state_unit(C, u >> 2, u & 3);
}

__device__ __forceinline__ void l0_scan(const Ctx& C) {
    float* SR = (float*)(C.ws + WS_ST); float* SM = (float*)(C.ws + WS_XB); const float* CHD = (const float*)(C.ws + WS_CHD);
    for (int idx = C.bid * 512 + C.tid; idx < 65536 + 32768; idx += C.G * 512) {
        if (idx < 65536) {
            const float dec = __expf(128.f * ret_log_gamma(idx >> 14)); float s = 0.f; float* p = SR + idx;
            for (int c0 = 0; c0 < 128; c0 += 8) { float kv[8];
#pragma unroll
                for (int j = 0; j < 8; ++j) kv[j] = p[(size_t)(c0 + j) * 65536];
#pragma unroll
                for (int j = 0; j < 8; ++j) { p[(size_t)(c0 + j) * 65536] = s; s = s * dec + kv[j]; } }
        } else {
            const int e = idx - 65536, head = e >> 12; float s = 0.f; float* p = SM + e;
            for (int c0 = 0; c0 < 128; c0 += 8) { float kv[8], dc[8];
#pragma unroll
                for (int j = 0; j < 8; ++j) { kv[j] = p[(size_t)(c0 + j) * 32768]; dc[j] = CHD[((c0 + j) * 2 + (head >> 2)) * 32 + (head & 3)]; }
#pragma unroll
                for (int j = 0; j < 8; ++j) { p[(size_t)(c0 + j) * 32768] = s; s = s * dc[j] + kv[j]; } }
        }
    }
}

__device__ __forceinline__ void mamba_out_unit(const Ctx& C, int c, int g) {
    LAS bf16_t* XT = (LAS bf16_t*)C.lds; LAS bf16_t* BM = (LAS bf16_t*)(C.lds + 69632); LAS bf16_t* CM = (LAS bf16_t*)(C.lds + 88064);
    LAS bf16_t* SP = (LAS bf16_t*)(C.lds + 106496); LAS bf16_t* STR = (LAS bf16_t*)(C.lds + 115712) + C.wave * (16 * 136);
    LAS float* DTS = (LAS float*)(C.lds + 150528); LAS float* ACS = DTS + 512; LAS float* AS = ACS + 512;
    const bf16_t* P = (const bf16_t*)(C.ws + WS_HP); const float* SM = (const float*)(C.ws + WS_XB); bf16_t* Y = (bf16_t*)(C.ws + WS_Y);
    const int t0 = c * 128, lane = C.lane, fr = lane & 15, fq = lane >> 4, w = C.wave, l0 = 16 * w, l = l0 + fr;
    stage_dt(C, t0, g, DTS, AS, ACS);
    stage_conv<48, 1>(C, t0, g, XT, BM, CM, DTS, ACS);
    __syncthreads();
    bf16x8 cmA[2]; cmA[0] = ldf(CM, 72, l0, 0, lane); cmA[1] = ldf(CM, 72, l0, 32, lane);
    f32x4 cb[8];
#pragma unroll
    for (int st = 0; st < 8; ++st) { cb[st] = F4Z; if (st <= w) { cb[st] = mma(cb[st], ldf(BM, 72, 16 * st, 0, lane), cmA[0]); cb[st] = mma(cb[st], ldf(BM, 72, 16 * st, 32, lane), cmA[1]); } }
    float ssq = 0.f;
#pragma unroll 1
    for (int hh = 0; hh < 4; ++hh) {
        const int h = 4 * g + hh;
        __syncthreads();
        {
            const float* src = SM + (size_t)(c * 8 + h) * 4096;
#pragma unroll
            for (int i = 0; i < 2; ++i) { const int e = (C.tid + 512 * i) * 4; const f32x4 v = *(const f32x4*)(src + e); u32x2 b; b.x = pk2(v[0], v[1]); b.y = pk2(v[2], v[3]); *(LAS u32x2*)(SP + (e >> 6) * 72 + (e & 63)) = b; }
        }
        const float al = ACS[hh * 128 + l];
#pragma unroll
        for (int st = 0; st < 8; ++st) {
            const f32x4 as4 = *(const LAS f32x4*)(ACS + hh * 128 + 16 * st + 4 * fq); float sc[4];
#pragma unroll
            for (int v = 0; v < 4; ++v) { const int s = 16 * st + 4 * fq + v; sc[v] = (st <= w && s <= l) ? cb[st][v] * __expf(al - as4[v]) : 0.f; }
            u32x2 b; b.x = pk2(sc[0], sc[1]); b.y = pk2(sc[2], sc[3]); *(LAS u32x2*)(STR + fr * 136 + 16 * st + 4 * fq) = b;
        }
        __syncthreads();
        bf16x8 sA[4];
#pragma unroll
        for (int k = 0; k < 4; ++k) sA[k] = ldf(STR, 136, 0, 32 * k, lane);
        const float eal = __expf(al), dsk = C.in[16][h], rdt = frcp(DTS[hh * 128 + l]);
#pragma unroll
        for (int pt = 0; pt < 4; ++pt) {
            f32x4 ya = F4Z, yo = F4Z;
#pragma unroll
            for (int k = 0; k < 4; ++k) ya = mma(ya, ldf(XT, 136, hh * 64 + 16 * pt, 32 * k, lane), sA[k]);
#pragma unroll
            for (int k = 0; k < 2; ++k) yo = mma(yo, ldf(SP, 72, 16 * pt, 32 * k, lane), cmA[k]);
            const int p = 16 * pt + 4 * fq;
            const u32x2 zz = *(const u32x2*)(P + (size_t)(t0 + l) * P0LD + C_Z + 256 * g + hh * 64 + p);
            const float z[4] = {bflo(zz.x), bfhi(zz.x), bflo(zz.y), bfhi(zz.y)};
            float y[4];
#pragma unroll
            for (int v = 0; v < 4; ++v) {
                const float xs = bf2f(XT[(hh * 64 + p + v) * 136 + l]) * rdt;
                y[v] = (ya[v] + yo[v] * eal + dsk * xs) * siluf_(z[v]); ssq += y[v] * y[v];
            }
            u32x2 b; b.x = pk2(y[0], y[1]); b.y = pk2(y[2], y[3]);
            *(u32x2*)(Y + (size_t)(t0 + l) * D + 512 + 256 * g + hh * 64 + p) = b;
        }
    }
    ssq += __shfl_xor(ssq, 16); ssq += __shfl_xor(ssq, 32);
    const float rinv = rsqrtf(ssq * (1.f / 256.f) + 1e-5f);
#pragma unroll 4
    for (int q = 0; q < 16; ++q) {
        const int ch = 256 * g + 16 * q + 4 * fq; const f32x4 ng = *(const f32x4*)(C.in[17] + ch);
        u32x2* yp = (u32x2*)(Y + (size_t)(t0 + l) * D + 512 + ch); const u32x2 yy = *yp;
        u32x2 b; b.x = pk2(bflo(yy.x) * rinv * ng[0], bfhi(yy.x) * rinv * ng[1]); b.y = pk2(bflo(yy.y) * rinv * ng[2], bfhi(yy.y) * rinv * ng[3]);
        *yp = b;
    }
    __syncthreads();
}
__device__ __forceinline__ void ret_out_unit(const Ctx& C, int c, int h) {
    LAS bf16_t* KN = (LAS bf16_t*)C.lds; LAS bf16_t* VT = KN + 128 * 136; LAS bf16_t* ST = VT + 128 * 136; LAS bf16_t* STR = ST + 128 * 136 + C.wave * (16 * 136);
    const bf16_t* P = (const bf16_t*)(C.ws + WS_HP); const float* SR = (const float*)(C.ws + WS_ST); bf16_t* Y = (bf16_t*)(C.ws + WS_Y);
    const int t0 = c * 128, lane = C.lane, fr = lane & 15, fq = lane >> 4, w = C.wave, i0 = 16 * w, ii = i0 + fr;
    const float lg = ret_log_gamma(h);
    stage_rot<false>(P, t0, C_K + h * 128, KN, 136, 0.08838834764831845f, 0.f, false, 128, C.tid, 512);
    stage_vT(P, t0, C_V + h * 128, VT, 136, C.tid);
    {
        const float* src = SR + (size_t)(c * 4 + h) * 16384;
#pragma unroll
        for (int i = 0; i < 8; ++i) { const int e = (C.tid + 512 * i) * 4; const f32x4 v = *(const f32x4*)(src + e); u32x2 b; b.x = pk2(v[0], v[1]); b.y = pk2(v[2], v[3]); *(LAS u32x2*)(ST + (e >> 7) * 136 + (e & 127)) = b; }
    }
    stage_rot<false>(P, t0 + i0, C_Q + h * 128, STR, 136, 1.f, 0.f, false, 16, lane, 64);
    __syncthreads();
    bf16x8 qA[4];
#pragma unroll
    for (int k = 0; k < 4; ++k) qA[k] = ldf(STR, 136, 0, 32 * k, lane);
    __syncthreads();
#pragma unroll
    for (int jt = 0; jt < 8; ++jt) {
        f32x4 sa = F4Z;
        if (jt <= w) {
#pragma unroll
            for (int k = 0; k < 4; ++k) sa = mma(sa, ldf(KN, 136, 16 * jt, 32 * k, lane), qA[k]);
        }
        float sc[4];
#pragma unroll
        for (int v = 0; v < 4; ++v) { const int j = 16 * jt + 4 * fq + v; sc[v] = (jt <= w && j <= ii) ? sa[v] * __expf(lg * (float)(ii - j)) : 0.f; }
        u32x2 b; b.x = pk2(sc[0], sc[1]); b.y = pk2(sc[2], sc[3]); *(LAS u32x2*)(STR + fr * 136 + 16 * jt + 4 * fq) = b;
    }
    __syncthreads();
    bf16x8 sA[4];
#pragma unroll
    for (int k = 0; k < 4; ++k) sA[k] = ldf(STR, 136, 0, 32 * k, lane);
    const float qfs = __expf(lg * (float)(ii + 1));
    f32x4 o[8]; float ssq = 0.f;
#pragma unroll
    for (int et = 0; et < 8; ++et) {
        f32x4 a = F4Z, a2 = F4Z;
#pragma unroll
        for (int k = 0; k < 4; ++k) { a = mma(a, ldf(VT, 136, 16 * et, 32 * k, lane), sA[k]); a2 = mma(a2, ldf(ST, 136, 16 * et, 32 * k, lane), qA[k]); }
        o[et] = a + a2 * qfs;
        ssq += (o[et][0] * o[et][0] + o[et][1] * o[et][1]) + (o[et][2] * o[et][2] + o[et][3] * o[et][3]);
    }
    ssq += __shfl_xor(ssq, 16); ssq += __shfl_xor(ssq, 32);
    const float rinv = rsqrtf(ssq * (1.f / 128.f) + 1e-6f);
#pragma unroll
    for (int et = 0; et < 8; ++et) {
        const int ch = h * 128 + 16 * et + 4 * fq;
        const u32x2 gg = *(const u32x2*)(P + (size_t)(t0 + ii) * P0LD + C_G + ch);
        u32x2 b; b.x = pk2(o[et][0] * rinv * siluf_(bflo(gg.x)), o[et][1] * rinv * siluf_(bfhi(gg.x))); b.y = pk2(o[et][2] * rinv * siluf_(bflo(gg.y)), o[et][3] * rinv * siluf_(bfhi(gg.y)));
        *(u32x2*)(Y + (size_t)(t0 + ii) * D + ch) = b;
    }
    __syncthreads();
}
__device__ __forceinline__ void l0_output(const Ctx& C) {
    for (int u = C.bid; u < 256; u += C.G) mamba_out_unit(C, u >> 1, u & 1);
    for (int u = C.bid; u < 512; u += C.G) ret_out_unit(C, u >> 2, u & 3);
}

constexpr size_t WS_WLOG = WS_ST, WS_AA = WS_ST + 16 * MiB, WS_GG = WS_WGU1, WS_PC = WS_Y, WS_UC = WS_XB;
constexpr size_t WS_LA = WS_LRUC, WS_HC = WS_LRUC + 512 * 1024, WS_HIN = WS_LRUC + 1024 * 1024;
constexpr int SW_WAT = 0, SW_WXT = 65536, SW_W2T = 131072, SW_A2T = 163840, SW_G2T = 196608;
__device__ __forceinline__ bf16_t* gg_row(unsigned char* ws, int t) { return (bf16_t*)(ws + WS_GG) + (size_t)t * 512; }
__device__ __forceinline__ float tanhf_(float x) { return 1.f - 2.f * frcp(1.f + __expf(2.f * x)); }

__device__ __forceinline__ void rwkv_prep(const Ctx& C, int c) {
    const bf16_t* P = (const bf16_t*)(C.ws + WS_HP); const bf16_t* SW = (const bf16_t*)(C.ws + WS_SMALLW);
    bf16_t* WLOG = (bf16_t*)(C.ws + WS_WLOG); bf16_t* AA = (bf16_t*)(C.ws + WS_AA);
    LAS bf16_t* TW = (LAS bf16_t*)C.lds; LAS bf16_t* AL = TW + 64 * 72; LAS bf16_t* SG = AL + 64 * 72;
    const float* mu = C.in[27];
    const int t0 = 64 * c, lane = C.lane, fr = lane & 15, fq = lane >> 4;
    for (int idx = C.tid; idx < 64 * 288; idx += 512) {
        const int tok = idx / 288, cc = idx % 288, col = 2560 + cc, t = t0 + tok;
        const float cur = bf2f(P[(size_t)t * P1LD + col]), prev = t > 0 ? bf2f(P[(size_t)(t - 1) * P1LD + col]) : 0.f;
        const float s = cur + (prev - cur) * mu[col - 1024];
        if (cc < 64) TW[tok * 72 + cc] = f2bf(tanhf_(s)); else if (cc < 128) AL[tok * 72 + cc - 64] = f2bf(s); else SG[tok * 168 + cc - 128] = f2bf(sigmoidf_(s));
    }
    __syncthreads();
    const int n0 = 64 * C.wave;
#pragma unroll 1
    for (int which = 0; which < 2; ++which) {
        const bf16_t* BT = SW + (which == 0 ? SW_W2T : SW_A2T); const LAS bf16_t* AM = which == 0 ? TW : AL;
        const float* bias = which == 0 ? C.in[28] : C.in[30]; bf16_t* O = which == 0 ? WLOG : AA;
#pragma unroll 1
        for (int nt = 0; nt < 4; ++nt) {
            const bf16x8 nf0 = ldfg(BT, 64, n0 + 16 * nt, 0, lane), nf1 = ldfg(BT, 64, n0 + 16 * nt, 32, lane);
            const int n = n0 + 16 * nt + 4 * fq; const f32x4 bv = *(const f32x4*)(bias + n);
#pragma unroll
            for (int mt = 0; mt < 4; ++mt) {
                f32x4 acc = F4Z; acc = mma(acc, nf0, ldf(AM, 72, 16 * mt, 0, lane)); acc = mma(acc, nf1, ldf(AM, 72, 16 * mt, 32, lane));
                float o[4];
#pragma unroll
                for (int v = 0; v < 4; ++v) { const float x = acc[v] + bv[v]; o[v] = which == 0 ? -__expf(-softplusf_(-x) - 0.5f) : sigmoidf_(x); }
                u32x2 b; b.x = pk2(o[0], o[1]); b.y = pk2(o[2], o[3]);
                *(u32x2*)(O + (size_t)(t0 + 16 * mt + fr) * 512 + n) = b;
            }
        }
    }
#pragma unroll 1
    for (int nt = 0; nt < 4; ++nt) {
        bf16x8 nf[5];
#pragma unroll
        for (int k = 0; k < 5; ++k) nf[k] = ldfg(SW + SW_G2T, 160, n0 + 16 * nt, 32 * k, lane);
        const int n = n0 + 16 * nt + 4 * fq;
#pragma unroll
        for (int mt = 0; mt < 4; ++mt) {
            f32x4 acc = F4Z;
#pragma unroll
            for (int k = 0; k < 5; ++k) acc = mma(acc, nf[k], ldf(SG, 168, 16 * mt, 32 * k, lane));
#ifdef GG_CONSTVAL
            acc = (f32x4){0.5f, 0.25f, -0.5f, 1.f};
#endif
            u32x2 b; b.x = pk2(acc[0], acc[1]); b.y = pk2(acc[2], acc[3]);
            *(u32x2*)(gg_row(C.ws, t0 + 16 * mt + fr) + n) = b;
        }
    }
    asm volatile("s_waitcnt vmcnt(0)" ::: "memory");
    __threadfence_block();
    __syncthreads();
}

template <int PASS>
__device__ __forceinline__ void rwkv_chunk(const Ctx& C, int c) {
    const bf16_t* P = (const bf16_t*)(C.ws + WS_HP);
    const bf16_t* WLOG = (const bf16_t*)(C.ws + WS_WLOG); const bf16_t* AA = (const bf16_t*)(C.ws + WS_AA);
    float* PC = (float*)(C.ws + WS_PC); float* UC = (float*)(C.ws + WS_UC); bf16_t* Y = (bf16_t*)(C.ws + WS_Y);
    LAS float* VW = (LAS float*)(C.lds + 40960); LAS float* VKK = VW + 4096; LAS float* VB = VKK + 4096; LAS float* VK = VB + 4096; LAS float* VR = VK + 4096; LAS float* VV = VR + 4096; LAS float* VG = VV + 4096; LAS float* VBON = VG + 4096;
    const int t0 = 64 * c, lane = C.lane, head = C.wave, ch = C.tid;
    const float* mu = C.in[27];
    f32x2 SU[32], SP[32];
    if (PASS == 1) {
#pragma unroll
        for (int k = 0; k < 32; ++k) { SU[k] = (f32x2){0.f, 0.f}; SP[k] = (f32x2){(2 * k == lane) ? 1.f : 0.f, (2 * k + 1 == lane) ? 1.f : 0.f}; }
    } else {
        const f32x4* src = (const f32x4*)(UC + ((size_t)(c * 8 + head) * 64 + lane) * 64);
#pragma unroll
        for (int k4 = 0; k4 < 16; ++k4) { f32x4 v = src[k4];
#ifdef RW3_ZERO
            v = F4Z;
#endif
            SU[2 * k4] = (f32x2){v[0], v[1]}; SU[2 * k4 + 1] = (f32x2){v[2], v[3]}; }
    }
    float pr = 0.f, pk = 0.f, pv = 0.f;
    if (t0 > 0) { const bf16_t* row = P + (size_t)(t0 - 1) * P1LD; pr = bf2f(row[1024 + ch]); pk = bf2f(row[1536 + ch]); pv = bf2f(row[2048 + ch]); }
#pragma unroll 1
    for (int sb = 0; sb < 8; ++sb) {
        const float mu_r = mu[ch], mu_k = mu[512 + ch], mu_v = mu[1024 + ch], kkc = C.in[33][ch], kac = C.in[34][ch], rkc = C.in[35][ch];
        constexpr int UF = PASS == 3 ? 8 : 4;
#pragma unroll 1
        for (int j0 = 0; j0 < 8; j0 += UF) {
            float cr[UF], ck[UF], cv[UF], aa[UF], wl[UF], gg[UF];
#pragma unroll
            for (int u = 0; u < UF; ++u) {
                const int t = t0 + 8 * sb + j0 + u; const bf16_t* row = P + (size_t)t * P1LD;
                ck[u] = bf2f(row[1536 + ch]); cv[u] = bf2f(row[2048 + ch]); aa[u] = bf2f(AA[(size_t)t * 512 + ch]); wl[u] = bf2f(WLOG[(size_t)t * 512 + ch]);
                if (PASS == 3) { cr[u] = bf2f(row[1024 + ch]); gg[u] = bf2f(gg_row(C.ws, t)[ch]); }
            }
            float kkr[UF], kp[UF], nrm[UF], bon[UF], rsv[UF];
#pragma unroll
            for (int u = 0; u < UF; ++u) {
                const float ks = ck[u] + (pk - ck[u]) * mu_k, vs = cv[u] + (pv - cv[u]) * mu_v; pk = ck[u]; pv = cv[u];
                kkr[u] = ks * kkc; nrm[u] = kkr[u] * kkr[u]; kp[u] = ks * (1.f + (aa[u] - 1.f) * kac);
                VV[(j0 + u) * 512 + ch] = vs; VK[(j0 + u) * 512 + ch] = kp[u]; VW[(j0 + u) * 512 + ch] = __expf(wl[u]);
                if (PASS == 3) { rsv[u] = cr[u] + (pr - cr[u]) * mu_r; pr = cr[u]; bon[u] = rsv[u] * kp[u] * rkc; VR[(j0 + u) * 512 + ch] = rsv[u]; VG[(j0 + u) * 512 + ch] = gg[u]; }
            }
#pragma unroll
            for (int o = 1; o < 64; o <<= 1) {
#pragma unroll
                for (int u = 0; u < UF; ++u) { nrm[u] += __shfl_xor(nrm[u], o); if (PASS == 3) bon[u] += __shfl_xor(bon[u], o); }
            }
#pragma unroll
            for (int u = 0; u < UF; ++u) {
                const float kk = kkr[u] * rsqrtf(fmaxf(nrm[u], 1e-24f));
                VKK[(j0 + u) * 512 + ch] = kk; VB[(j0 + u) * 512 + ch] = kk * aa[u];
                if (PASS == 3) { if (lane == 0) VBON[(j0 + u) * 8 + head] = bon[u]; }
            }
        }
        __syncthreads();
#pragma unroll 1
        for (int j = 0; j < 8; ++j) {
            const LAS f32x4* pw = (const LAS f32x4*)(VW + j * 512 + head * 64); const LAS f32x4* pkk = (const LAS f32x4*)(VKK + j * 512 + head * 64);
            const LAS f32x4* pb = (const LAS f32x4*)(VB + j * 512 + head * 64); const LAS f32x4* pkp = (const LAS f32x4*)(VK + j * 512 + head * 64);
            const LAS f32x4* prr = (const LAS f32x4*)(VR + j * 512 + head * 64);
#define LO2(v) __builtin_shufflevector(v, v, 0, 1)
#define HI2(v) __builtin_shufflevector(v, v, 2, 3)
#define FMA2(a, b, c) __builtin_elementwise_fma(a, b, c)
            f32x2 aU0 = {0.f, 0.f}, aU1 = {0.f, 0.f}, aP0 = {0.f, 0.f}, aP1 = {0.f, 0.f};
            {
                f32x4 q = pkk[0];
#pragma unroll
                for (int g = 0; g < 16; ++g) {
                    f32x4 qn = q; if (g + 1 < 16) qn = pkk[g + 1];
                    aU0 = FMA2(SU[2 * g], LO2(q), aU0); aU1 = FMA2(SU[2 * g + 1], HI2(q), aU1);
                    if (PASS == 1) { aP0 = FMA2(SP[2 * g], LO2(q), aP0); aP1 = FMA2(SP[2 * g + 1], HI2(q), aP1); }
                    q = qn;
                    __builtin_amdgcn_sched_barrier(0);
                }
            }
            const float skU = (aU0[0] + aU0[1]) + (aU1[0] + aU1[1]), skP = (aP0[0] + aP0[1]) + (aP1[0] + aP1[1]);
            const float vv = VV[j * 512 + ch];
            const f32x2 nsU = {-skU, -skU}, nsP = {-skP, -skP}, vv2 = {vv, vv};
            f32x2 y0 = {0.f, 0.f}, y1 = {0.f, 0.f};
            {
                f32x4 w4 = pw[0], b4 = pb[0], k4 = pkp[0], r4 = F4Z; if (PASS == 3) r4 = prr[0];
#pragma unroll
                for (int g = 0; g < 16; ++g) {
                    f32x4 nw = w4, nb = b4, nk = k4, nr = r4;
                    if (g + 1 < 16) { nw = pw[g + 1]; nb = pb[g + 1]; nk = pkp[g + 1]; if (PASS == 3) nr = prr[g + 1]; }
                    SU[2 * g] = FMA2(SU[2 * g], LO2(w4), FMA2(nsU, LO2(b4), vv2 * LO2(k4)));
                    SU[2 * g + 1] = FMA2(SU[2 * g + 1], HI2(w4), FMA2(nsU, HI2(b4), vv2 * HI2(k4)));
                    if (PASS == 1) { SP[2 * g] = FMA2(SP[2 * g], LO2(w4), nsP * LO2(b4)); SP[2 * g + 1] = FMA2(SP[2 * g + 1], HI2(w4), nsP * HI2(b4)); }
                    if (PASS == 3) { y0 = FMA2(SU[2 * g], LO2(r4), y0); y1 = FMA2(SU[2 * g + 1], HI2(r4), y1); }
                    w4 = nw; b4 = nb; k4 = nk; r4 = nr;
                    __builtin_amdgcn_sched_barrier(0);
                }
            }
            const float y = (y0[0] + y0[1]) + (y1[0] + y1[1]);
            if (PASS == 3) VKK[j * 512 + ch] = y;
        }
        if (PASS == 3) {
            const float lng = C.in[36][ch], lnb = C.in[37][ch];
            float y[8], s1[8], s2[8];
#pragma unroll
            for (int u = 0; u < 8; ++u) { y[u] = VKK[u * 512 + ch]; s1[u] = y[u]; }
#pragma unroll
            for (int o = 1; o < 64; o <<= 1) {
#pragma unroll
                for (int u = 0; u < 8; ++u) s1[u] += __shfl_xor(s1[u], o);
            }
#pragma unroll
            for (int u = 0; u < 8; ++u) { y[u] -= s1[u] * (1.f / 64.f); s2[u] = y[u] * y[u]; }
#pragma unroll
            for (int o = 1; o < 64; o <<= 1) {
#pragma unroll
                for (int u = 0; u < 8; ++u) s2[u] += __shfl_xor(s2[u], o);
            }
#pragma unroll
            for (int u = 0; u < 8; ++u) {
                const float yn = y[u] * rsqrtf(s2[u] * (1.f / 64.f) + 64e-5f) * lng + lnb;
                Y[(size_t)(t0 + 8 * sb + u) * D + 512 + ch] = f2bf((yn + VBON[u * 8 + head] * VV[u * 512 + ch]) * VG[u * 512 + ch]);
            }
        }
        __syncthreads();
    }
    if (PASS == 1) {
        f32x4* du = (f32x4*)(UC + ((size_t)(c * 8 + head) * 64 + lane) * 64); f32x4* dp = (f32x4*)(PC + ((size_t)(c * 8 + head) * 64 + lane) * 64);
#pragma unroll
        for (int k4 = 0; k4 < 16; ++k4) { du[k4] = (f32x4){SU[2 * k4][0], SU[2 * k4][1], SU[2 * k4 + 1][0], SU[2 * k4 + 1][1]}; dp[k4] = (f32x4){SP[2 * k4][0], SP[2 * k4][1], SP[2 * k4 + 1][0], SP[2 * k4 + 1][1]}; }
    }
}

template <int PASS>
__device__ __forceinline__ void lru_chunk(const Ctx& C, int c) {
    const bf16_t* P = (const bf16_t*)(C.ws + WS_HP); const bf16_t* SW = (const bf16_t*)(C.ws + WS_SMALLW); bf16_t* Y = (bf16_t*)(C.ws + WS_Y);
    LAS bf16_t* XC = (LAS bf16_t*)C.lds; LAS bf16_t* LAB = (LAS bf16_t*)(C.lds + 66560);
    const int t0 = 64 * c, lane = C.lane, fr = lane & 15, fq = lane >> 4;
    {
        const int grp = C.tid & 63, seg = C.tid >> 6, ch0 = 8 * grp, r0 = 8 * seg;
        const float* cw = C.in[20]; const float* cb = C.in[21];
        float w0[8], w1[8], w2[8], w3[8], bb[8], x0[8], x1[8], x2[8];
#pragma unroll
        for (int i = 0; i < 8; ++i) { w0[i] = cw[ch0 + i]; w1[i] = cw[512 + ch0 + i]; w2[i] = cw[1024 + ch0 + i]; w3[i] = cw[1536 + ch0 + i]; bb[i] = cb[ch0 + i]; }
        auto ldrow = [&](int t, float (&x)[8]) {
            if (t < 0) {
#pragma unroll
                for (int i = 0; i < 8; ++i) x[i] = 0.f;
            } else {
                const u32x4 a = *(const u32x4*)(P + (size_t)t * P1LD + ch0);
#pragma unroll
                for (int i = 0; i < 4; ++i) { x[2 * i] = bflo(a[i]); x[2 * i + 1] = bfhi(a[i]); }
            }
        };
        ldrow(t0 + r0 - 3, x0); ldrow(t0 + r0 - 2, x1); ldrow(t0 + r0 - 1, x2);
#pragma unroll
        for (int row = r0; row < r0 + 8; ++row) {
            float x3[8], v[8]; ldrow(t0 + row, x3);
#pragma unroll
            for (int i = 0; i < 8; ++i) { v[i] = bb[i] + w0[i] * x0[i] + w1[i] * x1[i] + w2[i] * x2[i] + w3[i] * x3[i]; x0[i] = x1[i]; x1[i] = x2[i]; x2[i] = x3[i]; }
            u32x4 w; w.x = pk2(v[0], v[1]); w.y = pk2(v[2], v[3]); w.z = pk2(v[4], v[5]); w.w = pk2(v[6], v[7]);
            *(LAS u32x4*)(XC + row * 520 + ch0) = w;
        }
    }
    __syncthreads();
    const int nb = C.wave >> 1, eh = C.wave & 1, cbase = nb * 128 + 64 * eh;
#pragma unroll 1
    for (int mt = 0; mt < 4; ++mt) {
        bf16x8 mf[4];
#pragma unroll
        for (int k = 0; k < 4; ++k) mf[k] = ldf(XC, 520, 16 * mt, nb * 128 + 32 * k, lane);
        unsigned ur[4][2];
#pragma unroll
        for (int nt = 0; nt < 4; ++nt) {
            f32x4 aa = F4Z, ax = F4Z;
#pragma unroll
            for (int k = 0; k < 4; ++k) {
                aa = mma(aa, ldfg(SW + SW_WAT + nb * 16384, 128, 64 * eh + 16 * nt, 32 * k, lane), mf[k]);
                ax = mma(ax, ldfg(SW + SW_WXT + nb * 16384, 128, 64 * eh + 16 * nt, 32 * k, lane), mf[k]);
            }
            const int chn = cbase + 16 * nt + 4 * fq;
            const f32x4 bav = *(const f32x4*)(C.in[23] + chn), bxv = *(const f32x4*)(C.in[25] + chn), lam = *(const f32x4*)(C.in[26] + chn);
            const u32x2 xw = *(const LAS u32x2*)(XC + (16 * mt + fr) * 520 + chn);
            const float xc[4] = {bflo(xw.x), bfhi(xw.x), bflo(xw.y), bfhi(xw.y)};
            float la[4], uu[4];
#pragma unroll
            for (int v = 0; v < 4; ++v) { const float r = sigmoidf_(aa[v] + bav[v]), ig = sigmoidf_(ax[v] + bxv[v]); la[v] = -8.f * softplusf_(-lam[v]) * r; uu[v] = sqrtf(fmaxf(-expm1f(2.f * la[v]), 0.f)) * ig * xc[v]; }
            *(LAS u32x2*)(LAB + (16 * mt + fr) * 512 + chn) = (u32x2){pk2(la[0], la[1]), pk2(la[2], la[3])};
            ur[nt][0] = pk2(uu[0], uu[1]); ur[nt][1] = pk2(uu[2], uu[3]);
        }
        __syncthreads();
#pragma unroll
        for (int nt = 0; nt < 4; ++nt) *(LAS u32x2*)(XC + (16 * mt + fr) * 520 + cbase + 16 * nt + 4 * fq) = (u32x2){ur[nt][0], ur[nt][1]};
    }
    __syncthreads();
    {
        const int ch = C.tid;
        float* LA = (float*)(C.ws + WS_LA); float* HC = (float*)(C.ws + WS_HC); const float* HIN = (const float*)(C.ws + WS_HIN);
        float h = PASS == 3 ? HIN[c * 512 + ch] : 0.f, sla = 0.f;
#pragma unroll 4
        for (int tok = 0; tok < 64; ++tok) {
            const float la = bf2f(LAB[tok * 512 + ch]), u = bf2f(XC[tok * 520 + ch]);
            h = fmaf(__expf(la), h, u); sla += la;
            if (PASS == 3) {
                const float gb = bf2f(P[(size_t)(t0 + tok) * P1LD + 512 + ch]);
                const float ge = 0.5f * gb * (1.f + tanhf_(0.7978845608028654f * (gb + 0.044715f * gb * gb * gb)));
                Y[(size_t)(t0 + tok) * D + ch] = f2bf(h * ge);
            }
        }
        if (PASS == 1) { LA[c * 512 + ch] = sla; HC[c * 512 + ch] = h; }
    }
    __syncthreads();
}

__device__ __forceinline__ void l1_pass_a(const Ctx& C) {
#ifndef SKIP_PREP
    for (int c = C.bid; c < 256; c += C.G) rwkv_prep(C, c);
#endif
#ifndef SKIP_RW1
    for (int c = C.bid; c < 256; c += C.G) rwkv_chunk<1>(C, c);
#endif
#ifndef SKIP_LRU1
    for (int c = C.bid; c < 256; c += C.G) lru_chunk<1>(C, c);
#endif
}
__device__ __forceinline__ void l1_pass_c(const Ctx& C) {
#ifndef SKIP_RW3
    for (int c = C.bid; c < 256; c += C.G) rwkv_chunk<3>(C, c);
#ifdef PROBE_RW3X2
    for (int c = C.bid; c < 256; c += C.G) rwkv_chunk<3>(C, c);
#endif
#endif
#ifndef SKIP_LRU3
    for (int c = C.bid; c < 256; c += C.G) lru_chunk<3>(C, c);
#ifdef PROBE_LRU3X2
    for (int c = C.bid; c < 256; c += C.G) lru_chunk<3>(C, c);
#endif
#endif
}

__device__ __forceinline__ void l1_middle(const Ctx& C) {
    const float* PC = (const float*)(C.ws + WS_PC); float* UC = (float*)(C.ws + WS_UC);
    const int lane = C.lane;
#ifndef SKIP_MID
    for (int gw = C.bid * 8 + C.wave; gw < 512; gw += C.G * 8) {
        const int head = gw >> 6, row = gw & 63;
        LAS float* SR = (LAS float*)(C.lds + C.wave * 256);
        float s = 0.f; SR[lane] = 0.f;
        float pa[64], pb[64];
#pragma unroll
        for (int i = 0; i < 64; ++i) pa[i] = PC[((size_t)(0 * 8 + head) * 64 + i) * 64 + lane];
        float* ub = UC + ((size_t)head * 64 + row) * 64 + lane;
        float u_cur = ub[0];
#pragma unroll 1
        for (int c = 0; c < 256; c += 2) {
            {
                const float u_nxt = ub[(size_t)(c + 1) * 32768];
#pragma unroll
                for (int i = 0; i < 64; ++i) pb[i] = PC[((size_t)((c + 1) * 8 + head) * 64 + i) * 64 + lane];
                ub[(size_t)c * 32768] = s;
                float a0 = 0.f, a1 = 0.f, a2 = 0.f, a3 = 0.f;
#pragma unroll
                for (int i4 = 0; i4 < 16; ++i4) { const f32x4 s4 = *(const LAS f32x4*)(SR + 4 * i4); a0 = fmaf(s4[0], pa[4 * i4], a0); a1 = fmaf(s4[1], pa[4 * i4 + 1], a1); a2 = fmaf(s4[2], pa[4 * i4 + 2], a2); a3 = fmaf(s4[3], pa[4 * i4 + 3], a3); }
                s = u_cur + ((a0 + a1) + (a2 + a3)); SR[lane] = s; u_cur = u_nxt;
            }
            {
                const int cn = (c + 2 < 256) ? c + 2 : 255;
                const float u_nxt = ub[(size_t)cn * 32768];
#pragma unroll
                for (int i = 0; i < 64; ++i) pa[i] = PC[((size_t)(cn * 8 + head) * 64 + i) * 64 + lane];
                ub[(size_t)(c + 1) * 32768] = s;
                float a0 = 0.f, a1 = 0.f, a2 = 0.f, a3 = 0.f;
#pragma unroll
                for (int i4 = 0; i4 < 16; ++i4) { const f32x4 s4 = *(const LAS f32x4*)(SR + 4 * i4); a0 = fmaf(s4[0], pb[4 * i4], a0); a1 = fmaf(s4[1], pb[4 * i4 + 1], a1); a2 = fmaf(s4[2], pb[4 * i4 + 2], a2); a3 = fmaf(s4[3], pb[4 * i4 + 3], a3); }
                s = u_cur + ((a0 + a1) + (a2 + a3)); SR[lane] = s; u_cur = u_nxt;
            }
        }
    }
#endif
    if (C.bid == (C.G > 64 ? 64 : 0)) {
        const float* LA = (const float*)(C.ws + WS_LA); const float* HC = (const float*)(C.ws + WS_HC); float* HIN = (float*)(C.ws + WS_HIN);
        const int ch = C.tid; float h = 0.f;
        for (int c0 = 0; c0 < 256; c0 += 8) { float la[8], hc[8];
#pragma unroll
            for (int j = 0; j < 8; ++j) { la[j] = LA[(c0 + j) * 512 + ch]; hc[j] = HC[(c0 + j) * 512 + ch]; }
#pragma unroll
            for (int j = 0; j < 8; ++j) { HIN[(c0 + j) * 512 + ch] = h; h = fmaf(__expf(la[j]), h, hc[j]); } }
    }
}

struct Args { const float* in[39]; float* out; unsigned char* ws; int ph_lo, ph_hi; };
constexpr int N_PHASES = 20;

__device__ __forceinline__ void ffn_gu(const Ctx& C, LAS unsigned char* lds, size_t wgu, int site) {
    pg8::Gemm g{(const bf16_t*)(C.ws + WS_XB), (const bf16_t*)(C.ws + wgu), T, 2 * FF, D}; pg8::StaticOrder S; S.init(T, 2 * FF, C.G, C.bid);
    EpiSwiglu E{(bf16_t*)(C.ws + WS_HP), (const float*)(C.ws + WS_SSQ) + (size_t)site * T * 16};
    pg8::gemm_phase<EpiSwiglu, pg8::StaticOrder, true, true>(lds, g, S, E);
}
__device__ __forceinline__ void ffn_down(const Ctx& C, LAS unsigned char* lds, size_t wd, int site_out, float alpha = 0.5f) {
    pg8::Gemm g{(const bf16_t*)(C.ws + WS_HP), (const bf16_t*)(C.ws + wd), T, D, FF}; pg8::StaticOrder S; S.init(T, D, C.G, C.bid);
    EpiResid E{C.X, (bf16_t*)(C.ws + WS_XB), (float*)(C.ws + WS_SSQ) + (size_t)site_out * T * 16, alpha};
    pg8::gemm_phase<EpiResid, pg8::StaticOrder, true, true>(lds, g, S, E);
}
__device__ __forceinline__ void out_proj(const Ctx& C, LAS unsigned char* lds, int site_out) {
    pg8::Gemm g{(const bf16_t*)(C.ws + WS_Y), (const bf16_t*)(C.ws + WS_WOUT), T, D, D}; pg8::StaticOrder S; S.init(T, D, C.G, C.bid);
    EpiResid E{C.X, (bf16_t*)(C.ws + WS_XB), (float*)(C.ws + WS_SSQ) + (size_t)site_out * T * 16, 1.0f};
    pg8::gemm_phase<EpiResid, pg8::StaticOrder, true, true>(lds, g, S, E);
}

__global__ void __launch_bounds__(512) mk_fwd(Args args) {
    extern __shared__ __attribute__((aligned(16))) unsigned char lds_raw[];
    cg::grid_group grid = cg::this_grid();
    Ctx C; C.in = args.in; C.X = args.out; C.ws = args.ws; C.lds = (LAS unsigned char*)lds_raw;
    C.tid = threadIdx.x; C.lane = C.tid & 63; C.wave = __builtin_amdgcn_readfirstlane(C.tid >> 6); C.G = gridDim.x; C.bid = blockIdx.x;
    LAS unsigned char* lds = C.lds;
    const int lo = args.ph_lo, hi = args.ph_hi;
#define IN(k) (lo <= (k) && (k) < hi)
#ifndef REP_MASK
#define REP_MASK 0
#endif
#define REPS(k) (((REP_MASK >> (k)) & 1) ? 2 : 1)
#define SEAM(k) do { if (IN(k) && IN((k) + 1)) { asm volatile("s_waitcnt vmcnt(0)" ::: "memory");     \
    grid.sync(); if (C.wave == 0) { __builtin_amdgcn_fence(__ATOMIC_ACQUIRE, "agent"); asm volatile("s_waitcnt vmcnt(0)" ::: "memory"); } __syncthreads(); } } while (0)

    if (IN(0)) {
        convert_weights(C, 0, 7);
        bf16_t* sw = (bf16_t*)(C.ws + WS_SMALLW);
        for (int n = 0; n < 4; ++n) { tr_small(C, C.in[22] + n * 16384, 128, 128, sw + n * 16384); tr_small(C, C.in[24] + n * 16384, 128, 128, sw + 65536 + n * 16384); }
        tr_small(C, C.in[29], 64, 512, sw + 131072); tr_small(C, C.in[31], 64, 512, sw + 163840); tr_small(C, C.in[32], 160, 512, sw + 196608);
        prologue_x(C);
    }
    SEAM(0);
    if (IN(1)) { ffn_gu(C, lds, WS_WGU1, 0); if (REPS(1) == 2) ffn_gu(C, lds, WS_WGU1, 0); }
    SEAM(1);
    if (IN(2)) { ffn_down(C, lds, WS_WD1, 1, 0.5f); if (REPS(2) == 2) ffn_down(C, lds, WS_WD1, 1, 0.f); }
    SEAM(2);
    if (IN(3)) {
        pg8::Gemm g{(const bf16_t*)(C.ws + WS_XB), (const bf16_t*)(C.ws + WS_WIN), T, 3584, D}; pg8::StaticOrder S; S.init(T, 3584, C.G, C.bid);
        EpiProj E{(bf16_t*)(C.ws + WS_HP), P0LD, 3328, (const float*)(C.ws + WS_SSQ) + (size_t)1 * T * 16, (float*)(C.ws + WS_DT), 3328};
        pg8::gemm_phase<EpiProj, pg8::StaticOrder, true, true>(lds, g, S, E);
    }
    SEAM(3);
    #ifndef SKIP4
    if (IN(4)) { l0_states(C); if (REPS(4) == 2) l0_states(C); }
#endif
    SEAM(4);
    #ifndef SKIP5
    if (IN(5)) { l0_scan(C); __syncthreads(); convert_weights(C, 1, 1); }
#endif
    SEAM(5);
    #ifndef SKIP6
    if (IN(6)) { l0_output(C); if (REPS(6) == 2) l0_output(C); }
#endif
    SEAM(6);
    if (IN(7)) out_proj(C, lds, 2);
    SEAM(7);
    if (IN(8)) { convert_weights(C, 1, 2); __syncthreads(); ffn_gu(C, lds, WS_WGU2, 2); }
    SEAM(8);
    if (IN(9)) ffn_down(C, lds, WS_WD2, 3);
    SEAM(9);
    if (IN(10)) ffn_gu(C, lds, WS_WGU1, 3);
    SEAM(10);
    if (IN(11)) ffn_down(C, lds, WS_WD1, 4);
    SEAM(11);
    if (IN(12)) {
        pg8::Gemm g{(const bf16_t*)(C.ws + WS_XB), (const bf16_t*)(C.ws + WS_WIN), T, 3072, D}; pg8::StaticOrder S; S.init(T, 3072, C.G, C.bid);
        EpiProj E{(bf16_t*)(C.ws + WS_HP), P1LD, 2848, (const float*)(C.ws + WS_SSQ) + (size_t)4 * T * 16, nullptr, -1};
        pg8::gemm_phase<EpiProj, pg8::StaticOrder, true, true>(lds, g, S, E);
    }
    SEAM(12);
    if (IN(13)) { l1_pass_a(C); if (REPS(13) == 2) l1_pass_a(C); }
    SEAM(13);
    if (IN(14)) { l1_middle(C); __syncthreads(); convert_weights(C, 1, 4); }
    SEAM(14);
    if (IN(15)) { l1_pass_c(C); if (REPS(15) == 2) l1_pass_c(C); }
    SEAM(15);
    if (IN(16)) out_proj(C, lds, 5);
    SEAM(16);
    if (IN(17)) ffn_gu(C, lds, WS_WGU2, 5);
    SEAM(17);
    if (IN(18)) ffn_down(C, lds, WS_WD2, 6);
    SEAM(18);
    if (IN(19)) final_norm(C);
#undef IN
#undef SEAM
}

extern "C" void kernel_launch(void* const* d_in, const int* in_sizes, int n_in, void* d_out, int out_size, void* d_ws, size_t ws_size, hipStream_t stream) {
    static int grid = 0;
    if (grid == 0) {
        if (n_in != 39 || out_size != T * D || ws_size < WS_END) { fprintf(stderr, "kernel_launch: unexpected problem: n_in %d out %d ws %zu\n", n_in, out_size, ws_size); grid = -1; return; }
        int dev = 0, cus = 0, per_cu = 0;
        hipGetDevice(&dev); hipDeviceGetAttribute(&cus, hipDeviceAttributeMultiprocessorCount, dev);
        if (hipFuncSetAttribute((const void*)mk_fwd, hipFuncAttributeMaxDynamicSharedMemorySize, LDS_BYTES) != hipSuccess) { fprintf(stderr, "kernel_launch: hipFuncSetAttribute failed\n"); grid = -1; return; }
        if (hipOccupancyMaxActiveBlocksPerMultiprocessor(&per_cu, (const void*)mk_fwd, 512, LDS_BYTES) != hipSuccess || per_cu < 1) { fprintf(stderr, "kernel_launch: occupancy query says %d\n", per_cu); per_cu = 1; (void)hipGetLastError(); }
        grid = cus * (per_cu > 1 ? 1 : per_cu);
    }
    if (grid < 0) return;
    Args a{};
    for (int i = 0; i < 39; ++i) a.in[i] = (const float*)d_in[i];
    a.out = (float*)d_out; a.ws = (unsigned char*)d_ws; a.ph_lo = 0; a.ph_hi = N_PHASES;
    void* kargs[] = {&a};
    hipError_t e = hipLaunchCooperativeKernel((const void*)mk_fwd, dim3(grid), dim3(512), kargs, LDS_BYTES, stream);
    if (e != hipSuccess) fprintf(stderr, "kernel_launch: cooperative launch failed: %s (grid %d)\n", hipGetErrorString(e), grid);
}
```

```cpp
#include <hip/hip_runtime.h>
#include <hip/hip_cooperative_groups.h>
#include <cstdio>
#include <cstdint>
namespace cg = cooperative_groups;
namespace pg8 {
#define PG8_LAS __attribute__((address_space(3)))
typedef unsigned short bf16_t;
typedef short bf16x8 __attribute__((ext_vector_type(8)));
typedef float f32x4 __attribute__((ext_vector_type(4)));
typedef unsigned u32x4 __attribute__((ext_vector_type(4)));
constexpr int BM = 256, BK = 64, HALF = 128, HTB = HALF * BK * 2  , STAGE_BYTES = 8 * HTB, NXCD = 8, WGM = 8;

__host__ __device__ __forceinline__ int lds_byte(int r, int c) { const int st = (r >> 4) * 2 + (c >> 5), rr = r & 15, cc = c & 31, ob = rr * 64 + cc * 2; return st * 1024 + (ob ^ (((ob >> 9) & 1) << 5)); }
__host__ __device__ __forceinline__ void stage_rc(int b, int& R, int& C) { const int st = b / 1024, sb = b % 1024, swz = sb ^ (((sb >> 9) & 1) << 5); R = (st >> 1) * 16 + swz / 64; C = (st & 1) * 32 + (swz % 64) / 2; }
__host__ __device__ __forceinline__ int perm32(int rho) { const int n = rho >> 4, i = rho & 15; return 8 * (i >> 2) + 4 * n + (i & 3); }

struct Unit { int pm, pn; };
struct Gemm { const bf16_t* A; const bf16_t* Bt; int M, N, K; };

struct StaticOrder {
    int nM, nN, nwg, G, c;
    __host__ __device__ void init(int M, int N, int G_, int c_) { nM = M / BM; nN = N / BM; nwg = nM * nN; G = G_; c = c_; }
    __host__ __device__ bool next(int i, Unit& u) const {
        const long L = (long)i * G + c; if (L >= nwg) return false;
        int wgid = (int)L; { const int q = nwg / NXCD, r = nwg % NXCD, xcd = wgid % NXCD, off = wgid / NXCD; wgid = (xcd < r ? xcd * (q + 1) : r * (q + 1) + (xcd - r) * q) + off; }
        const int nig = WGM * nN, gid = wgid / nig, fm = gid * WGM, gsz = (nM - fm) < WGM ? (nM - fm) : WGM;
        u.pm = fm + ((wgid % nig) % gsz); u.pn = (wgid % nig) / gsz; return true;
    }
    __device__ __forceinline__ void a_ready(const Unit&) const {}
    __device__ __forceinline__ void done(const Unit&) const {}
};
__device__ __forceinline__ unsigned cvt_pk_bf16(float lo, float hi) { unsigned r; asm volatile("v_cvt_pk_bf16_f32 %0, %1, %2" : "=v"(r) : "v"(lo), "v"(hi)); return r; }
template <class Epi, class Sched, bool ALIGN_EPI = false, bool SP2 = false>
__device__ __forceinline__ void gemm_phase(PG8_LAS unsigned char* lds, const Gemm g, const Sched& S, const Epi& E) {
    const int tid = threadIdx.x, wid = __builtin_amdgcn_readfirstlane(tid >> 6), lane = tid & 63, wr = wid >> 2, wc = wid & 3, fr = lane & 15, fq = lane >> 4;
    const int K = g.K, nt = K / BK;
    unsigned voffA[2], voffB[2];
#pragma unroll
    for (int i = 0; i < 2; ++i) { int R, C; stage_rc(tid * 16 + i * 8192, R, C); const int Rb = Epi::PERM ? ((R & ~31) + perm32(R & 31)) : R;
        voffA[i] = (unsigned)(R * K + C) * 2u; voffB[i] = (unsigned)(Rb * K + C) * 2u; }
    const size_t kstep = (size_t)(BK * 2);
    const size_t hstep = (size_t)HALF * K * 2;
    const size_t tstep = 2 * hstep;
    const unsigned ldsw = (unsigned)wid * 1024u;
    const int aoff = lds_byte(wr * 64 + fr, fq * 8), boff = lds_byte(wc * 32 + fr, fq * 8);
#define PG8_SA(b, h) (((b) * 2 + (h)) * HTB)
#define PG8_SB(b, h) ((4 + (b) * 2 + (h)) * HTB)
#define PG8_STAGE(bufoff, gbase, voff) do { _Pragma("unroll") for (int _i = 0; _i < 2; ++_i) \
        __builtin_amdgcn_global_load_lds((const unsigned*)((const char*)(gbase) + (voff)[_i]), (PG8_LAS unsigned*)(lds + (bufoff) + ldsw + _i * 8192), 16, 0, 0); } while (0)
#define PG8_LDA(dst, b, h) do { _Pragma("unroll") for (int m = 0; m < 4; ++m) _Pragma("unroll") for (int k = 0; k < 2; ++k) dst[m][k] = *(const PG8_LAS bf16x8*)(lds + PG8_SA(b, h) + aoff + m * 2048 + k * 1024); } while (0)
#define PG8_LDB(dst, b, h) do { _Pragma("unroll") for (int n = 0; n < 2; ++n) _Pragma("unroll") for (int k = 0; k < 2; ++k) dst[n][k] = *(const PG8_LAS bf16x8*)(lds + PG8_SB(b, h) + boff + n * 2048 + k * 1024); } while (0)
#define PG8_MMA(ai, bj, At, Bt) do { __builtin_amdgcn_s_setprio(1); _Pragma("unroll") for (int m = 0; m < 4; ++m) _Pragma("unroll") for (int n = 0; n < 2; ++n) _Pragma("unroll") for (int k = 0; k < 2; ++k) \
        acc[ai][bj][m][n] = __builtin_amdgcn_mfma_f32_16x16x32_bf16(Bt[n][k], At[m][k], acc[ai][bj][m][n], 0, 0, 0); __builtin_amdgcn_s_setprio(0); } while (0)
#define PG8_WAIT_V(n) asm volatile("s_waitcnt vmcnt(" #n ")" ::: "memory")
#define PG8_WAIT_L(n) asm volatile("s_waitcnt lgkmcnt(" #n ")" ::: "memory")
#define PG8_BAR __builtin_amdgcn_s_barrier()
#define PG8_SCHED __builtin_amdgcn_sched_barrier(0)
    Unit cur, nxt; int ui = 0;
    if (!S.next(0, cur)) return;
    f32x4 acc[2][2][4][2];
#pragma unroll
    for (int a = 0; a < 2; ++a)
#pragma unroll
        for (int b = 0; b < 2; ++b)
#pragma unroll
            for (int m = 0; m < 4; ++m)
#pragma unroll
                for (int n = 0; n < 2; ++n) acc[a][b][m][n] = (f32x4){0.f, 0.f, 0.f, 0.f};
    bf16x8 At[4][2], B0[2][2], B1[2][2];
    const char* cA = (const char*)g.A + (size_t)cur.pm * tstep; const char* cB = (const char*)g.Bt + (size_t)cur.pn * tstep;
    S.a_ready(cur);
    if constexpr (SP2) {
        PG8_STAGE(PG8_SB(0, 0), cB, voffB); PG8_STAGE(PG8_SB(0, 1), cB + hstep, voffB); PG8_STAGE(PG8_SA(0, 0), cA, voffA); PG8_STAGE(PG8_SA(0, 1), cA + hstep, voffA);
        if (wr == 1) PG8_BAR;
        PG8_WAIT_V(2); PG8_BAR;
        PG8_STAGE(PG8_SB(1, 0), cB + kstep, voffB); PG8_STAGE(PG8_SA(1, 0), cA + kstep, voffA); PG8_STAGE(PG8_SB(1, 1), cB + hstep + kstep, voffB);
        PG8_WAIT_V(6); PG8_BAR;
    } else {
        PG8_STAGE(PG8_SB(0, 0), cB, voffB); PG8_STAGE(PG8_SA(0, 0), cA, voffA); PG8_STAGE(PG8_SB(0, 1), cB + hstep, voffB); PG8_STAGE(PG8_SA(0, 1), cA + hstep, voffA);
        if (wr == 1) PG8_BAR;
        PG8_WAIT_V(4); PG8_BAR;
        PG8_STAGE(PG8_SB(1, 0), cB + kstep, voffB); PG8_STAGE(PG8_SA(1, 0), cA + kstep, voffA); PG8_STAGE(PG8_SB(1, 1), cB + hstep + kstep, voffB);
        PG8_WAIT_V(6); PG8_BAR;
    }
    for (;;) {
        const bool has_next = S.next(ui + 1, nxt);
        const char* nA = has_next ? (const char*)g.A + (size_t)nxt.pm * tstep : cA; const char* nB = has_next ? (const char*)g.Bt + (size_t)nxt.pn * tstep : cB;
        for (int t = 0; t < nt; t += 2) {
            const bool last = (t == nt - 2);
            const char* a1 = cA + (size_t)(t + 1) * kstep;
            const char* a2 = last ? nA : cA + (size_t)(t + 2) * kstep; const char* b2 = last ? nB : cB + (size_t)(t + 2) * kstep;
            const char* a3 = a2 + kstep; const char* b3 = b2 + kstep;
            if (last && has_next) S.a_ready(nxt);
            if constexpr (SP2) {
            PG8_LDB(B0, 0, 0); PG8_LDB(B1, 0, 1); PG8_SCHED; PG8_LDA(At, 0, 0); PG8_STAGE(PG8_SA(1, 1), a1 + hstep, voffA);
            PG8_WAIT_V(8); PG8_WAIT_L(0); PG8_BAR; PG8_MMA(0, 0, At, B0); PG8_MMA(0, 1, At, B1); PG8_BAR; PG8_SCHED;
            PG8_LDA(At, 0, 1); PG8_STAGE(PG8_SB(0, 0), b2, voffB); PG8_STAGE(PG8_SB(0, 1), b2 + hstep, voffB); PG8_STAGE(PG8_SA(0, 0), a2, voffA);
            PG8_WAIT_V(8); PG8_WAIT_L(0); PG8_BAR; PG8_MMA(1, 0, At, B0); PG8_MMA(1, 1, At, B1); PG8_BAR; PG8_SCHED;
            PG8_LDB(B0, 1, 0); PG8_LDB(B1, 1, 1); PG8_SCHED; PG8_LDA(At, 1, 0); PG8_STAGE(PG8_SA(0, 1), a2 + hstep, voffA);
            PG8_WAIT_V(8); PG8_WAIT_L(0); PG8_BAR; PG8_MMA(0, 0, At, B0); PG8_MMA(0, 1, At, B1); PG8_BAR; PG8_SCHED;
            PG8_LDA(At, 1, 1); PG8_STAGE(PG8_SB(1, 0), b3, voffB); PG8_STAGE(PG8_SB(1, 1), b3 + hstep, voffB); PG8_STAGE(PG8_SA(1, 0), a3, voffA);
            PG8_WAIT_V(8); PG8_WAIT_L(0); PG8_BAR; PG8_MMA(1, 0, At, B0); PG8_MMA(1, 1, At, B1); PG8_BAR; PG8_SCHED;
            } else {
            PG8_LDB(B0, 0, 0); PG8_SCHED; PG8_LDA(At, 0, 0); PG8_STAGE(PG8_SA(1, 1), a1 + hstep, voffA);
            PG8_WAIT_L(8); PG8_BAR; PG8_WAIT_L(0); PG8_MMA(0, 0, At, B0); PG8_BAR; PG8_SCHED;
            PG8_LDB(B1, 0, 1); PG8_STAGE(PG8_SB(0, 0), b2, voffB);
            PG8_BAR; PG8_WAIT_L(0); PG8_MMA(0, 1, At, B1); PG8_BAR;
            PG8_LDA(At, 0, 1); PG8_STAGE(PG8_SA(0, 0), a2, voffA);
            PG8_BAR; PG8_WAIT_L(0); PG8_MMA(1, 0, At, B0); PG8_BAR; PG8_SCHED;
            PG8_STAGE(PG8_SB(0, 1), b2 + hstep, voffB);
            PG8_WAIT_V(6); PG8_BAR; PG8_MMA(1, 1, At, B1); PG8_BAR;
            PG8_LDB(B0, 1, 0); PG8_SCHED; PG8_LDA(At, 1, 0); PG8_STAGE(PG8_SA(0, 1), a2 + hstep, voffA);
            PG8_WAIT_L(8); PG8_BAR; PG8_WAIT_L(0); PG8_MMA(0, 0, At, B0); PG8_BAR; PG8_SCHED;
            PG8_LDB(B1, 1, 1); PG8_STAGE(PG8_SB(1, 0), b3, voffB);
            PG8_BAR; PG8_WAIT_L(0); PG8_MMA(0, 1, At, B1); PG8_BAR;
            PG8_LDA(At, 1, 1); PG8_STAGE(PG8_SA(1, 0), a3, voffA);
            PG8_BAR; PG8_WAIT_L(0); PG8_MMA(1, 0, At, B0); PG8_BAR; PG8_SCHED;
            PG8_STAGE(PG8_SB(1, 1), b3 + hstep, voffB);
            PG8_WAIT_V(6); PG8_BAR; PG8_MMA(1, 1, At, B1); PG8_BAR;
            }
        }
        if constexpr (ALIGN_EPI) { if (wr == 0) PG8_BAR; }
        if constexpr (!Epi::AFTER_DRAIN) { E(acc, cur, wr, wc, fr, fq); S.done(cur); }
        if (!has_next) break;
#pragma unroll
        for (int a = 0; a < 2; ++a)
#pragma unroll
            for (int b = 0; b < 2; ++b)
#pragma unroll
                for (int m = 0; m < 4; ++m)
#pragma unroll
                    for (int n = 0; n < 2; ++n) acc[a][b][m][n] = (f32x4){0.f, 0.f, 0.f, 0.f};
        cur = nxt; cA = nA; cB = nB; ++ui;
        if constexpr (ALIGN_EPI) { if (wr == 1) PG8_BAR; }
    }
    PG8_WAIT_V(0);
    if constexpr (!ALIGN_EPI) { if (wr == 0) PG8_BAR; }
    PG8_BAR;
    if constexpr (Epi::AFTER_DRAIN) { E.fused(acc, cur, wr, wc, fr, fq, lds, wid, lane); S.done(cur); }
#undef PG8_SA
#undef PG8_SB
#undef PG8_STAGE
#undef PG8_LDA
#undef PG8_LDB
#undef PG8_MMA
#undef PG8_WAIT_V
#undef PG8_WAIT_L
#undef PG8_BAR
#undef PG8_SCHED
}
}

#define LAS __attribute__((address_space(3)))
typedef unsigned short bf16_t;
typedef short bf16x8 __attribute__((ext_vector_type(8)));
typedef float f32x4 __attribute__((ext_vector_type(4)));
typedef float f32x2 __attribute__((ext_vector_type(2)));
typedef unsigned u32x4 __attribute__((ext_vector_type(4)));
typedef unsigned u32x2 __attribute__((ext_vector_type(2)));

constexpr int T = 16384, D = 1024, FF = 2816;
constexpr int P0LD = 3328, P1LD = 2880;
constexpr int C_Q = 0, C_K = 512, C_V = 1024, C_G = 1536, C_Z = 2048, C_XBC = 2560;
constexpr size_t MiB = 1u << 20;
constexpr size_t WS_SSQ = 247 * MiB, WS_DT = 512 * 1024, WS_LRUC = 1 * MiB, WS_CHD = 2 * MiB + 512 * 1024, WS_SMALLW = 3 * MiB;
constexpr size_t WS_WGU1 = 4 * MiB, WS_WD1 = 15 * MiB, WS_WIN = 21 * MiB, WS_WOUT = 28 * MiB, WS_WGU2 = 30 * MiB, WS_WD2 = 41 * MiB;
constexpr size_t WS_XB = 47 * MiB, WS_Y = 79 * MiB, WS_HP = 111 * MiB, WS_ST = 215 * MiB, WS_END = 255 * MiB;
constexpr int LDS_BYTES = 163840;

typedef float f32x2_t __attribute__((ext_vector_type(2)));
typedef __bf16 bf16x2_t __attribute__((ext_vector_type(2)));
__device__ __forceinline__ unsigned pk2(float lo, float hi) { f32x2_t v = {lo, hi}; bf16x2_t b = __builtin_convertvector(v, bf16x2_t); return __builtin_bit_cast(unsigned, b); }
__device__ __forceinline__ unsigned short f2bf(float f) { return (unsigned short)(pk2(f, 0.f) & 0xffffu); }
__device__ __forceinline__ float bflo(unsigned w) { return __uint_as_float(w << 16); }
__device__ __forceinline__ float bfhi(unsigned w) { return __uint_as_float(w & 0xffff0000u); }
__device__ __forceinline__ float bf2f(unsigned short h) { return __uint_as_float(((unsigned)h) << 16); }
__device__ __forceinline__ float frcp(float x) { return __builtin_amdgcn_rcpf(x); }
__device__ __forceinline__ float sigmoidf_(float x) { return frcp(1.f + __expf(-x)); }
__device__ __forceinline__ float siluf_(float x) { return x * frcp(1.f + __expf(-x)); }
__device__ __forceinline__ float softplusf_(float x) { return x > 20.f ? x : log1pf(__expf(x)); }
__device__ __forceinline__ float wave_sum(float v) {
#pragma unroll
    for (int o = 1; o < 64; o <<= 1) v += __shfl_xor(v, o);
    return v;
}
__device__ __forceinline__ f32x4 mma(f32x4 acc, bf16x8 nfrag, bf16x8 mfrag) { return __builtin_amdgcn_mfma_f32_16x16x32_bf16(nfrag, mfrag, acc, 0, 0, 0); }
__device__ __forceinline__ bf16x8 ldf(const LAS bf16_t* base, int stride, int row0, int k0, int lane) { return *(const LAS bf16x8*)(base + (row0 + (lane & 15)) * stride + k0 + 8 * (lane >> 4)); }
__device__ __forceinline__ bf16x8 ldfg(const bf16_t* base, int stride, int row0, int k0, int lane) { return *(const bf16x8*)(base + (size_t)(row0 + (lane & 15)) * stride + k0 + 8 * (lane >> 4)); }
#define F4Z ((f32x4){0.f, 0.f, 0.f, 0.f})
__device__ __forceinline__ float ssq_row(const float* ssq, int row) {
    float s = 0.f;
#pragma unroll
    for (int k = 0; k < 16; ++k) s += ssq[(size_t)k * T + row];
    return s;
}

struct Ctx {
    const float* const* in; float* X; unsigned char* ws; LAS unsigned char* lds;
    int tid, lane, wave, G, bid;
};

__device__ __forceinline__ void tr_item(const float* W, int K, int N, bf16_t* WT, const float* gain, int k0, int n0, int drow0, LAS float* scr, int lane) {
    const int nn = n0 + (lane & 31);
    float wv[32];
#pragma unroll
    for (int i = 0; i < 32; ++i) { const int kk = 2 * i + (lane >> 5); wv[i] = (nn < N) ? W[(size_t)(k0 + kk) * N + nn] : 0.f; }
#pragma unroll
    for (int i = 0; i < 32; ++i) { const int kk = 2 * i + (lane >> 5); float v = wv[i]; if (gain) v *= gain[k0 + kk]; scr[kk * 33 + (lane & 31)] = v; }
    asm volatile("s_waitcnt lgkmcnt(0)" ::: "memory");
    const int c = lane & 7;
#pragma unroll
    for (int j = 0; j < 4; ++j) { const int n = (lane >> 3) + 8 * j; const LAS float* s = scr + (8 * c) * 33 + n;
        u32x4 o; o.x = pk2(s[0 * 33], s[1 * 33]); o.y = pk2(s[2 * 33], s[3 * 33]); o.z = pk2(s[4 * 33], s[5 * 33]); o.w = pk2(s[6 * 33], s[7 * 33]);
        if (n0 + n < N) *(u32x4*)(WT + (size_t)(drow0 + n) * K + k0 + 8 * c) = o; }
    asm volatile("s_waitcnt lgkmcnt(0)" ::: "memory");
}
__device__ __forceinline__ void tr_matrix(const Ctx& C, const float* W, int K, int N, bf16_t* WT, const float* gain, int mode, int& base) {
    LAS float* scr = (LAS float*)(C.lds + C.wave * 8448);
    const int nblk = (N + 31) / 32, nitems = (K / 64) * nblk, gw = C.bid * 8 + C.wave, ngw = C.G * 8;
    int first = (gw - (base % ngw) + ngw) % ngw;
    for (int it = first; it < nitems; it += ngw) {
        const int kb = it / nblk, nb = it % nblk, n0 = 32 * nb;
        const int drow0 = mode == 0 ? n0 : ((n0 >> 7) * 256 + (n0 & 127) + (mode == 2 ? 128 : 0));
        tr_item(W, K, N, WT, gain, 64 * kb, n0, drow0, scr, C.lane);
    }
    base += nitems;
}
__device__ __forceinline__ void convert_weights(const Ctx& C, int layer, int which) {
    int base = 0; unsigned char* ws = C.ws;
    if (which & 1) {
        tr_matrix(C, C.in[2] + (size_t)layer * D * FF, D, FF, (bf16_t*)(ws + WS_WGU1), C.in[1] + layer * D, 1, base);
        tr_matrix(C, C.in[3] + (size_t)layer * D * FF, D, FF, (bf16_t*)(ws + WS_WGU1), C.in[1] + layer * D, 2, base);
        tr_matrix(C, C.in[4] + (size_t)layer * D * FF, FF, D, (bf16_t*)(ws + WS_WD1), nullptr, 0, base);
    }
    if (which & 2) {
        if (layer == 0) { tr_matrix(C, C.in[10], D, 3336, (bf16_t*)(ws + WS_WIN), C.in[5], 0, base); tr_matrix(C, C.in[11], D, D, (bf16_t*)(ws + WS_WOUT), nullptr, 0, base); }
        else            { tr_matrix(C, C.in[18], D, 2848, (bf16_t*)(ws + WS_WIN), C.in[5] + D, 0, base); tr_matrix(C, C.in[19], D, D, (bf16_t*)(ws + WS_WOUT), nullptr, 0, base); }
    }
    if (which & 4) {
        tr_matrix(C, C.in[7] + (size_t)layer * D * FF, D, FF, (bf16_t*)(ws + WS_WGU2), C.in[6] + layer * D, 1, base);
        tr_matrix(C, C.in[8] + (size_t)layer * D * FF, D, FF, (bf16_t*)(ws + WS_WGU2), C.in[6] + layer * D, 2, base);
        tr_matrix(C, C.in[9] + (size_t)layer * D * FF, FF, D, (bf16_t*)(ws + WS_WD2), nullptr, 0, base);
    }
}
__device__ __forceinline__ void tr_small(const Ctx& C, const float* W, int K, int N, bf16_t* WT) {
    for (int idx = C.bid * 512 + C.tid; idx < K * N; idx += C.G * 512) { const int n = idx / K, k = idx % K; WT[idx] = f2bf(W[(size_t)k * N + n]); }
}

struct EpiSwiglu {
    static constexpr bool PERM = true, AFTER_DRAIN = false;
    bf16_t* H; const float* ssq;
    __device__ __forceinline__ void operator()(const f32x4 (&acc)[2][2][4][2], const pg8::Unit& u, int wr, int wc, int fr, int fq) const {
        const int row0 = u.pm * 256 + wr * 64 + fr, col0 = u.pn * 128 + wc * 32 + 8 * fq;
#pragma unroll
        for (int ai = 0; ai < 2; ++ai)
#pragma unroll
            for (int m = 0; m < 4; ++m) {
                const int row = row0 + ai * 128 + m * 16; const float r = rsqrtf(ssq_row(ssq, row) * (1.f / D) + 1e-6f);
                float h[8];
#pragma unroll
                for (int n = 0; n < 2; ++n)
#pragma unroll
                    for (int v = 0; v < 4; ++v) { const float g = acc[ai][0][m][n][v] * r, up = acc[ai][1][m][n][v] * r; h[4 * n + v] = siluf_(g) * up; }
                u32x4 w; w.x = pk2(h[0], h[1]); w.y = pk2(h[2], h[3]); w.z = pk2(h[4], h[5]); w.w = pk2(h[6], h[7]);
                *(u32x4*)(H + (size_t)row * FF + col0) = w;
            }
    }
};
struct EpiResid {
    static constexpr bool PERM = false, AFTER_DRAIN = false;
    float* X; bf16_t* XB; float* ssq_out; float alpha;
    __device__ __forceinline__ void operator()(const f32x4 (&acc)[2][2][4][2], const pg8::Unit& u, int wr, int wc, int fr, int fq) const {
        const int row0 = u.pm * 256 + wr * 64 + fr, col0 = u.pn * 256 + wc * 32 + 4 * fq;
#pragma unroll
        for (int ai = 0; ai < 2; ++ai)
#pragma unroll
            for (int m = 0; m < 4; ++m) {
                const int row = row0 + ai * 128 + m * 16; float s = 0.f;
#pragma unroll
                for (int bj = 0; bj < 2; ++bj)
#pragma unroll
                    for (int n = 0; n < 2; ++n) {
                        const size_t off = (size_t)row * D + col0 + bj * 128 + n * 16;
                        f32x4 x = *(const f32x4*)(X + off); x = x + acc[ai][bj][m][n] * alpha;
                        *(f32x4*)(X + off) = x; u32x2 b; b.x = pk2(x[0], x[1]); b.y = pk2(x[2], x[3]); *(u32x2*)(XB + off) = b;
                        s += (x[0] * x[0] + x[1] * x[1]) + (x[2] * x[2] + x[3] * x[3]);
                    }
                s += __shfl_xor(s, 16); s += __shfl_xor(s, 32);
                if (fq == 0) ssq_out[(size_t)(u.pn * 4 + wc) * T + row] = s;
            }
    }
};
struct EpiProj {
    static constexpr bool PERM = true, AFTER_DRAIN = false;
    bf16_t* P; int ldp, ncols; const float* ssq; float* DT; int dt_col0;
    __device__ __forceinline__ void operator()(const f32x4 (&acc)[2][2][4][2], const pg8::Unit& u, int wr, int wc, int fr, int fq) const {
        const int row0 = u.pm * 256 + wr * 64 + fr, col0 = u.pn * 256 + wc * 32 + 8 * fq;
#pragma unroll
        for (int ai = 0; ai < 2; ++ai)
#pragma unroll
            for (int m = 0; m < 4; ++m) {
                const int row = row0 + ai * 128 + m * 16; const float r = rsqrtf(ssq_row(ssq, row) * (1.f / D) + 1e-6f);
#pragma unroll
                for (int bj = 0; bj < 2; ++bj) {
                    const int c = col0 + bj * 128; const f32x4 v0 = acc[ai][bj][m][0] * r, v1 = acc[ai][bj][m][1] * r;
                    if (c + 8 <= ncols) { u32x4 w; w.x = pk2(v0[0], v0[1]); w.y = pk2(v0[2], v0[3]); w.z = pk2(v1[0], v1[1]); w.w = pk2(v1[2], v1[3]); *(u32x4*)(P + (size_t)row * ldp + c) = w; }
                    else if (DT && c == dt_col0) { *(f32x4*)(DT + (size_t)row * 8) = v0; *(f32x4*)(DT + (size_t)row * 8 + 4) = v1; }
                }
            }
    }
};

__device__ __forceinline__ void prologue_x(const Ctx& C) {
    const float* x = C.in[0]; bf16_t* XB = (bf16_t*)(C.ws + WS_XB); float* ssq = (float*)(C.ws + WS_SSQ);
    const int gw = C.bid * 8 + C.wave, ngw = C.G * 8;
    for (int m = gw; m < T; m += ngw) {
        const f32x4* xr = (const f32x4*)(x + (size_t)m * D) + C.lane; f32x4* orow = (f32x4*)(C.X + (size_t)m * D) + C.lane; u32x2* brow = (u32x2*)(XB + (size_t)m * D) + C.lane;
        float s = 0.f;
#pragma unroll
        for (int j = 0; j < 4; ++j) { const f32x4 v = xr[64 * j]; orow[64 * j] = v; u32x2 b; b.x = pk2(v[0], v[1]); b.y = pk2(v[2], v[3]); brow[64 * j] = b; s += (v[0] * v[0] + v[1] * v[1]) + (v[2] * v[2] + v[3] * v[3]); }
        s = wave_sum(s);
        if (C.lane == 0) ssq[m] = s;
    }
    for (int i = C.bid * 512 + C.tid; i < 15 * T; i += C.G * 512) ssq[T + i] = 0.f;
}
__device__ __forceinline__ void final_norm(const Ctx& C) {
    const float* ssq = (const float*)(C.ws + WS_SSQ) + (size_t)6 * T * 16; const float* g = C.in[38];
    const int gw = C.bid * 8 + C.wave, ngw = C.G * 8;
    f32x4 gv[4];
#pragma unroll
    for (int j = 0; j < 4; ++j) gv[j] = ((const f32x4*)g)[C.lane + 64 * j];
    for (int m = gw; m < T; m += ngw) {
        f32x4* xr = (f32x4*)(C.X + (size_t)m * D) + C.lane; const float r = rsqrtf(ssq_row(ssq, m) * (1.f / D) + 1e-6f);
#pragma unroll
        for (int j = 0; j < 4; ++j) { f32x4 v = xr[64 * j]; v = v * r * gv[j];
#ifdef SANITIZE
#pragma unroll
            for (int q = 0; q < 4; ++q) v[q] = (fabsf(v[q]) < 1e30f) ? v[q] : 0.f;
#endif
            xr[64 * j] = v; }
    }
}

__device__ __forceinline__ float ret_log_gamma(int h) { return logf(1.f - exp2f(-5.f - (float)h)); }

template <bool TR>
__device__ __forceinline__ void stage_rot(const bf16_t* P, int t0, int col0, LAS bf16_t* dst, int stride, float scale, float lg, bool kte, int nrows, int tl, int nth) {
    for (int it = tl; it < nrows * 8; it += nth) {
        const int row = it >> 3, d0 = (it & 7) * 8, t = t0 + row;
        const bf16_t* src = P + (size_t)t * P0LD + col0 + d0;
        const u32x4 a = *(const u32x4*)src, b = *(const u32x4*)(src + 64);
        const float rs = scale * (kte ? __expf(lg * (float)(127 - row)) : 1.f);
        float o1[8], o2[8];
#pragma unroll
        for (int i = 0; i < 8; ++i) {
            const unsigned wa = a[i >> 1], wb = b[i >> 1];
            const float x1 = (i & 1) ? bfhi(wa) : bflo(wa), x2 = (i & 1) ? bfhi(wb) : bflo(wb);
            const float invf = exp2f(-(float)(d0 + i) * (13.287712379549449f / 64.f));
            const float ang = (float)t * invf, n = rintf(ang * 0.15915494309189535f);
            float r = fmaf(-n, 6.2831854820251465f, ang); r = fmaf(-n, -1.7484556e-7f, r);
            const float s = __sinf(r), c = __cosf(r);
            o1[i] = (x1 * c - x2 * s) * rs; o2[i] = (x2 * c + x1 * s) * rs;
        }
        if (TR) {
#pragma unroll
            for (int i = 0; i < 8; ++i) { dst[(d0 + i) * stride + row] = f2bf(o1[i]); dst[(64 + d0 + i) * stride + row] = f2bf(o2[i]); }
        } else {
            u32x4 w1, w2; w1.x = pk2(o1[0], o1[1]); w1.y = pk2(o1[2], o1[3]); w1.z = pk2(o1[4], o1[5]); w1.w = pk2(o1[6], o1[7]);
            w2.x = pk2(o2[0], o2[1]); w2.y = pk2(o2[2], o2[3]); w2.z = pk2(o2[4], o2[5]); w2.w = pk2(o2[6], o2[7]);
            *(LAS u32x4*)(dst + row * stride + d0) = w1; *(LAS u32x4*)(dst + row * stride + 64 + d0) = w2;
        }
    }
}
__device__ __forceinline__ void stage_vT(const bf16_t* P, int t0, int col0, LAS bf16_t* dst, int stride, int tid) {
    for (int it = tid; it < 128 * 16; it += 512) {
        const int row = it >> 4, e0 = (it & 15) * 8;
        const u32x4 a = *(const u32x4*)(P + (size_t)(t0 + row) * P0LD + col0 + e0);
#pragma unroll
        for (int i = 0; i < 8; ++i) { const unsigned w = a[i >> 1]; dst[(e0 + i) * stride + row] = (unsigned short)((i & 1) ? (w >> 16) : (w & 0xffffu)); }
    }
}

__device__ __forceinline__ void stage_dt(const Ctx& C, int t0, int g, LAS float* DTS, LAS float* AS, LAS float* ACS) {
    const int l = C.tid & 127, hh = C.tid >> 7, h = 4 * g + hh;
    const float* DT = (const float*)(C.ws + WS_DT);
    const float dtv = softplusf_(DT[(size_t)(t0 + l) * 8 + h] + C.in[14][h]);
    DTS[hh * 128 + l] = dtv; AS[hh * 128 + l] = -dtv * __expf(C.in[15][h]);
    __syncthreads();
    float s = 0.f;
    for (int i = 0; i <= l; ++i) s += AS[hh * 128 + i];
    ACS[hh * 128 + l] = s;
    __syncthreads();
}

template <int NGRP, int MODE>
__device__ __forceinline__ void stage_conv(const Ctx& C, int t0, int g, LAS bf16_t* XT, LAS bf16_t* BB, LAS bf16_t* CC, const LAS float* DTS, const LAS float* ACS) {
    constexpr int NSEG = 512 / NGRP, RP = (128 + NSEG - 1) / NSEG;
    if (C.tid >= NGRP * NSEG) return;
    const bf16_t* P = (const bf16_t*)(C.ws + WS_HP);
    const int grp = C.tid % NGRP, seg = C.tid / NGRP;
    const int ch0 = grp < 32 ? 256 * g + 8 * grp : (grp < 40 ? 512 + 64 * g + 8 * (grp - 32) : 640 + 64 * g + 8 * (grp - 40));
    const float* cw = C.in[12]; const float* cb = C.in[13];
    float w0[8], w1[8], w2[8], w3[8], bb[8], x0[8], x1[8], x2[8];
#pragma unroll
    for (int i = 0; i < 8; ++i) { w0[i] = cw[ch0 + i]; w1[i] = cw[768 + ch0 + i]; w2[i] = cw[1536 + ch0 + i]; w3[i] = cw[2304 + ch0 + i]; bb[i] = cb[ch0 + i]; }
    const int r0 = seg * RP, r1 = (r0 + RP < 128) ? r0 + RP : 128;
    auto ldrow = [&](int t, float (&x)[8]) {
        if (t < 0) {
#pragma unroll
            for (int i = 0; i < 8; ++i) x[i] = 0.f;
        } else {
            const u32x4 a = *(const u32x4*)(P + (size_t)t * P0LD + C_XBC + ch0);
#pragma unroll
            for (int i = 0; i < 4; ++i) { x[2 * i] = bflo(a[i]); x[2 * i + 1] = bfhi(a[i]); }
        }
    };
    ldrow(t0 + r0 - 3, x0); ldrow(t0 + r0 - 2, x1); ldrow(t0 + r0 - 1, x2);
    for (int row = r0; row < r1; ++row) {
        float x3[8], v[8]; ldrow(t0 + row, x3);
#pragma unroll
        for (int i = 0; i < 8; ++i) { float s = bb[i] + w0[i] * x0[i] + w1[i] * x1[i] + w2[i] * x2[i] + w3[i] * x3[i]; v[i] = siluf_(s); x0[i] = x1[i]; x1[i] = x2[i]; x2[i] = x3[i]; }
        if (grp < 32) {
            const int hh = grp >> 3;
            float sc = DTS[hh * 128 + row]; if (MODE == 0) sc *= __expf(ACS[hh * 128 + 127] - ACS[hh * 128 + row]);
#pragma unroll
            for (int i = 0; i < 8; ++i) XT[(8 * grp + i) * 136 + row] = f2bf(v[i] * sc);
        } else if (MODE == 0) {
#pragma unroll
            for (int i = 0; i < 8; ++i) BB[(8 * (grp - 32) + i) * 136 + row] = f2bf(v[i]);
        } else {
            u32x4 w; w.x = pk2(v[0], v[1]); w.y = pk2(v[2], v[3]); w.z = pk2(v[4], v[5]); w.w = pk2(v[6], v[7]);
            if (grp < 40) *(LAS u32x4*)(BB + row * 72 + 8 * (grp - 32)) = w; else *(LAS u32x4*)(CC + row * 72 + 8 * (grp - 40)) = w;
        }
    }
}

__device__ __forceinline__ void ret_state_unit(const Ctx& C, int c, int h) {
    const bf16_t* P = (const bf16_t*)(C.ws + WS_HP); float* SR = (float*)(C.ws + WS_ST);
    LAS bf16_t* KT = (LAS bf16_t*)C.lds; LAS bf16_t* VT = KT + 128 * 136;
    const int t0 = c * 128, lane = C.lane, fr = lane & 15, fq = lane >> 4;
    stage_rot<true>(P, t0, C_K + h * 128, KT, 136, 0.08838834764831845f, ret_log_gamma(h), true, 128, C.tid, 512);
    stage_vT(P, t0, C_V + h * 128, VT, 136, C.tid);
    __syncthreads();
    const int e0 = 16 * C.wave; bf16x8 mf[4];
#pragma unroll
    for (int k = 0; k < 4; ++k) mf[k] = ldf(VT, 136, e0, 32 * k, lane);
    float* out = SR + ((size_t)(c * 4 + h) * 128 + e0 + fr) * 128 + 4 * fq;
#pragma unroll
    for (int dt = 0; dt < 8; ++dt) { f32x4 acc = F4Z;
#pragma unroll
        for (int k = 0; k < 4; ++k) acc = mma(acc, ldf(KT, 136, 16 * dt, 32 * k, lane), mf[k]);
        *(f32x4*)(out + 16 * dt) = acc; }
    __syncthreads();
}
__device__ __forceinline__ void mamba_state_unit(const Ctx& C, int c, int g) {
    LAS bf16_t* XT = (LAS bf16_t*)C.lds; LAS bf16_t* BT = XT + 256 * 136;
    LAS float* DTS = (LAS float*)(C.lds + 150528); LAS float* ACS = DTS + 512; LAS float* AS = ACS + 512;
    float* SM = (float*)(C.ws + WS_XB); float* CHD = (float*)(C.ws + WS_CHD);
    const int t0 = c * 128, lane = C.lane, fr = lane & 15, fq = lane >> 4;
    stage_dt(C, t0, g, DTS, AS, ACS);
    stage_conv<40, 0>(C, t0, g, XT, BT, nullptr, DTS, ACS);
    if (C.tid < 4) CHD[(c * 2 + g) * 32 + C.tid] = __expf(ACS[C.tid * 128 + 127]);
    __syncthreads();
    const int hh = C.wave >> 1, ph = C.wave & 1;
#pragma unroll
    for (int pt = 0; pt < 2; ++pt) {
        const int p0 = ph * 32 + 16 * pt; bf16x8 mf[4];
#pragma unroll
        for (int k = 0; k < 4; ++k) mf[k] = ldf(XT, 136, hh * 64 + p0, 32 * k, lane);
        float* out = SM + ((size_t)(c * 8 + 4 * g + hh) * 64 + p0 + fr) * 64 + 4 * fq;
#pragma unroll
        for (int nt = 0; nt < 4; ++nt) { f32x4 acc = F4Z;
#pragma unroll
            for (int k = 0; k < 4; ++k) acc = mma(acc, ldf(BT, 136, 16 * nt, 32 * k, lane), mf[k]);
            *(f32x4*)(out + 16 * nt) = acc; }
    }
    __syncthreads();
}
__device__ __forceinline__ void l0_states(const Ctx& C) {
    for (int u = C.bid; u < 256; u += C.G) mamba_state_unit(C, u >> 1, u & 1);
    for (int u = C.bid; u < 512; u += C.G) ret_state_unit(C, u >> 2, u & 3);
}

__device__ __forceinline__ void l0_scan(const Ctx& C) {
    float* SR = (float*)(C.ws + WS_ST); float* SM = (float*)(C.ws + WS_XB); const float* CHD = (const float*)(C.ws + WS_CHD);
    for (int idx = C.bid * 512 + C.tid; idx < 65536 + 32768; idx += C.G * 512) {
        if (idx < 65536) {
            const float dec = __expf(128.f * ret_log_gamma(idx >> 14)); float s = 0.f; float* p = SR + idx;
            for (int c0 = 0; c0 < 128; c0 += 8) { float kv[8];
#pragma unroll
                for (int j = 0; j < 8; ++j) kv[j] = p[(size_t)(c0 + j) * 65536];
#pragma unroll
                for (int j = 0; j < 8; ++j) { p[(size_t)(c0 + j) * 65536] = s; s = s * dec + kv[j]; } }
        } else {
            const int e = idx - 65536, head = e >> 12; float s = 0.f; float* p = SM + e;
            for (int c0 = 0; c0 < 128; c0 += 8) { float kv[8], dc[8];
#pragma unroll
                for (int j = 0; j < 8; ++j) { kv[j] = p[(size_t)(c0 + j) * 32768]; dc[j] = CHD[((c0 + j) * 2 + (head >> 2)) * 32 + (head & 3)]; }
#pragma unroll
                for (int j = 0; j < 8; ++j) { p[(size_t)(c0 + j) * 32768] = s; s = s * dc[j] + kv[j]; } }
        }
    }
}

__device__ __forceinline__ void mamba_out_unit(const Ctx& C, int c, int g) {
    LAS bf16_t* XT = (LAS bf16_t*)C.lds; LAS bf16_t* BM = (LAS bf16_t*)(C.lds + 69632); LAS bf16_t* CM = (LAS bf16_t*)(C.lds + 88064);
    LAS bf16_t* SP = (LAS bf16_t*)(C.lds + 106496); LAS bf16_t* STR = (LAS bf16_t*)(C.lds + 115712) + C.wave * (16 * 136);
    LAS float* DTS = (LAS float*)(C.lds + 150528); LAS float* ACS = DTS + 512; LAS float* AS = ACS + 512;
    const bf16_t* P = (const bf16_t*)(C.ws + WS_HP); const float* SM = (const float*)(C.ws + WS_XB); bf16_t* Y = (bf16_t*)(C.ws + WS_Y);
    const int t0 = c * 128, lane = C.lane, fr = lane & 15, fq = lane >> 4, w = C.wave, l0 = 16 * w, l = l0 + fr;
    stage_dt(C, t0, g, DTS, AS, ACS);
    stage_conv<48, 1>(C, t0, g, XT, BM, CM, DTS, ACS);
    __syncthreads();
    bf16x8 cmA[2]; cmA[0] = ldf(CM, 72, l0, 0, lane); cmA[1] = ldf(CM, 72, l0, 32, lane);
    f32x4 cb[8];
#pragma unroll
    for (int st = 0; st < 8; ++st) { cb[st] = F4Z; if (st <= w) { cb[st] = mma(cb[st], ldf(BM, 72, 16 * st, 0, lane), cmA[0]); cb[st] = mma(cb[st], ldf(BM, 72, 16 * st, 32, lane), cmA[1]); } }
    float ssq = 0.f;
#pragma unroll 1
    for (int hh = 0; hh < 4; ++hh) {
        const int h = 4 * g + hh;
        __syncthreads();
        {
            const float* src = SM + (size_t)(c * 8 + h) * 4096;
#pragma unroll
            for (int i = 0; i < 2; ++i) { const int e = (C.tid + 512 * i) * 4; const f32x4 v = *(const f32x4*)(src + e); u32x2 b; b.x = pk2(v[0], v[1]); b.y = pk2(v[2], v[3]); *(LAS u32x2*)(SP + (e >> 6) * 72 + (e & 63)) = b; }
        }
        const float al = ACS[hh * 128 + l];
#pragma unroll
        for (int st = 0; st < 8; ++st) {
            const f32x4 as4 = *(const LAS f32x4*)(ACS + hh * 128 + 16 * st + 4 * fq); float sc[4];
#pragma unroll
            for (int v = 0; v < 4; ++v) { const int s = 16 * st + 4 * fq + v; sc[v] = (st <= w && s <= l) ? cb[st][v] * __expf(al - as4[v]) : 0.f; }
            u32x2 b; b.x = pk2(sc[0], sc[1]); b.y = pk2(sc[2], sc[3]); *(LAS u32x2*)(STR + fr * 136 + 16 * st + 4 * fq) = b;
        }
        __syncthreads();
        bf16x8 sA[4];
#pragma unroll
        for (int k = 0; k < 4; ++k) sA[k] = ldf(STR, 136, 0, 32 * k, lane);
        const float eal = __expf(al), dsk = C.in[16][h], rdt = frcp(DTS[hh * 128 + l]);
#pragma unroll
        for (int pt = 0; pt < 4; ++pt) {
            f32x4 ya = F4Z, yo = F4Z;
#pragma unroll
            for (int k = 0; k < 4; ++k) ya = mma(ya, ldf(XT, 136, hh * 64 + 16 * pt, 32 * k, lane), sA[k]);
#pragma unroll
            for (int k = 0; k < 2; ++k) yo = mma(yo, ldf(SP, 72, 16 * pt, 32 * k, lane), cmA[k]);
            const int p = 16 * pt + 4 * fq;
            const u32x2 zz = *(const u32x2*)(P + (size_t)(t0 + l) * P0LD + C_Z + 256 * g + hh * 64 + p);
            const float z[4] = {bflo(zz.x), bfhi(zz.x), bflo(zz.y), bfhi(zz.y)};
            float y[4];
#pragma unroll
            for (int v = 0; v < 4; ++v) {
                const float xs = bf2f(XT[(hh * 64 + p + v) * 136 + l]) * rdt;
                y[v] = (ya[v] + yo[v] * eal + dsk * xs) * siluf_(z[v]); ssq += y[v] * y[v];
            }
            u32x2 b; b.x = pk2(y[0], y[1]); b.y = pk2(y[2], y[3]);
            *(u32x2*)(Y + (size_t)(t0 + l) * D + 512 + 256 * g + hh * 64 + p) = b;
        }
    }
    ssq += __shfl_xor(ssq, 16); ssq += __shfl_xor(ssq, 32);
    const float rinv = rsqrtf(ssq * (1.f / 256.f) + 1e-5f);
#pragma unroll 4
    for (int q = 0; q < 16; ++q) {
        const int ch = 256 * g + 16 * q + 4 * fq; const f32x4 ng = *(const f32x4*)(C.in[17] + ch);
        u32x2* yp = (u32x2*)(Y + (size_t)(t0 + l) * D + 512 + ch); const u32x2 yy = *yp;
        u32x2 b; b.x = pk2(bflo(yy.x) * rinv * ng[0], bfhi(yy.x) * rinv * ng[1]); b.y = pk2(bflo(yy.y) * rinv * ng[2], bfhi(yy.y) * rinv * ng[3]);
        *yp = b;
    }
    __syncthreads();
}
__device__ __forceinline__ void ret_out_unit(const Ctx& C, int c, int h) {
    LAS bf16_t* KN = (LAS bf16_t*)C.lds; LAS bf16_t* VT = KN + 128 * 136; LAS bf16_t* ST = VT + 128 * 136; LAS bf16_t* STR = ST + 128 * 136 + C.wave * (16 * 136);
    const bf16_t* P = (const bf16_t*)(C.ws + WS_HP); const float* SR = (const float*)(C.ws + WS_ST); bf16_t* Y = (bf16_t*)(C.ws + WS_Y);
    const int t0 = c * 128, lane = C.lane, fr = lane & 15, fq = lane >> 4, w = C.wave, i0 = 16 * w, ii = i0 + fr;
    const float lg = ret_log_gamma(h);
    stage_rot<false>(P, t0, C_K + h * 128, KN, 136, 0.08838834764831845f, 0.f, false, 128, C.tid, 512);
    stage_vT(P, t0, C_V + h * 128, VT, 136, C.tid);
    {
        const float* src = SR + (size_t)(c * 4 + h) * 16384;
#pragma unroll
        for (int i = 0; i < 8; ++i) { const int e = (C.tid + 512 * i) * 4; const f32x4 v = *(const f32x4*)(src + e); u32x2 b; b.x = pk2(v[0], v[1]); b.y = pk2(v[2], v[3]); *(LAS u32x2*)(ST + (e >> 7) * 136 + (e & 127)) = b; }
    }
    stage_rot<false>(P, t0 + i0, C_Q + h * 128, STR, 136, 1.f, 0.f, false, 16, lane, 64);
    __syncthreads();
    bf16x8 qA[4];
#pragma unroll
    for (int k = 0; k < 4; ++k) qA[k] = ldf(STR, 136, 0, 32 * k, lane);
    __syncthreads();
#pragma unroll
    for (int jt = 0; jt < 8; ++jt) {
        f32x4 sa = F4Z;
        if (jt <= w) {
#pragma unroll
            for (int k = 0; k < 4; ++k) sa = mma(sa, ldf(KN, 136, 16 * jt, 32 * k, lane), qA[k]);
        }
        float sc[4];
#pragma unroll
        for (int v = 0; v < 4; ++v) { const int j = 16 * jt + 4 * fq + v; sc[v] = (jt <= w && j <= ii) ? sa[v] * __expf(lg * (float)(ii - j)) : 0.f; }
        u32x2 b; b.x = pk2(sc[0], sc[1]); b.y = pk2(sc[2], sc[3]); *(LAS u32x2*)(STR + fr * 136 + 16 * jt + 4 * fq) = b;
    }
    __syncthreads();
    bf16x8 sA[4];
#pragma unroll
    for (int k = 0; k < 4; ++k) sA[k] = ldf(STR, 136, 0, 32 * k, lane);
    const float qfs = __expf(lg * (float)(ii + 1));
    f32x4 o[8]; float ssq = 0.f;
#pragma unroll
    for (int et = 0; et < 8; ++et) {
        f32x4 a = F4Z, a2 = F4Z;
#pragma unroll
        for (int k = 0; k < 4; ++k) { a = mma(a, ldf(VT, 136, 16 * et, 32 * k, lane), sA[k]); a2 = mma(a2, ldf(ST, 136, 16 * et, 32 * k, lane), qA[k]); }
        o[et] = a + a2 * qfs;
        ssq += (o[et][0] * o[et][0] + o[et][1] * o[et][1]) + (o[et][2] * o[et][2] + o[et][3] * o[et][3]);
    }
    ssq += __shfl_xor(ssq, 16); ssq += __shfl_xor(ssq, 32);
    const float rinv = rsqrtf(ssq * (1.f / 128.f) + 1e-6f);
#pragma unroll
    for (int et = 0; et < 8; ++et) {
        const int ch = h * 128 + 16 * et + 4 * fq;
        const u32x2 gg = *(const u32x2*)(P + (size_t)(t0 + ii) * P0LD + C_G + ch);
        u32x2 b; b.x = pk2(o[et][0] * rinv * siluf_(bflo(gg.x)), o[et][1] * rinv * siluf_(bfhi(gg.x))); b.y = pk2(o[et][2] * rinv * siluf_(bflo(gg.y)), o[et][3] * rinv * siluf_(bfhi(gg.y)));
        *(u32x2*)(Y + (size_t)(t0 + ii) * D + ch) = b;
    }
    __syncthreads();
}
__device__ __forceinline__ void l0_output(const Ctx& C) {
    for (int u = C.bid; u < 256; u += C.G) mamba_out_unit(C, u >> 1, u & 1);
    for (int u = C.bid; u < 512; u += C.G) ret_out_unit(C, u >> 2, u & 3);
}

constexpr size_t WS_WLOG = WS_ST, WS_AA = WS_ST + 16 * MiB, WS_GG = WS_WGU1, WS_PC = WS_Y, WS_UC = WS_XB;
constexpr size_t WS_LA = WS_LRUC, WS_HC = WS_LRUC + 512 * 1024, WS_HIN = WS_LRUC + 1024 * 1024;
constexpr int SW_WAT = 0, SW_WXT = 65536, SW_W2T = 131072, SW_A2T = 163840, SW_G2T = 196608;
__device__ __forceinline__ bf16_t* gg_row(unsigned char* ws, int t) { return (bf16_t*)(ws + WS_GG) + (size_t)t * 512; }
__device__ __forceinline__ float tanhf_(float x) { return 1.f - 2.f * frcp(1.f + __expf(2.f * x)); }

__device__ __forceinline__ void rwkv_prep(const Ctx& C, int c) {
    const bf16_t* P = (const bf16_t*)(C.ws + WS_HP); const bf16_t* SW = (const bf16_t*)(C.ws + WS_SMALLW);
    bf16_t* WLOG = (bf16_t*)(C.ws + WS_WLOG); bf16_t* AA = (bf16_t*)(C.ws + WS_AA);
    LAS bf16_t* TW = (LAS bf16_t*)C.lds; LAS bf16_t* AL = TW + 64 * 72; LAS bf16_t* SG = AL + 64 * 72;
    const float* mu = C.in[27];
    const int t0 = 64 * c, lane = C.lane, fr = lane & 15, fq = lane >> 4;
    for (int idx = C.tid; idx < 64 * 288; idx += 512) {
        const int tok = idx / 288, cc = idx % 288, col = 2560 + cc, t = t0 + tok;
        const float cur = bf2f(P[(size_t)t * P1LD + col]), prev = t > 0 ? bf2f(P[(size_t)(t - 1) * P1LD + col]) : 0.f;
        const float s = cur + (prev - cur) * mu[col - 1024];
        if (cc < 64) TW[tok * 72 + cc] = f2bf(tanhf_(s)); else if (cc < 128) AL[tok * 72 + cc - 64] = f2bf(s); else SG[tok * 168 + cc - 128] = f2bf(sigmoidf_(s));
    }
    __syncthreads();
    const int n0 = 64 * C.wave;
#pragma unroll 1
    for (int which = 0; which < 2; ++which) {
        const bf16_t* BT = SW + (which == 0 ? SW_W2T : SW_A2T); const LAS bf16_t* AM = which == 0 ? TW : AL;
        const float* bias = which == 0 ? C.in[28] : C.in[30]; bf16_t* O = which == 0 ? WLOG : AA;
#pragma unroll 1
        for (int nt = 0; nt < 4; ++nt) {
            const bf16x8 nf0 = ldfg(BT, 64, n0 + 16 * nt, 0, lane), nf1 = ldfg(BT, 64, n0 + 16 * nt, 32, lane);
            const int n = n0 + 16 * nt + 4 * fq; const f32x4 bv = *(const f32x4*)(bias + n);
#pragma unroll
            for (int mt = 0; mt < 4; ++mt) {
                f32x4 acc = F4Z; acc = mma(acc, nf0, ldf(AM, 72, 16 * mt, 0, lane)); acc = mma(acc, nf1, ldf(AM, 72, 16 * mt, 32, lane));
                float o[4];
#pragma unroll
                for (int v = 0; v < 4; ++v) { const float x = acc[v] + bv[v]; o[v] = which == 0 ? -__expf(-softplusf_(-x) - 0.5f) : sigmoidf_(x); }
                u32x2 b; b.x = pk2(o[0], o[1]); b.y = pk2(o[2], o[3]);
                *(u32x2*)(O + (size_t)(t0 + 16 * mt + fr) * 512 + n) = b;
            }
        }
    }
#pragma unroll 1
    for (int nt = 0; nt < 4; ++nt) {
        bf16x8 nf[5];
#pragma unroll
        for (int k = 0; k < 5; ++k) nf[k] = ldfg(SW + SW_G2T, 160, n0 + 16 * nt, 32 * k, lane);
        const int n = n0 + 16 * nt + 4 * fq;
#pragma unroll
        for (int mt = 0; mt < 4; ++mt) {
            f32x4 acc = F4Z;
#pragma unroll
            for (int k = 0; k < 5; ++k) acc = mma(acc, nf[k], ldf(SG, 168, 16 * mt, 32 * k, lane));
#ifdef GG_CONSTVAL
            acc = (f32x4){0.5f, 0.25f, -0.5f, 1.f};
#endif
            u32x2 b; b.x = pk2(acc[0], acc[1]); b.y = pk2(acc[2], acc[3]);
            *(u32x2*)(gg_row(C.ws, t0 + 16 * mt + fr) + n) = b;
        }
    }
    asm volatile("s_waitcnt vmcnt(0)" ::: "memory");
    __threadfence_block();
    __syncthreads();
}

template <int PASS>
__device__ __forceinline__ void rwkv_chunk(const Ctx& C, int c) {
    const bf16_t* P = (const bf16_t*)(C.ws + WS_HP);
    const bf16_t* WLOG = (const bf16_t*)(C.ws + WS_WLOG); const bf16_t* AA = (const bf16_t*)(C.ws + WS_AA);
    float* PC = (float*)(C.ws + WS_PC); float* UC = (float*)(C.ws + WS_UC); bf16_t* Y = (bf16_t*)(C.ws + WS_Y);
    LAS float* VW = (LAS float*)(C.lds + 40960); LAS float* VKK = VW + 4096; LAS float* VB = VKK + 4096; LAS float* VK = VB + 4096; LAS float* VR = VK + 4096; LAS float* VV = VR + 4096; LAS float* VG = VV + 4096; LAS float* VBON = VG + 4096;
    const int t0 = 64 * c, lane = C.lane, head = C.wave, ch = C.tid;
    const float* mu = C.in[27];
    f32x2 SU[32], SP[32];
    if (PASS == 1) {
#pragma unroll
        for (int k = 0; k < 32; ++k) { SU[k] = (f32x2){0.f, 0.f}; SP[k] = (f32x2){(2 * k == lane) ? 1.f : 0.f, (2 * k + 1 == lane) ? 1.f : 0.f}; }
    } else {
        const f32x4* src = (const f32x4*)(UC + ((size_t)(c * 8 + head) * 64 + lane) * 64);
#pragma unroll
        for (int k4 = 0; k4 < 16; ++k4) { f32x4 v = src[k4];
#ifdef RW3_ZERO
            v = F4Z;
#endif
            SU[2 * k4] = (f32x2){v[0], v[1]}; SU[2 * k4 + 1] = (f32x2){v[2], v[3]}; }
    }
    float pr = 0.f, pk = 0.f, pv = 0.f;
    if (t0 > 0) { const bf16_t* row = P + (size_t)(t0 - 1) * P1LD; pr = bf2f(row[1024 + ch]); pk = bf2f(row[1536 + ch]); pv = bf2f(row[2048 + ch]); }
#pragma unroll 1
    for (int sb = 0; sb < 8; ++sb) {
        const float mu_r = mu[ch], mu_k = mu[512 + ch], mu_v = mu[1024 + ch], kkc = C.in[33][ch], kac = C.in[34][ch], rkc = C.in[35][ch];
        constexpr int UF = PASS == 3 ? 8 : 4;
#pragma unroll 1
        for (int j0 = 0; j0 < 8; j0 += UF) {
            float cr[UF], ck[UF], cv[UF], aa[UF], wl[UF], gg[UF];
#pragma unroll
            for (int u = 0; u < UF; ++u) {
                const int t = t0 + 8 * sb + j0 + u; const bf16_t* row = P + (size_t)t * P1LD;
                ck[u] = bf2f(row[1536 + ch]); cv[u] = bf2f(row[2048 + ch]); aa[u] = bf2f(AA[(size_t)t * 512 + ch]); wl[u] = bf2f(WLOG[(size_t)t * 512 + ch]);
                if (PASS == 3) { cr[u] = bf2f(row[1024 + ch]); gg[u] = bf2f(gg_row(C.ws, t)[ch]); }
            }
            float kkr[UF], kp[UF], nrm[UF], bon[UF], rsv[UF];
#pragma unroll
            for (int u = 0; u < UF; ++u) {
                const float ks = ck[u] + (pk - ck[u]) * mu_k, vs = cv[u] + (pv - cv[u]) * mu_v; pk = ck[u]; pv = cv[u];
                kkr[u] = ks * kkc; nrm[u] = kkr[u] * kkr[u]; kp[u] = ks * (1.f + (aa[u] - 1.f) * kac);
                VV[(j0 + u) * 512 + ch] = vs; VK[(j0 + u) * 512 + ch] = kp[u]; VW[(j0 + u) * 512 + ch] = __expf(wl[u]);
                if (PASS == 3) { rsv[u] = cr[u] + (pr - cr[u]) * mu_r; pr = cr[u]; bon[u] = rsv[u] * kp[u] * rkc; VR[(j0 + u) * 512 + ch] = rsv[u]; VG[(j0 + u) * 512 + ch] = gg[u]; }
            }
#pragma unroll
            for (int o = 1; o < 64; o <<= 1) {
#pragma unroll
                for (int u = 0; u < UF; ++u) { nrm[u] += __shfl_xor(nrm[u], o); if (PASS == 3) bon[u] += __shfl_xor(bon[u], o); }
            }
#pragma unroll
            for (int u = 0; u < UF; ++u) {
                const float kk = kkr[u] * rsqrtf(fmaxf(nrm[u], 1e-24f));
                VKK[(j0 + u) * 512 + ch] = kk; VB[(j0 + u) * 512 + ch] = kk * aa[u];
                if (PASS == 3) { if (lane == 0) VBON[(j0 + u) * 8 + head] = bon[u]; }
            }
        }
        __syncthreads();
#pragma unroll 1
        for (int j = 0; j < 8; ++j) {
            const LAS f32x4* pw = (const LAS f32x4*)(VW + j * 512 + head * 64); const LAS f32x4* pkk = (const LAS f32x4*)(VKK + j * 512 + head * 64);
            const LAS f32x4* pb = (const LAS f32x4*)(VB + j * 512 + head * 64); const LAS f32x4* pkp = (const LAS f32x4*)(VK + j * 512 + head * 64);
            const LAS f32x4* prr = (const LAS f32x4*)(VR + j * 512 + head * 64);
#define LO2(v) __builtin_shufflevector(v, v, 0, 1)
#define HI2(v) __builtin_shufflevector(v, v, 2, 3)
#define FMA2(a, b, c) __builtin_elementwise_fma(a, b, c)
            f32x2 aU0 = {0.f, 0.f}, aU1 = {0.f, 0.f}, aP0 = {0.f, 0.f}, aP1 = {0.f, 0.f};
            {
                f32x4 q = pkk[0];
#pragma unroll
                for (int g = 0; g < 16; ++g) {
                    f32x4 qn = q; if (g + 1 < 16) qn = pkk[g + 1];
                    aU0 = FMA2(SU[2 * g], LO2(q), aU0); aU1 = FMA2(SU[2 * g + 1], HI2(q), aU1);
                    if (PASS == 1) { aP0 = FMA2(SP[2 * g], LO2(q), aP0); aP1 = FMA2(SP[2 * g + 1], HI2(q), aP1); }
                    q = qn;
                    if (PASS == 1) __builtin_amdgcn_sched_barrier(0);
                }
            }
            const float skU = (aU0[0] + aU0[1]) + (aU1[0] + aU1[1]), skP = (aP0[0] + aP0[1]) + (aP1[0] + aP1[1]);
            const float vv = VV[j * 512 + ch];
            const f32x2 nsU = {-skU, -skU}, nsP = {-skP, -skP}, vv2 = {vv, vv};
            f32x2 y0 = {0.f, 0.f}, y1 = {0.f, 0.f};
            {
                f32x4 w4 = pw[0], b4 = pb[0], k4 = pkp[0], r4 = F4Z; if (PASS == 3) r4 = prr[0];
#pragma unroll
                for (int g = 0; g < 16; ++g) {
                    f32x4 nw = w4, nb = b4, nk = k4, nr = r4;
                    if (g + 1 < 16) { nw = pw[g + 1]; nb = pb[g + 1]; nk = pkp[g + 1]; if (PASS == 3) nr = prr[g + 1]; }
                    SU[2 * g] = FMA2(SU[2 * g], LO2(w4), FMA2(nsU, LO2(b4), vv2 * LO2(k4)));
                    SU[2 * g + 1] = FMA2(SU[2 * g + 1], HI2(w4), FMA2(nsU, HI2(b4), vv2 * HI2(k4)));
                    if (PASS == 1) { SP[2 * g] = FMA2(SP[2 * g], LO2(w4), nsP * LO2(b4)); SP[2 * g + 1] = FMA2(SP[2 * g + 1], HI2(w4), nsP * HI2(b4)); }
                    if (PASS == 3) { y0 = FMA2(SU[2 * g], LO2(r4), y0); y1 = FMA2(SU[2 * g + 1], HI2(r4), y1); }
                    w4 = nw; b4 = nb; k4 = nk; r4 = nr;
                    if (PASS == 1) __builtin_amdgcn_sched_barrier(0);
                }
            }
            const float y = (y0[0] + y0[1]) + (y1[0] + y1[1]);
            if (PASS == 3) VKK[j * 512 + ch] = y;
        }
        if (PASS == 3) {
            const float lng = C.in[36][ch], lnb = C.in[37][ch];
            float y[8], s1[8], s2[8];
#pragma unroll
            for (int u = 0; u < 8; ++u) { y[u] = VKK[u * 512 + ch]; s1[u] = y[u]; }
#pragma unroll
            for (int o = 1; o < 64; o <<= 1) {
#pragma unroll
                for (int u = 0; u < 8; ++u) s1[u] += __shfl_xor(s1[u], o);
            }
#pragma unroll
            for (int u = 0; u < 8; ++u) { y[u] -= s1[u] * (1.f / 64.f); s2[u] = y[u] * y[u]; }
#pragma unroll
            for (int o = 1; o < 64; o <<= 1) {
#pragma unroll
                for (int u = 0; u < 8; ++u) s2[u] += __shfl_xor(s2[u], o);
            }
#pragma unroll
            for (int u = 0; u < 8; ++u) {
                const float yn = y[u] * rsqrtf(s2[u] * (1.f / 64.f) + 64e-5f) * lng + lnb;
                Y[(size_t)(t0 + 8 * sb + u) * D + 512 + ch] = f2bf((yn + VBON[u * 8 + head] * VV[u * 512 + ch]) * VG[u * 512 + ch]);
            }
        }
        __syncthreads();
    }
    if (PASS == 1) {
        f32x4* du = (f32x4*)(UC + ((size_t)(c * 8 + head) * 64 + lane) * 64); f32x4* dp = (f32x4*)(PC + ((size_t)(c * 8 + head) * 64 + lane) * 64);
#pragma unroll
        for (int k4 = 0; k4 < 16; ++k4) { du[k4] = (f32x4){SU[2 * k4][0], SU[2 * k4][1], SU[2 * k4 + 1][0], SU[2 * k4 + 1][1]}; dp[k4] = (f32x4){SP[2 * k4][0], SP[2 * k4][1], SP[2 * k4 + 1][0], SP[2 * k4 + 1][1]}; }
    }
}

template <int PASS>
__device__ __forceinline__ void lru_chunk(const Ctx& C, int c) {
    const bf16_t* P = (const bf16_t*)(C.ws + WS_HP); const bf16_t* SW = (const bf16_t*)(C.ws + WS_SMALLW); bf16_t* Y = (bf16_t*)(C.ws + WS_Y);
    LAS bf16_t* XC = (LAS bf16_t*)C.lds; LAS bf16_t* LAB = (LAS bf16_t*)(C.lds + 66560);
    const int t0 = 64 * c, lane = C.lane, fr = lane & 15, fq = lane >> 4;
    {
        const int grp = C.tid & 63, seg = C.tid >> 6, ch0 = 8 * grp, r0 = 8 * seg;
        const float* cw = C.in[20]; const float* cb = C.in[21];
        float w0[8], w1[8], w2[8], w3[8], bb[8], x0[8], x1[8], x2[8];
#pragma unroll
        for (int i = 0; i < 8; ++i) { w0[i] = cw[ch0 + i]; w1[i] = cw[512 + ch0 + i]; w2[i] = cw[1024 + ch0 + i]; w3[i] = cw[1536 + ch0 + i]; bb[i] = cb[ch0 + i]; }
        auto ldrow = [&](int t, float (&x)[8]) {
            if (t < 0) {
#pragma unroll
                for (int i = 0; i < 8; ++i) x[i] = 0.f;
            } else {
                const u32x4 a = *(const u32x4*)(P + (size_t)t * P1LD + ch0);
#pragma unroll
                for (int i = 0; i < 4; ++i) { x[2 * i] = bflo(a[i]); x[2 * i + 1] = bfhi(a[i]); }
            }
        };
        ldrow(t0 + r0 - 3, x0); ldrow(t0 + r0 - 2, x1); ldrow(t0 + r0 - 1, x2);
#pragma unroll
        for (int row = r0; row < r0 + 8; ++row) {
            float x3[8], v[8]; ldrow(t0 + row, x3);
#pragma unroll
            for (int i = 0; i < 8; ++i) { v[i] = bb[i] + w0[i] * x0[i] + w1[i] * x1[i] + w2[i] * x2[i] + w3[i] * x3[i]; x0[i] = x1[i]; x1[i] = x2[i]; x2[i] = x3[i]; }
            u32x4 w; w.x = pk2(v[0], v[1]); w.y = pk2(v[2], v[3]); w.z = pk2(v[4], v[5]); w.w = pk2(v[6], v[7]);
            *(LAS u32x4*)(XC + row * 520 + ch0) = w;
        }
    }
    __syncthreads();
    const int nb = C.wave >> 1, eh = C.wave & 1, cbase = nb * 128 + 64 * eh;
#pragma unroll 1
    for (int mt = 0; mt < 4; ++mt) {
        bf16x8 mf[4];
#pragma unroll
        for (int k = 0; k < 4; ++k) mf[k] = ldf(XC, 520, 16 * mt, nb * 128 + 32 * k, lane);
        unsigned ur[4][2];
#pragma unroll
        for (int nt = 0; nt < 4; ++nt) {
            f32x4 aa = F4Z, ax = F4Z;
#pragma unroll
            for (int k = 0; k < 4; ++k) {
                aa = mma(aa, ldfg(SW + SW_WAT + nb * 16384, 128, 64 * eh + 16 * nt, 32 * k, lane), mf[k]);
                ax = mma(ax, ldfg(SW + SW_WXT + nb * 16384, 128, 64 * eh + 16 * nt, 32 * k, lane), mf[k]);
            }
            const int chn = cbase + 16 * nt + 4 * fq;
            const f32x4 bav = *(const f32x4*)(C.in[23] + chn), bxv = *(const f32x4*)(C.in[25] + chn), lam = *(const f32x4*)(C.in[26] + chn);
            const u32x2 xw = *(const LAS u32x2*)(XC + (16 * mt + fr) * 520 + chn);
            const float xc[4] = {bflo(xw.x), bfhi(xw.x), bflo(xw.y), bfhi(xw.y)};
            float la[4], uu[4];
#pragma unroll
            for (int v = 0; v < 4; ++v) { const float r = sigmoidf_(aa[v] + bav[v]), ig = sigmoidf_(ax[v] + bxv[v]); la[v] = -8.f * softplusf_(-lam[v]) * r; uu[v] = sqrtf(fmaxf(-expm1f(2.f * la[v]), 0.f)) * ig * xc[v]; }
            *(LAS u32x2*)(LAB + (16 * mt + fr) * 512 + chn) = (u32x2){pk2(la[0], la[1]), pk2(la[2], la[3])};
            ur[nt][0] = pk2(uu[0], uu[1]); ur[nt][1] = pk2(uu[2], uu[3]);
        }
        __syncthreads();
#pragma unroll
        for (int nt = 0; nt < 4; ++nt) *(LAS u32x2*)(XC + (16 * mt + fr) * 520 + cbase + 16 * nt + 4 * fq) = (u32x2){ur[nt][0], ur[nt][1]};
    }
    __syncthreads();
    {
        const int ch = C.tid;
        float* LA = (float*)(C.ws + WS_LA); float* HC = (float*)(C.ws + WS_HC); const float* HIN = (const float*)(C.ws + WS_HIN);
        float h = PASS == 3 ? HIN[c * 512 + ch] : 0.f, sla = 0.f;
#pragma unroll 4
        for (int tok = 0; tok < 64; ++tok) {
            const float la = bf2f(LAB[tok * 512 + ch]), u = bf2f(XC[tok * 520 + ch]);
            h = fmaf(__expf(la), h, u); sla += la;
            if (PASS == 3) {
                const float gb = bf2f(P[(size_t)(t0 + tok) * P1LD + 512 + ch]);
                const float ge = 0.5f * gb * (1.f + tanhf_(0.7978845608028654f * (gb + 0.044715f * gb * gb * gb)));
                Y[(size_t)(t0 + tok) * D + ch] = f2bf(h * ge);
            }
        }
        if (PASS == 1) { LA[c * 512 + ch] = sla; HC[c * 512 + ch] = h; }
    }
    __syncthreads();
}

__device__ __forceinline__ void l1_pass_a(const Ctx& C) {
#ifndef SKIP_PREP
    for (int c = C.bid; c < 256; c += C.G) rwkv_prep(C, c);
#endif
#ifndef SKIP_RW1
    for (int c = C.bid; c < 256; c += C.G) rwkv_chunk<1>(C, c);
#endif
#ifndef SKIP_LRU1
    for (int c = C.bid; c < 256; c += C.G) lru_chunk<1>(C, c);
#endif
}
__device__ __forceinline__ void l1_pass_c(const Ctx& C) {
#ifndef SKIP_RW3
    for (int c = C.bid; c < 256; c += C.G) rwkv_chunk<3>(C, c);
#ifdef PROBE_RW3X2
    for (int c = C.bid; c < 256; c += C.G) rwkv_chunk<3>(C, c);
#endif
#endif
#ifndef SKIP_LRU3
    for (int c = C.bid; c < 256; c += C.G) lru_chunk<3>(C, c);
#ifdef PROBE_LRU3X2
    for (int c = C.bid; c < 256; c += C.G) lru_chunk<3>(C, c);
#endif
#endif
}

__device__ __forceinline__ void l1_middle(const Ctx& C) {
    const float* PC = (const float*)(C.ws + WS_PC); float* UC = (float*)(C.ws + WS_UC);
    const int lane = C.lane;
#ifndef SKIP_MID
    for (int gw = C.bid * 8 + C.wave; gw < 512; gw += C.G * 8) {
        const int head = gw >> 6, row = gw & 63;
        LAS float* SR = (LAS float*)(C.lds + C.wave * 256);
        float s = 0.f; SR[lane] = 0.f;
        float pa[64], pb[64];
#pragma unroll
        for (int i = 0; i < 64; ++i) pa[i] = PC[((size_t)(0 * 8 + head) * 64 + i) * 64 + lane];
        float* ub = UC + ((size_t)head * 64 + row) * 64 + lane;
        float u_cur = ub[0];
#pragma unroll 1
        for (int c = 0; c < 256; c += 2) {
            {
                const float u_nxt = ub[(size_t)(c + 1) * 32768];
#pragma unroll
                for (int i = 0; i < 64; ++i) pb[i] = PC[((size_t)((c + 1) * 8 + head) * 64 + i) * 64 + lane];
                ub[(size_t)c * 32768] = s;
                float a0 = 0.f, a1 = 0.f, a2 = 0.f, a3 = 0.f;
#pragma unroll
                for (int i4 = 0; i4 < 16; ++i4) { const f32x4 s4 = *(const LAS f32x4*)(SR + 4 * i4); a0 = fmaf(s4[0], pa[4 * i4], a0); a1 = fmaf(s4[1], pa[4 * i4 + 1], a1); a2 = fmaf(s4[2], pa[4 * i4 + 2], a2); a3 = fmaf(s4[3], pa[4 * i4 + 3], a3); }
                s = u_cur + ((a0 + a1) + (a2 + a3)); SR[lane] = s; u_cur = u_nxt;
            }
            {
                const int cn = (c + 2 < 256) ? c + 2 : 255;
                const float u_nxt = ub[(size_t)cn * 32768];
#pragma unroll
                for (int i = 0; i < 64; ++i) pa[i] = PC[((size_t)(cn * 8 + head) * 64 + i) * 64 + lane];
                ub[(size_t)(c + 1) * 32768] = s;
                float a0 = 0.f, a1 = 0.f, a2 = 0.f, a3 = 0.f;
#pragma unroll
                for (int i4 = 0; i4 < 16; ++i4) { const f32x4 s4 = *(const LAS f32x4*)(SR + 4 * i4); a0 = fmaf(s4[0], pb[4 * i4], a0); a1 = fmaf(s4[1], pb[4 * i4 + 1], a1); a2 = fmaf(s4[2], pb[4 * i4 + 2], a2); a3 = fmaf(s4[3], pb[4 * i4 + 3], a3); }
                s = u_cur + ((a0 + a1) + (a2 + a3)); SR[lane] = s; u_cur = u_nxt;
            }
        }
    }
#endif
    if (C.bid == (C.G > 64 ? 64 : 0)) {
        const float* LA = (const float*)(C.ws + WS_LA); const float* HC = (const float*)(C.ws + WS_HC); float* HIN = (float*)(C.ws + WS_HIN);
        const int ch = C.tid; float h = 0.f;
        for (int c0 = 0; c0 < 256; c0 += 8) { float la[8], hc[8];
#pragma unroll
            for (int j = 0; j < 8; ++j) { la[j] = LA[(c0 + j) * 512 + ch]; hc[j] = HC[(c0 + j) * 512 + ch]; }
#pragma unroll
            for (int j = 0; j < 8; ++j) { HIN[(c0 + j) * 512 + ch] = h; h = fmaf(__expf(la[j]), h, hc[j]); } }
    }
}

struct Args { const float* in[39]; float* out; unsigned char* ws; int ph_lo, ph_hi; };
constexpr int N_PHASES = 20;

__device__ __forceinline__ void ffn_gu(const Ctx& C, LAS unsigned char* lds, size_t wgu, int site) {
    pg8::Gemm g{(const bf16_t*)(C.ws + WS_XB), (const bf16_t*)(C.ws + wgu), T, 2 * FF, D}; pg8::StaticOrder S; S.init(T, 2 * FF, C.G, C.bid);
    EpiSwiglu E{(bf16_t*)(C.ws + WS_HP), (const float*)(C.ws + WS_SSQ) + (size_t)site * T * 16};
    pg8::gemm_phase<EpiSwiglu, pg8::StaticOrder, true, true>(lds, g, S, E);
}
__device__ __forceinline__ void ffn_down(const Ctx& C, LAS unsigned char* lds, size_t wd, int site_out, float alpha = 0.5f) {
    pg8::Gemm g{(const bf16_t*)(C.ws + WS_HP), (const bf16_t*)(C.ws + wd), T, D, FF}; pg8::StaticOrder S; S.init(T, D, C.G, C.bid);
    EpiResid E{C.X, (bf16_t*)(C.ws + WS_XB), (float*)(C.ws + WS_SSQ) + (size_t)site_out * T * 16, alpha};
    pg8::gemm_phase<EpiResid, pg8::StaticOrder, true, true>(lds, g, S, E);
}
__device__ __forceinline__ void out_proj(const Ctx& C, LAS unsigned char* lds, int site_out) {
    pg8::Gemm g{(const bf16_t*)(C.ws + WS_Y), (const bf16_t*)(C.ws + WS_WOUT), T, D, D}; pg8::StaticOrder S; S.init(T, D, C.G, C.bid);
    EpiResid E{C.X, (bf16_t*)(C.ws + WS_XB), (float*)(C.ws + WS_SSQ) + (size_t)site_out * T * 16, 1.0f};
    pg8::gemm_phase<EpiResid, pg8::StaticOrder, true, true>(lds, g, S, E);
}

__global__ void __launch_bounds__(512) mk_fwd(Args args) {
    extern __shared__ __attribute__((aligned(16))) unsigned char lds_raw[];
    cg::grid_group grid = cg::this_grid();
    Ctx C; C.in = args.in; C.X = args.out; C.ws = args.ws; C.lds = (LAS unsigned char*)lds_raw;
    C.tid = threadIdx.x; C.lane = C.tid & 63; C.wave = __builtin_amdgcn_readfirstlane(C.tid >> 6); C.G = gridDim.x; C.bid = blockIdx.x;
    LAS unsigned char* lds = C.lds;
    const int lo = args.ph_lo, hi = args.ph_hi;
#define IN(k) (lo <= (k) && (k) < hi)
#ifndef REP_MASK
#define REP_MASK 0
#endif
#define REPS(k) (((REP_MASK >> (k)) & 1) ? 2 : 1)
#define SEAM(k) do { if (IN(k) && IN((k) + 1)) { asm volatile("s_waitcnt vmcnt(0)" ::: "memory");     \
    grid.sync(); if (C.wave == 0) { __builtin_amdgcn_fence(__ATOMIC_ACQUIRE, "agent"); asm volatile("s_waitcnt vmcnt(0)" ::: "memory"); } __syncthreads(); } } while (0)

    if (IN(0)) {
        convert_weights(C, 0, 7);
        bf16_t* sw = (bf16_t*)(C.ws + WS_SMALLW);
        for (int n = 0; n < 4; ++n) { tr_small(C, C.in[22] + n * 16384, 128, 128, sw + n * 16384); tr_small(C, C.in[24] + n * 16384, 128, 128, sw + 65536 + n * 16384); }
        tr_small(C, C.in[29], 64, 512, sw + 131072); tr_small(C, C.in[31], 64, 512, sw + 163840); tr_small(C, C.in[32], 160, 512, sw + 196608);
        prologue_x(C);
    }
    SEAM(0);
    if (IN(1)) { ffn_gu(C, lds, WS_WGU1, 0); if (REPS(1) == 2) ffn_gu(C, lds, WS_WGU1, 0); }
    SEAM(1);
    if (IN(2)) { ffn_down(C, lds, WS_WD1, 1, 0.5f); if (REPS(2) == 2) ffn_down(C, lds, WS_WD1, 1, 0.f); }
    SEAM(2);
    if (IN(3)) {
        pg8::Gemm g{(const bf16_t*)(C.ws + WS_XB), (const bf16_t*)(C.ws + WS_WIN), T, 3584, D}; pg8::StaticOrder S; S.init(T, 3584, C.G, C.bid);
        EpiProj E{(bf16_t*)(C.ws + WS_HP), P0LD, 3328, (const float*)(C.ws + WS_SSQ) + (size_t)1 * T * 16, (float*)(C.ws + WS_DT), 3328};
        pg8::gemm_phase<EpiProj, pg8::StaticOrder, true, true>(lds, g, S, E);
    }
    SEAM(3);
    #ifndef SKIP4
    if (IN(4)) { l0_states(C); if (REPS(4) == 2) l0_states(C); }
#endif
    SEAM(4);
    #ifndef SKIP5
    if (IN(5)) { l0_scan(C); __syncthreads(); convert_weights(C, 1, 1); }
#endif
    SEAM(5);
    #ifndef SKIP6
    if (IN(6)) { l0_output(C); if (REPS(6) == 2) l0_output(C); }
#endif
    SEAM(6);
    if (IN(7)) out_proj(C, lds, 2);
    SEAM(7);
    if (IN(8)) { convert_weights(C, 1, 2); __syncthreads(); ffn_gu(C, lds, WS_WGU2, 2); }
    SEAM(8);
    if (IN(9)) ffn_down(C, lds, WS_WD2, 3);
    SEAM(9);
    if (IN(10)) ffn_gu(C, lds, WS_WGU1, 3);
    SEAM(10);
    if (IN(11)) ffn_down(C, lds, WS_WD1, 4);
    SEAM(11);
    if (IN(12)) {
        pg8::Gemm g{(const bf16_t*)(C.ws + WS_XB), (const bf16_t*)(C.ws + WS_WIN), T, 3072, D}; pg8::StaticOrder S; S.init(T, 3072, C.G, C.bid);
        EpiProj E{(bf16_t*)(C.ws + WS_HP), P1LD, 2848, (const float*)(C.ws + WS_SSQ) + (size_t)4 * T * 16, nullptr, -1};
        pg8::gemm_phase<EpiProj, pg8::StaticOrder, true, true>(lds, g, S, E);
    }
    SEAM(12);
    if (IN(13)) { l1_pass_a(C); if (REPS(13) == 2) l1_pass_a(C); }
    SEAM(13);
    if (IN(14)) { l1_middle(C); __syncthreads(); convert_weights(C, 1, 4); }
    SEAM(14);
    if (IN(15)) { l1_pass_c(C); if (REPS(15) == 2) l1_pass_c(C); }
    SEAM(15);
    if (IN(16)) out_proj(C, lds, 5);
    SEAM(16);
    if (IN(17)) ffn_gu(C, lds, WS_WGU2, 5);
    SEAM(17);
    if (IN(18)) ffn_down(C, lds, WS_WD2, 6);
    SEAM(18);
    if (IN(19)) final_norm(C);
#undef IN
#undef SEAM
}

extern "C" void kernel_launch(void* const* d_in, const int* in_sizes, int n_in, void* d_out, int out_size, void* d_ws, size_t ws_size, hipStream_t stream) {
    static int grid = 0;
    if (grid == 0) {
        if (n_in != 39 || out_size != T * D || ws_size < WS_END) { fprintf(stderr, "kernel_launch: unexpected problem: n_in %d out %d ws %zu\n", n_in, out_size, ws_size); grid = -1; return; }
        int dev = 0, cus = 0, per_cu = 0;
        hipGetDevice(&dev); hipDeviceGetAttribute(&cus, hipDeviceAttributeMultiprocessorCount, dev);
        if (hipFuncSetAttribute((const void*)mk_fwd, hipFuncAttributeMaxDynamicSharedMemorySize, LDS_BYTES) != hipSuccess) { fprintf(stderr, "kernel_launch: hipFuncSetAttribute failed\n"); grid = -1; return; }
        if (hipOccupancyMaxActiveBlocksPerMultiprocessor(&per_cu, (const void*)mk_fwd, 512, LDS_BYTES) != hipSuccess || per_cu < 1) { fprintf(stderr, "kernel_launch: occupancy query says %d\n", per_cu); per_cu = 1; (void)hipGetLastError(); }
        grid = cus * (per_cu > 1 ? 1 : per_cu);
    }
    if (grid < 0) return;
    Args a{};
    for (int i = 0; i < 39; ++i) a.in[i] = (const float*)d_in[i];
    a.out = (float*)d_out; a.ws = (unsigned char*)d_ws; a.ph_lo = 0; a.ph_hi = N_PHASES;
    void* kargs[] = {&a};
    hipError_t e = hipLaunchCooperativeKernel((const void*)mk_fwd, dim3(grid), dim3(512), kargs, LDS_BYTES, stream);
    if (e != hipSuccess) fprintf(stderr, "kernel_launch: cooperative launch failed: %s (grid %d)\n", hipGetErrorString(e), grid);
}
```

```cpp
#include <hip/hip_runtime.h>
#include <hip/hip_cooperative_groups.h>
#include <cstdio>
#include <cstdint>
namespace cg = cooperative_groups;
namespace pg8 {
#define PG8_LAS __attribute__((address_space(3)))
typedef unsigned short bf16_t;
typedef short bf16x8 __attribute__((ext_vector_type(8)));
typedef float f32x4 __attribute__((ext_vector_type(4)));
typedef unsigned u32x4 __attribute__((ext_vector_type(4)));
constexpr int BM = 256, BK = 64, HALF = 128, HTB = HALF * BK * 2  , STAGE_BYTES = 8 * HTB, NXCD = 8, WGM = 8;

__host__ __device__ __forceinline__ int lds_byte(int r, int c) { const int st = (r >> 4) * 2 + (c >> 5), rr = r & 15, cc = c & 31, ob = rr * 64 + cc * 2; return st * 1024 + (ob ^ (((ob >> 9) & 1) << 5)); }
__host__ __device__ __forceinline__ void stage_rc(int b, int& R, int& C) { const int st = b / 1024, sb = b % 1024, swz = sb ^ (((sb >> 9) & 1) << 5); R = (st >> 1) * 16 + swz / 64; C = (st & 1) * 32 + (swz % 64) / 2; }
__host__ __device__ __forceinline__ int perm32(int rho) { const int n = rho >> 4, i = rho & 15; return 8 * (i >> 2) + 4 * n + (i & 3); }

struct Unit { int pm, pn; };
struct Gemm { const bf16_t* A; const bf16_t* Bt; int M, N, K; };

struct StaticOrder {
    int nM, nN, nwg, G, c;
    __host__ __device__ void init(int M, int N, int G_, int c_) { nM = M / BM; nN = N / BM; nwg = nM * nN; G = G_; c = c_; }
    __host__ __device__ bool next(int i, Unit& u) const {
        const long L = (long)i * G + c; if (L >= nwg) return false;
        int wgid = (int)L; { const int q = nwg / NXCD, r = nwg % NXCD, xcd = wgid % NXCD, off = wgid / NXCD; wgid = (xcd < r ? xcd * (q + 1) : r * (q + 1) + (xcd - r) * q) + off; }
        const int nig = WGM * nN, gid = wgid / nig, fm = gid * WGM, gsz = (nM - fm) < WGM ? (nM - fm) : WGM;
        u.pm = fm + ((wgid % nig) % gsz); u.pn = (wgid % nig) / gsz; return true;
    }
    __device__ __forceinline__ void a_ready(const Unit&) const {}
    __device__ __forceinline__ void done(const Unit&) const {}
};
__device__ __forceinline__ unsigned cvt_pk_bf16(float lo, float hi) { unsigned r; asm volatile("v_cvt_pk_bf16_f32 %0, %1, %2" : "=v"(r) : "v"(lo), "v"(hi)); return r; }
template <class Epi, class Sched, bool ALIGN_EPI = false, bool SP2 = false>
__device__ __forceinline__ void gemm_phase(PG8_LAS unsigned char* lds, const Gemm g, const Sched& S, const Epi& E) {
    const int tid = threadIdx.x, wid = __builtin_amdgcn_readfirstlane(tid >> 6), lane = tid & 63, wr = wid >> 2, wc = wid & 3, fr = lane & 15, fq = lane >> 4;
    const int K = g.K, nt = K / BK;
    unsigned voffA[2], voffB[2];
#pragma unroll
    for (int i = 0; i < 2; ++i) { int R, C; stage_rc(tid * 16 + i * 8192, R, C); const int Rb = Epi::PERM ? ((R & ~31) + perm32(R & 31)) : R;
        voffA[i] = (unsigned)(R * K + C) * 2u; voffB[i] = (unsigned)(Rb * K + C) * 2u; }
    const size_t kstep = (size_t)(BK * 2);
    const size_t hstep = (size_t)HALF * K * 2;
    const size_t tstep = 2 * hstep;
    const unsigned ldsw = (unsigned)wid * 1024u;
    const int aoff = lds_byte(wr * 64 + fr, fq * 8), boff = lds_byte(wc * 32 + fr, fq * 8);
#define PG8_SA(b, h) (((b) * 2 + (h)) * HTB)
#define PG8_SB(b, h) ((4 + (b) * 2 + (h)) * HTB)
#define PG8_STAGE(bufoff, gbase, voff) do { _Pragma("unroll") for (int _i = 0; _i < 2; ++_i) \
        __builtin_amdgcn_global_load_lds((const unsigned*)((const char*)(gbase) + (voff)[_i]), (PG8_LAS unsigned*)(lds + (bufoff) + ldsw + _i * 8192), 16, 0, 0); } while (0)
#define PG8_LDA(dst, b, h) do { _Pragma("unroll") for (int m = 0; m < 4; ++m) _Pragma("unroll") for (int k = 0; k < 2; ++k) dst[m][k] = *(const PG8_LAS bf16x8*)(lds + PG8_SA(b, h) + aoff + m * 2048 + k * 1024); } while (0)
#define PG8_LDB(dst, b, h) do { _Pragma("unroll") for (int n = 0; n < 2; ++n) _Pragma("unroll") for (int k = 0; k < 2; ++k) dst[n][k] = *(const PG8_LAS bf16x8*)(lds + PG8_SB(b, h) + boff + n * 2048 + k * 1024); } while (0)
#define PG8_MMA(ai, bj, At, Bt) do { __builtin_amdgcn_s_setprio(1); _Pragma("unroll") for (int m = 0; m < 4; ++m) _Pragma("unroll") for (int n = 0; n < 2; ++n) _Pragma("unroll") for (int k = 0; k < 2; ++k) \
        acc[ai][bj][m][n] = __builtin_amdgcn_mfma_f32_16x16x32_bf16(Bt[n][k], At[m][k], acc[ai][bj][m][n], 0, 0, 0); __builtin_amdgcn_s_setprio(0); } while (0)
#define PG8_WAIT_V(n) asm volatile("s_waitcnt vmcnt(" #n ")" ::: "memory")
#define PG8_WAIT_L(n) asm volatile("s_waitcnt lgkmcnt(" #n ")" ::: "memory")
#define PG8_BAR __builtin_amdgcn_s_barrier()
#define PG8_SCHED __builtin_amdgcn_sched_barrier(0)
    Unit cur, nxt; int ui = 0;
    if (!S.next(0, cur)) return;
    f32x4 acc[2][2][4][2];
#pragma unroll
    for (int a = 0; a < 2; ++a)
#pragma unroll
        for (int b = 0; b < 2; ++b)
#pragma unroll
            for (int m = 0; m < 4; ++m)
#pragma unroll
                for (int n = 0; n < 2; ++n) acc[a][b][m][n] = (f32x4){0.f, 0.f, 0.f, 0.f};
    bf16x8 At[4][2], B0[2][2], B1[2][2];
    const char* cA = (const char*)g.A + (size_t)cur.pm * tstep; const char* cB = (const char*)g.Bt + (size_t)cur.pn * tstep;
    S.a_ready(cur);
    if constexpr (SP2) {
        PG8_STAGE(PG8_SB(0, 0), cB, voffB); PG8_STAGE(PG8_SB(0, 1), cB + hstep, voffB); PG8_STAGE(PG8_SA(0, 0), cA, voffA); PG8_STAGE(PG8_SA(0, 1), cA + hstep, voffA);
        if (wr == 1) PG8_BAR;
        PG8_WAIT_V(2); PG8_BAR;
        PG8_STAGE(PG8_SB(1, 0), cB + kstep, voffB); PG8_STAGE(PG8_SA(1, 0), cA + kstep, voffA); PG8_STAGE(PG8_SB(1, 1), cB + hstep + kstep, voffB);
        PG8_WAIT_V(6); PG8_BAR;
    } else {
        PG8_STAGE(PG8_SB(0, 0), cB, voffB); PG8_STAGE(PG8_SA(0, 0), cA, voffA); PG8_STAGE(PG8_SB(0, 1), cB + hstep, voffB); PG8_STAGE(PG8_SA(0, 1), cA + hstep, voffA);
        if (wr == 1) PG8_BAR;
        PG8_WAIT_V(4); PG8_BAR;
        PG8_STAGE(PG8_SB(1, 0), cB + kstep, voffB); PG8_STAGE(PG8_SA(1, 0), cA + kstep, voffA); PG8_STAGE(PG8_SB(1, 1), cB + hstep + kstep, voffB);
        PG8_WAIT_V(6); PG8_BAR;
    }
    for (;;) {
        const bool has_next = S.next(ui + 1, nxt);
        const char* nA = has_next ? (const char*)g.A + (size_t)nxt.pm * tstep : cA; const char* nB = has_next ? (const char*)g.Bt + (size_t)nxt.pn * tstep : cB;
        for (int t = 0; t < nt; t += 2) {
            const bool last = (t == nt - 2);
            const char* a1 = cA + (size_t)(t + 1) * kstep;
            const char* a2 = last ? nA : cA + (size_t)(t + 2) * kstep; const char* b2 = last ? nB : cB + (size_t)(t + 2) * kstep;
            const char* a3 = a2 + kstep; const char* b3 = b2 + kstep;
            if (last && has_next) S.a_ready(nxt);
            if constexpr (SP2) {
            PG8_LDB(B0, 0, 0); PG8_LDB(B1, 0, 1); PG8_SCHED; PG8_LDA(At, 0, 0); PG8_STAGE(PG8_SA(1, 1), a1 + hstep, voffA);
            PG8_WAIT_V(8); PG8_WAIT_L(0); PG8_BAR; PG8_MMA(0, 0, At, B0); PG8_MMA(0, 1, At, B1); PG8_BAR; PG8_SCHED;
            PG8_LDA(At, 0, 1); PG8_STAGE(PG8_SB(0, 0), b2, voffB); PG8_STAGE(PG8_SB(0, 1), b2 + hstep, voffB); PG8_STAGE(PG8_SA(0, 0), a2, voffA);
            PG8_WAIT_V(8); PG8_WAIT_L(0); PG8_BAR; PG8_MMA(1, 0, At, B0); PG8_MMA(1, 1, At, B1); PG8_BAR; PG8_SCHED;
            PG8_LDB(B0, 1, 0); PG8_LDB(B1, 1, 1); PG8_SCHED; PG8_LDA(At, 1, 0); PG8_STAGE(PG8_SA(0, 1), a2 + hstep, voffA);
            PG8_WAIT_V(8); PG8_WAIT_L(0); PG8_BAR; PG8_MMA(0, 0, At, B0); PG8_MMA(0, 1, At, B1); PG8_BAR; PG8_SCHED;
            PG8_LDA(At, 1, 1); PG8_STAGE(PG8_SB(1, 0), b3, voffB); PG8_STAGE(PG8_SB(1, 1), b3 + hstep, voffB); PG8_STAGE(PG8_SA(1, 0), a3, voffA);
            PG8_WAIT_V(8); PG8_WAIT_L(0); PG8_BAR; PG8_MMA(1, 0, At, B0); PG8_MMA(1, 1, At, B1); PG8_BAR; PG8_SCHED;
            } else {
            PG8_LDB(B0, 0, 0); PG8_SCHED; PG8_LDA(At, 0, 0); PG8_STAGE(PG8_SA(1, 1), a1 + hstep, voffA);
            PG8_WAIT_L(8); PG8_BAR; PG8_WAIT_L(0); PG8_MMA(0, 0, At, B0); PG8_BAR; PG8_SCHED;
            PG8_LDB(B1, 0, 1); PG8_STAGE(PG8_SB(0, 0), b2, voffB);
            PG8_BAR; PG8_WAIT_L(0); PG8_MMA(0, 1, At, B1); PG8_BAR;
            PG8_LDA(At, 0, 1); PG8_STAGE(PG8_SA(0, 0), a2, voffA);
            PG8_BAR; PG8_WAIT_L(0); PG8_MMA(1, 0, At, B0); PG8_BAR; PG8_SCHED;
            PG8_STAGE(PG8_SB(0, 1), b2 + hstep, voffB);
            PG8_WAIT_V(6); PG8_BAR; PG8_MMA(1, 1, At, B1); PG8_BAR;
            PG8_LDB(B0, 1, 0); PG8_SCHED; PG8_LDA(At, 1, 0); PG8_STAGE(PG8_SA(0, 1), a2 + hstep, voffA);
            PG8_WAIT_L(8); PG8_BAR; PG8_WAIT_L(0); PG8_MMA(0, 0, At, B0); PG8_BAR; PG8_SCHED;
            PG8_LDB(B1, 1, 1); PG8_STAGE(PG8_SB(1, 0), b3, voffB);
            PG8_BAR; PG8_WAIT_L(0); PG8_MMA(0, 1, At, B1); PG8_BAR;
            PG8_LDA(At, 1, 1); PG8_STAGE(PG8_SA(1, 0), a3, voffA);
            PG8_BAR; PG8_WAIT_L(0); PG8_MMA(1, 0, At, B0); PG8_BAR; PG8_SCHED;
            PG8_STAGE(PG8_SB(1, 1), b3 + hstep, voffB);
            PG8_WAIT_V(6); PG8_BAR; PG8_MMA(1, 1, At, B1); PG8_BAR;
            }
        }
        if constexpr (ALIGN_EPI) { if (wr == 0) PG8_BAR; }
        if constexpr (!Epi::AFTER_DRAIN) { E(acc, cur, wr, wc, fr, fq); S.done(cur); }
        if (!has_next) break;
#pragma unroll
        for (int a = 0; a < 2; ++a)
#pragma unroll
            for (int b = 0; b < 2; ++b)
#pragma unroll
                for (int m = 0; m < 4; ++m)
#pragma unroll
                    for (int n = 0; n < 2; ++n) acc[a][b][m][n] = (f32x4){0.f, 0.f, 0.f, 0.f};
        cur = nxt; cA = nA; cB = nB; ++ui;
        if constexpr (ALIGN_EPI) { if (wr == 1) PG8_BAR; }
    }
    PG8_WAIT_V(0);
    if constexpr (!ALIGN_EPI) { if (wr == 0) PG8_BAR; }
    PG8_BAR;
    if constexpr (Epi::AFTER_DRAIN) { E.fused(acc, cur, wr, wc, fr, fq, lds, wid, lane); S.done(cur); }
#undef PG8_SA
#undef PG8_SB
#undef PG8_STAGE
#undef PG8_LDA
#undef PG8_LDB
#undef PG8_MMA
#undef PG8_WAIT_V
#undef PG8_WAIT_L
#undef PG8_BAR
#undef PG8_SCHED
}
}

#define LAS __attribute__((address_space(3)))
typedef unsigned short bf16_t;
typedef short bf16x8 __attribute__((ext_vector_type(8)));
typedef float f32x4 __attribute__((ext_vector_type(4)));
typedef float f32x2 __attribute__((ext_vector_type(2)));
typedef unsigned u32x4 __attribute__((ext_vector_type(4)));
typedef unsigned u32x2 __attribute__((ext_vector_type(2)));

constexpr int T = 16384, D = 1024, FF = 2816;
constexpr int P0LD = 3328, P1LD = 2880;
constexpr int C_Q = 0, C_K = 512, C_V = 1024, C_G = 1536, C_Z = 2048, C_XBC = 2560;
constexpr size_t MiB = 1u << 20;
constexpr size_t WS_SSQ = 247 * MiB, WS_DT = 512 * 1024, WS_LRUC = 1 * MiB, WS_CHD = 2 * MiB + 512 * 1024, WS_SMALLW = 3 * MiB;
constexpr size_t WS_WGU1 = 4 * MiB, WS_WD1 = 15 * MiB, WS_WIN = 21 * MiB, WS_WOUT = 28 * MiB, WS_WGU2 = 30 * MiB, WS_WD2 = 41 * MiB;
constexpr size_t WS_XB = 47 * MiB, WS_Y = 79 * MiB, WS_HP = 111 * MiB, WS_ST = 215 * MiB, WS_END = 255 * MiB;
constexpr int LDS_BYTES = 163840;

typedef float f32x2_t __attribute__((ext_vector_type(2)));
typedef __bf16 bf16x2_t __attribute__((ext_vector_type(2)));
__device__ __forceinline__ unsigned pk2(float lo, float hi) { f32x2_t v = {lo, hi}; bf16x2_t b = __builtin_convertvector(v, bf16x2_t); return __builtin_bit_cast(unsigned, b); }
__device__ __forceinline__ unsigned short f2bf(float f) { return (unsigned short)(pk2(f, 0.f) & 0xffffu); }
__device__ __forceinline__ float bflo(unsigned w) { return __uint_as_float(w << 16); }
__device__ __forceinline__ float bfhi(unsigned w) { return __uint_as_float(w & 0xffff0000u); }
__device__ __forceinline__ float bf2f(unsigned short h) { return __uint_as_float(((unsigned)h) << 16); }
__device__ __forceinline__ float frcp(float x) { return __builtin_amdgcn_rcpf(x); }
__device__ __forceinline__ float sigmoidf_(float x) { return frcp(1.f + __expf(-x)); }
__device__ __forceinline__ float siluf_(float x) { return x * frcp(1.f + __expf(-x)); }
__device__ __forceinline__ float softplusf_(float x) { return x > 20.f ? x : log1pf(__expf(x)); }
__device__ __forceinline__ float wave_sum(float v) {
#pragma unroll
    for (int o = 1; o < 64; o <<= 1) v += __shfl_xor(v, o);
    return v;
}
__device__ __forceinline__ float wave_sum_dpp(float v) {
    v += __builtin_bit_cast(float, __builtin_amdgcn_update_dpp(0, __builtin_bit_cast(int, v), 0x111, 0xf, 0xf, true));
    v += __builtin_bit_cast(float, __builtin_amdgcn_update_dpp(0, __builtin_bit_cast(int, v), 0x112, 0xf, 0xf, true));
    v += __builtin_bit_cast(float, __builtin_amdgcn_update_dpp(0, __builtin_bit_cast(int, v), 0x114, 0xf, 0xf, true));
    v += __builtin_bit_cast(float, __builtin_amdgcn_update_dpp(0, __builtin_bit_cast(int, v), 0x118, 0xf, 0xf, true));
    v += __builtin_bit_cast(float, __builtin_amdgcn_update_dpp(0, __builtin_bit_cast(int, v), 0x142, 0xa, 0xf, false));
    v += __builtin_bit_cast(float, __builtin_amdgcn_update_dpp(0, __builtin_bit_cast(int, v), 0x143, 0xc, 0xf, false));
    return __builtin_bit_cast(float, __builtin_amdgcn_readlane(__builtin_bit_cast(int, v), 63));
}
__device__ __forceinline__ f32x4 mma(f32x4 acc, bf16x8 nfrag, bf16x8 mfrag) { return __builtin_amdgcn_mfma_f32_16x16x32_bf16(nfrag, mfrag, acc, 0, 0, 0); }
__device__ __forceinline__ bf16x8 ldf(const LAS bf16_t* base, int stride, int row0, int k0, int lane) { return *(const LAS bf16x8*)(base + (row0 + (lane & 15)) * stride + k0 + 8 * (lane >> 4)); }
__device__ __forceinline__ bf16x8 ldfg(const bf16_t* base, int stride, int row0, int k0, int lane) { return *(const bf16x8*)(base + (size_t)(row0 + (lane & 15)) * stride + k0 + 8 * (lane >> 4)); }
#define F4Z ((f32x4){0.f, 0.f, 0.f, 0.f})
__device__ __forceinline__ float ssq_row(const float* ssq, int row) {
    float s = 0.f;
#pragma unroll
    for (int k = 0; k < 16; ++k) s += ssq[(size_t)k * T + row];
    return s;
}

struct Ctx {
    const float* const* in; float* X; unsigned char* ws; LAS unsigned char* lds;
    int tid, lane, wave, G, bid;
    int cv_b0, cv_nb;
};

__device__ __forceinline__ void tr_item(const float* W, int K, int N, bf16_t* WT, const float* gain, int k0, int n0, int drow0, LAS float* scr, int lane) {
    const int nn = n0 + (lane & 31);
    float wv[32];
#pragma unroll
    for (int i = 0; i < 32; ++i) { const int kk = 2 * i + (lane >> 5); wv[i] = (nn < N) ? W[(size_t)(k0 + kk) * N + nn] : 0.f; }
#pragma unroll
    for (int i = 0; i < 32; ++i) { const int kk = 2 * i + (lane >> 5); float v = wv[i]; if (gain) v *= gain[k0 + kk]; scr[kk * 33 + (lane & 31)] = v; }
    asm volatile("s_waitcnt lgkmcnt(0)" ::: "memory");
    const int c = lane & 7;
#pragma unroll
    for (int j = 0; j < 4; ++j) { const int n = (lane >> 3) + 8 * j; const LAS float* s = scr + (8 * c) * 33 + n;
        u32x4 o; o.x = pk2(s[0 * 33], s[1 * 33]); o.y = pk2(s[2 * 33], s[3 * 33]); o.z = pk2(s[4 * 33], s[5 * 33]); o.w = pk2(s[6 * 33], s[7 * 33]);
        if (n0 + n < N) *(u32x4*)(WT + (size_t)(drow0 + n) * K + k0 + 8 * c) = o; }
    asm volatile("s_waitcnt lgkmcnt(0)" ::: "memory");
}
__device__ __forceinline__ void tr_matrix(const Ctx& C, const float* W, int K, int N, bf16_t* WT, const float* gain, int mode, int& base) {
    LAS float* scr = (LAS float*)(C.lds + C.wave * 8448);
    const int nblk = (N + 31) / 32, nitems = (K / 64) * nblk, gw = (C.bid - C.cv_b0) * 8 + C.wave, ngw = C.cv_nb * 8;
    int first = (gw - (base % ngw) + ngw) % ngw;
    for (int it = first; it < nitems; it += ngw) {
        const int kb = it / nblk, nb = it % nblk, n0 = 32 * nb;
        const int drow0 = mode == 0 ? n0 : ((n0 >> 7) * 256 + (n0 & 127) + (mode == 2 ? 128 : 0));
        tr_item(W, K, N, WT, gain, 64 * kb, n0, drow0, scr, C.lane);
    }
    base += nitems;
}
__device__ __forceinline__ void convert_weights(const Ctx& C, int layer, int which) {
    int base = 0; unsigned char* ws = C.ws;
    if (which & 1) {
        tr_matrix(C, C.in[2] + (size_t)layer * D * FF, D, FF, (bf16_t*)(ws + WS_WGU1), C.in[1] + layer * D, 1, base);
        tr_matrix(C, C.in[3] + (size_t)layer * D * FF, D, FF, (bf16_t*)(ws + WS_WGU1), C.in[1] + layer * D, 2, base);
        tr_matrix(C, C.in[4] + (size_t)layer * D * FF, FF, D, (bf16_t*)(ws + WS_WD1), nullptr, 0, base);
    }
    if (which & 2) {
        if (layer == 0) { tr_matrix(C, C.in[10], D, 3336, (bf16_t*)(ws + WS_WIN), C.in[5], 0, base); tr_matrix(C, C.in[11], D, D, (bf16_t*)(ws + WS_WOUT), nullptr, 0, base); }
        else            { tr_matrix(C, C.in[18], D, 2848, (bf16_t*)(ws + WS_WIN), C.in[5] + D, 0, base); tr_matrix(C, C.in[19], D, D, (bf16_t*)(ws + WS_WOUT), nullptr, 0, base); }
    }
    if (which & 4) {
        tr_matrix(C, C.in[7] + (size_t)layer * D * FF, D, FF, (bf16_t*)(ws + WS_WGU2), C.in[6] + layer * D, 1, base);
        tr_matrix(C, C.in[8] + (size_t)layer * D * FF, D, FF, (bf16_t*)(ws + WS_WGU2), C.in[6] + layer * D, 2, base);
        tr_matrix(C, C.in[9] + (size_t)layer * D * FF, FF, D, (bf16_t*)(ws + WS_WD2), nullptr, 0, base);
    }
}
__device__ __forceinline__ void tr_small(const Ctx& C, const float* W, int K, int N, bf16_t* WT) {
    for (int idx = C.bid * 512 + C.tid; idx < K * N; idx += C.G * 512) { const int n = idx / K, k = idx % K; WT[idx] = f2bf(W[(size_t)k * N + n]); }
}

__device__ __forceinline__ void panel_rscale(const float* ssq, LAS float* rs, int pm) {
    asm volatile("s_waitcnt lgkmcnt(0)" ::: "memory"); __builtin_amdgcn_s_barrier(); asm volatile("" ::: "memory");
    if (threadIdx.x < 256) rs[threadIdx.x] = rsqrtf(ssq_row(ssq, pm * 256 + (int)threadIdx.x) * (1.f / D) + 1e-6f);
    asm volatile("s_waitcnt lgkmcnt(0)" ::: "memory"); __builtin_amdgcn_s_barrier(); asm volatile("" ::: "memory");
}

struct EpiSwiglu {
    static constexpr bool PERM = true, AFTER_DRAIN = false;
    bf16_t* H; const float* ssq; LAS float* rs;
    __device__ __forceinline__ void operator()(const f32x4 (&acc)[2][2][4][2], const pg8::Unit& u, int wr, int wc, int fr, int fq) const {
        panel_rscale(ssq, rs, u.pm);
        const int row0 = u.pm * 256 + wr * 64 + fr, col0 = u.pn * 128 + wc * 32 + 8 * fq;
#pragma unroll
        for (int ai = 0; ai < 2; ++ai)
#pragma unroll
            for (int m = 0; m < 4; ++m) {
                const int row = row0 + ai * 128 + m * 16; const float r = rs[wr * 64 + fr + ai * 128 + m * 16];
                float h[8];
#pragma unroll
                for (int n = 0; n < 2; ++n)
#pragma unroll
                    for (int v = 0; v < 4; ++v) { const float g = acc[ai][0][m][n][v] * r, up = acc[ai][1][m][n][v] * r; h[4 * n + v] = siluf_(g) * up; }
                u32x4 w; w.x = pk2(h[0], h[1]); w.y = pk2(h[2], h[3]); w.z = pk2(h[4], h[5]); w.w = pk2(h[6], h[7]);
                *(u32x4*)(H + (size_t)row * FF + col0) = w;
            }
    }
};
struct EpiResid {
    static constexpr bool PERM = true, AFTER_DRAIN = false;
    bf16_t* XB; float* ssq_out; float alpha;
    __device__ __forceinline__ void operator()(const f32x4 (&acc)[2][2][4][2], const pg8::Unit& u, int wr, int wc, int fr, int fq) const {
        const int row0 = u.pm * 256 + wr * 64 + fr, col0 = u.pn * 256 + wc * 32 + 8 * fq;
#pragma unroll
        for (int ai = 0; ai < 2; ++ai)
#pragma unroll
            for (int m = 0; m < 4; ++m) {
                const int row = row0 + ai * 128 + m * 16; float s = 0.f;
#pragma unroll
                for (int bj = 0; bj < 2; ++bj) {
                    const size_t off = (size_t)row * D + col0 + bj * 128;
                    const u32x4 xo = *(const u32x4*)(XB + off);
                    const f32x4 a0 = acc[ai][bj][m][0] * alpha, a1 = acc[ai][bj][m][1] * alpha;
                    u32x4 bq; bq.x = pk2(bflo(xo.x) + a0[0], bfhi(xo.x) + a0[1]); bq.y = pk2(bflo(xo.y) + a0[2], bfhi(xo.y) + a0[3]);
                    bq.z = pk2(bflo(xo.z) + a1[0], bfhi(xo.z) + a1[1]); bq.w = pk2(bflo(xo.w) + a1[2], bfhi(xo.w) + a1[3]);
                    *(u32x4*)(XB + off) = bq;
#pragma unroll
                    for (int q = 0; q < 4; ++q) { const float x0 = bflo(bq[q]), x1 = bfhi(bq[q]); s += x0 * x0 + x1 * x1; }
                }
                s += __shfl_xor(s, 16); s += __shfl_xor(s, 32);
                if (fq == 0) ssq_out[(size_t)(u.pn * 4 + wc) * T + row] = s;
            }
    }
};
struct EpiProj {
    static constexpr bool PERM = true, AFTER_DRAIN = false;
    bf16_t* P; int ldp, ncols; const float* ssq; float* DT; int dt_col0; LAS float* rs;
    __device__ __forceinline__ void operator()(const f32x4 (&acc)[2][2][4][2], const pg8::Unit& u, int wr, int wc, int fr, int fq) const {
        panel_rscale(ssq, rs, u.pm);
        const int row0 = u.pm * 256 + wr * 64 + fr, col0 = u.pn * 256 + wc * 32 + 8 * fq;
#pragma unroll
        for (int ai = 0; ai < 2; ++ai)
#pragma unroll
            for (int m = 0; m < 4; ++m) {
                const int row = row0 + ai * 128 + m * 16; const float r = rs[wr * 64 + fr + ai * 128 + m * 16];
#pragma unroll
                for (int bj = 0; bj < 2; ++bj) {
                    const int c = col0 + bj * 128; const f32x4 v0 = acc[ai][bj][m][0] * r, v1 = acc[ai][bj][m][1] * r;
                    if (c + 8 <= ncols) { u32x4 w; w.x = pk2(v0[0], v0[1]); w.y = pk2(v0[2], v0[3]); w.z = pk2(v1[0], v1[1]); w.w = pk2(v1[2], v1[3]); *(u32x4*)(P + (size_t)row * ldp + c) = w; }
                    else if (DT && c == dt_col0) { *(f32x4*)(DT + (size_t)row * 8) = v0; *(f32x4*)(DT + (size_t)row * 8 + 4) = v1; }
                }
            }
    }
};

__device__ __forceinline__ void prologue_x(const Ctx& C) {
    const float* x = C.in[0]; bf16_t* XB = (bf16_t*)(C.ws + WS_XB); float* ssq = (float*)(C.ws + WS_SSQ);
    const int gw = C.bid * 8 + C.wave, ngw = C.G * 8;
#pragma unroll 4
    for (int m = gw; m < T; m += ngw) {
        const f32x4* xr = (const f32x4*)(x + (size_t)m * D) + C.lane; u32x2* brow = (u32x2*)(XB + (size_t)m * D) + C.lane;
        float s = 0.f;
#pragma unroll
        for (int j = 0; j < 4; ++j) { const f32x4 v = xr[64 * j]; u32x2 q; q.x = pk2(v[0], v[1]); q.y = pk2(v[2], v[3]); brow[64 * j] = q; const float x0 = bflo(q.x), x1 = bfhi(q.x), x2 = bflo(q.y), x3 = bfhi(q.y); s += (x0 * x0 + x1 * x1) + (x2 * x2 + x3 * x3); }
        s = wave_sum(s);
        if (C.lane == 0) ssq[m] = s;
    }
    for (int i = C.bid * 512 + C.tid; i < 15 * T; i += C.G * 512) ssq[T + i] = 0.f;
}
__device__ __forceinline__ void final_norm(const Ctx& C) {
    const float* ssq = (const float*)(C.ws + WS_SSQ) + (size_t)6 * T * 16; const float* g = C.in[38];
    const int gw = C.bid * 8 + C.wave, ngw = C.G * 8;
    f32x4 gv[4];
#pragma unroll
    for (int j = 0; j < 4; ++j) gv[j] = ((const f32x4*)g)[C.lane + 64 * j];
    const bf16_t* XB = (const bf16_t*)(C.ws + WS_XB);
#pragma unroll 4
    for (int m = gw; m < T; m += ngw) {
        const u32x2* br = (const u32x2*)(XB + (size_t)m * D) + C.lane; f32x4* orow = (f32x4*)(C.X + (size_t)m * D) + C.lane; const float r = rsqrtf(ssq_row(ssq, m) * (1.f / D) + 1e-6f);
#pragma unroll
        for (int j = 0; j < 4; ++j) { const u32x2 q = br[64 * j]; f32x4 v = {bflo(q.x), bfhi(q.x), bflo(q.y), bfhi(q.y)}; v = v * r * gv[j]; orow[64 * j] = v; }
    }
}

__device__ __forceinline__ float ret_log_gamma(int h) { return logf(1.f - exp2f(-5.f - (float)h)); }

template <bool TR>
__device__ __forceinline__ void stage_rot(const bf16_t* P, int t0, int col0, LAS bf16_t* dst, int stride, float scale, float lg, bool kte, int nrows, int tl, int nth) {
    for (int it = tl; it < nrows * 8; it += nth) {
        const int row = TR ? it % nrows : it >> 3, d0 = TR ? (it / nrows) * 8 : (it & 7) * 8, t = t0 + row;
        const bf16_t* src = P + (size_t)t * P0LD + col0 + d0;
        const u32x4 a = *(const u32x4*)src, b = *(const u32x4*)(src + 64);
        const float rs = scale * (kte ? __expf(lg * (float)(127 - row)) : 1.f);
        float o1[8], o2[8];
#pragma unroll
        for (int i = 0; i < 8; ++i) {
            const unsigned wa = a[i >> 1], wb = b[i >> 1];
            const float x1 = (i & 1) ? bfhi(wa) : bflo(wa), x2 = (i & 1) ? bfhi(wb) : bflo(wb);
            const float invf = exp2f(-(float)(d0 + i) * (13.287712379549449f / 64.f));
            const float ang = (float)t * invf, n = rintf(ang * 0.15915494309189535f);
            float r = fmaf(-n, 6.2831854820251465f, ang); r = fmaf(-n, -1.7484556e-7f, r);
            const float s = __sinf(r), c = __cosf(r);
            o1[i] = (x1 * c - x2 * s) * rs; o2[i] = (x2 * c + x1 * s) * rs;
        }
        if (TR) {
#pragma unroll
            for (int i = 0; i < 8; ++i) { dst[(d0 + i) * stride + row] = f2bf(o1[i]); dst[(64 + d0 + i) * stride + row] = f2bf(o2[i]); }
        } else {
            u32x4 w1, w2; w1.x = pk2(o1[0], o1[1]); w1.y = pk2(o1[2], o1[3]); w1.z = pk2(o1[4], o1[5]); w1.w = pk2(o1[6], o1[7]);
            w2.x = pk2(o2[0], o2[1]); w2.y = pk2(o2[2], o2[3]); w2.z = pk2(o2[4], o2[5]); w2.w = pk2(o2[6], o2[7]);
            *(LAS u32x4*)(dst + row * stride + d0) = w1; *(LAS u32x4*)(dst + row * stride + 64 + d0) = w2;
        }
    }
}
__device__ __forceinline__ void stage_vT(const bf16_t* P, int t0, int col0, LAS bf16_t* dst, int stride, int tid) {
    for (int it = tid; it < 128 * 16; it += 512) {
        const int row = it & 127, e0 = (it >> 7) * 8;
        const u32x4 a = *(const u32x4*)(P + (size_t)(t0 + row) * P0LD + col0 + e0);
#pragma unroll
        for (int i = 0; i < 8; ++i) { const unsigned w = a[i >> 1]; dst[(e0 + i) * stride + row] = (unsigned short)((i & 1) ? (w >> 16) : (w & 0xffffu)); }
    }
}

__device__ __forceinline__ void stage_dt(const Ctx& C, int t0, int g, LAS float* DTS, LAS float* AS, LAS float* ACS) {
    const int l = C.tid & 127, hh = C.tid >> 7, h = 4 * g + hh;
    const float* DT = (const float*)(C.ws + WS_DT);
    const float dtv = softplusf_(DT[(size_t)(t0 + l) * 8 + h] + C.in[14][h]);
    DTS[hh * 128 + l] = dtv; AS[hh * 128 + l] = -dtv * __expf(C.in[15][h]);
    __syncthreads();
    float s = 0.f;
    for (int i = 0; i <= l; ++i) s += AS[hh * 128 + i];
    ACS[hh * 128 + l] = s;
    __syncthreads();
}

template <int NGRP, int MODE>
__device__ __forceinline__ void stage_conv(const Ctx& C, int t0, int g, LAS bf16_t* XT, LAS bf16_t* BB, LAS bf16_t* CC, const LAS float* DTS, const LAS float* ACS) {
    constexpr int NSEG = 512 / NGRP, RP = (128 + NSEG - 1) / NSEG;
    if (C.tid >= NGRP * NSEG) return;
    const bf16_t* P = (const bf16_t*)(C.ws + WS_HP);
    const int seg = C.tid % NSEG, grp = C.tid / NSEG;
    const int ch0 = grp < 32 ? 256 * g + 8 * grp : (grp < 40 ? 512 + 64 * g + 8 * (grp - 32) : 640 + 64 * g + 8 * (grp - 40));
    const float* cw = C.in[12]; const float* cb = C.in[13];
    float w0[8], w1[8], w2[8], w3[8], bb[8], x0[8], x1[8], x2[8];
#pragma unroll
    for (int i = 0; i < 8; ++i) { w0[i] = cw[ch0 + i]; w1[i] = cw[768 + ch0 + i]; w2[i] = cw[1536 + ch0 + i]; w3[i] = cw[2304 + ch0 + i]; bb[i] = cb[ch0 + i]; }
    const int r0 = seg * RP, r1 = (r0 + RP < 128) ? r0 + RP : 128;
    auto ldrow = [&](int t, float (&x)[8]) {
        if (t < 0) {
#pragma unroll
            for (int i = 0; i < 8; ++i) x[i] = 0.f;
        } else {
            const u32x4 a = *(const u32x4*)(P + (size_t)t * P0LD + C_XBC + ch0);
#pragma unroll
            for (int i = 0; i < 4; ++i) { x[2 * i] = bflo(a[i]); x[2 * i + 1] = bfhi(a[i]); }
        }
    };
    ldrow(t0 + r0 - 3, x0); ldrow(t0 + r0 - 2, x1); ldrow(t0 + r0 - 1, x2);
    for (int row = r0; row < r1; ++row) {
        float x3[8], v[8]; ldrow(t0 + row, x3);
#pragma unroll
        for (int i = 0; i < 8; ++i) { float s = bb[i] + w0[i] * x0[i] + w1[i] * x1[i] + w2[i] * x2[i] + w3[i] * x3[i]; v[i] = siluf_(s); x0[i] = x1[i]; x1[i] = x2[i]; x2[i] = x3[i]; }
        if (grp < 32) {
            const int hh = grp >> 3;
            float sc = DTS[hh * 128 + row]; if (MODE == 0) sc *= __expf(ACS[hh * 128 + 127] - ACS[hh * 128 + row]);
#pragma unroll
            for (int i = 0; i < 8; ++i) XT[(8 * grp + i) * 136 + row] = f2bf(v[i] * sc);
        } else if (MODE == 0) {
#pragma unroll
            for (int i = 0; i < 8; ++i) BB[(8 * (grp - 32) + i) * 136 + row] = f2bf(v[i]);
        } else {
            u32x4 w; w.x = pk2(v[0], v[1]); w.y = pk2(v[2], v[3]); w.z = pk2(v[4], v[5]); w.w = pk2(v[6], v[7]);
            if (grp < 40) *(LAS u32x4*)(BB + row * 72 + 8 * (grp - 32)) = w; else *(LAS u32x4*)(CC + row * 72 + 8 * (grp - 40)) = w;
        }
    }
}

__device__ __forceinline__ void ret_state_unit(const Ctx& C, int c, int h) {
    const bf16_t* P = (const bf16_t*)(C.ws + WS_HP); float* SR = (float*)(C.ws + WS_ST);
    LAS bf16_t* KT = (LAS bf16_t*)C.lds; LAS bf16_t* VT = KT + 128 * 136;
    const int t0 = c * 128, lane = C.lane, fr = lane & 15, fq = lane >> 4;
    stage_rot<true>(P, t0, C_K + h * 128, KT, 136, 0.08838834764831845f, ret_log_gamma(h), true, 128, C.tid, 512);
    stage_vT(P, t0, C_V + h * 128, VT, 136, C.tid);
    __syncthreads();
    const int e0 = 16 * C.wave; bf16x8 mf[4];
#pragma unroll
    for (int k = 0; k < 4; ++k) mf[k] = ldf(VT, 136, e0, 32 * k, lane);
    float* out = SR + ((size_t)(c * 4 + h) * 128 + e0 + fr) * 128 + 4 * fq;
#pragma unroll
    for (int dt = 0; dt < 8; ++dt) { f32x4 acc = F4Z;
#pragma unroll
        for (int k = 0; k < 4; ++k) acc = mma(acc, ldf(KT, 136, 16 * dt, 32 * k, lane), mf[k]);
        *(f32x4*)(out + 16 * dt) = acc; }
    __syncthreads();
}
__device__ __forceinline__ void mamba_state_unit(const Ctx& C, int c, int g) {
    LAS bf16_t* XT = (LAS bf16_t*)C.lds; LAS bf16_t* BT = XT + 256 * 136;
    LAS float* DTS = (LAS float*)(C.lds + 150528); LAS float* ACS = DTS + 512; LAS float* AS = ACS + 512;
    float* SM = C.X;     float* CHD = (float*)(C.ws + WS_CHD);
    const int t0 = c * 128, lane = C.lane, fr = lane & 15, fq = lane >> 4;
    stage_dt(C, t0, g, DTS, AS, ACS);
    stage_conv<40, 0>(C, t0, g, XT, BT, nullptr, DTS, ACS);
    if (C.tid < 4) CHD[(c * 2 + g) * 32 + C.tid] = __expf(ACS[C.tid * 128 + 127]);
    __syncthreads();
    const int hh = C.wave >> 1, ph = C.wave & 1;
#pragma unroll
    for (int pt = 0; pt < 2; ++pt) {
        const int p0 = ph * 32 + 16 * pt; bf16x8 mf[4];
#pragma unroll
        for (int k = 0; k < 4; ++k) mf[k] = ldf(XT, 136, hh * 64 + p0, 32 * k, lane);
        float* out = SM + ((size_t)(c * 8 + 4 * g + hh) * 64 + p0 + fr) * 64 + 4 * fq;
#pragma unroll
        for (int nt = 0; nt < 4; ++nt) { f32x4 acc = F4Z;
#pragma unroll
            for (int k = 0; k < 4; ++k) acc = mma(acc, ldf(BT, 136, 16 * nt, 32 * k, lane), mf[k]);
            *(f32x4*)(out + 16 * nt) = acc; }
    }
    __syncthreads();
}
__device__ __forceinline__ void l0_states(const Ctx& C) {
    for (int u = C.bid; u < 256; u += C.G) mamba_state_unit(C, u >> 1, u & 1);
    for (int u = C.bid; u < 512; u += C.G) ret_state_unit(C, u >> 2, u & 3);
}

__device__ __forceinline__ void l0_scan(const Ctx& C) {
    float* SR = (float*)(C.ws + WS_ST); float* SM = C.X;     const float* CHD = (const float*)(C.ws + WS_CHD);
    for (int idx = C.bid * 512 + C.tid; idx < 65536 + 32768; idx += C.G * 512) {
        if (idx < 65536) {
            const float dec = __expf(128.f * ret_log_gamma(idx >> 14)); float s = 0.f; float* p = SR + idx;
            for (int c0 = 0; c0 < 128; c0 += 32) { float kv[32];
#pragma unroll
                for (int j = 0; j < 32; ++j) kv[j] = p[(size_t)(c0 + j) * 65536];
#pragma unroll
                for (int j = 0; j < 32; ++j) { p[(size_t)(c0 + j) * 65536] = s; s = s * dec + kv[j]; } }
        } else {
            const int e = idx - 65536, head = e >> 12; float s = 0.f; float* p = SM + e;
            for (int c0 = 0; c0 < 128; c0 += 32) { float kv[32], dc[32];
#pragma unroll
                for (int j = 0; j < 32; ++j) { kv[j] = p[(size_t)(c0 + j) * 32768]; dc[j] = CHD[((c0 + j) * 2 + (head >> 2)) * 32 + (head & 3)]; }
#pragma unroll
                for (int j = 0; j < 32; ++j) { p[(size_t)(c0 + j) * 32768] = s; s = s * dc[j] + kv[j]; } }
        }
    }
}

__device__ __forceinline__ void mamba_out_unit(const Ctx& C, int c, int g) {
    LAS bf16_t* XT = (LAS bf16_t*)C.lds; LAS bf16_t* BM = (LAS bf16_t*)(C.lds + 69632); LAS bf16_t* CM = (LAS bf16_t*)(C.lds + 88064);
    LAS bf16_t* SP = (LAS bf16_t*)(C.lds + 106496); LAS bf16_t* STR = (LAS bf16_t*)(C.lds + 115712) + C.wave * (16 * 136);
    LAS float* DTS = (LAS float*)(C.lds + 150528); LAS float* ACS = DTS + 512; LAS float* AS = ACS + 512;
    const bf16_t* P = (const bf16_t*)(C.ws + WS_HP); const float* SM = C.X; bf16_t* Y = (bf16_t*)(C.ws + WS_Y);
    const int t0 = c * 128, lane = C.lane, fr = lane & 15, fq = lane >> 4, w = C.wave, l0 = 16 * w, l = l0 + fr;
    stage_dt(C, t0, g, DTS, AS, ACS);
    stage_conv<48, 1>(C, t0, g, XT, BM, CM, DTS, ACS);
    __syncthreads();
    bf16x8 cmA[2]; cmA[0] = ldf(CM, 72, l0, 0, lane); cmA[1] = ldf(CM, 72, l0, 32, lane);
    f32x4 cb[8];
#pragma unroll
    for (int st = 0; st < 8; ++st) { cb[st] = F4Z; if (st <= w) { cb[st] = mma(cb[st], ldf(BM, 72, 16 * st, 0, lane), cmA[0]); cb[st] = mma(cb[st], ldf(BM, 72, 16 * st, 32, lane), cmA[1]); } }
    float ssq = 0.f;
#pragma unroll 1
    for (int hh = 0; hh < 4; ++hh) {
        const int h = 4 * g + hh;
        __syncthreads();
        {
            const float* src = SM + (size_t)(c * 8 + h) * 4096;
#pragma unroll
            for (int i = 0; i < 2; ++i) { const int e = (C.tid + 512 * i) * 4; const f32x4 v = *(const f32x4*)(src + e); u32x2 b; b.x = pk2(v[0], v[1]); b.y = pk2(v[2], v[3]); *(LAS u32x2*)(SP + (e >> 6) * 72 + (e & 63)) = b; }
        }
        const float al = ACS[hh * 128 + l];
#pragma unroll
        for (int st = 0; st < 8; ++st) {
            const f32x4 as4 = *(const LAS f32x4*)(ACS + hh * 128 + 16 * st + 4 * fq); float sc[4];
#pragma unroll
            for (int v = 0; v < 4; ++v) { const int s = 16 * st + 4 * fq + v; sc[v] = (st <= w && s <= l) ? cb[st][v] * __expf(al - as4[v]) : 0.f; }
            u32x2 b; b.x = pk2(sc[0], sc[1]); b.y = pk2(sc[2], sc[3]); *(LAS u32x2*)(STR + fr * 136 + 16 * st + 4 * fq) = b;
        }
        __syncthreads();
        bf16x8 sA[4];
#pragma unroll
        for (int k = 0; k < 4; ++k) sA[k] = ldf(STR, 136, 0, 32 * k, lane);
        const float eal = __expf(al), dsk = C.in[16][h], dtl = DTS[hh * 128 + l], rdt = dtl > 1e-30f ? frcp(dtl) : 0.f;
#pragma unroll
        for (int pt = 0; pt < 4; ++pt) {
            f32x4 ya = F4Z, yo = F4Z;
#pragma unroll
            for (int k = 0; k < 4; ++k) ya = mma(ya, ldf(XT, 136, hh * 64 + 16 * pt, 32 * k, lane), sA[k]);
#pragma unroll
            for (int k = 0; k < 2; ++k) yo = mma(yo, ldf(SP, 72, 16 * pt, 32 * k, lane), cmA[k]);
            const int p = 16 * pt + 4 * fq;
            const u32x2 zz = *(const u32x2*)(P + (size_t)(t0 + l) * P0LD + C_Z + 256 * g + hh * 64 + p);
            const float z[4] = {bflo(zz.x), bfhi(zz.x), bflo(zz.y), bfhi(zz.y)};
            float y[4];
#pragma unroll
            for (int v = 0; v < 4; ++v) {
                const float xs = bf2f(XT[(hh * 64 + p + v) * 136 + l]) * rdt;
                y[v] = (ya[v] + yo[v] * eal + dsk * xs) * siluf_(z[v]); ssq += y[v] * y[v];
            }
            u32x2 b; b.x = pk2(y[0], y[1]); b.y = pk2(y[2], y[3]);
            *(u32x2*)(Y + (size_t)(t0 + l) * D + 512 + 256 * g + hh * 64 + p) = b;
        }
    }
    ssq += __shfl_xor(ssq, 16); ssq += __shfl_xor(ssq, 32);
    const float rinv = rsqrtf(ssq * (1.f / 256.f) + 1e-5f);
#pragma unroll 4
    for (int q = 0; q < 16; ++q) {
        const int ch = 256 * g + 16 * q + 4 * fq; const f32x4 ng = *(const f32x4*)(C.in[17] + ch);
        u32x2* yp = (u32x2*)(Y + (size_t)(t0 + l) * D + 512 + ch); const u32x2 yy = *yp;
        u32x2 b; b.x = pk2(bflo(yy.x) * rinv * ng[0], bfhi(yy.x) * rinv * ng[1]); b.y = pk2(bflo(yy.y) * rinv * ng[2], bfhi(yy.y) * rinv * ng[3]);
        *yp = b;
    }
    __syncthreads();
}
__device__ __forceinline__ void ret_out_unit(const Ctx& C, int c, int h) {
    LAS bf16_t* KN = (LAS bf16_t*)C.lds; LAS bf16_t* VT = KN + 128 * 136; LAS bf16_t* ST = VT + 128 * 136; LAS bf16_t* STR = ST + 128 * 136 + C.wave * (16 * 136);
    const bf16_t* P = (const bf16_t*)(C.ws + WS_HP); const float* SR = (const float*)(C.ws + WS_ST); bf16_t* Y = (bf16_t*)(C.ws + WS_Y);
    const int t0 = c * 128, lane = C.lane, fr = lane & 15, fq = lane >> 4, w = C.wave, i0 = 16 * w, ii = i0 + fr;
    const float lg = ret_log_gamma(h);
    stage_rot<false>(P, t0, C_K + h * 128, KN, 136, 0.08838834764831845f, 0.f, false, 128, C.tid, 512);
    stage_vT(P, t0, C_V + h * 128, VT, 136, C.tid);
    {
        const float* src = SR + (size_t)(c * 4 + h) * 16384;
#pragma unroll
        for (int i = 0; i < 8; ++i) { const int e = (C.tid + 512 * i) * 4; const f32x4 v = *(const f32x4*)(src + e); u32x2 b; b.x = pk2(v[0], v[1]); b.y = pk2(v[2], v[3]); *(LAS u32x2*)(ST + (e >> 7) * 136 + (e & 127)) = b; }
    }
    stage_rot<false>(P, t0 + i0, C_Q + h * 128, STR, 136, 1.f, 0.f, false, 16, lane, 64);
    __syncthreads();
    bf16x8 qA[4];
#pragma unroll
    for (int k = 0; k < 4; ++k) qA[k] = ldf(STR, 136, 0, 32 * k, lane);
    __syncthreads();
#pragma unroll
    for (int jt = 0; jt < 8; ++jt) {
        f32x4 sa = F4Z;
        if (jt <= w) {
#pragma unroll
            for (int k = 0; k < 4; ++k) sa = mma(sa, ldf(KN, 136, 16 * jt, 32 * k, lane), qA[k]);
        }
        float sc[4];
#pragma unroll
        for (int v = 0; v < 4; ++v) { const int j = 16 * jt + 4 * fq + v; sc[v] = (jt <= w && j <= ii) ? sa[v] * __expf(lg * (float)(ii - j)) : 0.f; }
        u32x2 b; b.x = pk2(sc[0], sc[1]); b.y = pk2(sc[2], sc[3]); *(LAS u32x2*)(STR + fr * 136 + 16 * jt + 4 * fq) = b;
    }
    __syncthreads();
    bf16x8 sA[4];
#pragma unroll
    for (int k = 0; k < 4; ++k) sA[k] = ldf(STR, 136, 0, 32 * k, lane);
    const float qfs = __expf(lg * (float)(ii + 1));
    f32x4 o[8]; float ssq = 0.f;
#pragma unroll
    for (int et = 0; et < 8; ++et) {
        f32x4 a = F4Z, a2 = F4Z;
#pragma unroll
        for (int k = 0; k < 4; ++k) { a = mma(a, ldf(VT, 136, 16 * et, 32 * k, lane), sA[k]); a2 = mma(a2, ldf(ST, 136, 16 * et, 32 * k, lane), qA[k]); }
        o[et] = a + a2 * qfs;
        ssq += (o[et][0] * o[et][0] + o[et][1] * o[et][1]) + (o[et][2] * o[et][2] + o[et][3] * o[et][3]);
    }
    ssq += __shfl_xor(ssq, 16); ssq += __shfl_xor(ssq, 32);
    const float rinv = rsqrtf(ssq * (1.f / 128.f) + 1e-6f);
#pragma unroll
    for (int et = 0; et < 8; ++et) {
        const int ch = h * 128 + 16 * et + 4 * fq;
        const u32x2 gg = *(const u32x2*)(P + (size_t)(t0 + ii) * P0LD + C_G + ch);
        u32x2 b; b.x = pk2(o[et][0] * rinv * siluf_(bflo(gg.x)), o[et][1] * rinv * siluf_(bfhi(gg.x))); b.y = pk2(o[et][2] * rinv * siluf_(bflo(gg.y)), o[et][3] * rinv * siluf_(bfhi(gg.y)));
        *(u32x2*)(Y + (size_t)(t0 + ii) * D + ch) = b;
    }
    __syncthreads();
}
__device__ __forceinline__ void l0_output(const Ctx& C) {
    for (int u = C.bid; u < 256; u += C.G) mamba_out_unit(C, u >> 1, u & 1);
    for (int u = C.bid; u < 512; u += C.G) ret_out_unit(C, u >> 2, u & 3);
}

constexpr size_t WS_WLOG = WS_ST, WS_AA = WS_ST + 16 * MiB, WS_GG = WS_WGU1, WS_PC = WS_Y;
constexpr size_t WS_LA = WS_LRUC, WS_HC = WS_LRUC + 512 * 1024, WS_HIN = WS_LRUC + 1024 * 1024;
constexpr int SW_WAT = 0, SW_WXT = 65536, SW_W2T = 131072, SW_A2T = 163840, SW_G2T = 196608;
__device__ __forceinline__ bf16_t* gg_row(unsigned char* ws, int t) { return (bf16_t*)(ws + WS_GG) + (size_t)t * 512; }
__device__ __forceinline__ float tanhf_(float x) { return 1.f - 2.f * frcp(1.f + __expf(2.f * x)); }

__device__ __forceinline__ void rwkv_prep(const Ctx& C, int c) {
    const bf16_t* P = (const bf16_t*)(C.ws + WS_HP); const bf16_t* SW = (const bf16_t*)(C.ws + WS_SMALLW);
    bf16_t* WLOG = (bf16_t*)(C.ws + WS_WLOG); bf16_t* AA = (bf16_t*)(C.ws + WS_AA);
    LAS bf16_t* TW = (LAS bf16_t*)C.lds; LAS bf16_t* AL = TW + 64 * 72; LAS bf16_t* SG = AL + 64 * 72;
    const float* mu = C.in[27];
    const int t0 = 64 * c, lane = C.lane, fr = lane & 15, fq = lane >> 4;
#pragma unroll 12
    for (int idx = C.tid; idx < 64 * 288; idx += 512) {
        const int tok = idx / 288, cc = idx % 288, col = 2560 + cc, t = t0 + tok;
        const float cur = bf2f(P[(size_t)t * P1LD + col]), prev = t > 0 ? bf2f(P[(size_t)(t - 1) * P1LD + col]) : 0.f;
        const float s = cur + (prev - cur) * mu[col - 1024];
        if (cc < 64) TW[tok * 72 + cc] = f2bf(tanhf_(s)); else if (cc < 128) AL[tok * 72 + cc - 64] = f2bf(s); else SG[tok * 168 + cc - 128] = f2bf(sigmoidf_(s));
    }
    __syncthreads();
    const int n0 = 64 * C.wave;
#pragma unroll 1
    for (int which = 0; which < 2; ++which) {
        const bf16_t* BT = SW + (which == 0 ? SW_W2T : SW_A2T); const LAS bf16_t* AM = which == 0 ? TW : AL;
        const float* bias = which == 0 ? C.in[28] : C.in[30]; bf16_t* O = which == 0 ? WLOG : AA;
#pragma unroll
        for (int nt = 0; nt < 4; ++nt) {
            const bf16x8 nf0 = ldfg(BT, 64, n0 + 16 * nt, 0, lane), nf1 = ldfg(BT, 64, n0 + 16 * nt, 32, lane);
            const int n = n0 + 16 * nt + 4 * fq; const f32x4 bv = *(const f32x4*)(bias + n);
#pragma unroll
            for (int mt = 0; mt < 4; ++mt) {
                f32x4 acc = F4Z; acc = mma(acc, nf0, ldf(AM, 72, 16 * mt, 0, lane)); acc = mma(acc, nf1, ldf(AM, 72, 16 * mt, 32, lane));
                float o[4];
#pragma unroll
                for (int v = 0; v < 4; ++v) { const float x = acc[v] + bv[v]; o[v] = which == 0 ? -__expf(-softplusf_(-x) - 0.5f) : sigmoidf_(x); }
                u32x2 b; b.x = pk2(o[0], o[1]); b.y = pk2(o[2], o[3]);
                *(u32x2*)(O + (size_t)(t0 + 16 * mt + fr) * 512 + n) = b;
            }
        }
    }
#pragma unroll 2
    for (int nt = 0; nt < 4; ++nt) {
        bf16x8 nf[5];
#pragma unroll
        for (int k = 0; k < 5; ++k) nf[k] = ldfg(SW + SW_G2T, 160, n0 + 16 * nt, 32 * k, lane);
        const int n = n0 + 16 * nt + 4 * fq;
#pragma unroll
        for (int mt = 0; mt < 4; ++mt) {
            f32x4 acc = F4Z;
#pragma unroll
            for (int k = 0; k < 5; ++k) acc = mma(acc, nf[k], ldf(SG, 168, 16 * mt, 32 * k, lane));
#ifdef GG_CONSTVAL
            acc = (f32x4){0.5f, 0.25f, -0.5f, 1.f};
#endif
            u32x2 b; b.x = pk2(acc[0], acc[1]); b.y = pk2(acc[2], acc[3]);
            *(u32x2*)(gg_row(C.ws, t0 + 16 * mt + fr) + n) = b;
        }
    }
    asm volatile("s_waitcnt vmcnt(0)" ::: "memory");
    __threadfence_block();
    __syncthreads();
}

#ifndef RW1_SB_SK
#define RW1_SB_SK 0
#endif
#ifndef RW1_SB_MAIN
#define RW1_SB_MAIN 2
#endif
template <int PASS>
__device__ __forceinline__ void rwkv_chunk(const Ctx& C, int c) {
    const bf16_t* P = (const bf16_t*)(C.ws + WS_HP);
    const bf16_t* WLOG = (const bf16_t*)(C.ws + WS_WLOG); const bf16_t* AA = (const bf16_t*)(C.ws + WS_AA);
    float* PC = (float*)(C.ws + WS_PC); float* UC = C.X; bf16_t* Y = (bf16_t*)(C.ws + WS_Y);
    LAS float* VW = (LAS float*)(C.lds + 40960); LAS float* VKK = VW + 4096; LAS float* VB = VKK + 4096; LAS float* VK = VB + 4096; LAS float* VR = VK + 4096; LAS float* VV = VR + 4096; LAS float* VG = VV + 4096; LAS float* VBON = VG + 4096;
    const int t0 = 64 * c, lane = C.lane, head = C.wave, ch = C.tid;
    const float* mu = C.in[27];
    f32x2 SU[32], SP[32];
    if (PASS == 1) {
#pragma unroll
        for (int k = 0; k < 32; ++k) { SU[k] = (f32x2){0.f, 0.f}; SP[k] = (f32x2){(2 * k == lane) ? 1.f : 0.f, (2 * k + 1 == lane) ? 1.f : 0.f}; }
    } else {
        const f32x4* src = (const f32x4*)(UC + ((size_t)(c * 8 + head) * 64 + lane) * 64);
#pragma unroll
        for (int k4 = 0; k4 < 16; ++k4) { f32x4 v = src[k4];
#ifdef RW3_ZERO
            v = F4Z;
#endif
            SU[2 * k4] = (f32x2){v[0], v[1]}; SU[2 * k4 + 1] = (f32x2){v[2], v[3]}; }
    }
    float pr = 0.f, pk = 0.f, pv = 0.f;
    if (t0 > 0) { const bf16_t* row = P + (size_t)(t0 - 1) * P1LD; pr = bf2f(row[1024 + ch]); pk = bf2f(row[1536 + ch]); pv = bf2f(row[2048 + ch]); }
#pragma unroll 1
    for (int sb = 0; sb < 8; ++sb) {
        const float mu_r = mu[ch], mu_k = mu[512 + ch], mu_v = mu[1024 + ch], kkc = C.in[33][ch], kac = C.in[34][ch], rkc = C.in[35][ch];
        constexpr int UF = PASS == 3 ? 8 : 4;
#pragma unroll 1
        for (int j0 = 0; j0 < 8; j0 += UF) {
            float cr[UF], ck[UF], cv[UF], aa[UF], wl[UF], gg[UF];
#pragma unroll
            for (int u = 0; u < UF; ++u) {
                const int t = t0 + 8 * sb + j0 + u; const bf16_t* row = P + (size_t)t * P1LD;
                ck[u] = bf2f(row[1536 + ch]); cv[u] = bf2f(row[2048 + ch]); aa[u] = bf2f(AA[(size_t)t * 512 + ch]); wl[u] = bf2f(WLOG[(size_t)t * 512 + ch]);
                if (PASS == 3) { cr[u] = bf2f(row[1024 + ch]); gg[u] = bf2f(gg_row(C.ws, t)[ch]); }
            }
            float kkr[UF], kp[UF], nrm[UF], bon[UF], rsv[UF];
#pragma unroll
            for (int u = 0; u < UF; ++u) {
                const float ks = ck[u] + (pk - ck[u]) * mu_k, vs = cv[u] + (pv - cv[u]) * mu_v; pk = ck[u]; pv = cv[u];
                kkr[u] = ks * kkc; nrm[u] = kkr[u] * kkr[u]; kp[u] = ks * (1.f + (aa[u] - 1.f) * kac);
                VV[(j0 + u) * 512 + ch] = vs; VK[(j0 + u) * 512 + ch] = kp[u]; VW[(j0 + u) * 512 + ch] = __expf(wl[u]);
                if (PASS == 3) { rsv[u] = cr[u] + (pr - cr[u]) * mu_r; pr = cr[u]; bon[u] = rsv[u] * kp[u] * rkc; VR[(j0 + u) * 512 + ch] = rsv[u]; VG[(j0 + u) * 512 + ch] = gg[u]; }
            }
#pragma unroll
            for (int u = 0; u < UF; ++u) { nrm[u] = wave_sum_dpp(nrm[u]); if (PASS == 3) bon[u] = wave_sum_dpp(bon[u]); }
#pragma unroll
            for (int u = 0; u < UF; ++u) {
                const float kk = kkr[u] * rsqrtf(fmaxf(nrm[u], 1e-24f));
                VKK[(j0 + u) * 512 + ch] = kk; VB[(j0 + u) * 512 + ch] = kk * aa[u];
                if (PASS == 3) { if (lane == 0) VBON[(j0 + u) * 8 + head] = bon[u]; }
            }
        }
        __syncthreads();
#pragma unroll 1
        for (int j = 0; j < 8; ++j) {
            const LAS f32x4* pw = (const LAS f32x4*)(VW + j * 512 + head * 64); const LAS f32x4* pkk = (const LAS f32x4*)(VKK + j * 512 + head * 64);
            const LAS f32x4* pb = (const LAS f32x4*)(VB + j * 512 + head * 64); const LAS f32x4* pkp = (const LAS f32x4*)(VK + j * 512 + head * 64);
            const LAS f32x4* prr = (const LAS f32x4*)(VR + j * 512 + head * 64);
#define LO2(v) __builtin_shufflevector(v, v, 0, 1)
#define HI2(v) __builtin_shufflevector(v, v, 2, 3)
#define FMA2(a, b, c) __builtin_elementwise_fma(a, b, c)
            f32x2 aU0 = {0.f, 0.f}, aU1 = {0.f, 0.f}, aP0 = {0.f, 0.f}, aP1 = {0.f, 0.f};
            {
                f32x4 q = pkk[0];
#pragma unroll
                for (int g = 0; g < 16; ++g) {
                    f32x4 qn = q; if (g + 1 < 16) qn = pkk[g + 1];
                    aU0 = FMA2(SU[2 * g], LO2(q), aU0); aU1 = FMA2(SU[2 * g + 1], HI2(q), aU1);
                    if (PASS == 1) { aP0 = FMA2(SP[2 * g], LO2(q), aP0); aP1 = FMA2(SP[2 * g + 1], HI2(q), aP1); }
                    q = qn;
#if RW1_SB_SK == 1
                    if (PASS == 1) __builtin_amdgcn_sched_barrier(0);
#elif RW1_SB_SK == 4
                    if (PASS == 1 && (g & 3) == 3) __builtin_amdgcn_sched_barrier(0);
#endif
                }
            }
            float skU = (aU0[0] + aU0[1]) + (aU1[0] + aU1[1]); const float skP = (aP0[0] + aP0[1]) + (aP1[0] + aP1[1]);
#ifdef PROBE_VALU
            if (PASS == 3) { f32x2 d0 = {0.f, 0.f}, d1 = {0.f, 0.f}; const f32x2 cc = {1.0001f, 0.9999f};
#pragma unroll
                for (int g = 0; g < 32; ++g) { d0 = FMA2(SU[g], cc, d0); d1 = FMA2(SU[g], d0, d1); }
                skU += 1e-37f * ((d0[0] + d0[1]) + (d1[0] + d1[1])); }
#endif
#ifdef PROBE_LDS
            if (PASS == 3) { f32x4 d0 = F4Z;
#pragma unroll
                for (int g = 0; g < 16; ++g) d0 += pkp[g];
                skU += 1e-37f * ((d0[0] + d0[1]) + (d0[2] + d0[3])); }
#endif
            const float vv = VV[j * 512 + ch];
            const f32x2 nsU = {-skU, -skU}, nsP = {-skP, -skP}, vv2 = {vv, vv};
            f32x2 y0 = {0.f, 0.f}, y1 = {0.f, 0.f};
            {
                f32x4 w4 = pw[0], b4 = pb[0], k4 = pkp[0], r4 = F4Z; if (PASS == 3) r4 = prr[0];
#pragma unroll
                for (int g = 0; g < 16; ++g) {
                    f32x4 nw = w4, nb = b4, nk = k4, nr = r4;
                    if (g + 1 < 16) { nw = pw[g + 1]; nb = pb[g + 1]; nk = pkp[g + 1]; if (PASS == 3) nr = prr[g + 1]; }
                    SU[2 * g] = FMA2(SU[2 * g], LO2(w4), FMA2(nsU, LO2(b4), vv2 * LO2(k4)));
                    SU[2 * g + 1] = FMA2(SU[2 * g + 1], HI2(w4), FMA2(nsU, HI2(b4), vv2 * HI2(k4)));
                    if (PASS == 1) { SP[2 * g] = FMA2(SP[2 * g], LO2(w4), nsP * LO2(b4)); SP[2 * g + 1] = FMA2(SP[2 * g + 1], HI2(w4), nsP * HI2(b4)); }
                    if (PASS == 3) { y0 = FMA2(SU[2 * g], LO2(r4), y0); y1 = FMA2(SU[2 * g + 1], HI2(r4), y1); }
                    w4 = nw; b4 = nb; k4 = nk; r4 = nr;
#if RW1_SB_MAIN == 1
                    if (PASS == 1) __builtin_amdgcn_sched_barrier(0);
#elif RW1_SB_MAIN == 4
                    if (PASS == 1 && (g & 3) == 3) __builtin_amdgcn_sched_barrier(0);
#elif RW1_SB_MAIN == 2
                    if (PASS == 1 && (g & 1) == 1) __builtin_amdgcn_sched_barrier(0);
#endif
                }
            }
            const float y = (y0[0] + y0[1]) + (y1[0] + y1[1]);
            if (PASS == 3) VKK[j * 512 + ch] = y;
        }
        if (PASS == 3) {
            const float lng = C.in[36][ch], lnb = C.in[37][ch];
            float y[8], s1[8], s2[8];
#pragma unroll
            for (int u = 0; u < 8; ++u) { y[u] = VKK[u * 512 + ch]; s1[u] = y[u]; }
#pragma unroll
            for (int u = 0; u < 8; ++u) s1[u] = wave_sum_dpp(s1[u]);
#pragma unroll
            for (int u = 0; u < 8; ++u) { y[u] -= s1[u] * (1.f / 64.f); s2[u] = y[u] * y[u]; }
#pragma unroll
            for (int u = 0; u < 8; ++u) s2[u] = wave_sum_dpp(s2[u]);
#pragma unroll
            for (int u = 0; u < 8; ++u) {
                const float yn = y[u] * rsqrtf(s2[u] * (1.f / 64.f) + 64e-5f) * lng + lnb;
                Y[(size_t)(t0 + 8 * sb + u) * D + 512 + ch] = f2bf((yn + VBON[u * 8 + head] * VV[u * 512 + ch]) * VG[u * 512 + ch]);
            }
        }
        __syncthreads();
    }
    if (PASS == 1) {
        f32x4* du = (f32x4*)(UC + ((size_t)(c * 8 + head) * 64 + lane) * 64); f32x4* dp = (f32x4*)(PC + ((size_t)(c * 8 + head) * 64 + lane) * 64);
#pragma unroll
        for (int k4 = 0; k4 < 16; ++k4) { du[k4] = (f32x4){SU[2 * k4][0], SU[2 * k4][1], SU[2 * k4 + 1][0], SU[2 * k4 + 1][1]}; dp[k4] = (f32x4){SP[2 * k4][0], SP[2 * k4][1], SP[2 * k4 + 1][0], SP[2 * k4 + 1][1]}; }
    }
}

template <int PASS>
__device__ __forceinline__ void lru_chunk(const Ctx& C, int c) {
    const bf16_t* P = (const bf16_t*)(C.ws + WS_HP); const bf16_t* SW = (const bf16_t*)(C.ws + WS_SMALLW); bf16_t* Y = (bf16_t*)(C.ws + WS_Y);
    LAS bf16_t* XC = (LAS bf16_t*)C.lds; LAS bf16_t* LAB = (LAS bf16_t*)(C.lds + 66560);
    const int t0 = 64 * c, lane = C.lane, fr = lane & 15, fq = lane >> 4;
    {
        const int grp = C.tid & 63, seg = C.tid >> 6, ch0 = 8 * grp, r0 = 8 * seg;
        const float* cw = C.in[20]; const float* cb = C.in[21];
        float w0[8], w1[8], w2[8], w3[8], bb[8], x0[8], x1[8], x2[8];
#pragma unroll
        for (int i = 0; i < 8; ++i) { w0[i] = cw[ch0 + i]; w1[i] = cw[512 + ch0 + i]; w2[i] = cw[1024 + ch0 + i]; w3[i] = cw[1536 + ch0 + i]; bb[i] = cb[ch0 + i]; }
        auto ldrow = [&](int t, float (&x)[8]) {
            if (t < 0) {
#pragma unroll
                for (int i = 0; i < 8; ++i) x[i] = 0.f;
            } else {
                const u32x4 a = *(const u32x4*)(P + (size_t)t * P1LD + ch0);
#pragma unroll
                for (int i = 0; i < 4; ++i) { x[2 * i] = bflo(a[i]); x[2 * i + 1] = bfhi(a[i]); }
            }
        };
        ldrow(t0 + r0 - 3, x0); ldrow(t0 + r0 - 2, x1); ldrow(t0 + r0 - 1, x2);
#pragma unroll
        for (int row = r0; row < r0 + 8; ++row) {
            float x3[8], v[8]; ldrow(t0 + row, x3);
#pragma unroll
            for (int i = 0; i < 8; ++i) { v[i] = bb[i] + w0[i] * x0[i] + w1[i] * x1[i] + w2[i] * x2[i] + w3[i] * x3[i]; x0[i] = x1[i]; x1[i] = x2[i]; x2[i] = x3[i]; }
            u32x4 w; w.x = pk2(v[0], v[1]); w.y = pk2(v[2], v[3]); w.z = pk2(v[4], v[5]); w.w = pk2(v[6], v[7]);
            *(LAS u32x4*)(XC + row * 520 + ch0) = w;
        }
    }
    __syncthreads();
    const int nb = C.wave >> 1, eh = C.wave & 1, cbase = nb * 128 + 64 * eh;
    unsigned ur[4][4][2];
#pragma unroll
    for (int nth = 0; nth < 2; ++nth) {
        bf16x8 wfa[2][4], wfx[2][4];
#pragma unroll
        for (int n2 = 0; n2 < 2; ++n2)
#pragma unroll
            for (int k = 0; k < 4; ++k) { wfa[n2][k] = ldfg(SW + SW_WAT + nb * 16384, 128, 64 * eh + 16 * (2 * nth + n2), 32 * k, lane); wfx[n2][k] = ldfg(SW + SW_WXT + nb * 16384, 128, 64 * eh + 16 * (2 * nth + n2), 32 * k, lane); }
        f32x4 bav[2], bxv[2], sp8[2];
#pragma unroll
        for (int n2 = 0; n2 < 2; ++n2) { const int chn = cbase + 16 * (2 * nth + n2) + 4 * fq; bav[n2] = *(const f32x4*)(C.in[23] + chn); bxv[n2] = *(const f32x4*)(C.in[25] + chn); const f32x4 lam = *(const f32x4*)(C.in[26] + chn);
#pragma unroll
            for (int v = 0; v < 4; ++v) sp8[n2][v] = -8.f * softplusf_(-lam[v]); }
#pragma unroll
        for (int mt = 0; mt < 4; ++mt) {
            bf16x8 mf[4];
#pragma unroll
            for (int k = 0; k < 4; ++k) mf[k] = ldf(XC, 520, 16 * mt, nb * 128 + 32 * k, lane);
#pragma unroll
            for (int n2 = 0; n2 < 2; ++n2) {
                const int nt = 2 * nth + n2, chn = cbase + 16 * nt + 4 * fq;
                f32x4 aa = F4Z, ax = F4Z;
#pragma unroll
                for (int k = 0; k < 4; ++k) { aa = mma(aa, wfa[n2][k], mf[k]); ax = mma(ax, wfx[n2][k], mf[k]); }
                const u32x2 xw = *(const LAS u32x2*)(XC + (16 * mt + fr) * 520 + chn);
                const float xc[4] = {bflo(xw.x), bfhi(xw.x), bflo(xw.y), bfhi(xw.y)};
                float la[4], uu[4];
#pragma unroll
                for (int v = 0; v < 4; ++v) { const float r = sigmoidf_(aa[v] + bav[n2][v]), ig = sigmoidf_(ax[v] + bxv[n2][v]); la[v] = sp8[n2][v] * r; uu[v] = sqrtf(fmaxf(-expm1f(2.f * la[v]), 0.f)) * ig * xc[v]; }
                *(LAS u32x2*)(LAB + (16 * mt + fr) * 512 + chn) = (u32x2){pk2(la[0], la[1]), pk2(la[2], la[3])};
                ur[mt][nt][0] = pk2(uu[0], uu[1]); ur[mt][nt][1] = pk2(uu[2], uu[3]);
            }
            __builtin_amdgcn_sched_barrier(0);
        }
    }
    __syncthreads();
#pragma unroll
    for (int mt = 0; mt < 4; ++mt)
#pragma unroll
        for (int nt = 0; nt < 4; ++nt) *(LAS u32x2*)(XC + (16 * mt + fr) * 520 + cbase + 16 * nt + 4 * fq) = (u32x2){ur[mt][nt][0], ur[mt][nt][1]};
    __syncthreads();
    {
        const int ch = C.tid;
        float* LA = (float*)(C.ws + WS_LA); float* HC = (float*)(C.ws + WS_HC); const float* HIN = (const float*)(C.ws + WS_HIN);
        float h = PASS == 3 ? HIN[c * 512 + ch] : 0.f, sla = 0.f;
        if (PASS == 3) {
            float gbv[64];
#pragma unroll
            for (int tok = 0; tok < 64; ++tok) gbv[tok] = bf2f(P[(size_t)(t0 + tok) * P1LD + 512 + ch]);
#pragma unroll
            for (int tok = 0; tok < 64; ++tok) {
                const float la = bf2f(LAB[tok * 512 + ch]), u = bf2f(XC[tok * 520 + ch]);
                h = fmaf(__expf(la), h, u);
                const float gb = gbv[tok], ge = 0.5f * gb * (1.f + tanhf_(0.7978845608028654f * (gb + 0.044715f * gb * gb * gb)));
                Y[(size_t)(t0 + tok) * D + ch] = f2bf(h * ge);
            }
        } else {
#pragma unroll 8
            for (int tok = 0; tok < 64; ++tok) {
                const float la = bf2f(LAB[tok * 512 + ch]), u = bf2f(XC[tok * 520 + ch]);
                h = fmaf(__expf(la), h, u); sla += la;
            }
        }
        if (PASS == 1) { LA[c * 512 + ch] = sla; HC[c * 512 + ch] = h; }
    }
    __syncthreads();
}

__device__ __forceinline__ void l1_pass_a(const Ctx& C) {
#ifndef SKIP_PREP
    for (int c = C.bid; c < 256; c += C.G) rwkv_prep(C, c);
#endif
#ifndef SKIP_RW1
    for (int c = C.bid; c < 256; c += C.G) rwkv_chunk<1>(C, c);
#ifdef PROBE_RW1X2
    for (int c = C.bid; c < 256; c += C.G) rwkv_chunk<1>(C, c);
#endif
#endif
#ifndef SKIP_LRU1
    for (int c = C.bid; c < 256; c += C.G) lru_chunk<1>(C, c);
#endif
}
__device__ __forceinline__ void l1_pass_c(const Ctx& C) {
#ifndef SKIP_RW3
    for (int c = C.bid; c < 256; c += C.G) rwkv_chunk<3>(C, c);
#ifdef PROBE_RW3X2
    for (int c = C.bid; c < 256; c += C.G) rwkv_chunk<3>(C, c);
#endif
#endif
#ifndef SKIP_LRU3
    for (int c = C.bid; c < 256; c += C.G) lru_chunk<3>(C, c);
#ifdef PROBE_LRU3X2
    for (int c = C.bid; c < 256; c += C.G) lru_chunk<3>(C, c);
#endif
#endif
}

__device__ __forceinline__ void l1_middle(const Ctx& C) {
    const float* PC = (const float*)(C.ws + WS_PC); float* UC = C.X;
    const int lane = C.lane;
#ifndef SKIP_MID
    if (C.bid < 128 && C.G >= 128) {
        const int head = C.bid >> 4, rowA = (C.bid & 15) * 4 + 2 * (C.wave & 1); const bool rowwave = C.wave < 2;
        LAS float* SRA = (LAS float*)(C.lds + (C.wave & 1) * 512); LAS float* SRB = SRA + 64; LAS float* RING = (LAS float*)(C.lds + 4096);
        const float* pcb = PC + (size_t)head * 4096 + C.tid * 8;
        float* ubA = UC + ((size_t)head * 64 + rowA) * 64 + lane; float* ubB = ubA + 64;
        float sA = 0.f, sB = 0.f; if (rowwave) { SRA[lane] = 0.f; SRB[lane] = 0.f; }
        f32x4 qa0, qb0, qa1, qb1, qa2, qb2, qa3, qb3; float uA0, uA1, uA2, uA3, uB0, uB1, uB2, uB3;
#define MID_LD(qa, qb, cc) do { const f32x4* p_ = (const f32x4*)(pcb + (size_t)(cc) * 32768); qa = p_[0]; qb = p_[1]; } while (0)
#define MID_ST(qa, qb, cc) do { LAS f32x4* d_ = (LAS f32x4*)(RING + ((cc) & 7) * 4096 + C.tid * 8); d_[0] = qa; d_[1] = qb; } while (0)
        MID_LD(qa0, qb0, 0); MID_LD(qa1, qb1, 1); MID_LD(qa2, qb2, 2); MID_LD(qa3, qb3, 3);
        MID_ST(qa0, qb0, 0); MID_ST(qa1, qb1, 1); MID_ST(qa2, qb2, 2); MID_ST(qa3, qb3, 3);
        MID_LD(qa0, qb0, 4); MID_LD(qa1, qb1, 5); MID_LD(qa2, qb2, 6); MID_LD(qa3, qb3, 7);
        uA0 = ubA[0]; uA1 = ubA[32768]; uA2 = ubA[2 * 32768]; uA3 = ubA[3 * 32768]; uB0 = ubB[0]; uB1 = ubB[32768]; uB2 = ubB[2 * 32768]; uB3 = ubB[3 * 32768];
        __syncthreads();
#define MID_STEP(cc, qa, qb, uuA, uuB) do { \
            if (rowwave) { const LAS float* P_ = RING + ((cc) & 7) * 4096 + lane; \
            float a0 = 0.f, a1 = 0.f, a2 = 0.f, a3 = 0.f, b0 = 0.f, b1 = 0.f, b2 = 0.f, b3 = 0.f; \
            _Pragma("unroll") for (int i4 = 0; i4 < 16; ++i4) { const f32x4 sa4 = *(const LAS f32x4*)(SRA + 4 * i4), sb4 = *(const LAS f32x4*)(SRB + 4 * i4); \
                const float p0 = P_[(4 * i4) * 64], p1 = P_[(4 * i4 + 1) * 64], p2 = P_[(4 * i4 + 2) * 64], p3 = P_[(4 * i4 + 3) * 64]; \
                a0 = fmaf(sa4[0], p0, a0); a1 = fmaf(sa4[1], p1, a1); a2 = fmaf(sa4[2], p2, a2); a3 = fmaf(sa4[3], p3, a3); \
                b0 = fmaf(sb4[0], p0, b0); b1 = fmaf(sb4[1], p1, b1); b2 = fmaf(sb4[2], p2, b2); b3 = fmaf(sb4[3], p3, b3); } \
            ubA[(size_t)(cc) * 32768] = sA; ubB[(size_t)(cc) * 32768] = sB;      \
            sA = uuA + ((a0 + a1) + (a2 + a3)); sB = uuB + ((b0 + b1) + (b2 + b3)); SRA[lane] = sA; SRB[lane] = sB; } \
            if ((cc) + 4 < 256) { MID_ST(qa, qb, (cc) + 4); if (rowwave) { uuA = ubA[(size_t)((cc) + 4) * 32768]; uuB = ubB[(size_t)((cc) + 4) * 32768]; } } \
            if ((cc) + 8 < 256) MID_LD(qa, qb, (cc) + 8); \
            __syncthreads(); } while (0)
#pragma unroll 1
        for (int c = 0; c < 256; c += 4) { MID_STEP(c, qa0, qb0, uA0, uB0); MID_STEP(c + 1, qa1, qb1, uA1, uB1); MID_STEP(c + 2, qa2, qb2, uA2, uB2); MID_STEP(c + 3, qa3, qb3, uA3, uB3); }
#undef MID_LD
#undef MID_ST
#undef MID_STEP
    }
#endif
    if (C.bid == (C.G > 128 ? 128 : 0)) {
        const float* LA = (const float*)(C.ws + WS_LA); const float* HC = (const float*)(C.ws + WS_HC); float* HIN = (float*)(C.ws + WS_HIN);
        const int ch = C.tid; float h = 0.f;
        for (int c0 = 0; c0 < 256; c0 += 32) { float la[32], hc[32];
#pragma unroll
            for (int j = 0; j < 32; ++j) { la[j] = LA[(c0 + j) * 512 + ch]; hc[j] = HC[(c0 + j) * 512 + ch]; }
#pragma unroll
            for (int j = 0; j < 32; ++j) { HIN[(c0 + j) * 512 + ch] = h; h = fmaf(__expf(la[j]), h, hc[j]); } }
    }
}

#define XB_TMO      128
#define XB_XCNT(j)  (256  + 64 * (j))
#define XB_XSUB(j)  (1280 + 64 * (j))
#define XB_XGEN(j)  (2304 + 64 * (j))
#define XB_TOP      3328
#define XB_TOPGEN   3392
#define XCD_BAR_WORDS 3456
#define XB_SPIN_CAP (1u << 18)

__device__ __forceinline__ unsigned xb_ld(unsigned* p)              { return __hip_atomic_load(p, __ATOMIC_RELAXED, __HIP_MEMORY_SCOPE_AGENT); }
__device__ __forceinline__ unsigned xb_add(unsigned* p, unsigned v) { return __hip_atomic_fetch_add(p, v, __ATOMIC_RELAXED, __HIP_MEMORY_SCOPE_AGENT); }
__device__ __forceinline__ unsigned xb_xcc_id() { return (unsigned)__builtin_amdgcn_s_getreg((3 << 11) | 20) & 0xFu; }
#define XB_SPIN(cond, bar) do { unsigned _sp = 0; while (cond) { __builtin_amdgcn_s_sleep(1); \
    if ((++_sp & 255u) == 0u) { if (xb_ld(&(bar)[XB_TMO])) break; if (_sp > XB_SPIN_CAP) { atomicAdd(&(bar)[XB_TMO], 1u); break; } } } } while (0)

struct XcdBarrier {
    unsigned* bar; unsigned x;
    volatile LAS unsigned* st;
};

__device__ __forceinline__ XcdBarrier xcd_barrier_post(unsigned* bar, volatile LAS unsigned* st) {
    XcdBarrier b; b.bar = bar; b.x = xb_xcc_id(); b.st = st;
    if (threadIdx.x == 0) (void)xb_add(&bar[XB_XCNT(b.x)], 1u);
    return b;
}
__device__ __forceinline__ void xcd_barrier_complete(unsigned* bar, unsigned x, unsigned& nloc, unsigned& nx) {
    const unsigned G = gridDim.x * gridDim.y * gridDim.z;
    unsigned sum, cnt, mine, sp = 0u;
    for (;;) {
        sum = 0u; cnt = 0u; mine = 0u;
#pragma unroll
        for (unsigned j = 0; j < 16; ++j) { const unsigned c = xb_ld(&bar[XB_XCNT(j)]); sum += c; cnt += (c > 0u) ? 1u : 0u; mine = (j == x) ? c : mine; }
        if (sum == G) break;
        __builtin_amdgcn_s_sleep(1);
        if ((++sp & 255u) == 0u) { if (xb_ld(&bar[XB_TMO])) break; if (sp > XB_SPIN_CAP) { atomicAdd(&bar[XB_TMO], 1u); break; } }
    }
    nloc = mine > 0u ? mine : 1u; nx = cnt > 0u ? cnt : 1u;
}

__device__ __forceinline__ void xcd_barrier(const XcdBarrier& b) {
    asm volatile("s_waitcnt vmcnt(0)" ::: "memory");
    __syncthreads();
    if (threadIdx.x == 0) {
        unsigned* bar = b.bar;
        __builtin_amdgcn_s_waitcnt(0);
        unsigned nloc = b.st[0], nx = b.st[1];
        if (nloc == 0u) { xcd_barrier_complete(bar, b.x, nloc, nx); b.st[0] = nloc; b.st[1] = nx; }
        const unsigned old = xb_add(&bar[XB_XSUB(b.x)], 1u);
        const unsigned gen = old / nloc;
        if (old + 1u == (gen + 1u) * nloc) {
            __builtin_amdgcn_fence(__ATOMIC_RELEASE, "agent");
            asm volatile("s_waitcnt vmcnt(0)" ::: "memory");
            const unsigned og = xb_add(&bar[XB_TOP], 1u);
            const unsigned tg = og / nx;
            if (og + 1u == (tg + 1u) * nx) xb_add(&bar[XB_TOPGEN], 1u);
            else XB_SPIN(xb_ld(&bar[XB_TOPGEN]) == tg, bar);
            __builtin_amdgcn_fence(__ATOMIC_ACQUIRE, "agent");
            xb_add(&bar[XB_XGEN(b.x)], 1u);
            asm volatile("s_waitcnt vmcnt(0)" ::: "memory");
        } else {
            XB_SPIN(xb_ld(&bar[XB_XGEN(b.x)]) == gen, bar);
            __builtin_amdgcn_fence(__ATOMIC_ACQUIRE, "agent");
            asm volatile("s_waitcnt vmcnt(0)" ::: "memory");
        }
    }
    __syncthreads();
}

struct Args { const float* in[39]; float* out; unsigned char* ws; int ph_lo, ph_hi; };
constexpr int N_PHASES = 20;

__device__ __forceinline__ void ffn_gu(const Ctx& C, LAS unsigned char* lds, size_t wgu, int site) {
    pg8::Gemm g{(const bf16_t*)(C.ws + WS_XB), (const bf16_t*)(C.ws + wgu), T, 2 * FF, D}; pg8::StaticOrder S; S.init(T, 2 * FF, C.G, C.bid);
    EpiSwiglu E{(bf16_t*)(C.ws + WS_HP), (const float*)(C.ws + WS_SSQ) + (size_t)site * T * 16, (LAS float*)(C.lds + 131072)};
    pg8::gemm_phase<EpiSwiglu, pg8::StaticOrder, true, true>(lds, g, S, E);
}
__device__ __forceinline__ void ffn_down(const Ctx& C, LAS unsigned char* lds, size_t wd, int site_out, float alpha = 0.5f) {
    pg8::Gemm g{(const bf16_t*)(C.ws + WS_HP), (const bf16_t*)(C.ws + wd), T, D, FF}; pg8::StaticOrder S; S.init(T, D, C.G, C.bid);
    EpiResid E{(bf16_t*)(C.ws + WS_XB), (float*)(C.ws + WS_SSQ) + (size_t)site_out * T * 16, alpha};
    pg8::gemm_phase<EpiResid, pg8::StaticOrder, true, true>(lds, g, S, E);
}
__device__ __forceinline__ void out_proj(const Ctx& C, LAS unsigned char* lds, int site_out) {
    pg8::Gemm g{(const bf16_t*)(C.ws + WS_Y), (const bf16_t*)(C.ws + WS_WOUT), T, D, D}; pg8::StaticOrder S; S.init(T, D, C.G, C.bid);
    EpiResid E{(bf16_t*)(C.ws + WS_XB), (float*)(C.ws + WS_SSQ) + (size_t)site_out * T * 16, 1.0f};
    pg8::gemm_phase<EpiResid, pg8::StaticOrder, true, true>(lds, g, S, E);
}


__device__ __forceinline__ void grid_bar(unsigned* ctr, unsigned target, int tid) {
    asm volatile("s_waitcnt vmcnt(0)" ::: "memory");
    __syncthreads();
    if (tid == 0) {
        __builtin_amdgcn_fence(__ATOMIC_RELEASE, "agent");
        asm volatile("s_waitcnt vmcnt(0)" ::: "memory");
        __hip_atomic_fetch_add(ctr, 1u, __ATOMIC_RELAXED, __HIP_MEMORY_SCOPE_AGENT);
        const unsigned long long t0 = __builtin_amdgcn_s_memrealtime();
        while (__hip_atomic_load(ctr, __ATOMIC_RELAXED, __HIP_MEMORY_SCOPE_AGENT) < target) {
            __builtin_amdgcn_s_sleep(2);
            if (__builtin_amdgcn_s_memrealtime() - t0 > 50000000ull) break;
        }
        __builtin_amdgcn_fence(__ATOMIC_ACQUIRE, "agent");
        asm volatile("s_waitcnt vmcnt(0)" ::: "memory");
    }
    __syncthreads();
}

__global__ void __launch_bounds__(512) mk_fwd(Args args) {
    extern __shared__ __attribute__((aligned(16))) unsigned char lds_raw[];
    cg::grid_group grid = cg::this_grid();
    Ctx C; C.in = args.in; C.X = args.out; C.ws = args.ws; C.lds = (LAS unsigned char*)lds_raw;
    C.tid = threadIdx.x; C.lane = C.tid & 63; C.wave = __builtin_amdgcn_readfirstlane(C.tid >> 6); C.G = gridDim.x; C.bid = blockIdx.x; C.cv_b0 = 0; C.cv_nb = C.G;
    LAS unsigned char* lds = C.lds;
    const int lo = args.ph_lo, hi = args.ph_hi;
#define IN(k) (lo <= (k) && (k) < hi)
#ifndef REP_MASK
#define REP_MASK 0
#endif
#define REPS(k) (((REP_MASK >> (k)) & 1) ? 2 : 1)
#ifdef PROBE_SEAMX2
#define SEAM_EXTRA grid.sync(); if (C.wave == 0) { __builtin_amdgcn_fence(__ATOMIC_ACQUIRE, "agent"); asm volatile("s_waitcnt vmcnt(0)" ::: "memory"); } __syncthreads();
#else
#define SEAM_EXTRA
#endif
#define SEAM(k) do { if (IN(k) && IN((k) + 1)) xcd_barrier(xbar); } while (0)
    if (lo < 0) grid.sync();
    volatile LAS unsigned* xst = (volatile LAS unsigned*)(C.lds + 163824);
    if (C.tid == 0) { xst[0] = 0u; xst[1] = 0u; }
    __syncthreads();
    const XcdBarrier xbar = xcd_barrier_post((unsigned*)C.ws, xst);

#define TAIL_CONVERT(layer, which) do { if (C.G == 256) { if (C.bid >= 128) { __syncthreads(); C.cv_b0 = 128; C.cv_nb = 128; convert_weights(C, (layer), (which)); C.cv_b0 = 0; C.cv_nb = C.G; } } \
    else { __syncthreads(); convert_weights(C, (layer), (which)); } } while (0)

    if (IN(0)) {
#define PROLOGUE_BODY convert_weights(C, 0, 1); bf16_t* sw = (bf16_t*)(C.ws + WS_SMALLW); for (int n = 0; n < 4; ++n) { tr_small(C, C.in[22] + n * 16384, 128, 128, sw + n * 16384); tr_small(C, C.in[24] + n * 16384, 128, 128, sw + 65536 + n * 16384); } tr_small(C, C.in[29], 64, 512, sw + 131072); tr_small(C, C.in[31], 64, 512, sw + 163840); tr_small(C, C.in[32], 160, 512, sw + 196608); prologue_x(C);
        PROLOGUE_BODY
        if (REPS(0) == 2) { PROLOGUE_BODY }
    }
    SEAM(0);
    if (IN(1)) { ffn_gu(C, lds, WS_WGU1, 0); if (REPS(1) == 2) ffn_gu(C, lds, WS_WGU1, 0); TAIL_CONVERT(0, 6); }
    SEAM(1);
    if (IN(2)) { ffn_down(C, lds, WS_WD1, 1, 0.5f); if (REPS(2) == 2) ffn_down(C, lds, WS_WD1, 1, 0.f); }
    SEAM(2);
    if (IN(3)) {
        pg8::Gemm g{(const bf16_t*)(C.ws + WS_XB), (const bf16_t*)(C.ws + WS_WIN), T, 3584, D}; pg8::StaticOrder S; S.init(T, 3584, C.G, C.bid);
        EpiProj E{(bf16_t*)(C.ws + WS_HP), P0LD, 3328, (const float*)(C.ws + WS_SSQ) + (size_t)1 * T * 16, (float*)(C.ws + WS_DT), 3328, (LAS float*)(C.lds + 131072)};
        pg8::gemm_phase<EpiProj, pg8::StaticOrder, true, true>(lds, g, S, E);
        if (REPS(3) == 2) pg8::gemm_phase<EpiProj, pg8::StaticOrder, true, true>(lds, g, S, E);
    }
    SEAM(3);
    #ifndef SKIP4
    if (IN(4)) { l0_states(C); if (REPS(4) == 2) l0_states(C); }
#endif
    SEAM(4);
    #ifndef SKIP5
    if (IN(5)) l0_scan(C);
#endif
    SEAM(5);
    #ifndef SKIP6
    if (IN(6)) { l0_output(C); if (REPS(6) == 2) l0_output(C); }
#endif
    SEAM(6);
    if (IN(7)) out_proj(C, lds, 2);
    SEAM(7);
    if (IN(8)) { ffn_gu(C, lds, WS_WGU2, 2); TAIL_CONVERT(1, 1); }
    SEAM(8);
    if (IN(9)) ffn_down(C, lds, WS_WD2, 3);
    SEAM(9);
    if (IN(10)) { ffn_gu(C, lds, WS_WGU1, 3); TAIL_CONVERT(1, 6); }
    SEAM(10);
    if (IN(11)) ffn_down(C, lds, WS_WD1, 4);
    SEAM(11);
    if (IN(12)) {
        pg8::Gemm g{(const bf16_t*)(C.ws + WS_XB), (const bf16_t*)(C.ws + WS_WIN), T, 3072, D}; pg8::StaticOrder S; S.init(T, 3072, C.G, C.bid);
        EpiProj E{(bf16_t*)(C.ws + WS_HP), P1LD, 2848, (const float*)(C.ws + WS_SSQ) + (size_t)4 * T * 16, nullptr, -1, (LAS float*)(C.lds + 131072)};
        pg8::gemm_phase<EpiProj, pg8::StaticOrder, true, true>(lds, g, S, E);
    }
    SEAM(12);
    if (IN(13)) { l1_pass_a(C); if (REPS(13) == 2) l1_pass_a(C); }
    SEAM(13);
    if (IN(14)) l1_middle(C);
    SEAM(14);
    if (IN(15)) { l1_pass_c(C); if (REPS(15) == 2) l1_pass_c(C); }
    SEAM(15);
    if (IN(16)) out_proj(C, lds, 5);
    SEAM(16);
    if (IN(17)) ffn_gu(C, lds, WS_WGU2, 5);
    SEAM(17);
    if (IN(18)) ffn_down(C, lds, WS_WD2, 6);
    SEAM(18);
    if (IN(19)) final_norm(C);
#undef IN
#undef SEAM
}

extern "C" void kernel_launch(void* const* d_in, const int* in_sizes, int n_in, void* d_out, int out_size, void* d_ws, size_t ws_size, hipStream_t stream) {
    static int grid = 0;
    if (grid == 0) {
        if (n_in != 39 || out_size != T * D || ws_size < WS_END) { fprintf(stderr, "kernel_launch: unexpected problem: n_in %d out %d ws %zu\n", n_in, out_size, ws_size); grid = -1; return; }
        int dev = 0, cus = 0, per_cu = 0;
        hipGetDevice(&dev); hipDeviceGetAttribute(&cus, hipDeviceAttributeMultiprocessorCount, dev);
        if (hipFuncSetAttribute((const void*)mk_fwd, hipFuncAttributeMaxDynamicSharedMemorySize, LDS_BYTES) != hipSuccess) { fprintf(stderr, "kernel_launch: hipFuncSetAttribute failed\n"); grid = -1; return; }
        if (hipOccupancyMaxActiveBlocksPerMultiprocessor(&per_cu, (const void*)mk_fwd, 512, LDS_BYTES) != hipSuccess || per_cu < 1) { fprintf(stderr, "kernel_launch: occupancy query says %d\n", per_cu); per_cu = 1; (void)hipGetLastError(); }
        grid = cus * (per_cu > 1 ? 1 : per_cu);
    }
    if (grid < 0) return;
    if (hipMemsetAsync(d_ws, 0, 16384, stream) != hipSuccess) { fprintf(stderr, "kernel_launch: memset of the barrier word failed\n"); return; }
    Args a{};
    for (int i = 0; i < 39; ++i) a.in[i] = (const float*)d_in[i];
    a.out = (float*)d_out; a.ws = (unsigned char*)d_ws; a.ph_lo = 0; a.ph_hi = N_PHASES;
    void* kargs[] = {&a};
    hipError_t e = hipLaunchCooperativeKernel((const void*)mk_fwd, dim3(grid), dim3(512), kargs, LDS_BYTES, stream);
    if (e != hipSuccess) fprintf(stderr, "kernel_launch: cooperative launch failed: %s (grid %d)\n", hipGetErrorString(e), grid);
}
```

```cpp
#include <hip/hip_runtime.h>
#include <hip/hip_cooperative_groups.h>
#include <cstdio>
#include <cstdint>
namespace cg = cooperative_groups;
namespace pg8 {
#define PG8_LAS __attribute__((address_space(3)))
typedef unsigned short bf16_t;
typedef short bf16x8 __attribute__((ext_vector_type(8)));
typedef float f32x4 __attribute__((ext_vector_type(4)));
typedef unsigned u32x4 __attribute__((ext_vector_type(4)));
constexpr int BM = 256, BK = 64, HALF = 128, HTB = HALF * BK * 2  , STAGE_BYTES = 8 * HTB, NXCD = 8, WGM = 8;

__host__ __device__ __forceinline__ int lds_byte(int r, int c) { const int st = (r >> 4) * 2 + (c >> 5), rr = r & 15, cc = c & 31, ob = rr * 64 + cc * 2; return st * 1024 + (ob ^ (((ob >> 9) & 1) << 5)); }
__host__ __device__ __forceinline__ void stage_rc(int b, int& R, int& C) { const int st = b / 1024, sb = b % 1024, swz = sb ^ (((sb >> 9) & 1) << 5); R = (st >> 1) * 16 + swz / 64; C = (st & 1) * 32 + (swz % 64) / 2; }
__host__ __device__ __forceinline__ int perm32(int rho) { const int n = rho >> 4, i = rho & 15; return 8 * (i >> 2) + 4 * n + (i & 3); }

struct Unit { int pm, pn; };
struct Gemm { const bf16_t* A; const bf16_t* Bt; int M, N, K; };

struct StaticOrder {
    int nM, nN, nwg, G, c;
    __host__ __device__ void init(int M, int N, int G_, int c_) { nM = M / BM; nN = N / BM; nwg = nM * nN; G = G_; c = c_; }
    __host__ __device__ bool next(int i, Unit& u) const {
        const long L = (long)i * G + c; if (L >= nwg) return false;
        int wgid = (int)L; { const int q = nwg / NXCD, r = nwg % NXCD, xcd = wgid % NXCD, off = wgid / NXCD; wgid = (xcd < r ? xcd * (q + 1) : r * (q + 1) + (xcd - r) * q) + off; }
        const int nig = WGM * nN, gid = wgid / nig, fm = gid * WGM, gsz = (nM - fm) < WGM ? (nM - fm) : WGM;
        u.pm = fm + ((wgid % nig) % gsz); u.pn = (wgid % nig) / gsz; return true;
    }
    __device__ __forceinline__ void a_ready(const Unit&) const {}
    __device__ __forceinline__ void done(const Unit&) const {}
};
__device__ __forceinline__ unsigned cvt_pk_bf16(float lo, float hi) { unsigned r; asm volatile("v_cvt_pk_bf16_f32 %0, %1, %2" : "=v"(r) : "v"(lo), "v"(hi)); return r; }
template <class Epi, class Sched, bool ALIGN_EPI = false, bool SP2 = false>
__device__ __forceinline__ void gemm_phase(PG8_LAS unsigned char* lds, const Gemm g, const Sched& S, const Epi& E) {
    const int tid = threadIdx.x, wid = __builtin_amdgcn_readfirstlane(tid >> 6), lane = tid & 63, wr = wid >> 2, wc = wid & 3, fr = lane & 15, fq = lane >> 4;
    const int K = g.K, nt = K / BK;
    unsigned voffA[2], voffB[2];
#pragma unroll
    for (int i = 0; i < 2; ++i) { int R, C; stage_rc(tid * 16 + i * 8192, R, C); const int Rb = Epi::PERM ? ((R & ~31) + perm32(R & 31)) : R;
        voffA[i] = (unsigned)(R * K + C) * 2u; voffB[i] = (unsigned)(Rb * K + C) * 2u; }
    const size_t kstep = (size_t)(BK * 2);
    const size_t hstep = (size_t)HALF * K * 2;
    const size_t tstep = 2 * hstep;
    const unsigned ldsw = (unsigned)wid * 1024u;
    const int aoff = lds_byte(wr * 64 + fr, fq * 8), boff = lds_byte(wc * 32 + fr, fq * 8);
#define PG8_SA(b, h) (((b) * 2 + (h)) * HTB)
#define PG8_SB(b, h) ((4 + (b) * 2 + (h)) * HTB)
#define PG8_STAGE(bufoff, gbase, voff) do { _Pragma("unroll") for (int _i = 0; _i < 2; ++_i) \
        __builtin_amdgcn_global_load_lds((const unsigned*)((const char*)(gbase) + (voff)[_i]), (PG8_LAS unsigned*)(lds + (bufoff) + ldsw + _i * 8192), 16, 0, 0); } while (0)
#define PG8_LDA(dst, b, h) do { _Pragma("unroll") for (int m = 0; m < 4; ++m) _Pragma("unroll") for (int k = 0; k < 2; ++k) dst[m][k] = *(const PG8_LAS bf16x8*)(lds + PG8_SA(b, h) + aoff + m * 2048 + k * 1024); } while (0)
#define PG8_LDB(dst, b, h) do { _Pragma("unroll") for (int n = 0; n < 2; ++n) _Pragma("unroll") for (int k = 0; k < 2; ++k) dst[n][k] = *(const PG8_LAS bf16x8*)(lds + PG8_SB(b, h) + boff + n * 2048 + k * 1024); } while (0)
#define PG8_MMA(ai, bj, At, Bt) do { __builtin_amdgcn_s_setprio(1); _Pragma("unroll") for (int m = 0; m < 4; ++m) _Pragma("unroll") for (int n = 0; n < 2; ++n) _Pragma("unroll") for (int k = 0; k < 2; ++k) \
        acc[ai][bj][m][n] = __builtin_amdgcn_mfma_f32_16x16x32_bf16(Bt[n][k], At[m][k], acc[ai][bj][m][n], 0, 0, 0); __builtin_amdgcn_s_setprio(0); } while (0)
#define PG8_WAIT_V(n) asm volatile("s_waitcnt vmcnt(" #n ")" ::: "memory")
#define PG8_WAIT_L(n) asm volatile("s_waitcnt lgkmcnt(" #n ")" ::: "memory")
#define PG8_BAR __builtin_amdgcn_s_barrier()
#define PG8_SCHED __builtin_amdgcn_sched_barrier(0)
    Unit cur, nxt; int ui = 0;
    if (!S.next(0, cur)) return;
    f32x4 acc[2][2][4][2];
#pragma unroll
    for (int a = 0; a < 2; ++a)
#pragma unroll
        for (int b = 0; b < 2; ++b)
#pragma unroll
            for (int m = 0; m < 4; ++m)
#pragma unroll
                for (int n = 0; n < 2; ++n) acc[a][b][m][n] = (f32x4){0.f, 0.f, 0.f, 0.f};
    bf16x8 At[4][2], B0[2][2], B1[2][2];
    const char* cA = (const char*)g.A + (size_t)cur.pm * tstep; const char* cB = (const char*)g.Bt + (size_t)cur.pn * tstep;
    S.a_ready(cur);
    if constexpr (SP2) {
        PG8_STAGE(PG8_SB(0, 0), cB, voffB); PG8_STAGE(PG8_SB(0, 1), cB + hstep, voffB); PG8_STAGE(PG8_SA(0, 0), cA, voffA); PG8_STAGE(PG8_SA(0, 1), cA + hstep, voffA);
        if (wr == 1) PG8_BAR;
        PG8_WAIT_V(2); PG8_BAR;
        PG8_STAGE(PG8_SB(1, 0), cB + kstep, voffB); PG8_STAGE(PG8_SA(1, 0), cA + kstep, voffA); PG8_STAGE(PG8_SB(1, 1), cB + hstep + kstep, voffB);
        PG8_WAIT_V(6); PG8_BAR;
    } else {
        PG8_STAGE(PG8_SB(0, 0), cB, voffB); PG8_STAGE(PG8_SA(0, 0), cA, voffA); PG8_STAGE(PG8_SB(0, 1), cB + hstep, voffB); PG8_STAGE(PG8_SA(0, 1), cA + hstep, voffA);
        if (wr == 1) PG8_BAR;
        PG8_WAIT_V(4); PG8_BAR;
        PG8_STAGE(PG8_SB(1, 0), cB + kstep, voffB); PG8_STAGE(PG8_SA(1, 0), cA + kstep, voffA); PG8_STAGE(PG8_SB(1, 1), cB + hstep + kstep, voffB);
        PG8_WAIT_V(6); PG8_BAR;
    }
    for (;;) {
        const bool has_next = S.next(ui + 1, nxt);
        const char* nA = has_next ? (const char*)g.A + (size_t)nxt.pm * tstep : cA; const char* nB = has_next ? (const char*)g.Bt + (size_t)nxt.pn * tstep : cB;
        for (int t = 0; t < nt; t += 2) {
            const bool last = (t == nt - 2);
            const char* a1 = cA + (size_t)(t + 1) * kstep;
            const char* a2 = last ? nA : cA + (size_t)(t + 2) * kstep; const char* b2 = last ? nB : cB + (size_t)(t + 2) * kstep;
            const char* a3 = a2 + kstep; const char* b3 = b2 + kstep;
            if (last && has_next) S.a_ready(nxt);
            if constexpr (SP2) {
            PG8_LDB(B0, 0, 0); PG8_LDB(B1, 0, 1); PG8_SCHED; PG8_LDA(At, 0, 0); PG8_STAGE(PG8_SA(1, 1), a1 + hstep, voffA);
            PG8_WAIT_V(8); PG8_WAIT_L(0); PG8_BAR; PG8_MMA(0, 0, At, B0); PG8_MMA(0, 1, At, B1); PG8_BAR; PG8_SCHED;
            PG8_LDA(At, 0, 1); PG8_STAGE(PG8_SB(0, 0), b2, voffB); PG8_STAGE(PG8_SB(0, 1), b2 + hstep, voffB); PG8_STAGE(PG8_SA(0, 0), a2, voffA);
            PG8_WAIT_V(8); PG8_WAIT_L(0); PG8_BAR; PG8_MMA(1, 0, At, B0); PG8_MMA(1, 1, At, B1); PG8_BAR; PG8_SCHED;
            PG8_LDB(B0, 1, 0); PG8_LDB(B1, 1, 1); PG8_SCHED; PG8_LDA(At, 1, 0); PG8_STAGE(PG8_SA(0, 1), a2 + hstep, voffA);
            PG8_WAIT_V(8); PG8_WAIT_L(0); PG8_BAR; PG8_MMA(0, 0, At, B0); PG8_MMA(0, 1, At, B1); PG8_BAR; PG8_SCHED;
            PG8_LDA(At, 1, 1); PG8_STAGE(PG8_SB(1, 0), b3, voffB); PG8_STAGE(PG8_SB(1, 1), b3 + hstep, voffB); PG8_STAGE(PG8_SA(1, 0), a3, voffA);
            PG8_WAIT_V(8); PG8_WAIT_L(0); PG8_BAR; PG8_MMA(1, 0, At, B0); PG8_MMA(1, 1, At, B1); PG8_BAR; PG8_SCHED;
            } else {
            PG8_LDB(B0, 0, 0); PG8_SCHED; PG8_LDA(At, 0, 0); PG8_STAGE(PG8_SA(1, 1), a1 + hstep, voffA);
            PG8_WAIT_L(8); PG8_BAR; PG8_WAIT_L(0); PG8_MMA(0, 0, At, B0); PG8_BAR; PG8_SCHED;
            PG8_LDB(B1, 0, 1); PG8_STAGE(PG8_SB(0, 0), b2, voffB);
            PG8_BAR; PG8_WAIT_L(0); PG8_MMA(0, 1, At, B1); PG8_BAR;
            PG8_LDA(At, 0, 1); PG8_STAGE(PG8_SA(0, 0), a2, voffA);
            PG8_BAR; PG8_WAIT_L(0); PG8_MMA(1, 0, At, B0); PG8_BAR; PG8_SCHED;
            PG8_STAGE(PG8_SB(0, 1), b2 + hstep, voffB);
            PG8_WAIT_V(6); PG8_BAR; PG8_MMA(1, 1, At, B1); PG8_BAR;
            PG8_LDB(B0, 1, 0); PG8_SCHED; PG8_LDA(At, 1, 0); PG8_STAGE(PG8_SA(0, 1), a2 + hstep, voffA);
            PG8_WAIT_L(8); PG8_BAR; PG8_WAIT_L(0); PG8_MMA(0, 0, At, B0); PG8_BAR; PG8_SCHED;
            PG8_LDB(B1, 1, 1); PG8_STAGE(PG8_SB(1, 0), b3, voffB);
            PG8_BAR; PG8_WAIT_L(0); PG8_MMA(0, 1, At, B1); PG8_BAR;
            PG8_LDA(At, 1, 1); PG8_STAGE(PG8_SA(1, 0), a3, voffA);
            PG8_BAR; PG8_WAIT_L(0); PG8_MMA(1, 0, At, B0); PG8_BAR; PG8_SCHED;
            PG8_STAGE(PG8_SB(1, 1), b3 + hstep, voffB);
            PG8_WAIT_V(6); PG8_BAR; PG8_MMA(1, 1, At, B1); PG8_BAR;
            }
        }
        if constexpr (ALIGN_EPI) { if (wr == 0) PG8_BAR; }
        if constexpr (!Epi::AFTER_DRAIN) { E(acc, cur, wr, wc, fr, fq); S.done(cur); }
        if (!has_next) break;
#pragma unroll
        for (int a = 0; a < 2; ++a)
#pragma unroll
            for (int b = 0; b < 2; ++b)
#pragma unroll
                for (int m = 0; m < 4; ++m)
#pragma unroll
                    for (int n = 0; n < 2; ++n) acc[a][b][m][n] = (f32x4){0.f, 0.f, 0.f, 0.f};
        cur = nxt; cA = nA; cB = nB; ++ui;
        if constexpr (ALIGN_EPI) { if (wr == 1) PG8_BAR; }
    }
    PG8_WAIT_V(0);
    if constexpr (!ALIGN_EPI) { if (wr == 0) PG8_BAR; }
    PG8_BAR;
    if constexpr (Epi::AFTER_DRAIN) { E.fused(acc, cur, wr, wc, fr, fq, lds, wid, lane); S.done(cur); }
#undef PG8_SA
#undef PG8_SB
#undef PG8_STAGE
#undef PG8_LDA
#undef PG8_LDB
#undef PG8_MMA
#undef PG8_WAIT_V
#undef PG8_WAIT_L
#undef PG8_BAR
#undef PG8_SCHED
}
}

#define LAS __attribute__((address_space(3)))
typedef unsigned short bf16_t;
typedef short bf16x8 __attribute__((ext_vector_type(8)));
typedef float f32x4 __attribute__((ext_vector_type(4)));
typedef float f32x2 __attribute__((ext_vector_type(2)));
typedef unsigned u32x4 __attribute__((ext_vector_type(4)));
typedef unsigned u32x2 __attribute__((ext_vector_type(2)));

constexpr int T = 16384, D = 1024, FF = 2816;
constexpr int P0LD = 3328, P1LD = 2880;
constexpr int C_Q = 0, C_K = 512, C_V = 1024, C_G = 1536, C_Z = 2048, C_XBC = 2560;
constexpr size_t MiB = 1u << 20;
constexpr size_t WS_SSQ = 247 * MiB, WS_DT = 512 * 1024, WS_LRUC = 1 * MiB, WS_CHD = 2 * MiB + 512 * 1024, WS_SMALLW = 3 * MiB;
constexpr size_t WS_WGU1 = 4 * MiB, WS_WD1 = 15 * MiB, WS_WIN = 21 * MiB, WS_WOUT = 28 * MiB, WS_WGU2 = 30 * MiB, WS_WD2 = 41 * MiB;
constexpr size_t WS_XB = 47 * MiB, WS_Y = 79 * MiB, WS_HP = 111 * MiB, WS_ST = 215 * MiB, WS_END = 255 * MiB;
constexpr int LDS_BYTES = 163840;

typedef float f32x2_t __attribute__((ext_vector_type(2)));
typedef __bf16 bf16x2_t __attribute__((ext_vector_type(2)));
__device__ __forceinline__ unsigned pk2(float lo, float hi) { f32x2_t v = {lo, hi}; bf16x2_t b = __builtin_convertvector(v, bf16x2_t); return __builtin_bit_cast(unsigned, b); }
__device__ __forceinline__ unsigned short f2bf(float f) { return (unsigned short)(pk2(f, 0.f) & 0xffffu); }
__device__ __forceinline__ float bflo(unsigned w) { return __uint_as_float(w << 16); }
__device__ __forceinline__ float bfhi(unsigned w) { return __uint_as_float(w & 0xffff0000u); }
__device__ __forceinline__ float bf2f(unsigned short h) { return __uint_as_float(((unsigned)h) << 16); }
__device__ __forceinline__ float frcp(float x) { return __builtin_amdgcn_rcpf(x); }
__device__ __forceinline__ float sigmoidf_(float x) { return frcp(1.f + __expf(-x)); }
__device__ __forceinline__ float siluf_(float x) { return x * frcp(1.f + __expf(-x)); }
__device__ __forceinline__ float softplusf_(float x) { return x > 20.f ? x : log1pf(__expf(x)); }
__device__ __forceinline__ float wave_sum(float v) {
#pragma unroll
    for (int o = 1; o < 64; o <<= 1) v += __shfl_xor(v, o);
    return v;
}
__device__ __forceinline__ float wave_sum_dpp(float v) {
    v += __builtin_bit_cast(float, __builtin_amdgcn_update_dpp(0, __builtin_bit_cast(int, v), 0x111, 0xf, 0xf, true));
    v += __builtin_bit_cast(float, __builtin_amdgcn_update_dpp(0, __builtin_bit_cast(int, v), 0x112, 0xf, 0xf, true));
    v += __builtin_bit_cast(float, __builtin_amdgcn_update_dpp(0, __builtin_bit_cast(int, v), 0x114, 0xf, 0xf, true));
    v += __builtin_bit_cast(float, __builtin_amdgcn_update_dpp(0, __builtin_bit_cast(int, v), 0x118, 0xf, 0xf, true));
    v += __builtin_bit_cast(float, __builtin_amdgcn_update_dpp(0, __builtin_bit_cast(int, v), 0x142, 0xa, 0xf, false));
    v += __builtin_bit_cast(float, __builtin_amdgcn_update_dpp(0, __builtin_bit_cast(int, v), 0x143, 0xc, 0xf, false));
    return __builtin_bit_cast(float, __builtin_amdgcn_readlane(__builtin_bit_cast(int, v), 63));
}
__device__ __forceinline__ f32x4 mma(f32x4 acc, bf16x8 nfrag, bf16x8 mfrag) { return __builtin_amdgcn_mfma_f32_16x16x32_bf16(nfrag, mfrag, acc, 0, 0, 0); }
__device__ __forceinline__ bf16x8 ldf(const LAS bf16_t* base, int stride, int row0, int k0, int lane) { return *(const LAS bf16x8*)(base + (row0 + (lane & 15)) * stride + k0 + 8 * (lane >> 4)); }
__device__ __forceinline__ bf16x8 ldfg(const bf16_t* base, int stride, int row0, int k0, int lane) { return *(const bf16x8*)(base + (size_t)(row0 + (lane & 15)) * stride + k0 + 8 * (lane >> 4)); }
#define F4Z ((f32x4){0.f, 0.f, 0.f, 0.f})
__device__ __forceinline__ float ssq_row(const float* ssq, int row) {
    float s = 0.f;
#pragma unroll
    for (int k = 0; k < 16; ++k) s += ssq[(size_t)k * T + row];
    return s;
}

struct Ctx {
    const float* const* in; float* X; unsigned char* ws; LAS unsigned char* lds;
    int tid, lane, wave, G, bid;
    int cv_b0, cv_nb;
};

__device__ __forceinline__ void tr_item(const float* W, int K, int N, bf16_t* WT, const float* gain, int k0, int n0, int drow0, LAS float* scr, int lane) {
    const int nn = n0 + (lane & 31);
    float wv[32];
#pragma unroll
    for (int i = 0; i < 32; ++i) { const int kk = 2 * i + (lane >> 5); wv[i] = (nn < N) ? W[(size_t)(k0 + kk) * N + nn] : 0.f; }
#pragma unroll
    for (int i = 0; i < 32; ++i) { const int kk = 2 * i + (lane >> 5); float v = wv[i]; if (gain) v *= gain[k0 + kk]; scr[kk * 33 + (lane & 31)] = v; }
    asm volatile("s_waitcnt lgkmcnt(0)" ::: "memory");
    const int c = lane & 7;
#pragma unroll
    for (int j = 0; j < 4; ++j) { const int n = (lane >> 3) + 8 * j; const LAS float* s = scr + (8 * c) * 33 + n;
        u32x4 o; o.x = pk2(s[0 * 33], s[1 * 33]); o.y = pk2(s[2 * 33], s[3 * 33]); o.z = pk2(s[4 * 33], s[5 * 33]); o.w = pk2(s[6 * 33], s[7 * 33]);
        if (n0 + n < N) *(u32x4*)(WT + (size_t)(drow0 + n) * K + k0 + 8 * c) = o; }
    asm volatile("s_waitcnt lgkmcnt(0)" ::: "memory");
}
__device__ __forceinline__ void tr_matrix(const Ctx& C, const float* W, int K, int N, bf16_t* WT, const float* gain, int mode, int& base) {
    LAS float* scr = (LAS float*)(C.lds + C.wave * 8448);
    const int nblk = (N + 31) / 32, nitems = (K / 64) * nblk, gw = (C.bid - C.cv_b0) * 8 + C.wave, ngw = C.cv_nb * 8;
    int first = (gw - (base % ngw) + ngw) % ngw;
    for (int it = first; it < nitems; it += ngw) {
        const int kb = it / nblk, nb = it % nblk, n0 = 32 * nb;
        const int drow0 = mode == 0 ? n0 : ((n0 >> 7) * 256 + (n0 & 127) + (mode == 2 ? 128 : 0));
        tr_item(W, K, N, WT, gain, 64 * kb, n0, drow0, scr, C.lane);
    }
    base += nitems;
}
__device__ __forceinline__ void convert_weights(const Ctx& C, int layer, int which) {
    int base = 0; unsigned char* ws = C.ws;
    if (which & 1) {
        tr_matrix(C, C.in[2] + (size_t)layer * D * FF, D, FF, (bf16_t*)(ws + WS_WGU1), C.in[1] + layer * D, 1, base);
        tr_matrix(C, C.in[3] + (size_t)layer * D * FF, D, FF, (bf16_t*)(ws + WS_WGU1), C.in[1] + layer * D, 2, base);
        tr_matrix(C, C.in[4] + (size_t)layer * D * FF, FF, D, (bf16_t*)(ws + WS_WD1), nullptr, 0, base);
    }
    if (which & 2) {
        if (layer == 0) { tr_matrix(C, C.in[10], D, 3336, (bf16_t*)(ws + WS_WIN), C.in[5], 0, base); tr_matrix(C, C.in[11], D, D, (bf16_t*)(ws + WS_WOUT), nullptr, 0, base); }
        else            { tr_matrix(C, C.in[18], D, 2848, (bf16_t*)(ws + WS_WIN), C.in[5] + D, 0, base); tr_matrix(C, C.in[19], D, D, (bf16_t*)(ws + WS_WOUT), nullptr, 0, base); }
    }
    if (which & 4) {
        tr_matrix(C, C.in[7] + (size_t)layer * D * FF, D, FF, (bf16_t*)(ws + WS_WGU2), C.in[6] + layer * D, 1, base);
        tr_matrix(C, C.in[8] + (size_t)layer * D * FF, D, FF, (bf16_t*)(ws + WS_WGU2), C.in[6] + layer * D, 2, base);
        tr_matrix(C, C.in[9] + (size_t)layer * D * FF, FF, D, (bf16_t*)(ws + WS_WD2), nullptr, 0, base);
    }
}
__device__ __forceinline__ void tr_small(const Ctx& C, const float* W, int K, int N, bf16_t* WT) {
    for (int idx = C.bid * 512 + C.tid; idx < K * N; idx += C.G * 512) { const int n = idx / K, k = idx % K; WT[idx] = f2bf(W[(size_t)k * N + n]); }
}

__device__ __forceinline__ void panel_rscale(const float* ssq, LAS float* rs, int pm) {
    asm volatile("s_waitcnt lgkmcnt(0)" ::: "memory"); __builtin_amdgcn_s_barrier(); asm volatile("" ::: "memory");
    if (threadIdx.x < 256) rs[threadIdx.x] = rsqrtf(ssq_row(ssq, pm * 256 + (int)threadIdx.x) * (1.f / D) + 1e-6f);
    asm volatile("s_waitcnt lgkmcnt(0)" ::: "memory"); __builtin_amdgcn_s_barrier(); asm volatile("" ::: "memory");
}

struct EpiSwiglu {
    static constexpr bool PERM = true, AFTER_DRAIN = false;
    bf16_t* H; const float* ssq; LAS float* rs;
    __device__ __forceinline__ void operator()(const f32x4 (&acc)[2][2][4][2], const pg8::Unit& u, int wr, int wc, int fr, int fq) const {
        panel_rscale(ssq, rs, u.pm);
        const int row0 = u.pm * 256 + wr * 64 + fr, col0 = u.pn * 128 + wc * 32 + 8 * fq;
#pragma unroll
        for (int ai = 0; ai < 2; ++ai)
#pragma unroll
            for (int m = 0; m < 4; ++m) {
                const int row = row0 + ai * 128 + m * 16; const float r = rs[wr * 64 + fr + ai * 128 + m * 16];
                float h[8];
#pragma unroll
                for (int n = 0; n < 2; ++n)
#pragma unroll
                    for (int v = 0; v < 4; ++v) { const float g = acc[ai][0][m][n][v] * r, up = acc[ai][1][m][n][v] * r; h[4 * n + v] = siluf_(g) * up; }
                u32x4 w; w.x = pk2(h[0], h[1]); w.y = pk2(h[2], h[3]); w.z = pk2(h[4], h[5]); w.w = pk2(h[6], h[7]);
                *(u32x4*)(H + (size_t)row * FF + col0) = w;
            }
    }
};
struct EpiResid {
    static constexpr bool PERM = true, AFTER_DRAIN = false;
    bf16_t* XB; float* ssq_out; float alpha;
    __device__ __forceinline__ void operator()(const f32x4 (&acc)[2][2][4][2], const pg8::Unit& u, int wr, int wc, int fr, int fq) const {
        const int row0 = u.pm * 256 + wr * 64 + fr, col0 = u.pn * 256 + wc * 32 + 8 * fq;
#pragma unroll
        for (int ai = 0; ai < 2; ++ai)
#pragma unroll
            for (int m = 0; m < 4; ++m) {
                const int row = row0 + ai * 128 + m * 16; float s = 0.f;
#pragma unroll
                for (int bj = 0; bj < 2; ++bj) {
                    const size_t off = (size_t)row * D + col0 + bj * 128;
                    const u32x4 xo = *(const u32x4*)(XB + off);
                    const f32x4 a0 = acc[ai][bj][m][0] * alpha, a1 = acc[ai][bj][m][1] * alpha;
                    u32x4 bq; bq.x = pk2(bflo(xo.x) + a0[0], bfhi(xo.x) + a0[1]); bq.y = pk2(bflo(xo.y) + a0[2], bfhi(xo.y) + a0[3]);
                    bq.z = pk2(bflo(xo.z) + a1[0], bfhi(xo.z) + a1[1]); bq.w = pk2(bflo(xo.w) + a1[2], bfhi(xo.w) + a1[3]);
                    *(u32x4*)(XB + off) = bq;
#pragma unroll
                    for (int q = 0; q < 4; ++q) { const float x0 = bflo(bq[q]), x1 = bfhi(bq[q]); s += x0 * x0 + x1 * x1; }
                }
                s += __shfl_xor(s, 16); s += __shfl_xor(s, 32);
                if (fq == 0) ssq_out[(size_t)(u.pn * 4 + wc) * T + row] = s;
            }
    }
};
struct EpiProj {
    static constexpr bool PERM = true, AFTER_DRAIN = false;
    bf16_t* P; int ldp, ncols; const float* ssq; float* DT; int dt_col0; LAS float* rs;
    __device__ __forceinline__ void operator()(const f32x4 (&acc)[2][2][4][2], const pg8::Unit& u, int wr, int wc, int fr, int fq) const {
        panel_rscale(ssq, rs, u.pm);
        const int row0 = u.pm * 256 + wr * 64 + fr, col0 = u.pn * 256 + wc * 32 + 8 * fq;
#pragma unroll
        for (int ai = 0; ai < 2; ++ai)
#pragma unroll
            for (int m = 0; m < 4; ++m) {
                const int row = row0 + ai * 128 + m * 16; const float r = rs[wr * 64 + fr + ai * 128 + m * 16];
#pragma unroll
                for (int bj = 0; bj < 2; ++bj) {
                    const int c = col0 + bj * 128; const f32x4 v0 = acc[ai][bj][m][0] * r, v1 = acc[ai][bj][m][1] * r;
                    if (c + 8 <= ncols) { u32x4 w; w.x = pk2(v0[0], v0[1]); w.y = pk2(v0[2], v0[3]); w.z = pk2(v1[0], v1[1]); w.w = pk2(v1[2], v1[3]); *(u32x4*)(P + (size_t)row * ldp + c) = w; }
                    else if (DT && c == dt_col0) { *(f32x4*)(DT + (size_t)row * 8) = v0; *(f32x4*)(DT + (size_t)row * 8 + 4) = v1; }
                }
            }
    }
};

__device__ __forceinline__ void prologue_x(const Ctx& C) {
    const float* x = C.in[0]; bf16_t* XB = (bf16_t*)(C.ws + WS_XB); float* ssq = (float*)(C.ws + WS_SSQ);
    const int gw = C.bid * 8 + C.wave, ngw = C.G * 8;
#pragma unroll 4
    for (int m = gw; m < T; m += ngw) {
        const f32x4* xr = (const f32x4*)(x + (size_t)m * D) + C.lane; u32x2* brow = (u32x2*)(XB + (size_t)m * D) + C.lane;
        float s = 0.f;
#pragma unroll
        for (int j = 0; j < 4; ++j) { const f32x4 v = xr[64 * j]; u32x2 q; q.x = pk2(v[0], v[1]); q.y = pk2(v[2], v[3]); brow[64 * j] = q; const float x0 = bflo(q.x), x1 = bfhi(q.x), x2 = bflo(q.y), x3 = bfhi(q.y); s += (x0 * x0 + x1 * x1) + (x2 * x2 + x3 * x3); }
        s = wave_sum(s);
        if (C.lane == 0) ssq[m] = s;
    }
    for (int i = C.bid * 512 + C.tid; i < 15 * T; i += C.G * 512) ssq[T + i] = 0.f;
}
__device__ __forceinline__ void final_norm(const Ctx& C) {
    const float* ssq = (const float*)(C.ws + WS_SSQ) + (size_t)6 * T * 16; const float* g = C.in[38];
    const int gw = C.bid * 8 + C.wave, ngw = C.G * 8;
    f32x4 gv[4];
#pragma unroll
    for (int j = 0; j < 4; ++j) gv[j] = ((const f32x4*)g)[C.lane + 64 * j];
    const bf16_t* XB = (const bf16_t*)(C.ws + WS_XB);
#pragma unroll 4
    for (int m = gw; m < T; m += ngw) {
        const u32x2* br = (const u32x2*)(XB + (size_t)m * D) + C.lane; f32x4* orow = (f32x4*)(C.X + (size_t)m * D) + C.lane; const float r = rsqrtf(ssq_row(ssq, m) * (1.f / D) + 1e-6f);
#pragma unroll
        for (int j = 0; j < 4; ++j) { const u32x2 q = br[64 * j]; f32x4 v = {bflo(q.x), bfhi(q.x), bflo(q.y), bfhi(q.y)}; v = v * r * gv[j]; orow[64 * j] = v; }
    }
}

__device__ __forceinline__ float ret_log_gamma(int h) { return logf(1.f - exp2f(-5.f - (float)h)); }

template <bool TR>
__device__ __forceinline__ void stage_rot(const bf16_t* P, int t0, int col0, LAS bf16_t* dst, int stride, float scale, float lg, bool kte, int nrows, int tl, int nth) {
    for (int it = tl; it < nrows * 8; it += nth) {
        const int row = TR ? it % nrows : it >> 3, d0 = TR ? (it / nrows) * 8 : (it & 7) * 8, t = t0 + row;
        const bf16_t* src = P + (size_t)t * P0LD + col0 + d0;
        const u32x4 a = *(const u32x4*)src, b = *(const u32x4*)(src + 64);
        const float rs = scale * (kte ? __expf(lg * (float)(127 - row)) : 1.f);
        float o1[8], o2[8];
#pragma unroll
        for (int i = 0; i < 8; ++i) {
            const unsigned wa = a[i >> 1], wb = b[i >> 1];
            const float x1 = (i & 1) ? bfhi(wa) : bflo(wa), x2 = (i & 1) ? bfhi(wb) : bflo(wb);
            const float invf = exp2f(-(float)(d0 + i) * (13.287712379549449f / 64.f));
            const float ang = (float)t * invf, n = rintf(ang * 0.15915494309189535f);
            float r = fmaf(-n, 6.2831854820251465f, ang); r = fmaf(-n, -1.7484556e-7f, r);
            const float s = __sinf(r), c = __cosf(r);
            o1[i] = (x1 * c - x2 * s) * rs; o2[i] = (x2 * c + x1 * s) * rs;
        }
        if (TR) {
#pragma unroll
            for (int i = 0; i < 8; ++i) { dst[(d0 + i) * stride + row] = f2bf(o1[i]); dst[(64 + d0 + i) * stride + row] = f2bf(o2[i]); }
        } else {
            u32x4 w1, w2; w1.x = pk2(o1[0], o1[1]); w1.y = pk2(o1[2], o1[3]); w1.z = pk2(o1[4], o1[5]); w1.w = pk2(o1[6], o1[7]);
            w2.x = pk2(o2[0], o2[1]); w2.y = pk2(o2[2], o2[3]); w2.z = pk2(o2[4], o2[5]); w2.w = pk2(o2[6], o2[7]);
            *(LAS u32x4*)(dst + row * stride + d0) = w1; *(LAS u32x4*)(dst + row * stride + 64 + d0) = w2;
        }
    }
}
__device__ __forceinline__ void stage_vT(const bf16_t* P, int t0, int col0, LAS bf16_t* dst, int stride, int tid) {
    for (int it = tid; it < 128 * 16; it += 512) {
        const int row = it & 127, e0 = (it >> 7) * 8;
        const u32x4 a = *(const u32x4*)(P + (size_t)(t0 + row) * P0LD + col0 + e0);
#pragma unroll
        for (int i = 0; i < 8; ++i) { const unsigned w = a[i >> 1]; dst[(e0 + i) * stride + row] = (unsigned short)((i & 1) ? (w >> 16) : (w & 0xffffu)); }
    }
}

__device__ __forceinline__ void stage_dt(const Ctx& C, int t0, int g, LAS float* DTS, LAS float* AS, LAS float* ACS) {
    const int l = C.tid & 127, hh = C.tid >> 7, h = 4 * g + hh;
    const float* DT = (const float*)(C.ws + WS_DT);
    const float dtv = softplusf_(DT[(size_t)(t0 + l) * 8 + h] + C.in[14][h]);
    DTS[hh * 128 + l] = dtv; AS[hh * 128 + l] = -dtv * __expf(C.in[15][h]);
    __syncthreads();
    float s = 0.f;
    for (int i = 0; i <= l; ++i) s += AS[hh * 128 + i];
    ACS[hh * 128 + l] = s;
    __syncthreads();
}

template <int NGRP, int MODE>
__device__ __forceinline__ void stage_conv(const Ctx& C, int t0, int g, LAS bf16_t* XT, LAS bf16_t* BB, LAS bf16_t* CC, const LAS float* DTS, const LAS float* ACS) {
    constexpr int NSEG = 512 / NGRP, RP = (128 + NSEG - 1) / NSEG;
    if (C.tid >= NGRP * NSEG) return;
    const bf16_t* P = (const bf16_t*)(C.ws + WS_HP);
    const int seg = C.tid % NSEG, grp = C.tid / NSEG;
    const int ch0 = grp < 32 ? 256 * g + 8 * grp : (grp < 40 ? 512 + 64 * g + 8 * (grp - 32) : 640 + 64 * g + 8 * (grp - 40));
    const float* cw = C.in[12]; const float* cb = C.in[13];
    float w0[8], w1[8], w2[8], w3[8], bb[8], x0[8], x1[8], x2[8];
#pragma unroll
    for (int i = 0; i < 8; ++i) { w0[i] = cw[ch0 + i]; w1[i] = cw[768 + ch0 + i]; w2[i] = cw[1536 + ch0 + i]; w3[i] = cw[2304 + ch0 + i]; bb[i] = cb[ch0 + i]; }
    const int r0 = seg * RP, r1 = (r0 + RP < 128) ? r0 + RP : 128;
    auto ldrow = [&](int t, float (&x)[8]) {
        if (t < 0) {
#pragma unroll
            for (int i = 0; i < 8; ++i) x[i] = 0.f;
        } else {
            const u32x4 a = *(const u32x4*)(P + (size_t)t * P0LD + C_XBC + ch0);
#pragma unroll
            for (int i = 0; i < 4; ++i) { x[2 * i] = bflo(a[i]); x[2 * i + 1] = bfhi(a[i]); }
        }
    };
    ldrow(t0 + r0 - 3, x0); ldrow(t0 + r0 - 2, x1); ldrow(t0 + r0 - 1, x2);
    for (int row = r0; row < r1; ++row) {
        float x3[8], v[8]; ldrow(t0 + row, x3);
#pragma unroll
        for (int i = 0; i < 8; ++i) { float s = bb[i] + w0[i] * x0[i] + w1[i] * x1[i] + w2[i] * x2[i] + w3[i] * x3[i]; v[i] = siluf_(s); x0[i] = x1[i]; x1[i] = x2[i]; x2[i] = x3[i]; }
        if (grp < 32) {
            const int hh = grp >> 3;
            float sc = DTS[hh * 128 + row]; if (MODE == 0) sc *= __expf(ACS[hh * 128 + 127] - ACS[hh * 128 + row]);
#pragma unroll
            for (int i = 0; i < 8; ++i) XT[(8 * grp + i) * 136 + row] = f2bf(v[i] * sc);
        } else if (MODE == 0) {
#pragma unroll
            for (int i = 0; i < 8; ++i) BB[(8 * (grp - 32) + i) * 136 + row] = f2bf(v[i]);
        } else {
            u32x4 w; w.x = pk2(v[0], v[1]); w.y = pk2(v[2], v[3]); w.z = pk2(v[4], v[5]); w.w = pk2(v[6], v[7]);
            if (grp < 40) *(LAS u32x4*)(BB + row * 72 + 8 * (grp - 32)) = w; else *(LAS u32x4*)(CC + row * 72 + 8 * (grp - 40)) = w;
        }
    }
}

__device__ __forceinline__ void ret_state_unit(const Ctx& C, int c, int h) {
    const bf16_t* P = (const bf16_t*)(C.ws + WS_HP); float* SR = (float*)(C.ws + WS_ST);
    LAS bf16_t* KT = (LAS bf16_t*)C.lds; LAS bf16_t* VT = KT + 128 * 136;
    const int t0 = c * 128, lane = C.lane, fr = lane & 15, fq = lane >> 4;
    stage_rot<true>(P, t0, C_K + h * 128, KT, 136, 0.08838834764831845f, ret_log_gamma(h), true, 128, C.tid, 512);
    stage_vT(P, t0, C_V + h * 128, VT, 136, C.tid);
    __syncthreads();
    const int e0 = 16 * C.wave; bf16x8 mf[4];
#pragma unroll
    for (int k = 0; k < 4; ++k) mf[k] = ldf(VT, 136, e0, 32 * k, lane);
    float* out = SR + ((size_t)(c * 4 + h) * 128 + e0 + fr) * 128 + 4 * fq;
#pragma unroll
    for (int dt = 0; dt < 8; ++dt) { f32x4 acc = F4Z;
#pragma unroll
        for (int k = 0; k < 4; ++k) acc = mma(acc, ldf(KT, 136, 16 * dt, 32 * k, lane), mf[k]);
        *(f32x4*)(out + 16 * dt) = acc; }
    __syncthreads();
}
__device__ __forceinline__ void mamba_state_unit(const Ctx& C, int c, int g) {
    LAS bf16_t* XT = (LAS bf16_t*)C.lds; LAS bf16_t* BT = XT + 256 * 136;
    LAS float* DTS = (LAS float*)(C.lds + 150528); LAS float* ACS = DTS + 512; LAS float* AS = ACS + 512;
    float* SM = C.X;     float* CHD = (float*)(C.ws + WS_CHD);
    const int t0 = c * 128, lane = C.lane, fr = lane & 15, fq = lane >> 4;
    stage_dt(C, t0, g, DTS, AS, ACS);
    stage_conv<40, 0>(C, t0, g, XT, BT, nullptr, DTS, ACS);
    if (C.tid < 4) CHD[(c * 2 + g) * 32 + C.tid] = __expf(ACS[C.tid * 128 + 127]);
    __syncthreads();
    const int hh = C.wave >> 1, ph = C.wave & 1;
#pragma unroll
    for (int pt = 0; pt < 2; ++pt) {
        const int p0 = ph * 32 + 16 * pt; bf16x8 mf[4];
#pragma unroll
        for (int k = 0; k < 4; ++k) mf[k] = ldf(XT, 136, hh * 64 + p0, 32 * k, lane);
        float* out = SM + ((size_t)(c * 8 + 4 * g + hh) * 64 + p0 + fr) * 64 + 4 * fq;
#pragma unroll
        for (int nt = 0; nt < 4; ++nt) { f32x4 acc = F4Z;
#pragma unroll
            for (int k = 0; k < 4; ++k) acc = mma(acc, ldf(BT, 136, 16 * nt, 32 * k, lane), mf[k]);
            *(f32x4*)(out + 16 * nt) = acc; }
    }
    __syncthreads();
}
__device__ __forceinline__ void l0_states(const Ctx& C) {
    for (int u = C.bid; u < 256; u += C.G) mamba_state_unit(C, u >> 1, u & 1);
    for (int u = C.bid; u < 512; u += C.G) ret_state_unit(C, u >> 2, u & 3);
}

__device__ __forceinline__ void l0_scan(const Ctx& C) {
    float* SR = (float*)(C.ws + WS_ST); float* SM = C.X;     const float* CHD = (const float*)(C.ws + WS_CHD);
    for (int idx = C.bid * 512 + C.tid; idx < 65536 + 32768; idx += C.G * 512) {
        if (idx < 65536) {
            const float dec = __expf(128.f * ret_log_gamma(idx >> 14)); float s = 0.f; float* p = SR + idx;
            for (int c0 = 0; c0 < 128; c0 += 32) { float kv[32];
#pragma unroll
                for (int j = 0; j < 32; ++j) kv[j] = p[(size_t)(c0 + j) * 65536];
#pragma unroll
                for (int j = 0; j < 32; ++j) { p[(size_t)(c0 + j) * 65536] = s; s = s * dec + kv[j]; } }
        } else {
            const int e = idx - 65536, head = e >> 12; float s = 0.f; float* p = SM + e;
            for (int c0 = 0; c0 < 128; c0 += 32) { float kv[32], dc[32];
#pragma unroll
                for (int j = 0; j < 32; ++j) { kv[j] = p[(size_t)(c0 + j) * 32768]; dc[j] = CHD[((c0 + j) * 2 + (head >> 2)) * 32 + (head & 3)]; }
#pragma unroll
                for (int j = 0; j < 32; ++j) { p[(size_t)(c0 + j) * 32768] = s; s = s * dc[j] + kv[j]; } }
        }
    }
}

__device__ __forceinline__ void mamba_out_unit(const Ctx& C, int c, int g) {
    LAS bf16_t* XT = (LAS bf16_t*)C.lds; LAS bf16_t* BM = (LAS bf16_t*)(C.lds + 69632); LAS bf16_t* CM = (LAS bf16_t*)(C.lds + 88064);
    LAS bf16_t* SP = (LAS bf16_t*)(C.lds + 106496); LAS bf16_t* STR = (LAS bf16_t*)(C.lds + 115712) + C.wave * (16 * 136);
    LAS float* DTS = (LAS float*)(C.lds + 150528); LAS float* ACS = DTS + 512; LAS float* AS = ACS + 512;
    const bf16_t* P = (const bf16_t*)(C.ws + WS_HP); const float* SM = C.X; bf16_t* Y = (bf16_t*)(C.ws + WS_Y);
    const int t0 = c * 128, lane = C.lane, fr = lane & 15, fq = lane >> 4, w = C.wave, l0 = 16 * w, l = l0 + fr;
    stage_dt(C, t0, g, DTS, AS, ACS);
    stage_conv<48, 1>(C, t0, g, XT, BM, CM, DTS, ACS);
    __syncthreads();
    bf16x8 cmA[2]; cmA[0] = ldf(CM, 72, l0, 0, lane); cmA[1] = ldf(CM, 72, l0, 32, lane);
    f32x4 cb[8];
#pragma unroll
    for (int st = 0; st < 8; ++st) { cb[st] = F4Z; if (st <= w) { cb[st] = mma(cb[st], ldf(BM, 72, 16 * st, 0, lane), cmA[0]); cb[st] = mma(cb[st], ldf(BM, 72, 16 * st, 32, lane), cmA[1]); } }
    float ssq = 0.f;
#pragma unroll 1
    for (int hh = 0; hh < 4; ++hh) {
        const int h = 4 * g + hh;
        __syncthreads();
        {
            const float* src = SM + (size_t)(c * 8 + h) * 4096;
#pragma unroll
            for (int i = 0; i < 2; ++i) { const int e = (C.tid + 512 * i) * 4; const f32x4 v = *(const f32x4*)(src + e); u32x2 b; b.x = pk2(v[0], v[1]); b.y = pk2(v[2], v[3]); *(LAS u32x2*)(SP + (e >> 6) * 72 + (e & 63)) = b; }
        }
        const float al = ACS[hh * 128 + l];
#pragma unroll
        for (int st = 0; st < 8; ++st) {
            const f32x4 as4 = *(const LAS f32x4*)(ACS + hh * 128 + 16 * st + 4 * fq); float sc[4];
#pragma unroll
            for (int v = 0; v < 4; ++v) { const int s = 16 * st + 4 * fq + v; sc[v] = (st <= w && s <= l) ? cb[st][v] * __expf(al - as4[v]) : 0.f; }
            u32x2 b; b.x = pk2(sc[0], sc[1]); b.y = pk2(sc[2], sc[3]); *(LAS u32x2*)(STR + fr * 136 + 16 * st + 4 * fq) = b;
        }
        __syncthreads();
        bf16x8 sA[4];
#pragma unroll
        for (int k = 0; k < 4; ++k) sA[k] = ldf(STR, 136, 0, 32 * k, lane);
        const float eal = __expf(al), dsk = C.in[16][h], dtl = DTS[hh * 128 + l], rdt = dtl > 1e-30f ? frcp(dtl) : 0.f;
#pragma unroll
        for (int pt = 0; pt < 4; ++pt) {
            f32x4 ya = F4Z, yo = F4Z;
#pragma unroll
            for (int k = 0; k < 4; ++k) ya = mma(ya, ldf(XT, 136, hh * 64 + 16 * pt, 32 * k, lane), sA[k]);
#pragma unroll
            for (int k = 0; k < 2; ++k) yo = mma(yo, ldf(SP, 72, 16 * pt, 32 * k, lane), cmA[k]);
            const int p = 16 * pt + 4 * fq;
            const u32x2 zz = *(const u32x2*)(P + (size_t)(t0 + l) * P0LD + C_Z + 256 * g + hh * 64 + p);
            const float z[4] = {bflo(zz.x), bfhi(zz.x), bflo(zz.y), bfhi(zz.y)};
            float y[4];
#pragma unroll
            for (int v = 0; v < 4; ++v) {
                const float xs = bf2f(XT[(hh * 64 + p + v) * 136 + l]) * rdt;
                y[v] = (ya[v] + yo[v] * eal + dsk * xs) * siluf_(z[v]); ssq += y[v] * y[v];
            }
            u32x2 b; b.x = pk2(y[0], y[1]); b.y = pk2(y[2], y[3]);
            *(u32x2*)(Y + (size_t)(t0 + l) * D + 512 + 256 * g + hh * 64 + p) = b;
        }
    }
    ssq += __shfl_xor(ssq, 16); ssq += __shfl_xor(ssq, 32);
    const float rinv = rsqrtf(ssq * (1.f / 256.f) + 1e-5f);
#pragma unroll 4
    for (int q = 0; q < 16; ++q) {
        const int ch = 256 * g + 16 * q + 4 * fq; const f32x4 ng = *(const f32x4*)(C.in[17] + ch);
        u32x2* yp = (u32x2*)(Y + (size_t)(t0 + l) * D + 512 + ch); const u32x2 yy = *yp;
        u32x2 b; b.x = pk2(bflo(yy.x) * rinv * ng[0], bfhi(yy.x) * rinv * ng[1]); b.y = pk2(bflo(yy.y) * rinv * ng[2], bfhi(yy.y) * rinv * ng[3]);
        *yp = b;
    }
    __syncthreads();
}
__device__ __forceinline__ void ret_out_unit(const Ctx& C, int c, int h) {
    LAS bf16_t* KN = (LAS bf16_t*)C.lds; LAS bf16_t* VT = KN + 128 * 136; LAS bf16_t* ST = VT + 128 * 136; LAS bf16_t* STR = ST + 128 * 136 + C.wave * (16 * 136);
    const bf16_t* P = (const bf16_t*)(C.ws + WS_HP); const float* SR = (const float*)(C.ws + WS_ST); bf16_t* Y = (bf16_t*)(C.ws + WS_Y);
    const int t0 = c * 128, lane = C.lane, fr = lane & 15, fq = lane >> 4, w = C.wave, i0 = 16 * w, ii = i0 + fr;
    const float lg = ret_log_gamma(h);
    stage_rot<false>(P, t0, C_K + h * 128, KN, 136, 0.08838834764831845f, 0.f, false, 128, C.tid, 512);
    stage_vT(P, t0, C_V + h * 128, VT, 136, C.tid);
    {
        const float* src = SR + (size_t)(c * 4 + h) * 16384;
#pragma unroll
        for (int i = 0; i < 8; ++i) { const int e = (C.tid + 512 * i) * 4; const f32x4 v = *(const f32x4*)(src + e); u32x2 b; b.x = pk2(v[0], v[1]); b.y = pk2(v[2], v[3]); *(LAS u32x2*)(ST + (e >> 7) * 136 + (e & 127)) = b; }
    }
    stage_rot<false>(P, t0 + i0, C_Q + h * 128, STR, 136, 1.f, 0.f, false, 16, lane, 64);
    __syncthreads();
    bf16x8 qA[4];
#pragma unroll
    for (int k = 0; k < 4; ++k) qA[k] = ldf(STR, 136, 0, 32 * k, lane);
    __syncthreads();
#pragma unroll
    for (int jt = 0; jt < 8; ++jt) {
        f32x4 sa = F4Z;
        if (jt <= w) {
#pragma unroll
            for (int k = 0; k < 4; ++k) sa = mma(sa, ldf(KN, 136, 16 * jt, 32 * k, lane), qA[k]);
        }
        float sc[4];
#pragma unroll
        for (int v = 0; v < 4; ++v) { const int j = 16 * jt + 4 * fq + v; sc[v] = (jt <= w && j <= ii) ? sa[v] * __expf(lg * (float)(ii - j)) : 0.f; }
        u32x2 b; b.x = pk2(sc[0], sc[1]); b.y = pk2(sc[2], sc[3]); *(LAS u32x2*)(STR + fr * 136 + 16 * jt + 4 * fq) = b;
    }
    __syncthreads();
    bf16x8 sA[4];
#pragma unroll
    for (int k = 0; k < 4; ++k) sA[k] = ldf(STR, 136, 0, 32 * k, lane);
    const float qfs = __expf(lg * (float)(ii + 1));
    f32x4 o[8]; float ssq = 0.f;
#pragma unroll
    for (int et = 0; et < 8; ++et) {
        f32x4 a = F4Z, a2 = F4Z;
#pragma unroll
        for (int k = 0; k < 4; ++k) { a = mma(a, ldf(VT, 136, 16 * et, 32 * k, lane), sA[k]); a2 = mma(a2, ldf(ST, 136, 16 * et, 32 * k, lane), qA[k]); }
        o[et] = a + a2 * qfs;
        ssq += (o[et][0] * o[et][0] + o[et][1] * o[et][1]) + (o[et][2] * o[et][2] + o[et][3] * o[et][3]);
    }
    ssq += __shfl_xor(ssq, 16); ssq += __shfl_xor(ssq, 32);
    const float rinv = rsqrtf(ssq * (1.f / 128.f) + 1e-6f);
#pragma unroll
    for (int et = 0; et < 8; ++et) {
        const int ch = h * 128 + 16 * et + 4 * fq;
        const u32x2 gg = *(const u32x2*)(P + (size_t)(t0 + ii) * P0LD + C_G + ch);
        u32x2 b; b.x = pk2(o[et][0] * rinv * siluf_(bflo(gg.x)), o[et][1] * rinv * siluf_(bfhi(gg.x))); b.y = pk2(o[et][2] * rinv * siluf_(bflo(gg.y)), o[et][3] * rinv * siluf_(bfhi(gg.y)));
        *(u32x2*)(Y + (size_t)(t0 + ii) * D + ch) = b;
    }
    __syncthreads();
}
__device__ __forceinline__ void l0_output(const Ctx& C) {
    for (int u = C.bid; u < 256; u += C.G) mamba_out_unit(C, u >> 1, u & 1);
    for (int u = C.bid; u < 512; u += C.G) ret_out_unit(C, u >> 2, u & 3);
}

constexpr size_t WS_WLOG = WS_ST, WS_AA = WS_ST + 16 * MiB, WS_GG = WS_WGU1, WS_PC = WS_Y;
constexpr size_t WS_LA = WS_LRUC, WS_HC = WS_LRUC + 512 * 1024, WS_HIN = WS_LRUC + 1024 * 1024;
constexpr int SW_WAT = 0, SW_WXT = 65536, SW_W2T = 131072, SW_A2T = 163840, SW_G2T = 196608;
__device__ __forceinline__ bf16_t* gg_row(unsigned char* ws, int t) { return (bf16_t*)(ws + WS_GG) + (size_t)t * 512; }
__device__ __forceinline__ float tanhf_(float x) { return 1.f - 2.f * frcp(1.f + __expf(2.f * x)); }

__device__ __forceinline__ void rwkv_prep(const Ctx& C, int c) {
    const bf16_t* P = (const bf16_t*)(C.ws + WS_HP); const bf16_t* SW = (const bf16_t*)(C.ws + WS_SMALLW);
    bf16_t* WLOG = (bf16_t*)(C.ws + WS_WLOG); bf16_t* AA = (bf16_t*)(C.ws + WS_AA);
    LAS bf16_t* TW = (LAS bf16_t*)C.lds; LAS bf16_t* AL = TW + 64 * 72; LAS bf16_t* SG = AL + 64 * 72;
    const float* mu = C.in[27];
    const int t0 = 64 * c, lane = C.lane, fr = lane & 15, fq = lane >> 4;
#pragma unroll 12
    for (int idx = C.tid; idx < 64 * 288; idx += 512) {
        const int tok = idx / 288, cc = idx % 288, col = 2560 + cc, t = t0 + tok;
        const float cur = bf2f(P[(size_t)t * P1LD + col]), prev = t > 0 ? bf2f(P[(size_t)(t - 1) * P1LD + col]) : 0.f;
        const float s = cur + (prev - cur) * mu[col - 1024];
        if (cc < 64) TW[tok * 72 + cc] = f2bf(tanhf_(s)); else if (cc < 128) AL[tok * 72 + cc - 64] = f2bf(s); else SG[tok * 168 + cc - 128] = f2bf(sigmoidf_(s));
    }
    __syncthreads();
    const int n0 = 64 * C.wave;
#pragma unroll 1
    for (int which = 0; which < 2; ++which) {
        const bf16_t* BT = SW + (which == 0 ? SW_W2T : SW_A2T); const LAS bf16_t* AM = which == 0 ? TW : AL;
        const float* bias = which == 0 ? C.in[28] : C.in[30]; bf16_t* O = which == 0 ? WLOG : AA;
#pragma unroll
        for (int nt = 0; nt < 4; ++nt) {
            const bf16x8 nf0 = ldfg(BT, 64, n0 + 16 * nt, 0, lane), nf1 = ldfg(BT, 64, n0 + 16 * nt, 32, lane);
            const int n = n0 + 16 * nt + 4 * fq; const f32x4 bv = *(const f32x4*)(bias + n);
#pragma unroll
            for (int mt = 0; mt < 4; ++mt) {
                f32x4 acc = F4Z; acc = mma(acc, nf0, ldf(AM, 72, 16 * mt, 0, lane)); acc = mma(acc, nf1, ldf(AM, 72, 16 * mt, 32, lane));
                float o[4];
#pragma unroll
                for (int v = 0; v < 4; ++v) { const float x = acc[v] + bv[v]; o[v] = which == 0 ? -__expf(-softplusf_(-x) - 0.5f) : sigmoidf_(x); }
                u32x2 b; b.x = pk2(o[0], o[1]); b.y = pk2(o[2], o[3]);
                *(u32x2*)(O + (size_t)(t0 + 16 * mt + fr) * 512 + n) = b;
            }
        }
    }
#pragma unroll 2
    for (int nt = 0; nt < 4; ++nt) {
        bf16x8 nf[5];
#pragma unroll
        for (int k = 0; k < 5; ++k) nf[k] = ldfg(SW + SW_G2T, 160, n0 + 16 * nt, 32 * k, lane);
        const int n = n0 + 16 * nt + 4 * fq;
#pragma unroll
        for (int mt = 0; mt < 4; ++mt) {
            f32x4 acc = F4Z;
#pragma unroll
            for (int k = 0; k < 5; ++k) acc = mma(acc, nf[k], ldf(SG, 168, 16 * mt, 32 * k, lane));
#ifdef GG_CONSTVAL
            acc = (f32x4){0.5f, 0.25f, -0.5f, 1.f};
#endif
            u32x2 b; b.x = pk2(acc[0], acc[1]); b.y = pk2(acc[2], acc[3]);
            *(u32x2*)(gg_row(C.ws, t0 + 16 * mt + fr) + n) = b;
        }
    }
    asm volatile("s_waitcnt vmcnt(0)" ::: "memory");
    __threadfence_block();
    __syncthreads();
}

#ifndef RW1_SB_SK
#define RW1_SB_SK 0
#endif
#ifndef RW1_SB_MAIN
#define RW1_SB_MAIN 2
#endif
template <int PASS>
__device__ __forceinline__ void rwkv_chunk(const Ctx& C, int c) {
    const bf16_t* P = (const bf16_t*)(C.ws + WS_HP);
    const bf16_t* WLOG = (const bf16_t*)(C.ws + WS_WLOG); const bf16_t* AA = (const bf16_t*)(C.ws + WS_AA);
    float* PC = (float*)(C.ws + WS_PC); float* UC = C.X; bf16_t* Y = (bf16_t*)(C.ws + WS_Y);
    LAS float* VW = (LAS float*)(C.lds + 40960); LAS float* VKK = VW + 4096; LAS float* VB = VKK + 4096; LAS float* VK = VB + 4096; LAS float* VR = VK + 4096; LAS float* VV = VR + 4096; LAS float* VG = VV + 4096; LAS float* VBON = VG + 4096;
    const int t0 = 64 * c, lane = C.lane, head = C.wave, ch = C.tid;
    const float* mu = C.in[27];
    f32x2 SU[32], SP[32];
    if (PASS == 1) {
#pragma unroll
        for (int k = 0; k < 32; ++k) { SU[k] = (f32x2){0.f, 0.f}; SP[k] = (f32x2){(2 * k == lane) ? 1.f : 0.f, (2 * k + 1 == lane) ? 1.f : 0.f}; }
    } else {
        const f32x4* src = (const f32x4*)(UC + ((size_t)(c * 8 + head) * 64 + lane) * 64);
#pragma unroll
        for (int k4 = 0; k4 < 16; ++k4) { f32x4 v = src[k4];
#ifdef RW3_ZERO
            v = F4Z;
#endif
            SU[2 * k4] = (f32x2){v[0], v[1]}; SU[2 * k4 + 1] = (f32x2){v[2], v[3]}; }
    }
    float pr = 0.f, pk = 0.f, pv = 0.f;
    if (t0 > 0) { const bf16_t* row = P + (size_t)(t0 - 1) * P1LD; pr = bf2f(row[1024 + ch]); pk = bf2f(row[1536 + ch]); pv = bf2f(row[2048 + ch]); }
#pragma unroll 1
    for (int sb = 0; sb < 8; ++sb) {
        const float mu_r = mu[ch], mu_k = mu[512 + ch], mu_v = mu[1024 + ch], kkc = C.in[33][ch], kac = C.in[34][ch], rkc = C.in[35][ch];
        constexpr int UF = PASS == 3 ? 8 : 4;
#pragma unroll 1
        for (int j0 = 0; j0 < 8; j0 += UF) {
            float cr[UF], ck[UF], cv[UF], aa[UF], wl[UF], gg[UF];
#pragma unroll
            for (int u = 0; u < UF; ++u) {
                const int t = t0 + 8 * sb + j0 + u; const bf16_t* row = P + (size_t)t * P1LD;
                ck[u] = bf2f(row[1536 + ch]); cv[u] = bf2f(row[2048 + ch]); aa[u] = bf2f(AA[(size_t)t * 512 + ch]); wl[u] = bf2f(WLOG[(size_t)t * 512 + ch]);
                if (PASS == 3) { cr[u] = bf2f(row[1024 + ch]); gg[u] = bf2f(gg_row(C.ws, t)[ch]); }
            }
            float kkr[UF], kp[UF], nrm[UF], bon[UF], rsv[UF];
#pragma unroll
            for (int u = 0; u < UF; ++u) {
                const float ks = ck[u] + (pk - ck[u]) * mu_k, vs = cv[u] + (pv - cv[u]) * mu_v; pk = ck[u]; pv = cv[u];
                kkr[u] = ks * kkc; nrm[u] = kkr[u] * kkr[u]; kp[u] = ks * (1.f + (aa[u] - 1.f) * kac);
                VV[(j0 + u) * 512 + ch] = vs; VK[(j0 + u) * 512 + ch] = kp[u]; VW[(j0 + u) * 512 + ch] = __expf(wl[u]);
                if (PASS == 3) { rsv[u] = cr[u] + (pr - cr[u]) * mu_r; pr = cr[u]; bon[u] = rsv[u] * kp[u] * rkc; VR[(j0 + u) * 512 + ch] = rsv[u]; VG[(j0 + u) * 512 + ch] = gg[u]; }
            }
#pragma unroll
            for (int u = 0; u < UF; ++u) { nrm[u] = wave_sum_dpp(nrm[u]); if (PASS == 3) bon[u] = wave_sum_dpp(bon[u]); }
#pragma unroll
            for (int u = 0; u < UF; ++u) {
                const float kk = kkr[u] * rsqrtf(fmaxf(nrm[u], 1e-24f));
                VKK[(j0 + u) * 512 + ch] = kk; VB[(j0 + u) * 512 + ch] = kk * aa[u];
                if (PASS == 3) { if (lane == 0) VBON[(j0 + u) * 8 + head] = bon[u]; }
            }
        }
        __syncthreads();
#pragma unroll 1
        for (int j = 0; j < 8; ++j) {
            const LAS f32x4* pw = (const LAS f32x4*)(VW + j * 512 + head * 64); const LAS f32x4* pkk = (const LAS f32x4*)(VKK + j * 512 + head * 64);
            const LAS f32x4* pb = (const LAS f32x4*)(VB + j * 512 + head * 64); const LAS f32x4* pkp = (const LAS f32x4*)(VK + j * 512 + head * 64);
            const LAS f32x4* prr = (const LAS f32x4*)(VR + j * 512 + head * 64);
#define LO2(v) __builtin_shufflevector(v, v, 0, 1)
#define HI2(v) __builtin_shufflevector(v, v, 2, 3)
#define FMA2(a, b, c) __builtin_elementwise_fma(a, b, c)
            f32x2 aU0 = {0.f, 0.f}, aU1 = {0.f, 0.f}, aP0 = {0.f, 0.f}, aP1 = {0.f, 0.f};
            {
                f32x4 q = pkk[0];
#pragma unroll
                for (int g = 0; g < 16; ++g) {
                    f32x4 qn = q; if (g + 1 < 16) qn = pkk[g + 1];
                    aU0 = FMA2(SU[2 * g], LO2(q), aU0); aU1 = FMA2(SU[2 * g + 1], HI2(q), aU1);
                    if (PASS == 1) { aP0 = FMA2(SP[2 * g], LO2(q), aP0); aP1 = FMA2(SP[2 * g + 1], HI2(q), aP1); }
                    q = qn;
#if RW1_SB_SK == 1
                    if (PASS == 1) __builtin_amdgcn_sched_barrier(0);
#elif RW1_SB_SK == 4
                    if (PASS == 1 && (g & 3) == 3) __builtin_amdgcn_sched_barrier(0);
#endif
                }
            }
            float skU = (aU0[0] + aU0[1]) + (aU1[0] + aU1[1]); const float skP = (aP0[0] + aP0[1]) + (aP1[0] + aP1[1]);
#ifdef PROBE_VALU
            if (PASS == 3) { f32x2 d0 = {0.f, 0.f}, d1 = {0.f, 0.f}; const f32x2 cc = {1.0001f, 0.9999f};
#pragma unroll
                for (int g = 0; g < 32; ++g) { d0 = FMA2(SU[g], cc, d0); d1 = FMA2(SU[g], d0, d1); }
                skU += 1e-37f * ((d0[0] + d0[1]) + (d1[0] + d1[1])); }
#endif
#ifdef PROBE_LDS
            if (PASS == 3) { f32x4 d0 = F4Z;
#pragma unroll
                for (int g = 0; g < 16; ++g) d0 += pkp[g];
                skU += 1e-37f * ((d0[0] + d0[1]) + (d0[2] + d0[3])); }
#endif
            const float vv = VV[j * 512 + ch];
            const f32x2 nsU = {-skU, -skU}, nsP = {-skP, -skP}, vv2 = {vv, vv};
            f32x2 y0 = {0.f, 0.f}, y1 = {0.f, 0.f};
            {
                f32x4 w4 = pw[0], b4 = pb[0], k4 = pkp[0], r4 = F4Z; if (PASS == 3) r4 = prr[0];
#pragma unroll
                for (int g = 0; g < 16; ++g) {
                    f32x4 nw = w4, nb = b4, nk = k4, nr = r4;
                    if (g + 1 < 16) { nw = pw[g + 1]; nb = pb[g + 1]; nk = pkp[g + 1]; if (PASS == 3) nr = prr[g + 1]; }
                    SU[2 * g] = FMA2(SU[2 * g], LO2(w4), FMA2(nsU, LO2(b4), vv2 * LO2(k4)));
                    SU[2 * g + 1] = FMA2(SU[2 * g + 1], HI2(w4), FMA2(nsU, HI2(b4), vv2 * HI2(k4)));
                    if (PASS == 1) { SP[2 * g] = FMA2(SP[2 * g], LO2(w4), nsP * LO2(b4)); SP[2 * g + 1] = FMA2(SP[2 * g + 1], HI2(w4), nsP * HI2(b4)); }
                    if (PASS == 3) { y0 = FMA2(SU[2 * g], LO2(r4), y0); y1 = FMA2(SU[2 * g + 1], HI2(r4), y1); }
                    w4 = nw; b4 = nb; k4 = nk; r4 = nr;
#if RW1_SB_MAIN == 1
                    if (PASS == 1) __builtin_amdgcn_sched_barrier(0);
#elif RW1_SB_MAIN == 4
                    if (PASS == 1 && (g & 3) == 3) __builtin_amdgcn_sched_barrier(0);
#elif RW1_SB_MAIN == 2
                    if (PASS == 1 && (g & 1) == 1) __builtin_amdgcn_sched_barrier(0);
#endif
                }
            }
            const float y = (y0[0] + y0[1]) + (y1[0] + y1[1]);
            if (PASS == 3) VKK[j * 512 + ch] = y;
        }
        if (PASS == 3) {
            const float lng = C.in[36][ch], lnb = C.in[37][ch];
            float y[8], s1[8], s2[8];
#pragma unroll
            for (int u = 0; u < 8; ++u) { y[u] = VKK[u * 512 + ch]; s1[u] = y[u]; }
#pragma unroll
            for (int u = 0; u < 8; ++u) s1[u] = wave_sum_dpp(s1[u]);
#pragma unroll
            for (int u = 0; u < 8; ++u) { y[u] -= s1[u] * (1.f / 64.f); s2[u] = y[u] * y[u]; }
#pragma unroll
            for (int u = 0; u < 8; ++u) s2[u] = wave_sum_dpp(s2[u]);
#pragma unroll
            for (int u = 0; u < 8; ++u) {
                const float yn = y[u] * rsqrtf(s2[u] * (1.f / 64.f) + 64e-5f) * lng + lnb;
                Y[(size_t)(t0 + 8 * sb + u) * D + 512 + ch] = f2bf((yn + VBON[u * 8 + head] * VV[u * 512 + ch]) * VG[u * 512 + ch]);
            }
        }
        __syncthreads();
    }
    if (PASS == 1) {
        f32x4* du = (f32x4*)(UC + ((size_t)(c * 8 + head) * 64 + lane) * 64); f32x4* dp = (f32x4*)(PC + ((size_t)(c * 8 + head) * 64 + lane) * 64);
#pragma unroll
        for (int k4 = 0; k4 < 16; ++k4) { du[k4] = (f32x4){SU[2 * k4][0], SU[2 * k4][1], SU[2 * k4 + 1][0], SU[2 * k4 + 1][1]}; dp[k4] = (f32x4){SP[2 * k4][0], SP[2 * k4][1], SP[2 * k4 + 1][0], SP[2 * k4 + 1][1]}; }
    }
}

template <int PASS>
__device__ __forceinline__ void lru_chunk(const Ctx& C, int c) {
    const bf16_t* P = (const bf16_t*)(C.ws + WS_HP); const bf16_t* SW = (const bf16_t*)(C.ws + WS_SMALLW); bf16_t* Y = (bf16_t*)(C.ws + WS_Y);
    LAS bf16_t* XC = (LAS bf16_t*)C.lds; LAS bf16_t* LAB = (LAS bf16_t*)(C.lds + 66560);
    const int t0 = 64 * c, lane = C.lane, fr = lane & 15, fq = lane >> 4;
    {
        const int grp = C.tid & 63, seg = C.tid >> 6, ch0 = 8 * grp, r0 = 8 * seg;
        const float* cw = C.in[20]; const float* cb = C.in[21];
        float w0[8], w1[8], w2[8], w3[8], bb[8], x0[8], x1[8], x2[8];
#pragma unroll
        for (int i = 0; i < 8; ++i) { w0[i] = cw[ch0 + i]; w1[i] = cw[512 + ch0 + i]; w2[i] = cw[1024 + ch0 + i]; w3[i] = cw[1536 + ch0 + i]; bb[i] = cb[ch0 + i]; }
        auto ldrow = [&](int t, float (&x)[8]) {
            if (t < 0) {
#pragma unroll
                for (int i = 0; i < 8; ++i) x[i] = 0.f;
            } else {
                const u32x4 a = *(const u32x4*)(P + (size_t)t * P1LD + ch0);
#pragma unroll
                for (int i = 0; i < 4; ++i) { x[2 * i] = bflo(a[i]); x[2 * i + 1] = bfhi(a[i]); }
            }
        };
        ldrow(t0 + r0 - 3, x0); ldrow(t0 + r0 - 2, x1); ldrow(t0 + r0 - 1, x2);
#pragma unroll
        for (int row = r0; row < r0 + 8; ++row) {
            float x3[8], v[8]; ldrow(t0 + row, x3);
#pragma unroll
            for (int i = 0; i < 8; ++i) { v[i] = bb[i] + w0[i] * x0[i] + w1[i] * x1[i] + w2[i] * x2[i] + w3[i] * x3[i]; x0[i] = x1[i]; x1[i] = x2[i]; x2[i] = x3[i]; }
            u32x4 w; w.x = pk2(v[0], v[1]); w.y = pk2(v[2], v[3]); w.z = pk2(v[4], v[5]); w.w = pk2(v[6], v[7]);
            *(LAS u32x4*)(XC + row * 520 + ch0) = w;
        }
    }
    __syncthreads();
    const int nb = C.wave >> 1, eh = C.wave & 1, cbase = nb * 128 + 64 * eh;
    unsigned ur[4][4][2];
#pragma unroll
    for (int nth = 0; nth < 2; ++nth) {
        bf16x8 wfa[2][4], wfx[2][4];
#pragma unroll
        for (int n2 = 0; n2 < 2; ++n2)
#pragma unroll
            for (int k = 0; k < 4; ++k) { wfa[n2][k] = ldfg(SW + SW_WAT + nb * 16384, 128, 64 * eh + 16 * (2 * nth + n2), 32 * k, lane); wfx[n2][k] = ldfg(SW + SW_WXT + nb * 16384, 128, 64 * eh + 16 * (2 * nth + n2), 32 * k, lane); }
        f32x4 bav[2], bxv[2], sp8[2];
#pragma unroll
        for (int n2 = 0; n2 < 2; ++n2) { const int chn = cbase + 16 * (2 * nth + n2) + 4 * fq; bav[n2] = *(const f32x4*)(C.in[23] + chn); bxv[n2] = *(const f32x4*)(C.in[25] + chn); const f32x4 lam = *(const f32x4*)(C.in[26] + chn);
#pragma unroll
            for (int v = 0; v < 4; ++v) sp8[n2][v] = -8.f * softplusf_(-lam[v]); }
#pragma unroll
        for (int mt = 0; mt < 4; ++mt) {
            bf16x8 mf[4];
#pragma unroll
            for (int k = 0; k < 4; ++k) mf[k] = ldf(XC, 520, 16 * mt, nb * 128 + 32 * k, lane);
#pragma unroll
            for (int n2 = 0; n2 < 2; ++n2) {
                const int nt = 2 * nth + n2, chn = cbase + 16 * nt + 4 * fq;
                f32x4 aa = F4Z, ax = F4Z;
#pragma unroll
                for (int k = 0; k < 4; ++k) { aa = mma(aa, wfa[n2][k], mf[k]); ax = mma(ax, wfx[n2][k], mf[k]); }
                const u32x2 xw = *(const LAS u32x2*)(XC + (16 * mt + fr) * 520 + chn);
                const float xc[4] = {bflo(xw.x), bfhi(xw.x), bflo(xw.y), bfhi(xw.y)};
                float la[4], uu[4];
#pragma unroll
                for (int v = 0; v < 4; ++v) { const float r = sigmoidf_(aa[v] + bav[n2][v]), ig = sigmoidf_(ax[v] + bxv[n2][v]); la[v] = sp8[n2][v] * r; uu[v] = sqrtf(fmaxf(-expm1f(2.f * la[v]), 0.f)) * ig * xc[v]; }
                *(LAS u32x2*)(LAB + (16 * mt + fr) * 512 + chn) = (u32x2){pk2(la[0], la[1]), pk2(la[2], la[3])};
                ur[mt][nt][0] = pk2(uu[0], uu[1]); ur[mt][nt][1] = pk2(uu[2], uu[3]);
            }
            __builtin_amdgcn_sched_barrier(0);
        }
    }
    __syncthreads();
#pragma unroll
    for (int mt = 0; mt < 4; ++mt)
#pragma unroll
        for (int nt = 0; nt < 4; ++nt) *(LAS u32x2*)(XC + (16 * mt + fr) * 520 + cbase + 16 * nt + 4 * fq) = (u32x2){ur[mt][nt][0], ur[mt][nt][1]};
    __syncthreads();
    {
        const int ch = C.tid;
        float* LA = (float*)(C.ws + WS_LA); float* HC = (float*)(C.ws + WS_HC); const float* HIN = (const float*)(C.ws + WS_HIN);
        float h = PASS == 3 ? HIN[c * 512 + ch] : 0.f, sla = 0.f;
        if (PASS == 3) {
            float gbv[64];
#pragma unroll
            for (int tok = 0; tok < 64; ++tok) gbv[tok] = bf2f(P[(size_t)(t0 + tok) * P1LD + 512 + ch]);
#pragma unroll
            for (int tok = 0; tok < 64; ++tok) {
                const float la = bf2f(LAB[tok * 512 + ch]), u = bf2f(XC[tok * 520 + ch]);
                h = fmaf(__expf(la), h, u);
                const float gb = gbv[tok], ge = 0.5f * gb * (1.f + tanhf_(0.7978845608028654f * (gb + 0.044715f * gb * gb * gb)));
                Y[(size_t)(t0 + tok) * D + ch] = f2bf(h * ge);
            }
        } else {
#pragma unroll 8
            for (int tok = 0; tok < 64; ++tok) {
                const float la = bf2f(LAB[tok * 512 + ch]), u = bf2f(XC[tok * 520 + ch]);
                h = fmaf(__expf(la), h, u); sla += la;
            }
        }
        if (PASS == 1) { LA[c * 512 + ch] = sla; HC[c * 512 + ch] = h; }
    }
    __syncthreads();
}

__device__ __forceinline__ void l1_pass_a(const Ctx& C) {
#ifndef SKIP_PREP
    for (int c = C.bid; c < 256; c += C.G) rwkv_prep(C, c);
#endif
#ifndef SKIP_RW1
    for (int c = C.bid; c < 256; c += C.G) rwkv_chunk<1>(C, c);
#ifdef PROBE_RW1X2
    for (int c = C.bid; c < 256; c += C.G) rwkv_chunk<1>(C, c);
#endif
#endif
#ifndef SKIP_LRU1
    for (int c = C.bid; c < 256; c += C.G) lru_chunk<1>(C, c);
#endif
}
__device__ __forceinline__ void l1_pass_c(const Ctx& C) {
#ifndef SKIP_RW3
    for (int c = C.bid; c < 256; c += C.G) rwkv_chunk<3>(C, c);
#ifdef PROBE_RW3X2
    for (int c = C.bid; c < 256; c += C.G) rwkv_chunk<3>(C, c);
#endif
#endif
#ifndef SKIP_LRU3
    for (int c = C.bid; c < 256; c += C.G) lru_chunk<3>(C, c);
#ifdef PROBE_LRU3X2
    for (int c = C.bid; c < 256; c += C.G) lru_chunk<3>(C, c);
#endif
#endif
}

__device__ __forceinline__ void l1_middle(const Ctx& C) {
    const float* PC = (const float*)(C.ws + WS_PC); float* UC = C.X;
    const int lane = C.lane;
#ifndef SKIP_MID
    if (C.bid < 128 && C.G >= 128) {
        const int head = C.bid >> 4, row = (C.bid & 15) * 4 + (C.wave & 3); const bool rowwave = C.wave < 4;
        LAS float* SR = (LAS float*)(C.lds + C.wave * 256); LAS float* RING = (LAS float*)(C.lds + 4096);
        const float* pcb = PC + (size_t)head * 4096 + C.tid * 8;
        float* ub = UC + ((size_t)head * 64 + row) * 64 + lane;
        float s = 0.f; SR[lane] = 0.f;
        f32x4 qa0, qb0, qa1, qb1, qa2, qb2, qa3, qb3; float u0, u1, u2, u3;
#define MID_LD(qa, qb, cc) do { const f32x4* p_ = (const f32x4*)(pcb + (size_t)(cc) * 32768); qa = p_[0]; qb = p_[1]; } while (0)
#define MID_ST(qa, qb, cc) do { LAS f32x4* d_ = (LAS f32x4*)(RING + ((cc) & 7) * 4096 + C.tid * 8); d_[0] = qa; d_[1] = qb; } while (0)
        MID_LD(qa0, qb0, 0); MID_LD(qa1, qb1, 1); MID_LD(qa2, qb2, 2); MID_LD(qa3, qb3, 3);
        MID_ST(qa0, qb0, 0); MID_ST(qa1, qb1, 1); MID_ST(qa2, qb2, 2); MID_ST(qa3, qb3, 3);
        MID_LD(qa0, qb0, 4); MID_LD(qa1, qb1, 5); MID_LD(qa2, qb2, 6); MID_LD(qa3, qb3, 7);
        u0 = ub[0]; u1 = ub[32768]; u2 = ub[2 * 32768]; u3 = ub[3 * 32768];
        __syncthreads();
#define MID_STEP(cc, qa, qb, uu) do { \
            if (rowwave) { const LAS float* P_ = RING + ((cc) & 7) * 4096 + lane; \
            float a0 = 0.f, a1 = 0.f, a2 = 0.f, a3 = 0.f; \
            _Pragma("unroll") for (int i4 = 0; i4 < 16; ++i4) { const f32x4 s4 = *(const LAS f32x4*)(SR + 4 * i4); \
                a0 = fmaf(s4[0], P_[(4 * i4) * 64], a0); a1 = fmaf(s4[1], P_[(4 * i4 + 1) * 64], a1); a2 = fmaf(s4[2], P_[(4 * i4 + 2) * 64], a2); a3 = fmaf(s4[3], P_[(4 * i4 + 3) * 64], a3); } \
            ub[(size_t)(cc) * 32768] = s;                      \
            s = uu + ((a0 + a1) + (a2 + a3)); SR[lane] = s; } \
            if ((cc) + 4 < 256) { MID_ST(qa, qb, (cc) + 4); if (rowwave) uu = ub[(size_t)((cc) + 4) * 32768]; } \
            if ((cc) + 8 < 256) MID_LD(qa, qb, (cc) + 8); } while (0)
#pragma unroll 1
        for (int c = 0; c < 256; c += 4) { MID_STEP(c, qa0, qb0, u0); MID_STEP(c + 1, qa1, qb1, u1); MID_STEP(c + 2, qa2, qb2, u2); MID_STEP(c + 3, qa3, qb3, u3); __syncthreads(); }
#undef MID_LD
#undef MID_ST
#undef MID_STEP
    }
#endif
    if (C.bid == (C.G > 128 ? 128 : 0)) {
        const float* LA = (const float*)(C.ws + WS_LA); const float* HC = (const float*)(C.ws + WS_HC); float* HIN = (float*)(C.ws + WS_HIN);
        const int ch = C.tid; float h = 0.f;
        for (int c0 = 0; c0 < 256; c0 += 32) { float la[32], hc[32];
#pragma unroll
            for (int j = 0; j < 32; ++j) { la[j] = LA[(c0 + j) * 512 + ch]; hc[j] = HC[(c0 + j) * 512 + ch]; }
#pragma unroll
            for (int j = 0; j < 32; ++j) { HIN[(c0 + j) * 512 + ch] = h; h = fmaf(__expf(la[j]), h, hc[j]); } }
    }
}

#define XB_TMO      128
#define XB_XCNT(j)  (256  + 64 * (j))
#define XB_XSUB(j)  (1280 + 64 * (j))
#define XB_XGEN(j)  (2304 + 64 * (j))
#define XB_TOP      3328
#define XB_TOPGEN   3392
#define XCD_BAR_WORDS 3456
#define XB_SPIN_CAP (1u << 18)

__device__ __forceinline__ unsigned xb_ld(unsigned* p)              { return __hip_atomic_load(p, __ATOMIC_RELAXED, __HIP_MEMORY_SCOPE_AGENT); }
__device__ __forceinline__ unsigned xb_add(unsigned* p, unsigned v) { return __hip_atomic_fetch_add(p, v, __ATOMIC_RELAXED, __HIP_MEMORY_SCOPE_AGENT); }
__device__ __forceinline__ unsigned xb_xcc_id() { return (unsigned)__builtin_amdgcn_s_getreg((3 << 11) | 20) & 0xFu; }
#define XB_SPIN(cond, bar) do { unsigned _sp = 0; while (cond) { __builtin_amdgcn_s_sleep(1); \
    if ((++_sp & 255u) == 0u) { if (xb_ld(&(bar)[XB_TMO])) break; if (_sp > XB_SPIN_CAP) { atomicAdd(&(bar)[XB_TMO], 1u); break; } } } } while (0)

struct XcdBarrier {
    unsigned* bar; unsigned x;
    volatile LAS unsigned* st;
};

__device__ __forceinline__ XcdBarrier xcd_barrier_post(unsigned* bar, volatile LAS unsigned* st) {
    XcdBarrier b; b.bar = bar; b.x = xb_xcc_id(); b.st = st;
    if (threadIdx.x == 0) (void)xb_add(&bar[XB_XCNT(b.x)], 1u);
    return b;
}
__device__ __forceinline__ void xcd_barrier_complete(unsigned* bar, unsigned x, unsigned& nloc, unsigned& nx) {
    const unsigned G = gridDim.x * gridDim.y * gridDim.z;
    unsigned sum, cnt, mine, sp = 0u;
    for (;;) {
        sum = 0u; cnt = 0u; mine = 0u;
#pragma unroll
        for (unsigned j = 0; j < 16; ++j) { const unsigned c = xb_ld(&bar[XB_XCNT(j)]); sum += c; cnt += (c > 0u) ? 1u : 0u; mine = (j == x) ? c : mine; }
        if (sum == G) break;
        __builtin_amdgcn_s_sleep(1);
        if ((++sp & 255u) == 0u) { if (xb_ld(&bar[XB_TMO])) break; if (sp > XB_SPIN_CAP) { atomicAdd(&bar[XB_TMO], 1u); break; } }
    }
    nloc = mine > 0u ? mine : 1u; nx = cnt > 0u ? cnt : 1u;
}

__device__ __forceinline__ void xcd_barrier(const XcdBarrier& b) {
    asm volatile("s_waitcnt vmcnt(0)" ::: "memory");
    __syncthreads();
    if (threadIdx.x == 0) {
        unsigned* bar = b.bar;
        __builtin_amdgcn_s_waitcnt(0);
        unsigned nloc = b.st[0], nx = b.st[1];
        if (nloc == 0u) { xcd_barrier_complete(bar, b.x, nloc, nx); b.st[0] = nloc; b.st[1] = nx; }
        const unsigned old = xb_add(&bar[XB_XSUB(b.x)], 1u);
        const unsigned gen = old / nloc;
        if (old + 1u == (gen + 1u) * nloc) {
            __builtin_amdgcn_fence(__ATOMIC_RELEASE, "agent");
            asm volatile("s_waitcnt vmcnt(0)" ::: "memory");
            const unsigned og = xb_add(&bar[XB_TOP], 1u);
            const unsigned tg = og / nx;
            if (og + 1u == (tg + 1u) * nx) xb_add(&bar[XB_TOPGEN], 1u);
            else XB_SPIN(xb_ld(&bar[XB_TOPGEN]) == tg, bar);
            __builtin_amdgcn_fence(__ATOMIC_ACQUIRE, "agent");
            xb_add(&bar[XB_XGEN(b.x)], 1u);
            asm volatile("s_waitcnt vmcnt(0)" ::: "memory");
        } else {
            XB_SPIN(xb_ld(&bar[XB_XGEN(b.x)]) == gen, bar);
            __builtin_amdgcn_fence(__ATOMIC_ACQUIRE, "agent");
            asm volatile("s_waitcnt vmcnt(0)" ::: "memory");
        }
    }
    __syncthreads();
}

struct Args { const float* in[39]; float* out; unsigned char* ws; int ph_lo, ph_hi; };
constexpr int N_PHASES = 20;

__device__ __forceinline__ void ffn_gu(const Ctx& C, LAS unsigned char* lds, size_t wgu, int site) {
    pg8::Gemm g{(const bf16_t*)(C.ws + WS_XB), (const bf16_t*)(C.ws + wgu), T, 2 * FF, D}; pg8::StaticOrder S; S.init(T, 2 * FF, C.G, C.bid);
    EpiSwiglu E{(bf16_t*)(C.ws + WS_HP), (const float*)(C.ws + WS_SSQ) + (size_t)site * T * 16, (LAS float*)(C.lds + 131072)};
    pg8::gemm_phase<EpiSwiglu, pg8::StaticOrder, true, true>(lds, g, S, E);
}
__device__ __forceinline__ void ffn_down(const Ctx& C, LAS unsigned char* lds, size_t wd, int site_out, float alpha = 0.5f) {
    pg8::Gemm g{(const bf16_t*)(C.ws + WS_HP), (const bf16_t*)(C.ws + wd), T, D, FF}; pg8::StaticOrder S; S.init(T, D, C.G, C.bid);
    EpiResid E{(bf16_t*)(C.ws + WS_XB), (float*)(C.ws + WS_SSQ) + (size_t)site_out * T * 16, alpha};
    pg8::gemm_phase<EpiResid, pg8::StaticOrder, true, true>(lds, g, S, E);
}
__device__ __forceinline__ void out_proj(const Ctx& C, LAS unsigned char* lds, int site_out) {
    pg8::Gemm g{(const bf16_t*)(C.ws + WS_Y), (const bf16_t*)(C.ws + WS_WOUT), T, D, D}; pg8::StaticOrder S; S.init(T, D, C.G, C.bid);
    EpiResid E{(bf16_t*)(C.ws + WS_XB), (float*)(C.ws + WS_SSQ) + (size_t)site_out * T * 16, 1.0f};
    pg8::gemm_phase<EpiResid, pg8::StaticOrder, true, true>(lds, g, S, E);
}


__device__ __forceinline__ void grid_bar(unsigned* ctr, unsigned target, int tid) {
    asm volatile("s_waitcnt vmcnt(0)" ::: "memory");
    __syncthreads();
    if (tid == 0) {
        __builtin_amdgcn_fence(__ATOMIC_RELEASE, "agent");
        asm volatile("s_waitcnt vmcnt(0)" ::: "memory");
        __hip_atomic_fetch_add(ctr, 1u, __ATOMIC_RELAXED, __HIP_MEMORY_SCOPE_AGENT);
        const unsigned long long t0 = __builtin_amdgcn_s_memrealtime();
        while (__hip_atomic_load(ctr, __ATOMIC_RELAXED, __HIP_MEMORY_SCOPE_AGENT) < target) {
            __builtin_amdgcn_s_sleep(2);
            if (__builtin_amdgcn_s_memrealtime() - t0 > 50000000ull) break;
        }
        __builtin_amdgcn_fence(__ATOMIC_ACQUIRE, "agent");
        asm volatile("s_waitcnt vmcnt(0)" ::: "memory");
    }
    __syncthreads();
}

__global__ void __launch_bounds__(512) mk_fwd(Args args) {
    extern __shared__ __attribute__((aligned(16))) unsigned char lds_raw[];
    cg::grid_group grid = cg::this_grid();
    Ctx C; C.in = args.in; C.X = args.out; C.ws = args.ws; C.lds = (LAS unsigned char*)lds_raw;
    C.tid = threadIdx.x; C.lane = C.tid & 63; C.wave = __builtin_amdgcn_readfirstlane(C.tid >> 6); C.G = gridDim.x; C.bid = blockIdx.x; C.cv_b0 = 0; C.cv_nb = C.G;
    LAS unsigned char* lds = C.lds;
    const int lo = args.ph_lo, hi = args.ph_hi;
#define IN(k) (lo <= (k) && (k) < hi)
#ifndef REP_MASK
#define REP_MASK 0
#endif
#define REPS(k) (((REP_MASK >> (k)) & 1) ? 2 : 1)
#ifdef PROBE_SEAMX2
#define SEAM_EXTRA grid.sync(); if (C.wave == 0) { __builtin_amdgcn_fence(__ATOMIC_ACQUIRE, "agent"); asm volatile("s_waitcnt vmcnt(0)" ::: "memory"); } __syncthreads();
#else
#define SEAM_EXTRA
#endif
#define SEAM(k) do { if (IN(k) && IN((k) + 1)) xcd_barrier(xbar); } while (0)
    if (lo < 0) grid.sync();
    volatile LAS unsigned* xst = (volatile LAS unsigned*)(C.lds + 163824);
    if (C.tid == 0) { xst[0] = 0u; xst[1] = 0u; }
    __syncthreads();
    const XcdBarrier xbar = xcd_barrier_post((unsigned*)C.ws, xst);

#define TAIL_CONVERT(layer, which) do { if (C.G == 256) { if (C.bid >= 128) { __syncthreads(); C.cv_b0 = 128; C.cv_nb = 128; convert_weights(C, (layer), (which)); C.cv_b0 = 0; C.cv_nb = C.G; } } \
    else { __syncthreads(); convert_weights(C, (layer), (which)); } } while (0)

    if (IN(0)) {
#define PROLOGUE_BODY convert_weights(C, 0, 1); bf16_t* sw = (bf16_t*)(C.ws + WS_SMALLW); for (int n = 0; n < 4; ++n) { tr_small(C, C.in[22] + n * 16384, 128, 128, sw + n * 16384); tr_small(C, C.in[24] + n * 16384, 128, 128, sw + 65536 + n * 16384); } tr_small(C, C.in[29], 64, 512, sw + 131072); tr_small(C, C.in[31], 64, 512, sw + 163840); tr_small(C, C.in[32], 160, 512, sw + 196608); prologue_x(C);
        PROLOGUE_BODY
        if (REPS(0) == 2) { PROLOGUE_BODY }
    }
    SEAM(0);
    if (IN(1)) { ffn_gu(C, lds, WS_WGU1, 0); if (REPS(1) == 2) ffn_gu(C, lds, WS_WGU1, 0); TAIL_CONVERT(0, 6); }
    SEAM(1);
    if (IN(2)) { ffn_down(C, lds, WS_WD1, 1, 0.5f); if (REPS(2) == 2) ffn_down(C, lds, WS_WD1, 1, 0.f); }
    SEAM(2);
    if (IN(3)) {
        pg8::Gemm g{(const bf16_t*)(C.ws + WS_XB), (const bf16_t*)(C.ws + WS_WIN), T, 3584, D}; pg8::StaticOrder S; S.init(T, 3584, C.G, C.bid);
        EpiProj E{(bf16_t*)(C.ws + WS_HP), P0LD, 3328, (const float*)(C.ws + WS_SSQ) + (size_t)1 * T * 16, (float*)(C.ws + WS_DT), 3328, (LAS float*)(C.lds + 131072)};
        pg8::gemm_phase<EpiProj, pg8::StaticOrder, true, true>(lds, g, S, E);
        if (REPS(3) == 2) pg8::gemm_phase<EpiProj, pg8::StaticOrder, true, true>(lds, g, S, E);
    }
    SEAM(3);
    #ifndef SKIP4
    if (IN(4)) { l0_states(C); if (REPS(4) == 2) l0_states(C); }
#endif
    SEAM(4);
    #ifndef SKIP5
    if (IN(5)) l0_scan(C);
#endif
    SEAM(5);
    #ifndef SKIP6
    if (IN(6)) { l0_output(C); if (REPS(6) == 2) l0_output(C); }
#endif
    SEAM(6);
    if (IN(7)) out_proj(C, lds, 2);
    SEAM(7);
    if (IN(8)) { ffn_gu(C, lds, WS_WGU2, 2); TAIL_CONVERT(1, 1); }
    SEAM(8);
    if (IN(9)) ffn_down(C, lds, WS_WD2, 3);
    SEAM(9);
    if (IN(10)) { ffn_gu(C, lds, WS_WGU1, 3); TAIL_CONVERT(1, 6); }
    SEAM(10);
    if (IN(11)) ffn_down(C, lds, WS_WD1, 4);
    SEAM(11);
    if (IN(12)) {
        pg8::Gemm g{(const bf16_t*)(C.ws + WS_XB), (const bf16_t*)(C.ws + WS_WIN), T, 3072, D}; pg8::StaticOrder S; S.init(T, 3072, C.G, C.bid);
        EpiProj E{(bf16_t*)(C.ws + WS_HP), P1LD, 2848, (const float*)(C.ws + WS_SSQ) + (size_t)4 * T * 16, nullptr, -1, (LAS float*)(C.lds + 131072)};
        pg8::gemm_phase<EpiProj, pg8::StaticOrder, true, true>(lds, g, S, E);
    }
    SEAM(12);
    if (IN(13)) { l1_pass_a(C); if (REPS(13) == 2) l1_pass_a(C); }
    SEAM(13);
    if (IN(14)) l1_middle(C);
    SEAM(14);
    if (IN(15)) { l1_pass_c(C); if (REPS(15) == 2) l1_pass_c(C); }
    SEAM(15);
    if (IN(16)) out_proj(C, lds, 5);
    SEAM(16);
    if (IN(17)) ffn_gu(C, lds, WS_WGU2, 5);
    SEAM(17);
    if (IN(18)) ffn_down(C, lds, WS_WD2, 6);
    SEAM(18);
    if (IN(19)) final_norm(C);
#undef IN
#undef SEAM
}

extern "C" void kernel_launch(void* const* d_in, const int* in_sizes, int n_in, void* d_out, int out_size, void* d_ws, size_t ws_size, hipStream_t stream) {
    static int grid = 0;
    if (grid == 0) {
        if (n_in != 39 || out_size != T * D || ws_size < WS_END) { fprintf(stderr, "kernel_launch: unexpected problem: n_in %d out %d ws %zu\n", n_in, out_size, ws_size); grid = -1; return; }
        int dev = 0, cus = 0, per_cu = 0;
        hipGetDevice(&dev); hipDeviceGetAttribute(&cus, hipDeviceAttributeMultiprocessorCount, dev);
        if (hipFuncSetAttribute((const void*)mk_fwd, hipFuncAttributeMaxDynamicSharedMemorySize, LDS_BYTES) != hipSuccess) { fprintf(stderr, "kernel_launch: hipFuncSetAttribute failed\n"); grid = -1; return; }
        if (hipOccupancyMaxActiveBlocksPerMultiprocessor(&per_cu, (const void*)mk_fwd, 512, LDS_BYTES) != hipSuccess || per_cu < 1) { fprintf(stderr, "kernel_launch: occupancy query says %d\n", per_cu); per_cu = 1; (void)hipGetLastError(); }
        grid = cus * (per_cu > 1 ? 1 : per_cu);
    }
    if (grid < 0) return;
    if (hipMemsetAsync(d_ws, 0, 16384, stream) != hipSuccess) { fprintf(stderr, "kernel_launch: memset of the barrier word failed\n"); return; }
    Args a{};
    for (int i = 0; i < 39; ++i) a.in[i] = (const float*)d_in[i];
    a.out = (float*)d_out; a.ws = (unsigned char*)d_ws; a.ph_lo = 0; a.ph_hi = N_PHASES;
    void* kargs[] = {&a};
    hipError_t e = hipLaunchCooperativeKernel((const void*)mk_fwd, dim3(grid), dim3(512), kargs, LDS_BYTES, stream);
    if (e != hipSuccess) fprintf(stderr, "kernel_launch: cooperative launch failed: %s (grid %d)\n", hipGetErrorString(e), grid);
}
```

```cpp
#include <hip/hip_runtime.h>
#include <hip/hip_cooperative_groups.h>
#include <cstdio>
#include <cstdint>
namespace cg = cooperative_groups;
namespace pg8 {
#define PG8_LAS __attribute__((address_space(3)))
typedef unsigned short bf16_t;
typedef short bf16x8 __attribute__((ext_vector_type(8)));
typedef float f32x4 __attribute__((ext_vector_type(4)));
typedef unsigned u32x4 __attribute__((ext_vector_type(4)));
constexpr int BM = 256, BK = 64, HALF = 128, HTB = HALF * BK * 2  , STAGE_BYTES = 8 * HTB, NXCD = 8, WGM = 8;

__host__ __device__ __forceinline__ int lds_byte(int r, int c) { const int st = (r >> 4) * 2 + (c >> 5), rr = r & 15, cc = c & 31, ob = rr * 64 + cc * 2; return st * 1024 + (ob ^ (((ob >> 9) & 1) << 5)); }
__host__ __device__ __forceinline__ void stage_rc(int b, int& R, int& C) { const int st = b / 1024, sb = b % 1024, swz = sb ^ (((sb >> 9) & 1) << 5); R = (st >> 1) * 16 + swz / 64; C = (st & 1) * 32 + (swz % 64) / 2; }
__host__ __device__ __forceinline__ int perm32(int rho) { const int n = rho >> 4, i = rho & 15; return 8 * (i >> 2) + 4 * n + (i & 3); }

struct Unit { int pm, pn; };
struct Gemm { const bf16_t* A; const bf16_t* Bt; int M, N, K; };

struct StaticOrder {
    int nM, nN, nwg, G, c;
    __host__ __device__ void init(int M, int N, int G_, int c_) { nM = M / BM; nN = N / BM; nwg = nM * nN; G = G_; c = c_; }
    __host__ __device__ bool next(int i, Unit& u) const {
        const long L = (long)i * G + c; if (L >= nwg) return false;
        int wgid = (int)L; { const int q = nwg / NXCD, r = nwg % NXCD, xcd = wgid % NXCD, off = wgid / NXCD; wgid = (xcd < r ? xcd * (q + 1) : r * (q + 1) + (xcd - r) * q) + off; }
        const int nig = WGM * nN, gid = wgid / nig, fm = gid * WGM, gsz = (nM - fm) < WGM ? (nM - fm) : WGM;
        u.pm = fm + ((wgid % nig) % gsz); u.pn = (wgid % nig) / gsz; return true;
    }
    __device__ __forceinline__ void a_ready(const Unit&) const {}
    __device__ __forceinline__ void done(const Unit&) const {}
};
__device__ __forceinline__ unsigned cvt_pk_bf16(float lo, float hi) { unsigned r; asm volatile("v_cvt_pk_bf16_f32 %0, %1, %2" : "=v"(r) : "v"(lo), "v"(hi)); return r; }
template <class Epi, class Sched, bool ALIGN_EPI = false, bool SP2 = false>
__device__ __forceinline__ void gemm_phase(PG8_LAS unsigned char* lds, const Gemm g, const Sched& S, const Epi& E) {
    const int tid = threadIdx.x, wid = __builtin_amdgcn_readfirstlane(tid >> 6), lane = tid & 63, wr = wid >> 2, wc = wid & 3, fr = lane & 15, fq = lane >> 4;
    const int K = g.K, nt = K / BK;
    unsigned voffA[2], voffB[2];
#pragma unroll
    for (int i = 0; i < 2; ++i) { int R, C; stage_rc(tid * 16 + i * 8192, R, C); const int Rb = Epi::PERM ? ((R & ~31) + perm32(R & 31)) : R;
        voffA[i] = (unsigned)(R * K + C) * 2u; voffB[i] = (unsigned)(Rb * K + C) * 2u; }
    const size_t kstep = (size_t)(BK * 2);
    const size_t hstep = (size_t)HALF * K * 2;
    const size_t tstep = 2 * hstep;
    const unsigned ldsw = (unsigned)wid * 1024u;
    const int aoff = lds_byte(wr * 64 + fr, fq * 8), boff = lds_byte(wc * 32 + fr, fq * 8);
#define PG8_SA(b, h) (((b) * 2 + (h)) * HTB)
#define PG8_SB(b, h) ((4 + (b) * 2 + (h)) * HTB)
#define PG8_STAGE(bufoff, gbase, voff) do { _Pragma("unroll") for (int _i = 0; _i < 2; ++_i) \
        __builtin_amdgcn_global_load_lds((const unsigned*)((const char*)(gbase) + (voff)[_i]), (PG8_LAS unsigned*)(lds + (bufoff) + ldsw + _i * 8192), 16, 0, 0); } while (0)
#define PG8_LDA(dst, b, h) do { _Pragma("unroll") for (int m = 0; m < 4; ++m) _Pragma("unroll") for (int k = 0; k < 2; ++k) dst[m][k] = *(const PG8_LAS bf16x8*)(lds + PG8_SA(b, h) + aoff + m * 2048 + k * 1024); } while (0)
#define PG8_LDB(dst, b, h) do { _Pragma("unroll") for (int n = 0; n < 2; ++n) _Pragma("unroll") for (int k = 0; k < 2; ++k) dst[n][k] = *(const PG8_LAS bf16x8*)(lds + PG8_SB(b, h) + boff + n * 2048 + k * 1024); } while (0)
#define PG8_MMA(ai, bj, At, Bt) do { __builtin_amdgcn_s_setprio(1); _Pragma("unroll") for (int m = 0; m < 4; ++m) _Pragma("unroll") for (int n = 0; n < 2; ++n) _Pragma("unroll") for (int k = 0; k < 2; ++k) \
        acc[ai][bj][m][n] = __builtin_amdgcn_mfma_f32_16x16x32_bf16(Bt[n][k], At[m][k], acc[ai][bj][m][n], 0, 0, 0); __builtin_amdgcn_s_setprio(0); } while (0)
#define PG8_WAIT_V(n) asm volatile("s_waitcnt vmcnt(" #n ")" ::: "memory")
#define PG8_WAIT_L(n) asm volatile("s_waitcnt lgkmcnt(" #n ")" ::: "memory")
#define PG8_BAR __builtin_amdgcn_s_barrier()
#define PG8_SCHED __builtin_amdgcn_sched_barrier(0)
    Unit cur, nxt; int ui = 0;
    if (!S.next(0, cur)) return;
    f32x4 acc[2][2][4][2];
#pragma unroll
    for (int a = 0; a < 2; ++a)
#pragma unroll
        for (int b = 0; b < 2; ++b)
#pragma unroll
            for (int m = 0; m < 4; ++m)
#pragma unroll
                for (int n = 0; n < 2; ++n) acc[a][b][m][n] = (f32x4){0.f, 0.f, 0.f, 0.f};
    bf16x8 At[4][2], B0[2][2], B1[2][2];
    const char* cA = (const char*)g.A + (size_t)cur.pm * tstep; const char* cB = (const char*)g.Bt + (size_t)cur.pn * tstep;
    S.a_ready(cur);
    if constexpr (SP2) {
        PG8_STAGE(PG8_SB(0, 0), cB, voffB); PG8_STAGE(PG8_SB(0, 1), cB + hstep, voffB); PG8_STAGE(PG8_SA(0, 0), cA, voffA); PG8_STAGE(PG8_SA(0, 1), cA + hstep, voffA);
        if (wr == 1) PG8_BAR;
        PG8_WAIT_V(2); PG8_BAR;
        PG8_STAGE(PG8_SB(1, 0), cB + kstep, voffB); PG8_STAGE(PG8_SA(1, 0), cA + kstep, voffA); PG8_STAGE(PG8_SB(1, 1), cB + hstep + kstep, voffB);
        PG8_WAIT_V(6); PG8_BAR;
    } else {
        PG8_STAGE(PG8_SB(0, 0), cB, voffB); PG8_STAGE(PG8_SA(0, 0), cA, voffA); PG8_STAGE(PG8_SB(0, 1), cB + hstep, voffB); PG8_STAGE(PG8_SA(0, 1), cA + hstep, voffA);
        if (wr == 1) PG8_BAR;
        PG8_WAIT_V(4); PG8_BAR;
        PG8_STAGE(PG8_SB(1, 0), cB + kstep, voffB); PG8_STAGE(PG8_SA(1, 0), cA + kstep, voffA); PG8_STAGE(PG8_SB(1, 1), cB + hstep + kstep, voffB);
        PG8_WAIT_V(6); PG8_BAR;
    }
    for (;;) {
        const bool has_next = S.next(ui + 1, nxt);
        const char* nA = has_next ? (const char*)g.A + (size_t)nxt.pm * tstep : cA; const char* nB = has_next ? (const char*)g.Bt + (size_t)nxt.pn * tstep : cB;
        for (int t = 0; t < nt; t += 2) {
            const bool last = (t == nt - 2);
            const char* a1 = cA + (size_t)(t + 1) * kstep;
            const char* a2 = last ? nA : cA + (size_t)(t + 2) * kstep; const char* b2 = last ? nB : cB + (size_t)(t + 2) * kstep;
            const char* a3 = a2 + kstep; const char* b3 = b2 + kstep;
            if (last && has_next) S.a_ready(nxt);
            if constexpr (SP2) {
            PG8_LDB(B0, 0, 0); PG8_LDB(B1, 0, 1); PG8_SCHED; PG8_LDA(At, 0, 0); PG8_STAGE(PG8_SA(1, 1), a1 + hstep, voffA);
            PG8_WAIT_V(8); PG8_WAIT_L(0); PG8_BAR; PG8_MMA(0, 0, At, B0); PG8_MMA(0, 1, At, B1); PG8_BAR; PG8_SCHED;
            PG8_LDA(At, 0, 1); PG8_STAGE(PG8_SB(0, 0), b2, voffB); PG8_STAGE(PG8_SB(0, 1), b2 + hstep, voffB); PG8_STAGE(PG8_SA(0, 0), a2, voffA);
            PG8_WAIT_V(8); PG8_WAIT_L(0); PG8_BAR; PG8_MMA(1, 0, At, B0); PG8_MMA(1, 1, At, B1); PG8_BAR; PG8_SCHED;
            PG8_LDB(B0, 1, 0); PG8_LDB(B1, 1, 1); PG8_SCHED; PG8_LDA(At, 1, 0); PG8_STAGE(PG8_SA(0, 1), a2 + hstep, voffA);
            PG8_WAIT_V(8); PG8_WAIT_L(0); PG8_BAR; PG8_MMA(0, 0, At, B0); PG8_MMA(0, 1, At, B1); PG8_BAR; PG8_SCHED;
            PG8_LDA(At, 1, 1); PG8_STAGE(PG8_SB(1, 0), b3, voffB); PG8_STAGE(PG8_SB(1, 1), b3 + hstep, voffB); PG8_STAGE(PG8_SA(1, 0), a3, voffA);
            PG8_WAIT_V(8); PG8_WAIT_L(0); PG8_BAR; PG8_MMA(1, 0, At, B0); PG8_MMA(1, 1, At, B1); PG8_BAR; PG8_SCHED;
            } else {
            PG8_LDB(B0, 0, 0); PG8_SCHED; PG8_LDA(At, 0, 0); PG8_STAGE(PG8_SA(1, 1), a1 + hstep, voffA);
            PG8_WAIT_L(8); PG8_BAR; PG8_WAIT_L(0); PG8_MMA(0, 0, At, B0); PG8_BAR; PG8_SCHED;
            PG8_LDB(B1, 0, 1); PG8_STAGE(PG8_SB(0, 0), b2, voffB);
            PG8_BAR; PG8_WAIT_L(0); PG8_MMA(0, 1, At, B1); PG8_BAR;
            PG8_LDA(At, 0, 1); PG8_STAGE(PG8_SA(0, 0), a2, voffA);
            PG8_BAR; PG8_WAIT_L(0); PG8_MMA(1, 0, At, B0); PG8_BAR; PG8_SCHED;
            PG8_STAGE(PG8_SB(0, 1), b2 + hstep, voffB);
            PG8_WAIT_V(6); PG8_BAR; PG8_MMA(1, 1, At, B1); PG8_BAR;
            PG8_LDB(B0, 1, 0); PG8_SCHED; PG8_LDA(At, 1, 0); PG8_STAGE(PG8_SA(0, 1), a2 + hstep, voffA);
            PG8_WAIT_L(8); PG8_BAR; PG8_WAIT_L(0); PG8_MMA(0, 0, At, B0); PG8_BAR; PG8_SCHED;
            PG8_LDB(B1, 1, 1); PG8_STAGE(PG8_SB(1, 0), b3, voffB);
            PG8_BAR; PG8_WAIT_L(0); PG8_MMA(0, 1, At, B1); PG8_BAR;
            PG8_LDA(At, 1, 1); PG8_STAGE(PG8_SA(1, 0), a3, voffA);
            PG8_BAR; PG8_WAIT_L(0); PG8_MMA(1, 0, At, B0); PG8_BAR; PG8_SCHED;
            PG8_STAGE(PG8_SB(1, 1), b3 + hstep, voffB);
            PG8_WAIT_V(6); PG8_BAR; PG8_MMA(1, 1, At, B1); PG8_BAR;
            }
        }
        if constexpr (ALIGN_EPI) { if (wr == 0) PG8_BAR; }
        if constexpr (!Epi::AFTER_DRAIN) { E(acc, cur, wr, wc, fr, fq); S.done(cur); }
        if (!has_next) break;
#pragma unroll
        for (int a = 0; a < 2; ++a)
#pragma unroll
            for (int b = 0; b < 2; ++b)
#pragma unroll
                for (int m = 0; m < 4; ++m)
#pragma unroll
                    for (int n = 0; n < 2; ++n) acc[a][b][m][n] = (f32x4){0.f, 0.f, 0.f, 0.f};
        cur = nxt; cA = nA; cB = nB; ++ui;
        if constexpr (ALIGN_EPI) { if (wr == 1) PG8_BAR; }
    }
    PG8_WAIT_V(0);
    if constexpr (!ALIGN_EPI) { if (wr == 0) PG8_BAR; }
    PG8_BAR;
    if constexpr (Epi::AFTER_DRAIN) { E.fused(acc, cur, wr, wc, fr, fq, lds, wid, lane); S.done(cur); }
#undef PG8_SA
#undef PG8_SB
#undef PG8_STAGE
#undef PG8_LDA
#undef PG8_LDB
#undef PG8_MMA
#undef PG8_WAIT_V
#undef PG8_WAIT_L
#undef PG8_BAR
#undef PG8_SCHED
}
}

#define LAS __attribute__((address_space(3)))
typedef unsigned short bf16_t;
typedef short bf16x8 __attribute__((ext_vector_type(8)));
typedef float f32x4 __attribute__((ext_vector_type(4)));
typedef float f32x2 __attribute__((ext_vector_type(2)));
typedef unsigned u32x4 __attribute__((ext_vector_type(4)));
typedef unsigned u32x2 __attribute__((ext_vector_type(2)));

constexpr int T = 16384, D = 1024, FF = 2816;
constexpr int P0LD = 3328, P1LD = 2880;
constexpr int C_Q = 0, C_K = 512, C_V = 1024, C_G = 1536, C_Z = 2048, C_XBC = 2560;
constexpr size_t MiB = 1u << 20;
constexpr size_t WS_SSQ = 247 * MiB, WS_DT = 512 * 1024, WS_LRUC = 1 * MiB, WS_CHD = 2 * MiB + 512 * 1024, WS_SMALLW = 3 * MiB;
constexpr size_t WS_WGU1 = 4 * MiB, WS_WD1 = 15 * MiB, WS_WIN = 21 * MiB, WS_WOUT = 28 * MiB, WS_WGU2 = 30 * MiB, WS_WD2 = 41 * MiB;
constexpr size_t WS_XB = 47 * MiB, WS_Y = 79 * MiB, WS_HP = 111 * MiB, WS_ST = 215 * MiB, WS_END = 255 * MiB;
constexpr int LDS_BYTES = 163840;

typedef float f32x2_t __attribute__((ext_vector_type(2)));
typedef __bf16 bf16x2_t __attribute__((ext_vector_type(2)));
__device__ __forceinline__ unsigned pk2(float lo, float hi) { f32x2_t v = {lo, hi}; bf16x2_t b = __builtin_convertvector(v, bf16x2_t); return __builtin_bit_cast(unsigned, b); }
__device__ __forceinline__ unsigned short f2bf(float f) { return (unsigned short)(pk2(f, 0.f) & 0xffffu); }
__device__ __forceinline__ float bflo(unsigned w) { return __uint_as_float(w << 16); }
__device__ __forceinline__ float bfhi(unsigned w) { return __uint_as_float(w & 0xffff0000u); }
__device__ __forceinline__ float bf2f(unsigned short h) { return __uint_as_float(((unsigned)h) << 16); }
__device__ __forceinline__ float frcp(float x) { return __builtin_amdgcn_rcpf(x); }
__device__ __forceinline__ float sigmoidf_(float x) { return frcp(1.f + __expf(-x)); }
__device__ __forceinline__ float siluf_(float x) { return x * frcp(1.f + __expf(-x)); }
__device__ __forceinline__ float softplusf_(float x) { return x > 20.f ? x : log1pf(__expf(x)); }
__device__ __forceinline__ float softplus_fast(float x) { return x > 20.f ? x : __logf(1.f + __expf(x)); }
__device__ __forceinline__ float wave_sum(float v) {
#pragma unroll
    for (int o = 1; o < 64; o <<= 1) v += __shfl_xor(v, o);
    return v;
}
__device__ __forceinline__ float wave_sum_dpp(float v) {
    v += __builtin_bit_cast(float, __builtin_amdgcn_update_dpp(0, __builtin_bit_cast(int, v), 0x111, 0xf, 0xf, true));
    v += __builtin_bit_cast(float, __builtin_amdgcn_update_dpp(0, __builtin_bit_cast(int, v), 0x112, 0xf, 0xf, true));
    v += __builtin_bit_cast(float, __builtin_amdgcn_update_dpp(0, __builtin_bit_cast(int, v), 0x114, 0xf, 0xf, true));
    v += __builtin_bit_cast(float, __builtin_amdgcn_update_dpp(0, __builtin_bit_cast(int, v), 0x118, 0xf, 0xf, true));
    v += __builtin_bit_cast(float, __builtin_amdgcn_update_dpp(0, __builtin_bit_cast(int, v), 0x142, 0xa, 0xf, false));
    v += __builtin_bit_cast(float, __builtin_amdgcn_update_dpp(0, __builtin_bit_cast(int, v), 0x143, 0xc, 0xf, false));
    return __builtin_bit_cast(float, __builtin_amdgcn_readlane(__builtin_bit_cast(int, v), 63));
}
__device__ __forceinline__ f32x4 mma(f32x4 acc, bf16x8 nfrag, bf16x8 mfrag) { return __builtin_amdgcn_mfma_f32_16x16x32_bf16(nfrag, mfrag, acc, 0, 0, 0); }
__device__ __forceinline__ bf16x8 ldf(const LAS bf16_t* base, int stride, int row0, int k0, int lane) { return *(const LAS bf16x8*)(base + (row0 + (lane & 15)) * stride + k0 + 8 * (lane >> 4)); }
__device__ __forceinline__ bf16x8 ldfg(const bf16_t* base, int stride, int row0, int k0, int lane) { return *(const bf16x8*)(base + (size_t)(row0 + (lane & 15)) * stride + k0 + 8 * (lane >> 4)); }
#define F4Z ((f32x4){0.f, 0.f, 0.f, 0.f})
__device__ __forceinline__ float ssq_row(const float* ssq, int row) {
    float s = 0.f;
#pragma unroll
    for (int k = 0; k < 16; ++k) s += ssq[(size_t)k * T + row];
    return s;
}

struct Ctx {
    const float* const* in; float* X; unsigned char* ws; LAS unsigned char* lds;
    int tid, lane, wave, G, bid;
    int cv_b0, cv_nb;
};

__device__ __forceinline__ void tr_item(const float* W, int K, int N, bf16_t* WT, const float* gain, int k0, int n0, int drow0, LAS float* scr, int lane) {
    const int nn = n0 + (lane & 31);
    float wv[32];
#pragma unroll
    for (int i = 0; i < 32; ++i) { const int kk = 2 * i + (lane >> 5); wv[i] = (nn < N) ? W[(size_t)(k0 + kk) * N + nn] : 0.f; }
#pragma unroll
    for (int i = 0; i < 32; ++i) { const int kk = 2 * i + (lane >> 5); float v = wv[i]; if (gain) v *= gain[k0 + kk]; scr[kk * 33 + (lane & 31)] = v; }
    asm volatile("s_waitcnt lgkmcnt(0)" ::: "memory");
    const int c = lane & 7;
#pragma unroll
    for (int j = 0; j < 4; ++j) { const int n = (lane >> 3) + 8 * j; const LAS float* s = scr + (8 * c) * 33 + n;
        u32x4 o; o.x = pk2(s[0 * 33], s[1 * 33]); o.y = pk2(s[2 * 33], s[3 * 33]); o.z = pk2(s[4 * 33], s[5 * 33]); o.w = pk2(s[6 * 33], s[7 * 33]);
        if (n0 + n < N) *(u32x4*)(WT + (size_t)(drow0 + n) * K + k0 + 8 * c) = o; }
    asm volatile("s_waitcnt lgkmcnt(0)" ::: "memory");
}
__device__ __forceinline__ void tr_matrix(const Ctx& C, const float* W, int K, int N, bf16_t* WT, const float* gain, int mode, int& base) {
    LAS float* scr = (LAS float*)(C.lds + C.wave * 8448);
    const int nblk = (N + 31) / 32, nitems = (K / 64) * nblk, gw = (C.bid - C.cv_b0) * 8 + C.wave, ngw = C.cv_nb * 8;
    int first = (gw - (base % ngw) + ngw) % ngw;
    for (int it = first; it < nitems; it += ngw) {
        const int kb = it / nblk, nb = it % nblk, n0 = 32 * nb;
        const int drow0 = mode == 0 ? n0 : ((n0 >> 7) * 256 + (n0 & 127) + (mode == 2 ? 128 : 0));
        tr_item(W, K, N, WT, gain, 64 * kb, n0, drow0, scr, C.lane);
    }
    base += nitems;
}
__device__ __forceinline__ void convert_weights(const Ctx& C, int layer, int which) {
    int base = 0; unsigned char* ws = C.ws;
    if (which & 1) {
        tr_matrix(C, C.in[2] + (size_t)layer * D * FF, D, FF, (bf16_t*)(ws + WS_WGU1), C.in[1] + layer * D, 1, base);
        tr_matrix(C, C.in[3] + (size_t)layer * D * FF, D, FF, (bf16_t*)(ws + WS_WGU1), C.in[1] + layer * D, 2, base);
        tr_matrix(C, C.in[4] + (size_t)layer * D * FF, FF, D, (bf16_t*)(ws + WS_WD1), nullptr, 0, base);
    }
    if (which & 2) {
        if (layer == 0) { tr_matrix(C, C.in[10], D, 3336, (bf16_t*)(ws + WS_WIN), C.in[5], 0, base); tr_matrix(C, C.in[11], D, D, (bf16_t*)(ws + WS_WOUT), nullptr, 0, base); }
        else            { tr_matrix(C, C.in[18], D, 2848, (bf16_t*)(ws + WS_WIN), C.in[5] + D, 0, base); tr_matrix(C, C.in[19], D, D, (bf16_t*)(ws + WS_WOUT), nullptr, 0, base); }
    }
    if (which & 4) {
        tr_matrix(C, C.in[7] + (size_t)layer * D * FF, D, FF, (bf16_t*)(ws + WS_WGU2), C.in[6] + layer * D, 1, base);
        tr_matrix(C, C.in[8] + (size_t)layer * D * FF, D, FF, (bf16_t*)(ws + WS_WGU2), C.in[6] + layer * D, 2, base);
        tr_matrix(C, C.in[9] + (size_t)layer * D * FF, FF, D, (bf16_t*)(ws + WS_WD2), nullptr, 0, base);
    }
}
__device__ __forceinline__ void tr_small(const Ctx& C, const float* W, int K, int N, bf16_t* WT) {
    for (int idx = C.bid * 512 + C.tid; idx < K * N; idx += C.G * 512) { const int n = idx / K, k = idx % K; WT[idx] = f2bf(W[(size_t)k * N + n]); }
}

__device__ __forceinline__ void panel_rscale(const float* ssq, LAS float* rs, int pm) {
    asm volatile("s_waitcnt lgkmcnt(0)" ::: "memory"); __builtin_amdgcn_s_barrier(); asm volatile("" ::: "memory");
    if (threadIdx.x < 256) rs[threadIdx.x] = rsqrtf(ssq_row(ssq, pm * 256 + (int)threadIdx.x) * (1.f / D) + 1e-6f);
    asm volatile("s_waitcnt lgkmcnt(0)" ::: "memory"); __builtin_amdgcn_s_barrier(); asm volatile("" ::: "memory");
}

struct EpiSwiglu {
    static constexpr bool PERM = true, AFTER_DRAIN = false;
    bf16_t* H; const float* ssq; LAS float* rs;
    __device__ __forceinline__ void operator()(const f32x4 (&acc)[2][2][4][2], const pg8::Unit& u, int wr, int wc, int fr, int fq) const {
        panel_rscale(ssq, rs, u.pm);
        const int row0 = u.pm * 256 + wr * 64 + fr, col0 = u.pn * 128 + wc * 32 + 8 * fq;
#pragma unroll
        for (int ai = 0; ai < 2; ++ai)
#pragma unroll
            for (int m = 0; m < 4; ++m) {
                const int row = row0 + ai * 128 + m * 16; const float r = rs[wr * 64 + fr + ai * 128 + m * 16];
                float h[8];
#pragma unroll
                for (int n = 0; n < 2; ++n)
#pragma unroll
                    for (int v = 0; v < 4; ++v) { const float g = acc[ai][0][m][n][v] * r, up = acc[ai][1][m][n][v] * r; h[4 * n + v] = siluf_(g) * up; }
                u32x4 w; w.x = pk2(h[0], h[1]); w.y = pk2(h[2], h[3]); w.z = pk2(h[4], h[5]); w.w = pk2(h[6], h[7]);
                *(u32x4*)(H + (size_t)row * FF + col0) = w;
            }
    }
};
struct EpiResid {
    static constexpr bool PERM = true, AFTER_DRAIN = false;
    bf16_t* XB; float* ssq_out; float alpha;
    __device__ __forceinline__ void operator()(const f32x4 (&acc)[2][2][4][2], const pg8::Unit& u, int wr, int wc, int fr, int fq) const {
        const int row0 = u.pm * 256 + wr * 64 + fr, col0 = u.pn * 256 + wc * 32 + 8 * fq;
#pragma unroll
        for (int ai = 0; ai < 2; ++ai)
#pragma unroll
            for (int m = 0; m < 4; ++m) {
                const int row = row0 + ai * 128 + m * 16; float s = 0.f;
#pragma unroll
                for (int bj = 0; bj < 2; ++bj) {
                    const size_t off = (size_t)row * D + col0 + bj * 128;
                    const u32x4 xo = *(const u32x4*)(XB + off);
                    const f32x4 a0 = acc[ai][bj][m][0] * alpha, a1 = acc[ai][bj][m][1] * alpha;
                    u32x4 bq; bq.x = pk2(bflo(xo.x) + a0[0], bfhi(xo.x) + a0[1]); bq.y = pk2(bflo(xo.y) + a0[2], bfhi(xo.y) + a0[3]);
                    bq.z = pk2(bflo(xo.z) + a1[0], bfhi(xo.z) + a1[1]); bq.w = pk2(bflo(xo.w) + a1[2], bfhi(xo.w) + a1[3]);
                    *(u32x4*)(XB + off) = bq;
#pragma unroll
                    for (int q = 0; q < 4; ++q) { const float x0 = bflo(bq[q]), x1 = bfhi(bq[q]); s += x0 * x0 + x1 * x1; }
                }
                s += __shfl_xor(s, 16); s += __shfl_xor(s, 32);
                if (fq == 0) ssq_out[(size_t)(u.pn * 4 + wc) * T + row] = s;
            }
    }
};
struct EpiProj {
    static constexpr bool PERM = true, AFTER_DRAIN = false;
    bf16_t* P; int ldp, ncols; const float* ssq; float* DT; int dt_col0; LAS float* rs;
    __device__ __forceinline__ void operator()(const f32x4 (&acc)[2][2][4][2], const pg8::Unit& u, int wr, int wc, int fr, int fq) const {
        panel_rscale(ssq, rs, u.pm);
        const int row0 = u.pm * 256 + wr * 64 + fr, col0 = u.pn * 256 + wc * 32 + 8 * fq;
#pragma unroll
        for (int ai = 0; ai < 2; ++ai)
#pragma unroll
            for (int m = 0; m < 4; ++m) {
                const int row = row0 + ai * 128 + m * 16; const float r = rs[wr * 64 + fr + ai * 128 + m * 16];
#pragma unroll
                for (int bj = 0; bj < 2; ++bj) {
                    const int c = col0 + bj * 128; const f32x4 v0 = acc[ai][bj][m][0] * r, v1 = acc[ai][bj][m][1] * r;
                    if (c + 8 <= ncols) { u32x4 w; w.x = pk2(v0[0], v0[1]); w.y = pk2(v0[2], v0[3]); w.z = pk2(v1[0], v1[1]); w.w = pk2(v1[2], v1[3]); *(u32x4*)(P + (size_t)row * ldp + c) = w; }
                    else if (DT && c == dt_col0) { *(f32x4*)(DT + (size_t)row * 8) = v0; *(f32x4*)(DT + (size_t)row * 8 + 4) = v1; }
                }
            }
    }
};

__device__ __forceinline__ void prologue_x(const Ctx& C) {
    const float* x = C.in[0]; bf16_t* XB = (bf16_t*)(C.ws + WS_XB); float* ssq = (float*)(C.ws + WS_SSQ);
    const int gw = C.bid * 8 + C.wave, ngw = C.G * 8;
#pragma unroll 4
    for (int m = gw; m < T; m += ngw) {
        const f32x4* xr = (const f32x4*)(x + (size_t)m * D) + C.lane; u32x2* brow = (u32x2*)(XB + (size_t)m * D) + C.lane;
        float s = 0.f;
#pragma unroll
        for (int j = 0; j < 4; ++j) { const f32x4 v = xr[64 * j]; u32x2 q; q.x = pk2(v[0], v[1]); q.y = pk2(v[2], v[3]); brow[64 * j] = q; const float x0 = bflo(q.x), x1 = bfhi(q.x), x2 = bflo(q.y), x3 = bfhi(q.y); s += (x0 * x0 + x1 * x1) + (x2 * x2 + x3 * x3); }
        s = wave_sum(s);
        if (C.lane == 0) ssq[m] = s;
    }
    for (int i = C.bid * 512 + C.tid; i < 15 * T; i += C.G * 512) ssq[T + i] = 0.f;
}
__device__ __forceinline__ void final_norm(const Ctx& C) {
    const float* ssq = (const float*)(C.ws + WS_SSQ) + (size_t)6 * T * 16; const float* g = C.in[38];
    const int gw = C.bid * 8 + C.wave, ngw = C.G * 8;
    f32x4 gv[4];
#pragma unroll
    for (int j = 0; j < 4; ++j) gv[j] = ((const f32x4*)g)[C.lane + 64 * j];
    const bf16_t* XB = (const bf16_t*)(C.ws + WS_XB);
#pragma unroll 4
    for (int m = gw; m < T; m += ngw) {
        const u32x2* br = (const u32x2*)(XB + (size_t)m * D) + C.lane; f32x4* orow = (f32x4*)(C.X + (size_t)m * D) + C.lane; const float r = rsqrtf(ssq_row(ssq, m) * (1.f / D) + 1e-6f);
#pragma unroll
        for (int j = 0; j < 4; ++j) { const u32x2 q = br[64 * j]; f32x4 v = {bflo(q.x), bfhi(q.x), bflo(q.y), bfhi(q.y)}; v = v * r * gv[j]; orow[64 * j] = v; }
    }
}

__device__ __forceinline__ float ret_log_gamma(int h) { return logf(1.f - exp2f(-5.f - (float)h)); }

template <bool TR>
__device__ __forceinline__ void stage_rot(const bf16_t* P, int t0, int col0, LAS bf16_t* dst, int stride, float scale, float lg, bool kte, int nrows, int tl, int nth) {
    for (int it = tl; it < nrows * 8; it += nth) {
        const int row = TR ? it % nrows : it >> 3, d0 = TR ? (it / nrows) * 8 : (it & 7) * 8, t = t0 + row;
        const bf16_t* src = P + (size_t)t * P0LD + col0 + d0;
        const u32x4 a = *(const u32x4*)src, b = *(const u32x4*)(src + 64);
        const float rs = scale * (kte ? __expf(lg * (float)(127 - row)) : 1.f);
        float o1[8], o2[8];
#pragma unroll
        for (int i = 0; i < 8; ++i) {
            const unsigned wa = a[i >> 1], wb = b[i >> 1];
            const float x1 = (i & 1) ? bfhi(wa) : bflo(wa), x2 = (i & 1) ? bfhi(wb) : bflo(wb);
            const float invf = exp2f(-(float)(d0 + i) * (13.287712379549449f / 64.f));
            const float ang = (float)t * invf, n = rintf(ang * 0.15915494309189535f);
            float r = fmaf(-n, 6.2831854820251465f, ang); r = fmaf(-n, -1.7484556e-7f, r);
            const float s = __sinf(r), c = __cosf(r);
            o1[i] = (x1 * c - x2 * s) * rs; o2[i] = (x2 * c + x1 * s) * rs;
        }
        if (TR) {
#pragma unroll
            for (int i = 0; i < 8; ++i) { dst[(d0 + i) * stride + row] = f2bf(o1[i]); dst[(64 + d0 + i) * stride + row] = f2bf(o2[i]); }
        } else {
            u32x4 w1, w2; w1.x = pk2(o1[0], o1[1]); w1.y = pk2(o1[2], o1[3]); w1.z = pk2(o1[4], o1[5]); w1.w = pk2(o1[6], o1[7]);
            w2.x = pk2(o2[0], o2[1]); w2.y = pk2(o2[2], o2[3]); w2.z = pk2(o2[4], o2[5]); w2.w = pk2(o2[6], o2[7]);
            *(LAS u32x4*)(dst + row * stride + d0) = w1; *(LAS u32x4*)(dst + row * stride + 64 + d0) = w2;
        }
    }
}
__device__ __forceinline__ void stage_vT(const bf16_t* P, int t0, int col0, LAS bf16_t* dst, int stride, int tid) {
    for (int it = tid; it < 128 * 16; it += 512) {
        const int row = it & 127, e0 = (it >> 7) * 8;
        const u32x4 a = *(const u32x4*)(P + (size_t)(t0 + row) * P0LD + col0 + e0);
#pragma unroll
        for (int i = 0; i < 8; ++i) { const unsigned w = a[i >> 1]; dst[(e0 + i) * stride + row] = (unsigned short)((i & 1) ? (w >> 16) : (w & 0xffffu)); }
    }
}

__device__ __forceinline__ void stage_dt(const Ctx& C, int t0, int g, LAS float* DTS, LAS float* AS, LAS float* ACS) {
    const int l = C.tid & 127, hh = C.tid >> 7, h = 4 * g + hh;
    const float* DT = (const float*)(C.ws + WS_DT);
    const float dtv = softplusf_(DT[(size_t)(t0 + l) * 8 + h] + C.in[14][h]);
    DTS[hh * 128 + l] = dtv; AS[hh * 128 + l] = -dtv * __expf(C.in[15][h]);
    __syncthreads();
    float s = 0.f;
    for (int i = 0; i <= l; ++i) s += AS[hh * 128 + i];
    ACS[hh * 128 + l] = s;
    __syncthreads();
}

template <int NGRP, int MODE>
__device__ __forceinline__ void stage_conv(const Ctx& C, int t0, int g, LAS bf16_t* XT, LAS bf16_t* BB, LAS bf16_t* CC, const LAS float* DTS, const LAS float* ACS) {
    constexpr int NSEG = 512 / NGRP, RP = (128 + NSEG - 1) / NSEG;
    if (C.tid >= NGRP * NSEG) return;
    const bf16_t* P = (const bf16_t*)(C.ws + WS_HP);
    const int seg = C.tid % NSEG, grp = C.tid / NSEG;
    const int ch0 = grp < 32 ? 256 * g + 8 * grp : (grp < 40 ? 512 + 64 * g + 8 * (grp - 32) : 640 + 64 * g + 8 * (grp - 40));
    const float* cw = C.in[12]; const float* cb = C.in[13];
    float w0[8], w1[8], w2[8], w3[8], bb[8], x0[8], x1[8], x2[8];
#pragma unroll
    for (int i = 0; i < 8; ++i) { w0[i] = cw[ch0 + i]; w1[i] = cw[768 + ch0 + i]; w2[i] = cw[1536 + ch0 + i]; w3[i] = cw[2304 + ch0 + i]; bb[i] = cb[ch0 + i]; }
    const int r0 = seg * RP, r1 = (r0 + RP < 128) ? r0 + RP : 128;
    auto ldrow = [&](int t, float (&x)[8]) {
        if (t < 0) {
#pragma unroll
            for (int i = 0; i < 8; ++i) x[i] = 0.f;
        } else {
            const u32x4 a = *(const u32x4*)(P + (size_t)t * P0LD + C_XBC + ch0);
#pragma unroll
            for (int i = 0; i < 4; ++i) { x[2 * i] = bflo(a[i]); x[2 * i + 1] = bfhi(a[i]); }
        }
    };
    ldrow(t0 + r0 - 3, x0); ldrow(t0 + r0 - 2, x1); ldrow(t0 + r0 - 1, x2);
    for (int row = r0; row < r1; ++row) {
        float x3[8], v[8]; ldrow(t0 + row, x3);
#pragma unroll
        for (int i = 0; i < 8; ++i) { float s = bb[i] + w0[i] * x0[i] + w1[i] * x1[i] + w2[i] * x2[i] + w3[i] * x3[i]; v[i] = siluf_(s); x0[i] = x1[i]; x1[i] = x2[i]; x2[i] = x3[i]; }
        if (grp < 32) {
            const int hh = grp >> 3;
            float sc = DTS[hh * 128 + row]; if (MODE == 0) sc *= __expf(ACS[hh * 128 + 127] - ACS[hh * 128 + row]);
#pragma unroll
            for (int i = 0; i < 8; ++i) XT[(8 * grp + i) * 136 + row] = f2bf(v[i] * sc);
        } else if (MODE == 0) {
#pragma unroll
            for (int i = 0; i < 8; ++i) BB[(8 * (grp - 32) + i) * 136 + row] = f2bf(v[i]);
        } else {
            u32x4 w; w.x = pk2(v[0], v[1]); w.y = pk2(v[2], v[3]); w.z = pk2(v[4], v[5]); w.w = pk2(v[6], v[7]);
            if (grp < 40) *(LAS u32x4*)(BB + row * 72 + 8 * (grp - 32)) = w; else *(LAS u32x4*)(CC + row * 72 + 8 * (grp - 40)) = w;
        }
    }
}

__device__ __forceinline__ void ret_state_unit(const Ctx& C, int c, int h) {
    const bf16_t* P = (const bf16_t*)(C.ws + WS_HP); float* SR = (float*)(C.ws + WS_ST);
    LAS bf16_t* KT = (LAS bf16_t*)C.lds; LAS bf16_t* VT = KT + 128 * 136;
    const int t0 = c * 128, lane = C.lane, fr = lane & 15, fq = lane >> 4;
    stage_rot<true>(P, t0, C_K + h * 128, KT, 136, 0.08838834764831845f, ret_log_gamma(h), true, 128, C.tid, 512);
    stage_vT(P, t0, C_V + h * 128, VT, 136, C.tid);
    __syncthreads();
    const int e0 = 16 * C.wave; bf16x8 mf[4];
#pragma unroll
    for (int k = 0; k < 4; ++k) mf[k] = ldf(VT, 136, e0, 32 * k, lane);
    float* out = SR + ((size_t)(c * 4 + h) * 128 + e0 + fr) * 128 + 4 * fq;
#pragma unroll
    for (int dt = 0; dt < 8; ++dt) { f32x4 acc = F4Z;
#pragma unroll
        for (int k = 0; k < 4; ++k) acc = mma(acc, ldf(KT, 136, 16 * dt, 32 * k, lane), mf[k]);
        *(f32x4*)(out + 16 * dt) = acc; }
    __syncthreads();
}
__device__ __forceinline__ void mamba_state_unit(const Ctx& C, int c, int g) {
    LAS bf16_t* XT = (LAS bf16_t*)C.lds; LAS bf16_t* BT = XT + 256 * 136;
    LAS float* DTS = (LAS float*)(C.lds + 150528); LAS float* ACS = DTS + 512; LAS float* AS = ACS + 512;
    float* SM = C.X;     float* CHD = (float*)(C.ws + WS_CHD);
    const int t0 = c * 128, lane = C.lane, fr = lane & 15, fq = lane >> 4;
    stage_dt(C, t0, g, DTS, AS, ACS);
    stage_conv<40, 0>(C, t0, g, XT, BT, nullptr, DTS, ACS);
    if (C.tid < 4) CHD[(c * 2 + g) * 32 + C.tid] = __expf(ACS[C.tid * 128 + 127]);
    __syncthreads();
    const int hh = C.wave >> 1, ph = C.wave & 1;
#pragma unroll
    for (int pt = 0; pt < 2; ++pt) {
        const int p0 = ph * 32 + 16 * pt; bf16x8 mf[4];
#pragma unroll
        for (int k = 0; k < 4; ++k) mf[k] = ldf(XT, 136, hh * 64 + p0, 32 * k, lane);
        float* out = SM + ((size_t)(c * 8 + 4 * g + hh) * 64 + p0 + fr) * 64 + 4 * fq;
#pragma unroll
        for (int nt = 0; nt < 4; ++nt) { f32x4 acc = F4Z;
#pragma unroll
            for (int k = 0; k < 4; ++k) acc = mma(acc, ldf(BT, 136, 16 * nt, 32 * k, lane), mf[k]);
            *(f32x4*)(out + 16 * nt) = acc; }
    }
    __syncthreads();
}
__device__ __forceinline__ void l0_states(const Ctx& C) {
    for (int u = C.bid; u < 256; u += C.G) mamba_state_unit(C, u >> 1, u & 1);
    for (int u = C.bid; u < 512; u += C.G) ret_state_unit(C, u >> 2, u & 3);
}

__device__ __forceinline__ void l0_scan(const Ctx& C) {
    float* SR = (float*)(C.ws + WS_ST); float* SM = C.X;     const float* CHD = (const float*)(C.ws + WS_CHD);
    for (int idx = C.bid * 512 + C.tid; idx < 65536 + 32768; idx += C.G * 512) {
        if (idx < 65536) {
            const float dec = __expf(128.f * ret_log_gamma(idx >> 14)); float s = 0.f; float* p = SR + idx;
            for (int c0 = 0; c0 < 128; c0 += 32) { float kv[32];
#pragma unroll
                for (int j = 0; j < 32; ++j) kv[j] = p[(size_t)(c0 + j) * 65536];
#pragma unroll
                for (int j = 0; j < 32; ++j) { p[(size_t)(c0 + j) * 65536] = s; s = s * dec + kv[j]; } }
        } else {
            const int e = idx - 65536, head = e >> 12; float s = 0.f; float* p = SM + e;
            for (int c0 = 0; c0 < 128; c0 += 32) { float kv[32], dc[32];
#pragma unroll
                for (int j = 0; j < 32; ++j) { kv[j] = p[(size_t)(c0 + j) * 32768]; dc[j] = CHD[((c0 + j) * 2 + (head >> 2)) * 32 + (head & 3)]; }
#pragma unroll
                for (int j = 0; j < 32; ++j) { p[(size_t)(c0 + j) * 32768] = s; s = s * dc[j] + kv[j]; } }
        }
    }
}

__device__ __forceinline__ void mamba_out_unit(const Ctx& C, int c, int g) {
    LAS bf16_t* XT = (LAS bf16_t*)C.lds; LAS bf16_t* BM = (LAS bf16_t*)(C.lds + 69632); LAS bf16_t* CM = (LAS bf16_t*)(C.lds + 88064);
    LAS bf16_t* SP = (LAS bf16_t*)(C.lds + 106496); LAS bf16_t* STR = (LAS bf16_t*)(C.lds + 115712) + C.wave * (16 * 136);
    LAS float* DTS = (LAS float*)(C.lds + 150528); LAS float* ACS = DTS + 512; LAS float* AS = ACS + 512;
    const bf16_t* P = (const bf16_t*)(C.ws + WS_HP); const float* SM = C.X; bf16_t* Y = (bf16_t*)(C.ws + WS_Y);
    const int t0 = c * 128, lane = C.lane, fr = lane & 15, fq = lane >> 4, w = C.wave, l0 = 16 * w, l = l0 + fr;
    stage_dt(C, t0, g, DTS, AS, ACS);
    stage_conv<48, 1>(C, t0, g, XT, BM, CM, DTS, ACS);
    __syncthreads();
    bf16x8 cmA[2]; cmA[0] = ldf(CM, 72, l0, 0, lane); cmA[1] = ldf(CM, 72, l0, 32, lane);
    f32x4 cb[8];
#pragma unroll
    for (int st = 0; st < 8; ++st) { cb[st] = F4Z; if (st <= w) { cb[st] = mma(cb[st], ldf(BM, 72, 16 * st, 0, lane), cmA[0]); cb[st] = mma(cb[st], ldf(BM, 72, 16 * st, 32, lane), cmA[1]); } }
    float ssq = 0.f;
#pragma unroll 1
    for (int hh = 0; hh < 4; ++hh) {
        const int h = 4 * g + hh;
        __syncthreads();
        {
            const float* src = SM + (size_t)(c * 8 + h) * 4096;
#pragma unroll
            for (int i = 0; i < 2; ++i) { const int e = (C.tid + 512 * i) * 4; const f32x4 v = *(const f32x4*)(src + e); u32x2 b; b.x = pk2(v[0], v[1]); b.y = pk2(v[2], v[3]); *(LAS u32x2*)(SP + (e >> 6) * 72 + (e & 63)) = b; }
        }
        const float al = ACS[hh * 128 + l];
#pragma unroll
        for (int st = 0; st < 8; ++st) {
            const f32x4 as4 = *(const LAS f32x4*)(ACS + hh * 128 + 16 * st + 4 * fq); float sc[4];
#pragma unroll
            for (int v = 0; v < 4; ++v) { const int s = 16 * st + 4 * fq + v; sc[v] = (st <= w && s <= l) ? cb[st][v] * __expf(al - as4[v]) : 0.f; }
            u32x2 b; b.x = pk2(sc[0], sc[1]); b.y = pk2(sc[2], sc[3]); *(LAS u32x2*)(STR + fr * 136 + 16 * st + 4 * fq) = b;
        }
        __syncthreads();
        bf16x8 sA[4];
#pragma unroll
        for (int k = 0; k < 4; ++k) sA[k] = ldf(STR, 136, 0, 32 * k, lane);
        const float eal = __expf(al), dsk = C.in[16][h], dtl = DTS[hh * 128 + l], rdt = dtl > 1e-30f ? frcp(dtl) : 0.f;
#pragma unroll
        for (int pt = 0; pt < 4; ++pt) {
            f32x4 ya = F4Z, yo = F4Z;
#pragma unroll
            for (int k = 0; k < 4; ++k) ya = mma(ya, ldf(XT, 136, hh * 64 + 16 * pt, 32 * k, lane), sA[k]);
#pragma unroll
            for (int k = 0; k < 2; ++k) yo = mma(yo, ldf(SP, 72, 16 * pt, 32 * k, lane), cmA[k]);
            const int p = 16 * pt + 4 * fq;
            const u32x2 zz = *(const u32x2*)(P + (size_t)(t0 + l) * P0LD + C_Z + 256 * g + hh * 64 + p);
            const float z[4] = {bflo(zz.x), bfhi(zz.x), bflo(zz.y), bfhi(zz.y)};
            float y[4];
#pragma unroll
            for (int v = 0; v < 4; ++v) {
                const float xs = bf2f(XT[(hh * 64 + p + v) * 136 + l]) * rdt;
                y[v] = (ya[v] + yo[v] * eal + dsk * xs) * siluf_(z[v]); ssq += y[v] * y[v];
            }
            u32x2 b; b.x = pk2(y[0], y[1]); b.y = pk2(y[2], y[3]);
            *(u32x2*)(Y + (size_t)(t0 + l) * D + 512 + 256 * g + hh * 64 + p) = b;
        }
    }
    ssq += __shfl_xor(ssq, 16); ssq += __shfl_xor(ssq, 32);
    const float rinv = rsqrtf(ssq * (1.f / 256.f) + 1e-5f);
#pragma unroll 4
    for (int q = 0; q < 16; ++q) {
        const int ch = 256 * g + 16 * q + 4 * fq; const f32x4 ng = *(const f32x4*)(C.in[17] + ch);
        u32x2* yp = (u32x2*)(Y + (size_t)(t0 + l) * D + 512 + ch); const u32x2 yy = *yp;
        u32x2 b; b.x = pk2(bflo(yy.x) * rinv * ng[0], bfhi(yy.x) * rinv * ng[1]); b.y = pk2(bflo(yy.y) * rinv * ng[2], bfhi(yy.y) * rinv * ng[3]);
        *yp = b;
    }
    __syncthreads();
}
__device__ __forceinline__ void ret_out_unit(const Ctx& C, int c, int h) {
    LAS bf16_t* KN = (LAS bf16_t*)C.lds; LAS bf16_t* VT = KN + 128 * 136; LAS bf16_t* ST = VT + 128 * 136; LAS bf16_t* STR = ST + 128 * 136 + C.wave * (16 * 136);
    const bf16_t* P = (const bf16_t*)(C.ws + WS_HP); const float* SR = (const float*)(C.ws + WS_ST); bf16_t* Y = (bf16_t*)(C.ws + WS_Y);
    const int t0 = c * 128, lane = C.lane, fr = lane & 15, fq = lane >> 4, w = C.wave, i0 = 16 * w, ii = i0 + fr;
    const float lg = ret_log_gamma(h);
    stage_rot<false>(P, t0, C_K + h * 128, KN, 136, 0.08838834764831845f, 0.f, false, 128, C.tid, 512);
    stage_vT(P, t0, C_V + h * 128, VT, 136, C.tid);
    {
        const float* src = SR + (size_t)(c * 4 + h) * 16384;
#pragma unroll
        for (int i = 0; i < 8; ++i) { const int e = (C.tid + 512 * i) * 4; const f32x4 v = *(const f32x4*)(src + e); u32x2 b; b.x = pk2(v[0], v[1]); b.y = pk2(v[2], v[3]); *(LAS u32x2*)(ST + (e >> 7) * 136 + (e & 127)) = b; }
    }
    stage_rot<false>(P, t0 + i0, C_Q + h * 128, STR, 136, 1.f, 0.f, false, 16, lane, 64);
    __syncthreads();
    bf16x8 qA[4];
#pragma unroll
    for (int k = 0; k < 4; ++k) qA[k] = ldf(STR, 136, 0, 32 * k, lane);
    __syncthreads();
#pragma unroll
    for (int jt = 0; jt < 8; ++jt) {
        f32x4 sa = F4Z;
        if (jt <= w) {
#pragma unroll
            for (int k = 0; k < 4; ++k) sa = mma(sa, ldf(KN, 136, 16 * jt, 32 * k, lane), qA[k]);
        }
        float sc[4];
#pragma unroll
        for (int v = 0; v < 4; ++v) { const int j = 16 * jt + 4 * fq + v; sc[v] = (jt <= w && j <= ii) ? sa[v] * __expf(lg * (float)(ii - j)) : 0.f; }
        u32x2 b; b.x = pk2(sc[0], sc[1]); b.y = pk2(sc[2], sc[3]); *(LAS u32x2*)(STR + fr * 136 + 16 * jt + 4 * fq) = b;
    }
    __syncthreads();
    bf16x8 sA[4];
#pragma unroll
    for (int k = 0; k < 4; ++k) sA[k] = ldf(STR, 136, 0, 32 * k, lane);
    const float qfs = __expf(lg * (float)(ii + 1));
    f32x4 o[8]; float ssq = 0.f;
#pragma unroll
    for (int et = 0; et < 8; ++et) {
        f32x4 a = F4Z, a2 = F4Z;
#pragma unroll
        for (int k = 0; k < 4; ++k) { a = mma(a, ldf(VT, 136, 16 * et, 32 * k, lane), sA[k]); a2 = mma(a2, ldf(ST, 136, 16 * et, 32 * k, lane), qA[k]); }
        o[et] = a + a2 * qfs;
        ssq += (o[et][0] * o[et][0] + o[et][1] * o[et][1]) + (o[et][2] * o[et][2] + o[et][3] * o[et][3]);
    }
    ssq += __shfl_xor(ssq, 16); ssq += __shfl_xor(ssq, 32);
    const float rinv = rsqrtf(ssq * (1.f / 128.f) + 1e-6f);
#pragma unroll
    for (int et = 0; et < 8; ++et) {
        const int ch = h * 128 + 16 * et + 4 * fq;
        const u32x2 gg = *(const u32x2*)(P + (size_t)(t0 + ii) * P0LD + C_G + ch);
        u32x2 b; b.x = pk2(o[et][0] * rinv * siluf_(bflo(gg.x)), o[et][1] * rinv * siluf_(bfhi(gg.x))); b.y = pk2(o[et][2] * rinv * siluf_(bflo(gg.y)), o[et][3] * rinv * siluf_(bfhi(gg.y)));
        *(u32x2*)(Y + (size_t)(t0 + ii) * D + ch) = b;
    }
    __syncthreads();
}
__device__ __forceinline__ void l0_output(const Ctx& C) {
    for (int u = C.bid; u < 256; u += C.G) mamba_out_unit(C, u >> 1, u & 1);
    for (int u = C.bid; u < 512; u += C.G) ret_out_unit(C, u >> 2, u & 3);
}

constexpr size_t WS_WLOG = WS_ST, WS_AA = WS_ST + 16 * MiB, WS_GG = WS_WGU1, WS_PC = WS_Y;
constexpr size_t WS_LA = WS_LRUC, WS_HC = WS_LRUC + 512 * 1024, WS_HIN = WS_LRUC + 1024 * 1024;
constexpr int SW_WAT = 0, SW_WXT = 65536, SW_W2T = 131072, SW_A2T = 163840, SW_G2T = 196608;
__device__ __forceinline__ bf16_t* gg_row(unsigned char* ws, int t) { return (bf16_t*)(ws + WS_GG) + (size_t)t * 512; }
__device__ __forceinline__ float tanhf_(float x) { return 1.f - 2.f * frcp(1.f + __expf(2.f * x)); }

__device__ __forceinline__ void rwkv_prep(const Ctx& C, int c) {
    const bf16_t* P = (const bf16_t*)(C.ws + WS_HP); const bf16_t* SW = (const bf16_t*)(C.ws + WS_SMALLW);
    bf16_t* WLOG = (bf16_t*)(C.ws + WS_WLOG); bf16_t* AA = (bf16_t*)(C.ws + WS_AA);
    LAS bf16_t* TW = (LAS bf16_t*)C.lds; LAS bf16_t* AL = TW + 64 * 72; LAS bf16_t* SG = AL + 64 * 72;
    const float* mu = C.in[27];
    const int t0 = 64 * c, lane = C.lane, fr = lane & 15, fq = lane >> 4;
#pragma unroll 12
    for (int idx = C.tid; idx < 64 * 288; idx += 512) {
        const int tok = idx / 288, cc = idx % 288, col = 2560 + cc, t = t0 + tok;
        const float cur = bf2f(P[(size_t)t * P1LD + col]), prev = t > 0 ? bf2f(P[(size_t)(t - 1) * P1LD + col]) : 0.f;
        const float s = cur + (prev - cur) * mu[col - 1024];
        if (cc < 64) TW[tok * 72 + cc] = f2bf(tanhf_(s)); else if (cc < 128) AL[tok * 72 + cc - 64] = f2bf(s); else SG[tok * 168 + cc - 128] = f2bf(sigmoidf_(s));
    }
    __syncthreads();
    const int n0 = 64 * C.wave;
#pragma unroll 1
    for (int which = 0; which < 2; ++which) {
        const bf16_t* BT = SW + (which == 0 ? SW_W2T : SW_A2T); const LAS bf16_t* AM = which == 0 ? TW : AL;
        const float* bias = which == 0 ? C.in[28] : C.in[30]; bf16_t* O = which == 0 ? WLOG : AA;
#pragma unroll
        for (int nt = 0; nt < 4; ++nt) {
            const bf16x8 nf0 = ldfg(BT, 64, n0 + 16 * nt, 0, lane), nf1 = ldfg(BT, 64, n0 + 16 * nt, 32, lane);
            const int n = n0 + 16 * nt + 4 * fq; const f32x4 bv = *(const f32x4*)(bias + n);
#pragma unroll
            for (int mt = 0; mt < 4; ++mt) {
                f32x4 acc = F4Z; acc = mma(acc, nf0, ldf(AM, 72, 16 * mt, 0, lane)); acc = mma(acc, nf1, ldf(AM, 72, 16 * mt, 32, lane));
                float o[4];
#pragma unroll
                for (int v = 0; v < 4; ++v) { const float x = acc[v] + bv[v]; o[v] = which == 0 ? -__expf(-softplus_fast(-x) - 0.5f) : sigmoidf_(x); }
                u32x2 b; b.x = pk2(o[0], o[1]); b.y = pk2(o[2], o[3]);
                *(u32x2*)(O + (size_t)(t0 + 16 * mt + fr) * 512 + n) = b;
            }
        }
    }
#pragma unroll 2
    for (int nt = 0; nt < 4; ++nt) {
        bf16x8 nf[5];
#pragma unroll
        for (int k = 0; k < 5; ++k) nf[k] = ldfg(SW + SW_G2T, 160, n0 + 16 * nt, 32 * k, lane);
        const int n = n0 + 16 * nt + 4 * fq;
#pragma unroll
        for (int mt = 0; mt < 4; ++mt) {
            f32x4 acc = F4Z;
#pragma unroll
            for (int k = 0; k < 5; ++k) acc = mma(acc, nf[k], ldf(SG, 168, 16 * mt, 32 * k, lane));
#ifdef GG_CONSTVAL
            acc = (f32x4){0.5f, 0.25f, -0.5f, 1.f};
#endif
            u32x2 b; b.x = pk2(acc[0], acc[1]); b.y = pk2(acc[2], acc[3]);
            *(u32x2*)(gg_row(C.ws, t0 + 16 * mt + fr) + n) = b;
        }
    }
    asm volatile("s_waitcnt vmcnt(0)" ::: "memory");
    __threadfence_block();
    __syncthreads();
}

#ifndef RW1_SB_SK
#define RW1_SB_SK 0
#endif
#ifndef RW1_SB_MAIN
#define RW1_SB_MAIN 2
#endif
template <int PASS>
__device__ __forceinline__ void rwkv_chunk(const Ctx& C, int c) {
    const bf16_t* P = (const bf16_t*)(C.ws + WS_HP);
    const bf16_t* WLOG = (const bf16_t*)(C.ws + WS_WLOG); const bf16_t* AA = (const bf16_t*)(C.ws + WS_AA);
    float* PC = (float*)(C.ws + WS_PC); float* UC = C.X; bf16_t* Y = (bf16_t*)(C.ws + WS_Y);
    LAS float* VW = (LAS float*)(C.lds + 40960); LAS float* VKK = VW + 4096; LAS float* VB = VKK + 4096; LAS float* VK = VB + 4096; LAS float* VR = VK + 4096; LAS float* VV = VR + 4096; LAS float* VG = VV + 4096; LAS float* VBON = VG + 4096;
    const int t0 = 64 * c, lane = C.lane, head = C.wave, ch = C.tid;
    const float* mu = C.in[27];
    f32x2 SU[32], SP[32];
    if (PASS == 1) {
#pragma unroll
        for (int k = 0; k < 32; ++k) { SU[k] = (f32x2){0.f, 0.f}; SP[k] = (f32x2){(2 * k == lane) ? 1.f : 0.f, (2 * k + 1 == lane) ? 1.f : 0.f}; }
    } else {
        const f32x4* src = (const f32x4*)(UC + ((size_t)(c * 8 + head) * 64 + lane) * 64);
#pragma unroll
        for (int k4 = 0; k4 < 16; ++k4) { f32x4 v = src[k4];
#ifdef RW3_ZERO
            v = F4Z;
#endif
            SU[2 * k4] = (f32x2){v[0], v[1]}; SU[2 * k4 + 1] = (f32x2){v[2], v[3]}; }
    }
    float pr = 0.f, pk = 0.f, pv = 0.f;
    if (t0 > 0) { const bf16_t* row = P + (size_t)(t0 - 1) * P1LD; pr = bf2f(row[1024 + ch]); pk = bf2f(row[1536 + ch]); pv = bf2f(row[2048 + ch]); }
#pragma unroll 1
    for (int sb = 0; sb < 8; ++sb) {
        const float mu_r = mu[ch], mu_k = mu[512 + ch], mu_v = mu[1024 + ch], kkc = C.in[33][ch], kac = C.in[34][ch], rkc = C.in[35][ch];
        constexpr int UF = PASS == 3 ? 8 : 4;
#pragma unroll 1
        for (int j0 = 0; j0 < 8; j0 += UF) {
            float cr[UF], ck[UF], cv[UF], aa[UF], wl[UF], gg[UF];
#pragma unroll
            for (int u = 0; u < UF; ++u) {
                const int t = t0 + 8 * sb + j0 + u; const bf16_t* row = P + (size_t)t * P1LD;
                ck[u] = bf2f(row[1536 + ch]); cv[u] = bf2f(row[2048 + ch]); aa[u] = bf2f(AA[(size_t)t * 512 + ch]); wl[u] = bf2f(WLOG[(size_t)t * 512 + ch]);
                if (PASS == 3) { cr[u] = bf2f(row[1024 + ch]); gg[u] = bf2f(gg_row(C.ws, t)[ch]); }
            }
            float kkr[UF], kp[UF], nrm[UF], bon[UF], rsv[UF];
#pragma unroll
            for (int u = 0; u < UF; ++u) {
                const float ks = ck[u] + (pk - ck[u]) * mu_k, vs = cv[u] + (pv - cv[u]) * mu_v; pk = ck[u]; pv = cv[u];
                kkr[u] = ks * kkc; nrm[u] = kkr[u] * kkr[u]; kp[u] = ks * (1.f + (aa[u] - 1.f) * kac);
                VV[(j0 + u) * 512 + ch] = vs; VK[(j0 + u) * 512 + ch] = kp[u]; VW[(j0 + u) * 512 + ch] = __expf(wl[u]);
                if (PASS == 3) { rsv[u] = cr[u] + (pr - cr[u]) * mu_r; pr = cr[u]; bon[u] = rsv[u] * kp[u] * rkc; VR[(j0 + u) * 512 + ch] = rsv[u]; VG[(j0 + u) * 512 + ch] = gg[u]; }
            }
#pragma unroll
            for (int u = 0; u < UF; ++u) { nrm[u] = wave_sum_dpp(nrm[u]); if (PASS == 3) bon[u] = wave_sum_dpp(bon[u]); }
#pragma unroll
            for (int u = 0; u < UF; ++u) {
                const float kk = kkr[u] * rsqrtf(fmaxf(nrm[u], 1e-24f));
                VKK[(j0 + u) * 512 + ch] = kk; VB[(j0 + u) * 512 + ch] = kk * aa[u];
                if (PASS == 3) { if (lane == 0) VBON[(j0 + u) * 8 + head] = bon[u]; }
            }
        }
        __syncthreads();
#pragma unroll 1
        for (int j = 0; j < 8; ++j) {
            const LAS f32x4* pw = (const LAS f32x4*)(VW + j * 512 + head * 64); const LAS f32x4* pkk = (const LAS f32x4*)(VKK + j * 512 + head * 64);
            const LAS f32x4* pb = (const LAS f32x4*)(VB + j * 512 + head * 64); const LAS f32x4* pkp = (const LAS f32x4*)(VK + j * 512 + head * 64);
            const LAS f32x4* prr = (const LAS f32x4*)(VR + j * 512 + head * 64);
#define LO2(v) __builtin_shufflevector(v, v, 0, 1)
#define HI2(v) __builtin_shufflevector(v, v, 2, 3)
#define FMA2(a, b, c) __builtin_elementwise_fma(a, b, c)
            f32x2 aU0 = {0.f, 0.f}, aU1 = {0.f, 0.f}, aP0 = {0.f, 0.f}, aP1 = {0.f, 0.f};
            {
                f32x4 q = pkk[0];
#pragma unroll
                for (int g = 0; g < 16; ++g) {
                    f32x4 qn = q; if (g + 1 < 16) qn = pkk[g + 1];
                    aU0 = FMA2(SU[2 * g], LO2(q), aU0); aU1 = FMA2(SU[2 * g + 1], HI2(q), aU1);
                    if (PASS == 1) { aP0 = FMA2(SP[2 * g], LO2(q), aP0); aP1 = FMA2(SP[2 * g + 1], HI2(q), aP1); }
                    q = qn;
#if RW1_SB_SK == 1
                    if (PASS == 1) __builtin_amdgcn_sched_barrier(0);
#elif RW1_SB_SK == 4
                    if (PASS == 1 && (g & 3) == 3) __builtin_amdgcn_sched_barrier(0);
#endif
                }
            }
            float skU = (aU0[0] + aU0[1]) + (aU1[0] + aU1[1]); const float skP = (aP0[0] + aP0[1]) + (aP1[0] + aP1[1]);
#ifdef PROBE_VALU
            if (PASS == 3) { f32x2 d0 = {0.f, 0.f}, d1 = {0.f, 0.f}; const f32x2 cc = {1.0001f, 0.9999f};
#pragma unroll
                for (int g = 0; g < 32; ++g) { d0 = FMA2(SU[g], cc, d0); d1 = FMA2(SU[g], d0, d1); }
                skU += 1e-37f * ((d0[0] + d0[1]) + (d1[0] + d1[1])); }
#endif
#ifdef PROBE_LDS
            if (PASS == 3) { f32x4 d0 = F4Z;
#pragma unroll
                for (int g = 0; g < 16; ++g) d0 += pkp[g];
                skU += 1e-37f * ((d0[0] + d0[1]) + (d0[2] + d0[3])); }
#endif
            const float vv = VV[j * 512 + ch];
            const f32x2 nsU = {-skU, -skU}, nsP = {-skP, -skP}, vv2 = {vv, vv};
            f32x2 y0 = {0.f, 0.f}, y1 = {0.f, 0.f};
            {
                f32x4 w4 = pw[0], b4 = pb[0], k4 = pkp[0], r4 = F4Z; if (PASS == 3) r4 = prr[0];
#pragma unroll
                for (int g = 0; g < 16; ++g) {
                    f32x4 nw = w4, nb = b4, nk = k4, nr = r4;
                    if (g + 1 < 16) { nw = pw[g + 1]; nb = pb[g + 1]; nk = pkp[g + 1]; if (PASS == 3) nr = prr[g + 1]; }
                    SU[2 * g] = FMA2(SU[2 * g], LO2(w4), FMA2(nsU, LO2(b4), vv2 * LO2(k4)));
                    SU[2 * g + 1] = FMA2(SU[2 * g + 1], HI2(w4), FMA2(nsU, HI2(b4), vv2 * HI2(k4)));
                    if (PASS == 1) { SP[2 * g] = FMA2(SP[2 * g], LO2(w4), nsP * LO2(b4)); SP[2 * g + 1] = FMA2(SP[2 * g + 1], HI2(w4), nsP * HI2(b4)); }
                    if (PASS == 3) { y0 = FMA2(SU[2 * g], LO2(r4), y0); y1 = FMA2(SU[2 * g + 1], HI2(r4), y1); }
                    w4 = nw; b4 = nb; k4 = nk; r4 = nr;
#if RW1_SB_MAIN == 1
                    if (PASS == 1) __builtin_amdgcn_sched_barrier(0);
#elif RW1_SB_MAIN == 4
                    if (PASS == 1 && (g & 3) == 3) __builtin_amdgcn_sched_barrier(0);
#elif RW1_SB_MAIN == 2
                    if (PASS == 1 && (g & 1) == 1) __builtin_amdgcn_sched_barrier(0);
#endif
                }
            }
            const float y = (y0[0] + y0[1]) + (y1[0] + y1[1]);
            if (PASS == 3) VKK[j * 512 + ch] = y;
        }
        if (PASS == 3) {
            const float lng = C.in[36][ch], lnb = C.in[37][ch];
            float y[8], s1[8], s2[8];
#pragma unroll
            for (int u = 0; u < 8; ++u) { y[u] = VKK[u * 512 + ch]; s1[u] = y[u]; }
#pragma unroll
            for (int u = 0; u < 8; ++u) s1[u] = wave_sum_dpp(s1[u]);
#pragma unroll
            for (int u = 0; u < 8; ++u) { y[u] -= s1[u] * (1.f / 64.f); s2[u] = y[u] * y[u]; }
#pragma unroll
            for (int u = 0; u < 8; ++u) s2[u] = wave_sum_dpp(s2[u]);
#pragma unroll
            for (int u = 0; u < 8; ++u) {
                const float yn = y[u] * rsqrtf(s2[u] * (1.f / 64.f) + 64e-5f) * lng + lnb;
                Y[(size_t)(t0 + 8 * sb + u) * D + 512 + ch] = f2bf((yn + VBON[u * 8 + head] * VV[u * 512 + ch]) * VG[u * 512 + ch]);
            }
        }
        __syncthreads();
    }
    if (PASS == 1) {
        f32x4* du = (f32x4*)(UC + ((size_t)(c * 8 + head) * 64 + lane) * 64); f32x4* dp = (f32x4*)(PC + ((size_t)(c * 8 + head) * 64 + lane) * 64);
#pragma unroll
        for (int k4 = 0; k4 < 16; ++k4) { du[k4] = (f32x4){SU[2 * k4][0], SU[2 * k4][1], SU[2 * k4 + 1][0], SU[2 * k4 + 1][1]}; dp[k4] = (f32x4){SP[2 * k4][0], SP[2 * k4][1], SP[2 * k4 + 1][0], SP[2 * k4 + 1][1]}; }
    }
}

template <int PASS>
__device__ __forceinline__ void lru_chunk(const Ctx& C, int c) {
    const bf16_t* P = (const bf16_t*)(C.ws + WS_HP); const bf16_t* SW = (const bf16_t*)(C.ws + WS_SMALLW); bf16_t* Y = (bf16_t*)(C.ws + WS_Y);
    LAS bf16_t* XC = (LAS bf16_t*)C.lds; LAS bf16_t* LAB = (LAS bf16_t*)(C.lds + 66560);
    const int t0 = 64 * c, lane = C.lane, fr = lane & 15, fq = lane >> 4;
    {
        const int grp = C.tid & 63, seg = C.tid >> 6, ch0 = 8 * grp, r0 = 8 * seg;
        const float* cw = C.in[20]; const float* cb = C.in[21];
        float w0[8], w1[8], w2[8], w3[8], bb[8], x0[8], x1[8], x2[8];
#pragma unroll
        for (int i = 0; i < 8; ++i) { w0[i] = cw[ch0 + i]; w1[i] = cw[512 + ch0 + i]; w2[i] = cw[1024 + ch0 + i]; w3[i] = cw[1536 + ch0 + i]; bb[i] = cb[ch0 + i]; }
        auto ldrow = [&](int t, float (&x)[8]) {
            if (t < 0) {
#pragma unroll
                for (int i = 0; i < 8; ++i) x[i] = 0.f;
            } else {
                const u32x4 a = *(const u32x4*)(P + (size_t)t * P1LD + ch0);
#pragma unroll
                for (int i = 0; i < 4; ++i) { x[2 * i] = bflo(a[i]); x[2 * i + 1] = bfhi(a[i]); }
            }
        };
        ldrow(t0 + r0 - 3, x0); ldrow(t0 + r0 - 2, x1); ldrow(t0 + r0 - 1, x2);
#pragma unroll
        for (int row = r0; row < r0 + 8; ++row) {
            float x3[8], v[8]; ldrow(t0 + row, x3);
#pragma unroll
            for (int i = 0; i < 8; ++i) { v[i] = bb[i] + w0[i] * x0[i] + w1[i] * x1[i] + w2[i] * x2[i] + w3[i] * x3[i]; x0[i] = x1[i]; x1[i] = x2[i]; x2[i] = x3[i]; }
            u32x4 w; w.x = pk2(v[0], v[1]); w.y = pk2(v[2], v[3]); w.z = pk2(v[4], v[5]); w.w = pk2(v[6], v[7]);
            *(LAS u32x4*)(XC + row * 520 + ch0) = w;
        }
    }
    __syncthreads();
    const int nb = C.wave >> 1, eh = C.wave & 1, cbase = nb * 128 + 64 * eh;
    unsigned ur[4][4][2];
#pragma unroll
    for (int nth = 0; nth < 2; ++nth) {
        bf16x8 wfa[2][4], wfx[2][4];
#pragma unroll
        for (int n2 = 0; n2 < 2; ++n2)
#pragma unroll
            for (int k = 0; k < 4; ++k) { wfa[n2][k] = ldfg(SW + SW_WAT + nb * 16384, 128, 64 * eh + 16 * (2 * nth + n2), 32 * k, lane); wfx[n2][k] = ldfg(SW + SW_WXT + nb * 16384, 128, 64 * eh + 16 * (2 * nth + n2), 32 * k, lane); }
        f32x4 bav[2], bxv[2], sp8[2];
#pragma unroll
        for (int n2 = 0; n2 < 2; ++n2) { const int chn = cbase + 16 * (2 * nth + n2) + 4 * fq; bav[n2] = *(const f32x4*)(C.in[23] + chn); bxv[n2] = *(const f32x4*)(C.in[25] + chn); const f32x4 lam = *(const f32x4*)(C.in[26] + chn);
#pragma unroll
            for (int v = 0; v < 4; ++v) sp8[n2][v] = -8.f * softplusf_(-lam[v]); }
#pragma unroll
        for (int mt = 0; mt < 4; ++mt) {
            bf16x8 mf[4];
#pragma unroll
            for (int k = 0; k < 4; ++k) mf[k] = ldf(XC, 520, 16 * mt, nb * 128 + 32 * k, lane);
#pragma unroll
            for (int n2 = 0; n2 < 2; ++n2) {
                const int nt = 2 * nth + n2, chn = cbase + 16 * nt + 4 * fq;
                f32x4 aa = F4Z, ax = F4Z;
#pragma unroll
                for (int k = 0; k < 4; ++k) { aa = mma(aa, wfa[n2][k], mf[k]); ax = mma(ax, wfx[n2][k], mf[k]); }
                const u32x2 xw = *(const LAS u32x2*)(XC + (16 * mt + fr) * 520 + chn);
                const float xc[4] = {bflo(xw.x), bfhi(xw.x), bflo(xw.y), bfhi(xw.y)};
                float la[4], uu[4];
#pragma unroll
                for (int v = 0; v < 4; ++v) { const float r = sigmoidf_(aa[v] + bav[n2][v]), ig = sigmoidf_(ax[v] + bxv[n2][v]); la[v] = sp8[n2][v] * r; uu[v] = __builtin_amdgcn_sqrtf(fmaxf(1.f - __expf(2.f * la[v]), 0.f)) * ig * xc[v];     }
                *(LAS u32x2*)(LAB + (16 * mt + fr) * 512 + chn) = (u32x2){pk2(la[0], la[1]), pk2(la[2], la[3])};
                ur[mt][nt][0] = pk2(uu[0], uu[1]); ur[mt][nt][1] = pk2(uu[2], uu[3]);
            }
            __builtin_amdgcn_sched_barrier(0);
        }
    }
    __syncthreads();
#pragma unroll
    for (int mt = 0; mt < 4; ++mt)
#pragma unroll
        for (int nt = 0; nt < 4; ++nt) *(LAS u32x2*)(XC + (16 * mt + fr) * 520 + cbase + 16 * nt + 4 * fq) = (u32x2){ur[mt][nt][0], ur[mt][nt][1]};
    __syncthreads();
    {
        const int ch = C.tid;
        float* LA = (float*)(C.ws + WS_LA); float* HC = (float*)(C.ws + WS_HC); const float* HIN = (const float*)(C.ws + WS_HIN);
        float h = PASS == 3 ? HIN[c * 512 + ch] : 0.f, sla = 0.f;
        if (PASS == 3) {
            float gbv[64];
#pragma unroll
            for (int tok = 0; tok < 64; ++tok) gbv[tok] = bf2f(P[(size_t)(t0 + tok) * P1LD + 512 + ch]);
#pragma unroll
            for (int tok = 0; tok < 64; ++tok) {
                const float la = bf2f(LAB[tok * 512 + ch]), u = bf2f(XC[tok * 520 + ch]);
                h = fmaf(__expf(la), h, u);
                const float gb = gbv[tok], ge = 0.5f * gb * (1.f + tanhf_(0.7978845608028654f * (gb + 0.044715f * gb * gb * gb)));
                Y[(size_t)(t0 + tok) * D + ch] = f2bf(h * ge);
            }
        } else {
#pragma unroll 8
            for (int tok = 0; tok < 64; ++tok) {
                const float la = bf2f(LAB[tok * 512 + ch]), u = bf2f(XC[tok * 520 + ch]);
                h = fmaf(__expf(la), h, u); sla += la;
            }
        }
        if (PASS == 1) { LA[c * 512 + ch] = sla; HC[c * 512 + ch] = h; }
    }
    __syncthreads();
}

__device__ __forceinline__ void l1_pass_a(const Ctx& C) {
#ifndef SKIP_PREP
    for (int c = C.bid; c < 256; c += C.G) rwkv_prep(C, c);
#endif
#ifndef SKIP_RW1
    for (int c = C.bid; c < 256; c += C.G) rwkv_chunk<1>(C, c);
#ifdef PROBE_RW1X2
    for (int c = C.bid; c < 256; c += C.G) rwkv_chunk<1>(C, c);
#endif
#endif
#ifndef SKIP_LRU1
    for (int c = C.bid; c < 256; c += C.G) lru_chunk<1>(C, c);
#endif
}
__device__ __forceinline__ void l1_pass_c(const Ctx& C) {
#ifndef SKIP_RW3
    for (int c = C.bid; c < 256; c += C.G) rwkv_chunk<3>(C, c);
#ifdef PROBE_RW3X2
    for (int c = C.bid; c < 256; c += C.G) rwkv_chunk<3>(C, c);
#endif
#endif
#ifndef SKIP_LRU3
    for (int c = C.bid; c < 256; c += C.G) lru_chunk<3>(C, c);
#ifdef PROBE_LRU3X2
    for (int c = C.bid; c < 256; c += C.G) lru_chunk<3>(C, c);
#endif
#endif
}

__device__ __forceinline__ void l1_middle(const Ctx& C) {
    const float* PC = (const float*)(C.ws + WS_PC); float* UC = C.X;
    const int lane = C.lane;
#ifndef SKIP_MID
    if (C.bid < 128 && C.G >= 128) {
        const int head = C.bid >> 4, row = (C.bid & 15) * 4 + (C.wave & 3); const bool rowwave = C.wave < 4;
        LAS float* SR = (LAS float*)(C.lds + C.wave * 256); LAS float* RING = (LAS float*)(C.lds + 4096);
        const float* pcb = PC + (size_t)head * 4096 + C.tid * 8;
        float* ub = UC + ((size_t)head * 64 + row) * 64 + lane;
        float s = 0.f; SR[lane] = 0.f;
        f32x4 qa0, qb0, qa1, qb1, qa2, qb2, qa3, qb3; float u0, u1, u2, u3;
#define MID_LD(qa, qb, cc) do { const f32x4* p_ = (const f32x4*)(pcb + (size_t)(cc) * 32768); qa = p_[0]; qb = p_[1]; } while (0)
#define MID_ST(qa, qb, cc) do { LAS f32x4* d_ = (LAS f32x4*)(RING + ((cc) & 7) * 4096 + C.tid * 8); d_[0] = qa; d_[1] = qb; } while (0)
        MID_LD(qa0, qb0, 0); MID_LD(qa1, qb1, 1); MID_LD(qa2, qb2, 2); MID_LD(qa3, qb3, 3);
        MID_ST(qa0, qb0, 0); MID_ST(qa1, qb1, 1); MID_ST(qa2, qb2, 2); MID_ST(qa3, qb3, 3);
        MID_LD(qa0, qb0, 4); MID_LD(qa1, qb1, 5); MID_LD(qa2, qb2, 6); MID_LD(qa3, qb3, 7);
        u0 = ub[0]; u1 = ub[32768]; u2 = ub[2 * 32768]; u3 = ub[3 * 32768];
        __syncthreads();
#define MID_STEP(cc, qa, qb, uu) do { \
            if (rowwave) { const LAS float* P_ = RING + ((cc) & 7) * 4096 + lane; \
            float a0 = 0.f, a1 = 0.f, a2 = 0.f, a3 = 0.f; \
            _Pragma("unroll") for (int i4 = 0; i4 < 16; ++i4) { const f32x4 s4 = *(const LAS f32x4*)(SR + 4 * i4); \
                a0 = fmaf(s4[0], P_[(4 * i4) * 64], a0); a1 = fmaf(s4[1], P_[(4 * i4 + 1) * 64], a1); a2 = fmaf(s4[2], P_[(4 * i4 + 2) * 64], a2); a3 = fmaf(s4[3], P_[(4 * i4 + 3) * 64], a3); } \
            ub[(size_t)(cc) * 32768] = s;                      \
            s = uu + ((a0 + a1) + (a2 + a3)); SR[lane] = s; } \
            if ((cc) + 4 < 256) { MID_ST(qa, qb, (cc) + 4); if (rowwave) uu = ub[(size_t)((cc) + 4) * 32768]; } \
            if ((cc) + 8 < 256) MID_LD(qa, qb, (cc) + 8); } while (0)
#pragma unroll 1
        for (int c = 0; c < 256; c += 4) { MID_STEP(c, qa0, qb0, u0); MID_STEP(c + 1, qa1, qb1, u1); MID_STEP(c + 2, qa2, qb2, u2); MID_STEP(c + 3, qa3, qb3, u3); __syncthreads(); }
#undef MID_LD
#undef MID_ST
#undef MID_STEP
    }
#endif
    if (C.bid == (C.G > 128 ? 128 : 0)) {
        const float* LA = (const float*)(C.ws + WS_LA); const float* HC = (const float*)(C.ws + WS_HC); float* HIN = (float*)(C.ws + WS_HIN);
        const int ch = C.tid; float h = 0.f;
        for (int c0 = 0; c0 < 256; c0 += 32) { float la[32], hc[32];
#pragma unroll
            for (int j = 0; j < 32; ++j) { la[j] = LA[(c0 + j) * 512 + ch]; hc[j] = HC[(c0 + j) * 512 + ch]; }
#pragma unroll
            for (int j = 0; j < 32; ++j) { HIN[(c0 + j) * 512 + ch] = h; h = fmaf(__expf(la[j]), h, hc[j]); } }
    }
}

#define XB_TMO      128
#define XB_XCNT(j)  (256  + 64 * (j))
#define XB_XSUB(j)  (1280 + 64 * (j))
#define XB_XGEN(j)  (2304 + 64 * (j))
#define XB_TOP      3328
#define XB_TOPGEN   3392
#define XCD_BAR_WORDS 3456
#define XB_SPIN_CAP (1u << 18)

__device__ __forceinline__ unsigned xb_ld(unsigned* p)              { return __hip_atomic_load(p, __ATOMIC_RELAXED, __HIP_MEMORY_SCOPE_AGENT); }
__device__ __forceinline__ unsigned xb_add(unsigned* p, unsigned v) { return __hip_atomic_fetch_add(p, v, __ATOMIC_RELAXED, __HIP_MEMORY_SCOPE_AGENT); }
__device__ __forceinline__ unsigned xb_xcc_id() { return (unsigned)__builtin_amdgcn_s_getreg((3 << 11) | 20) & 0xFu; }
#define XB_SPIN(cond, bar) do { unsigned _sp = 0; while (cond) { __builtin_amdgcn_s_sleep(1); \
    if ((++_sp & 255u) == 0u) { if (xb_ld(&(bar)[XB_TMO])) break; if (_sp > XB_SPIN_CAP) { atomicAdd(&(bar)[XB_TMO], 1u); break; } } } } while (0)

struct XcdBarrier {
    unsigned* bar; unsigned x;
    volatile LAS unsigned* st;
};

__device__ __forceinline__ XcdBarrier xcd_barrier_post(unsigned* bar, volatile LAS unsigned* st) {
    XcdBarrier b; b.bar = bar; b.x = xb_xcc_id(); b.st = st;
    if (threadIdx.x == 0) (void)xb_add(&bar[XB_XCNT(b.x)], 1u);
    return b;
}
__device__ __forceinline__ void xcd_barrier_complete(unsigned* bar, unsigned x, unsigned& nloc, unsigned& nx) {
    const unsigned G = gridDim.x * gridDim.y * gridDim.z;
    unsigned sum, cnt, mine, sp = 0u;
    for (;;) {
        sum = 0u; cnt = 0u; mine = 0u;
#pragma unroll
        for (unsigned j = 0; j < 16; ++j) { const unsigned c = xb_ld(&bar[XB_XCNT(j)]); sum += c; cnt += (c > 0u) ? 1u : 0u; mine = (j == x) ? c : mine; }
        if (sum == G) break;
        __builtin_amdgcn_s_sleep(1);
        if ((++sp & 255u) == 0u) { if (xb_ld(&bar[XB_TMO])) break; if (sp > XB_SPIN_CAP) { atomicAdd(&bar[XB_TMO], 1u); break; } }
    }
    nloc = mine > 0u ? mine : 1u; nx = cnt > 0u ? cnt : 1u;
}

__device__ __forceinline__ void xcd_barrier(const XcdBarrier& b) {
    asm volatile("s_waitcnt vmcnt(0)" ::: "memory");
    __syncthreads();
    if (threadIdx.x == 0) {
        unsigned* bar = b.bar;
        __builtin_amdgcn_s_waitcnt(0);
        unsigned nloc = b.st[0], nx = b.st[1];
        if (nloc == 0u) { xcd_barrier_complete(bar, b.x, nloc, nx); b.st[0] = nloc; b.st[1] = nx; }
        const unsigned old = xb_add(&bar[XB_XSUB(b.x)], 1u);
        const unsigned gen = old / nloc;
        if (old + 1u == (gen + 1u) * nloc) {
            __builtin_amdgcn_fence(__ATOMIC_RELEASE, "agent");
            asm volatile("s_waitcnt vmcnt(0)" ::: "memory");
            const unsigned og = xb_add(&bar[XB_TOP], 1u);
            const unsigned tg = og / nx;
            if (og + 1u == (tg + 1u) * nx) xb_add(&bar[XB_TOPGEN], 1u);
            else XB_SPIN(xb_ld(&bar[XB_TOPGEN]) == tg, bar);
            __builtin_amdgcn_fence(__ATOMIC_ACQUIRE, "agent");
            xb_add(&bar[XB_XGEN(b.x)], 1u);
            asm volatile("s_waitcnt vmcnt(0)" ::: "memory");
        } else {
            XB_SPIN(xb_ld(&bar[XB_XGEN(b.x)]) == gen, bar);
            __builtin_amdgcn_fence(__ATOMIC_ACQUIRE, "agent");
            asm volatile("s_waitcnt vmcnt(0)" ::: "memory");
        }
    }
    __syncthreads();
}

struct Args { const float* in[39]; float* out; unsigned char* ws; int ph_lo, ph_hi; };
constexpr int N_PHASES = 20;

__device__ __forceinline__ void ffn_gu(const Ctx& C, LAS unsigned char* lds, size_t wgu, int site) {
    pg8::Gemm g{(const bf16_t*)(C.ws + WS_XB), (const bf16_t*)(C.ws + wgu), T, 2 * FF, D}; pg8::StaticOrder S; S.init(T, 2 * FF, C.G, C.bid);
    EpiSwiglu E{(bf16_t*)(C.ws + WS_HP), (const float*)(C.ws + WS_SSQ) + (size_t)site * T * 16, (LAS float*)(C.lds + 131072)};
    pg8::gemm_phase<EpiSwiglu, pg8::StaticOrder, true, true>(lds, g, S, E);
}
__device__ __forceinline__ void ffn_down(const Ctx& C, LAS unsigned char* lds, size_t wd, int site_out, float alpha = 0.5f) {
    pg8::Gemm g{(const bf16_t*)(C.ws + WS_HP), (const bf16_t*)(C.ws + wd), T, D, FF}; pg8::StaticOrder S; S.init(T, D, C.G, C.bid);
    EpiResid E{(bf16_t*)(C.ws + WS_XB), (float*)(C.ws + WS_SSQ) + (size_t)site_out * T * 16, alpha};
    pg8::gemm_phase<EpiResid, pg8::StaticOrder, true, true>(lds, g, S, E);
}
__device__ __forceinline__ void out_proj(const Ctx& C, LAS unsigned char* lds, int site_out) {
    pg8::Gemm g{(const bf16_t*)(C.ws + WS_Y), (const bf16_t*)(C.ws + WS_WOUT), T, D, D}; pg8::StaticOrder S; S.init(T, D, C.G, C.bid);
    EpiResid E{(bf16_t*)(C.ws + WS_XB), (float*)(C.ws + WS_SSQ) + (size_t)site_out * T * 16, 1.0f};
    pg8::gemm_phase<EpiResid, pg8::StaticOrder, true, true>(lds, g, S, E);
}


__device__ __forceinline__ void grid_bar(unsigned* ctr, unsigned target, int tid) {
    asm volatile("s_waitcnt vmcnt(0)" ::: "memory");
    __syncthreads();
    if (tid == 0) {
        __builtin_amdgcn_fence(__ATOMIC_RELEASE, "agent");
        asm volatile("s_waitcnt vmcnt(0)" ::: "memory");
        __hip_atomic_fetch_add(ctr, 1u, __ATOMIC_RELAXED, __HIP_MEMORY_SCOPE_AGENT);
        const unsigned long long t0 = __builtin_amdgcn_s_memrealtime();
        while (__hip_atomic_load(ctr, __ATOMIC_RELAXED, __HIP_MEMORY_SCOPE_AGENT) < target) {
            __builtin_amdgcn_s_sleep(2);
            if (__builtin_amdgcn_s_memrealtime() - t0 > 50000000ull) break;
        }
        __builtin_amdgcn_fence(__ATOMIC_ACQUIRE, "agent");
        asm volatile("s_waitcnt vmcnt(0)" ::: "memory");
    }
    __syncthreads();
}

__global__ void __launch_bounds__(512) mk_fwd(Args args) {
    extern __shared__ __attribute__((aligned(16))) unsigned char lds_raw[];
    cg::grid_group grid = cg::this_grid();
    Ctx C; C.in = args.in; C.X = args.out; C.ws = args.ws; C.lds = (LAS unsigned char*)lds_raw;
    C.tid = threadIdx.x; C.lane = C.tid & 63; C.wave = __builtin_amdgcn_readfirstlane(C.tid >> 6); C.G = gridDim.x; C.bid = blockIdx.x; C.cv_b0 = 0; C.cv_nb = C.G;
    LAS unsigned char* lds = C.lds;
    const int lo = args.ph_lo, hi = args.ph_hi;
#define IN(k) (lo <= (k) && (k) < hi)
#ifndef REP_MASK
#define REP_MASK 0
#endif
#define REPS(k) (((REP_MASK >> (k)) & 1) ? 2 : 1)
#ifdef PROBE_SEAMX2
#define SEAM_EXTRA grid.sync(); if (C.wave == 0) { __builtin_amdgcn_fence(__ATOMIC_ACQUIRE, "agent"); asm volatile("s_waitcnt vmcnt(0)" ::: "memory"); } __syncthreads();
#else
#define SEAM_EXTRA
#endif
#define SEAM(k) do { if (IN(k) && IN((k) + 1)) xcd_barrier(xbar); } while (0)
    if (lo < 0) grid.sync();
    volatile LAS unsigned* xst = (volatile LAS unsigned*)(C.lds + 163824);
    if (C.tid == 0) { xst[0] = 0u; xst[1] = 0u; }
    __syncthreads();
    const XcdBarrier xbar = xcd_barrier_post((unsigned*)C.ws, xst);

#define TAIL_CONVERT(layer, which) do { if (C.G == 256) { if (C.bid >= 128) { __syncthreads(); C.cv_b0 = 128; C.cv_nb = 128; convert_weights(C, (layer), (which)); C.cv_b0 = 0; C.cv_nb = C.G; } } \
    else { __syncthreads(); convert_weights(C, (layer), (which)); } } while (0)

    if (IN(0)) {
#define PROLOGUE_BODY convert_weights(C, 0, 1); bf16_t* sw = (bf16_t*)(C.ws + WS_SMALLW); for (int n = 0; n < 4; ++n) { tr_small(C, C.in[22] + n * 16384, 128, 128, sw + n * 16384); tr_small(C, C.in[24] + n * 16384, 128, 128, sw + 65536 + n * 16384); } tr_small(C, C.in[29], 64, 512, sw + 131072); tr_small(C, C.in[31], 64, 512, sw + 163840); tr_small(C, C.in[32], 160, 512, sw + 196608); prologue_x(C);
        PROLOGUE_BODY
        if (REPS(0) == 2) { PROLOGUE_BODY }
    }
    SEAM(0);
    if (IN(1)) { ffn_gu(C, lds, WS_WGU1, 0); if (REPS(1) == 2) ffn_gu(C, lds, WS_WGU1, 0); TAIL_CONVERT(0, 6); }
    SEAM(1);
    if (IN(2)) { ffn_down(C, lds, WS_WD1, 1, 0.5f); if (REPS(2) == 2) ffn_down(C, lds, WS_WD1, 1, 0.f); }
    SEAM(2);
    if (IN(3)) {
        pg8::Gemm g{(const bf16_t*)(C.ws + WS_XB), (const bf16_t*)(C.ws + WS_WIN), T, 3584, D}; pg8::StaticOrder S; S.init(T, 3584, C.G, C.bid);
        EpiProj E{(bf16_t*)(C.ws + WS_HP), P0LD, 3328, (const float*)(C.ws + WS_SSQ) + (size_t)1 * T * 16, (float*)(C.ws + WS_DT), 3328, (LAS float*)(C.lds + 131072)};
        pg8::gemm_phase<EpiProj, pg8::StaticOrder, true, true>(lds, g, S, E);
        if (REPS(3) == 2) pg8::gemm_phase<EpiProj, pg8::StaticOrder, true, true>(lds, g, S, E);
    }
    SEAM(3);
    #ifndef SKIP4
    if (IN(4)) { l0_states(C); if (REPS(4) == 2) l0_states(C); }
#endif
    SEAM(4);
    #ifndef SKIP5
    if (IN(5)) l0_scan(C);
#endif
    SEAM(5);
    #ifndef SKIP6
    if (IN(6)) { l0_output(C); if (REPS(6) == 2) l0_output(C); }
#endif
    SEAM(6);
    if (IN(7)) out_proj(C, lds, 2);
    SEAM(7);
    if (IN(8)) { ffn_gu(C, lds, WS_WGU2, 2); TAIL_CONVERT(1, 1); }
    SEAM(8);
    if (IN(9)) ffn_down(C, lds, WS_WD2, 3);
    SEAM(9);
    if (IN(10)) { ffn_gu(C, lds, WS_WGU1, 3); TAIL_CONVERT(1, 6); }
    SEAM(10);
    if (IN(11)) ffn_down(C, lds, WS_WD1, 4);
    SEAM(11);
    if (IN(12)) {
        pg8::Gemm g{(const bf16_t*)(C.ws + WS_XB), (const bf16_t*)(C.ws + WS_WIN), T, 3072, D}; pg8::StaticOrder S; S.init(T, 3072, C.G, C.bid);
        EpiProj E{(bf16_t*)(C.ws + WS_HP), P1LD, 2848, (const float*)(C.ws + WS_SSQ) + (size_t)4 * T * 16, nullptr, -1, (LAS float*)(C.lds + 131072)};
        pg8::gemm_phase<EpiProj, pg8::StaticOrder, true, true>(lds, g, S, E);
    }
    SEAM(12);
    if (IN(13)) { l1_pass_a(C); if (REPS(13) == 2) l1_pass_a(C); }
    SEAM(13);
    if (IN(14)) l1_middle(C);
    SEAM(14);
    if (IN(15)) { l1_pass_c(C); if (REPS(15) == 2) l1_pass_c(C); }
    SEAM(15);
    if (IN(16)) out_proj(C, lds, 5);
    SEAM(16);
    if (IN(17)) ffn_gu(C, lds, WS_WGU2, 5);
    SEAM(17);
    if (IN(18)) ffn_down(C, lds, WS_WD2, 6);
    SEAM(18);
    if (IN(19)) final_norm(C);
#undef IN
#undef SEAM
}

extern "C" void kernel_launch(void* const* d_in, const int* in_sizes, int n_in, void* d_out, int out_size, void* d_ws, size_t ws_size, hipStream_t stream) {
    static int grid = 0;
    if (grid == 0) {
        if (n_in != 39 || out_size != T * D || ws_size < WS_END) { fprintf(stderr, "kernel_launch: unexpected problem: n_in %d out %d ws %zu\n", n_in, out_size, ws_size); grid = -1; return; }
        int dev = 0, cus = 0, per_cu = 0;
        hipGetDevice(&dev); hipDeviceGetAttribute(&cus, hipDeviceAttributeMultiprocessorCount, dev);
        if (hipFuncSetAttribute((const void*)mk_fwd, hipFuncAttributeMaxDynamicSharedMemorySize, LDS_BYTES) != hipSuccess) { fprintf(stderr, "kernel_launch: hipFuncSetAttribute failed\n"); grid = -1; return; }
        if (hipOccupancyMaxActiveBlocksPerMultiprocessor(&per_cu, (const void*)mk_fwd, 512, LDS_BYTES) != hipSuccess || per_cu < 1) { fprintf(stderr, "kernel_launch: occupancy query says %d\n", per_cu); per_cu = 1; (void)hipGetLastError(); }
        grid = cus * (per_cu > 1 ? 1 : per_cu);
    }
    if (grid < 0) return;
    if (hipMemsetAsync(d_ws, 0, 16384, stream) != hipSuccess) { fprintf(stderr, "kernel_launch: memset of the barrier word failed\n"); return; }
    Args a{};
    for (int i = 0; i < 39; ++i) a.in[i] = (const float*)d_in[i];
    a.out = (float*)d_out; a.ws = (unsigned char*)d_ws; a.ph_lo = 0; a.ph_hi = N_PHASES;
    void* kargs[] = {&a};
    hipError_t e = hipLaunchCooperativeKernel((const void*)mk_fwd, dim3(grid), dim3(512), kargs, LDS_BYTES, stream);
    if (e != hipSuccess) fprintf(stderr, "kernel_launch: cooperative launch failed: %s (grid %d)\n", hipGetErrorString(e), grid);
}
```

```cpp
#include <hip/hip_runtime.h>
#include <hip/hip_cooperative_groups.h>
#include <cstdio>
#include <cstdint>
namespace cg = cooperative_groups;
namespace pg8 {
#define PG8_LAS __attribute__((address_space(3)))
typedef unsigned short bf16_t;
typedef short bf16x8 __attribute__((ext_vector_type(8)));
typedef float f32x4 __attribute__((ext_vector_type(4)));
typedef unsigned u32x4 __attribute__((ext_vector_type(4)));
constexpr int BM = 256, BK = 64, HALF = 128, HTB = HALF * BK * 2  , STAGE_BYTES = 8 * HTB, NXCD = 8, WGM = 8;

__host__ __device__ __forceinline__ int lds_byte(int r, int c) { const int st = (r >> 4) * 2 + (c >> 5), rr = r & 15, cc = c & 31, ob = rr * 64 + cc * 2; return st * 1024 + (ob ^ (((ob >> 9) & 1) << 5)); }
__host__ __device__ __forceinline__ void stage_rc(int b, int& R, int& C) { const int st = b / 1024, sb = b % 1024, swz = sb ^ (((sb >> 9) & 1) << 5); R = (st >> 1) * 16 + swz / 64; C = (st & 1) * 32 + (swz % 64) / 2; }
__host__ __device__ __forceinline__ int perm32(int rho) { const int n = rho >> 4, i = rho & 15; return 8 * (i >> 2) + 4 * n + (i & 3); }

struct Unit { int pm, pn; };
struct Gemm { const bf16_t* A; const bf16_t* Bt; int M, N, K; };

struct StaticOrder {
    int nM, nN, nwg, G, c;
    __host__ __device__ void init(int M, int N, int G_, int c_) { nM = M / BM; nN = N / BM; nwg = nM * nN; G = G_; c = c_; }
    __host__ __device__ bool next(int i, Unit& u) const {
        const long L = (long)i * G + c; if (L >= nwg) return false;
        int wgid = (int)L; { const int q = nwg / NXCD, r = nwg % NXCD, xcd = wgid % NXCD, off = wgid / NXCD; wgid = (xcd < r ? xcd * (q + 1) : r * (q + 1) + (xcd - r) * q) + off; }
        const int nig = WGM * nN, gid = wgid / nig, fm = gid * WGM, gsz = (nM - fm) < WGM ? (nM - fm) : WGM;
        u.pm = fm + ((wgid % nig) % gsz); u.pn = (wgid % nig) / gsz; return true;
    }
    __device__ __forceinline__ void a_ready(const Unit&) const {}
    __device__ __forceinline__ void done(const Unit&) const {}
};
__device__ __forceinline__ unsigned cvt_pk_bf16(float lo, float hi) { unsigned r; asm volatile("v_cvt_pk_bf16_f32 %0, %1, %2" : "=v"(r) : "v"(lo), "v"(hi)); return r; }
template <class Epi, class Sched, bool ALIGN_EPI = false, bool SP2 = false>
__device__ __forceinline__ void gemm_phase(PG8_LAS unsigned char* lds, const Gemm g, const Sched& S, const Epi& E) {
    const int tid = threadIdx.x, wid = __builtin_amdgcn_readfirstlane(tid >> 6), lane = tid & 63, wr = wid >> 2, wc = wid & 3, fr = lane & 15, fq = lane >> 4;
    const int K = g.K, nt = K / BK;
    unsigned voffA[2], voffB[2];
#pragma unroll
    for (int i = 0; i < 2; ++i) { int R, C; stage_rc(tid * 16 + i * 8192, R, C); const int Rb = Epi::PERM ? ((R & ~31) + perm32(R & 31)) : R;
        voffA[i] = (unsigned)(R * K + C) * 2u; voffB[i] = (unsigned)(Rb * K + C) * 2u; }
    const size_t kstep = (size_t)(BK * 2);
    const size_t hstep = (size_t)HALF * K * 2;
    const size_t tstep = 2 * hstep;
    const unsigned ldsw = (unsigned)wid * 1024u;
    const int aoff = lds_byte(wr * 64 + fr, fq * 8), boff = lds_byte(wc * 32 + fr, fq * 8);
#define PG8_SA(b, h) (((b) * 2 + (h)) * HTB)
#define PG8_SB(b, h) ((4 + (b) * 2 + (h)) * HTB)
#define PG8_STAGE(bufoff, gbase, voff) do { _Pragma("unroll") for (int _i = 0; _i < 2; ++_i) \
        __builtin_amdgcn_global_load_lds((const unsigned*)((const char*)(gbase) + (voff)[_i]), (PG8_LAS unsigned*)(lds + (bufoff) + ldsw + _i * 8192), 16, 0, 0); } while (0)
#define PG8_LDA(dst, b, h) do { _Pragma("unroll") for (int m = 0; m < 4; ++m) _Pragma("unroll") for (int k = 0; k < 2; ++k) dst[m][k] = *(const PG8_LAS bf16x8*)(lds + PG8_SA(b, h) + aoff + m * 2048 + k * 1024); } while (0)
#define PG8_LDB(dst, b, h) do { _Pragma("unroll") for (int n = 0; n < 2; ++n) _Pragma("unroll") for (int k = 0; k < 2; ++k) dst[n][k] = *(const PG8_LAS bf16x8*)(lds + PG8_SB(b, h) + boff + n * 2048 + k * 1024); } while (0)
#define PG8_MMA(ai, bj, At, Bt) do { __builtin_amdgcn_s_setprio(1); _Pragma("unroll") for (int m = 0; m < 4; ++m) _Pragma("unroll") for (int n = 0; n < 2; ++n) _Pragma("unroll") for (int k = 0; k < 2; ++k) \
        acc[ai][bj][m][n] = __builtin_amdgcn_mfma_f32_16x16x32_bf16(Bt[n][k], At[m][k], acc[ai][bj][m][n], 0, 0, 0); __builtin_amdgcn_s_setprio(0); } while (0)
#define PG8_WAIT_V(n) asm volatile("s_waitcnt vmcnt(" #n ")" ::: "memory")
#define PG8_WAIT_L(n) asm volatile("s_waitcnt lgkmcnt(" #n ")" ::: "memory")
#define PG8_BAR __builtin_amdgcn_s_barrier()
#define PG8_SCHED __builtin_amdgcn_sched_barrier(0)
    Unit cur, nxt; int ui = 0;
    if (!S.next(0, cur)) return;
    f32x4 acc[2][2][4][2];
#pragma unroll
    for (int a = 0; a < 2; ++a)
#pragma unroll
        for (int b = 0; b < 2; ++b)
#pragma unroll
            for (int m = 0; m < 4; ++m)
#pragma unroll
                for (int n = 0; n < 2; ++n) acc[a][b][m][n] = (f32x4){0.f, 0.f, 0.f, 0.f};
    bf16x8 At[4][2], B0[2][2], B1[2][2];
    const char* cA = (const char*)g.A + (size_t)cur.pm * tstep; const char* cB = (const char*)g.Bt + (size_t)cur.pn * tstep;
    S.a_ready(cur);
    if constexpr (SP2) {
        PG8_STAGE(PG8_SB(0, 0), cB, voffB); PG8_STAGE(PG8_SB(0, 1), cB + hstep, voffB); PG8_STAGE(PG8_SA(0, 0), cA, voffA); PG8_STAGE(PG8_SA(0, 1), cA + hstep, voffA);
        if (wr == 1) PG8_BAR;
        PG8_WAIT_V(2); PG8_BAR;
        PG8_STAGE(PG8_SB(1, 0), cB + kstep, voffB); PG8_STAGE(PG8_SA(1, 0), cA + kstep, voffA); PG8_STAGE(PG8_SB(1, 1), cB + hstep + kstep, voffB);
        PG8_WAIT_V(6); PG8_BAR;
    } else {
        PG8_STAGE(PG8_SB(0, 0), cB, voffB); PG8_STAGE(PG8_SA(0, 0), cA, voffA); PG8_STAGE(PG8_SB(0, 1), cB + hstep, voffB); PG8_STAGE(PG8_SA(0, 1), cA + hstep, voffA);
        if (wr == 1) PG8_BAR;
        PG8_WAIT_V(4); PG8_BAR;
        PG8_STAGE(PG8_SB(1, 0), cB + kstep, voffB); PG8_STAGE(PG8_SA(1, 0), cA + kstep, voffA); PG8_STAGE(PG8_SB(1, 1), cB + hstep + kstep, voffB);
        PG8_WAIT_V(6); PG8_BAR;
    }
    for (;;) {
        const bool has_next = S.next(ui + 1, nxt);
        const char* nA = has_next ? (const char*)g.A + (size_t)nxt.pm * tstep : cA; const char* nB = has_next ? (const char*)g.Bt + (size_t)nxt.pn * tstep : cB;
        for (int t = 0; t < nt; t += 2) {
            const bool last = (t == nt - 2);
            const char* a1 = cA + (size_t)(t + 1) * kstep;
            const char* a2 = last ? nA : cA + (size_t)(t + 2) * kstep; const char* b2 = last ? nB : cB + (size_t)(t + 2) * kstep;
            const char* a3 = a2 + kstep; const char* b3 = b2 + kstep;
            if (last && has_next) S.a_ready(nxt);
            if constexpr (SP2) {
            PG8_LDB(B0, 0, 0); PG8_LDB(B1, 0, 1); PG8_SCHED; PG8_LDA(At, 0, 0); PG8_STAGE(PG8_SA(1, 1), a1 + hstep, voffA);
            PG8_WAIT_V(8); PG8_WAIT_L(0); PG8_BAR; PG8_MMA(0, 0, At, B0); PG8_MMA(0, 1, At, B1); PG8_BAR; PG8_SCHED;
            PG8_LDA(At, 0, 1); PG8_STAGE(PG8_SB(0, 0), b2, voffB); PG8_STAGE(PG8_SB(0, 1), b2 + hstep, voffB); PG8_STAGE(PG8_SA(0, 0), a2, voffA);
            PG8_WAIT_V(8); PG8_WAIT_L(0); PG8_BAR; PG8_MMA(1, 0, At, B0); PG8_MMA(1, 1, At, B1); PG8_BAR; PG8_SCHED;
            PG8_LDB(B0, 1, 0); PG8_LDB(B1, 1, 1); PG8_SCHED; PG8_LDA(At, 1, 0); PG8_STAGE(PG8_SA(0, 1), a2 + hstep, voffA);
            PG8_WAIT_V(8); PG8_WAIT_L(0); PG8_BAR; PG8_MMA(0, 0, At, B0); PG8_MMA(0, 1, At, B1); PG8_BAR; PG8_SCHED;
            PG8_LDA(At, 1, 1); PG8_STAGE(PG8_SB(1, 0), b3, voffB); PG8_STAGE(PG8_SB(1, 1), b3 + hstep, voffB); PG8_STAGE(PG8_SA(1, 0), a3, voffA);
            PG8_WAIT_V(8); PG8_WAIT_L(0); PG8_BAR; PG8_MMA(1, 0, At, B0); PG8_MMA(1, 1, At, B1); PG8_BAR; PG8_SCHED;
            } else {
            PG8_LDB(B0, 0, 0); PG8_SCHED; PG8_LDA(At, 0, 0); PG8_STAGE(PG8_SA(1, 1), a1 + hstep, voffA);
            PG8_WAIT_L(8); PG8_BAR; PG8_WAIT_L(0); PG8_MMA(0, 0, At, B0); PG8_BAR; PG8_SCHED;
            PG8_LDB(B1, 0, 1); PG8_STAGE(PG8_SB(0, 0), b2, voffB);
            PG8_BAR; PG8_WAIT_L(0); PG8_MMA(0, 1, At, B1); PG8_BAR;
            PG8_LDA(At, 0, 1); PG8_STAGE(PG8_SA(0, 0), a2, voffA);
            PG8_BAR; PG8_WAIT_L(0); PG8_MMA(1, 0, At, B0); PG8_BAR; PG8_SCHED;
            PG8_STAGE(PG8_SB(0, 1), b2 + hstep, voffB);
            PG8_WAIT_V(6); PG8_BAR; PG8_MMA(1, 1, At, B1); PG8_BAR;
            PG8_LDB(B0, 1, 0); PG8_SCHED; PG8_LDA(At, 1, 0); PG8_STAGE(PG8_SA(0, 1), a2 + hstep, voffA);
            PG8_WAIT_L(8); PG8_BAR; PG8_WAIT_L(0); PG8_MMA(0, 0, At, B0); PG8_BAR; PG8_SCHED;
            PG8_LDB(B1, 1, 1); PG8_STAGE(PG8_SB(1, 0), b3, voffB);
            PG8_BAR; PG8_WAIT_L(0); PG8_MMA(0, 1, At, B1); PG8_BAR;
            PG8_LDA(At, 1, 1); PG8_STAGE(PG8_SA(1, 0), a3, voffA);
            PG8_BAR; PG8_WAIT_L(0); PG8_MMA(1, 0, At, B0); PG8_BAR; PG8_SCHED;
            PG8_STAGE(PG8_SB(1, 1), b3 + hstep, voffB);
            PG8_WAIT_V(6); PG8_BAR; PG8_MMA(1, 1, At, B1); PG8_BAR;
            }
        }
        if constexpr (ALIGN_EPI) { if (wr == 0) PG8_BAR; }
        if constexpr (!Epi::AFTER_DRAIN) { E(acc, cur, wr, wc, fr, fq); S.done(cur); }
        if (!has_next) break;
#pragma unroll
        for (int a = 0; a < 2; ++a)
#pragma unroll
            for (int b = 0; b < 2; ++b)
#pragma unroll
                for (int m = 0; m < 4; ++m)
#pragma unroll
                    for (int n = 0; n < 2; ++n) acc[a][b][m][n] = (f32x4){0.f, 0.f, 0.f, 0.f};
        cur = nxt; cA = nA; cB = nB; ++ui;
        if constexpr (ALIGN_EPI) { if (wr == 1) PG8_BAR; }
    }
    PG8_WAIT_V(0);
    if constexpr (!ALIGN_EPI) { if (wr == 0) PG8_BAR; }
    PG8_BAR;
    if constexpr (Epi::AFTER_DRAIN) { E.fused(acc, cur, wr, wc, fr, fq, lds, wid, lane); S.done(cur); }
#undef PG8_SA
#undef PG8_SB
#undef PG8_STAGE
#undef PG8_LDA
#undef PG8_LDB
#undef PG8_MMA
#undef PG8_WAIT_V
#undef PG8_WAIT_L
#undef PG8_BAR
#undef PG8_SCHED
}
}

#define LAS __attribute__((address_space(3)))
typedef unsigned short bf16_t;
typedef short bf16x8 __attribute__((ext_vector_type(8)));
typedef float f32x4 __attribute__((ext_vector_type(4)));
typedef float f32x2 __attribute__((ext_vector_type(2)));
typedef unsigned u32x4 __attribute__((ext_vector_type(4)));
typedef unsigned u32x2 __attribute__((ext_vector_type(2)));

constexpr int T = 16384, D = 1024, FF = 2816;
constexpr int P0LD = 3328, P1LD = 2880;
constexpr int C_Q = 0, C_K = 512, C_V = 1024, C_G = 1536, C_Z = 2048, C_XBC = 2560;
constexpr size_t MiB = 1u << 20;
constexpr size_t WS_SSQ = 247 * MiB, WS_DT = 512 * 1024, WS_LRUC = 1 * MiB, WS_CHD = 2 * MiB + 512 * 1024, WS_SMALLW = 3 * MiB;
constexpr size_t WS_WGU1 = 4 * MiB, WS_WD1 = 15 * MiB, WS_WIN = 21 * MiB, WS_WOUT = 28 * MiB, WS_WGU2 = 30 * MiB, WS_WD2 = 41 * MiB;
constexpr size_t WS_XB = 47 * MiB, WS_Y = 79 * MiB, WS_HP = 111 * MiB, WS_ST = 215 * MiB, WS_END = 255 * MiB;
constexpr int LDS_BYTES = 163840;

typedef float f32x2_t __attribute__((ext_vector_type(2)));
typedef __bf16 bf16x2_t __attribute__((ext_vector_type(2)));
__device__ __forceinline__ unsigned pk2(float lo, float hi) { f32x2_t v = {lo, hi}; bf16x2_t b = __builtin_convertvector(v, bf16x2_t); return __builtin_bit_cast(unsigned, b); }
__device__ __forceinline__ unsigned short f2bf(float f) { return (unsigned short)(pk2(f, 0.f) & 0xffffu); }
__device__ __forceinline__ float bflo(unsigned w) { return __uint_as_float(w << 16); }
__device__ __forceinline__ float bfhi(unsigned w) { return __uint_as_float(w & 0xffff0000u); }
__device__ __forceinline__ float bf2f(unsigned short h) { return __uint_as_float(((unsigned)h) << 16); }
__device__ __forceinline__ float frcp(float x) { return __builtin_amdgcn_rcpf(x); }
__device__ __forceinline__ float sigmoidf_(float x) { return frcp(1.f + __expf(-x)); }
__device__ __forceinline__ float siluf_(float x) { return x * frcp(1.f + __expf(-x)); }
__device__ __forceinline__ float softplusf_(float x) { return x > 20.f ? x : log1pf(__expf(x)); }
__device__ __forceinline__ float softplus_fast(float x) { return x > 20.f ? x : __logf(1.f + __expf(x)); }
__device__ __forceinline__ float wave_sum(float v) {
#pragma unroll
    for (int o = 1; o < 64; o <<= 1) v += __shfl_xor(v, o);
    return v;
}
__device__ __forceinline__ float wave_sum_dpp(float v) {
    v += __builtin_bit_cast(float, __builtin_amdgcn_update_dpp(0, __builtin_bit_cast(int, v), 0x111, 0xf, 0xf, true));
    v += __builtin_bit_cast(float, __builtin_amdgcn_update_dpp(0, __builtin_bit_cast(int, v), 0x112, 0xf, 0xf, true));
    v += __builtin_bit_cast(float, __builtin_amdgcn_update_dpp(0, __builtin_bit_cast(int, v), 0x114, 0xf, 0xf, true));
    v += __builtin_bit_cast(float, __builtin_amdgcn_update_dpp(0, __builtin_bit_cast(int, v), 0x118, 0xf, 0xf, true));
    v += __builtin_bit_cast(float, __builtin_amdgcn_update_dpp(0, __builtin_bit_cast(int, v), 0x142, 0xa, 0xf, false));
    v += __builtin_bit_cast(float, __builtin_amdgcn_update_dpp(0, __builtin_bit_cast(int, v), 0x143, 0xc, 0xf, false));
    return __builtin_bit_cast(float, __builtin_amdgcn_readlane(__builtin_bit_cast(int, v), 63));
}
__device__ __forceinline__ f32x4 mma(f32x4 acc, bf16x8 nfrag, bf16x8 mfrag) { return __builtin_amdgcn_mfma_f32_16x16x32_bf16(nfrag, mfrag, acc, 0, 0, 0); }
__device__ __forceinline__ bf16x8 ldf(const LAS bf16_t* base, int stride, int row0, int k0, int lane) { return *(const LAS bf16x8*)(base + (row0 + (lane & 15)) * stride + k0 + 8 * (lane >> 4)); }
__device__ __forceinline__ bf16x8 ldfg(const bf16_t* base, int stride, int row0, int k0, int lane) { return *(const bf16x8*)(base + (size_t)(row0 + (lane & 15)) * stride + k0 + 8 * (lane >> 4)); }
#define F4Z ((f32x4){0.f, 0.f, 0.f, 0.f})
__device__ __forceinline__ float ssq_row(const float* ssq, int row) {
    float s = 0.f;
#pragma unroll
    for (int k = 0; k < 16; ++k) s += ssq[(size_t)k * T + row];
    return s;
}

struct Ctx {
    const float* const* in; float* X; unsigned char* ws; LAS unsigned char* lds;
    int tid, lane, wave, G, bid;
    int cv_b0, cv_nb;
};

__device__ __forceinline__ void tr_item(const float* W, int K, int N, bf16_t* WT, const float* gain, int k0, int n0, int drow0, LAS float* scr, int lane) {
    const int nn = n0 + (lane & 31);
    float wv[32];
#pragma unroll
    for (int i = 0; i < 32; ++i) { const int kk = 2 * i + (lane >> 5); wv[i] = (nn < N) ? W[(size_t)(k0 + kk) * N + nn] : 0.f; }
#pragma unroll
    for (int i = 0; i < 32; ++i) { const int kk = 2 * i + (lane >> 5); float v = wv[i]; if (gain) v *= gain[k0 + kk]; scr[kk * 33 + (lane & 31)] = v; }
    asm volatile("s_waitcnt lgkmcnt(0)" ::: "memory");
    const int c = lane & 7;
#pragma unroll
    for (int j = 0; j < 4; ++j) { const int n = (lane >> 3) + 8 * j; const LAS float* s = scr + (8 * c) * 33 + n;
        u32x4 o; o.x = pk2(s[0 * 33], s[1 * 33]); o.y = pk2(s[2 * 33], s[3 * 33]); o.z = pk2(s[4 * 33], s[5 * 33]); o.w = pk2(s[6 * 33], s[7 * 33]);
        if (n0 + n < N) *(u32x4*)(WT + (size_t)(drow0 + n) * K + k0 + 8 * c) = o; }
    asm volatile("s_waitcnt lgkmcnt(0)" ::: "memory");
}
__device__ __forceinline__ void tr_matrix(const Ctx& C, const float* W, int K, int N, bf16_t* WT, const float* gain, int mode, int& base) {
    LAS float* scr = (LAS float*)(C.lds + C.wave * 8448);
    const int nblk = (N + 31) / 32, nitems = (K / 64) * nblk, gw = (C.bid - C.cv_b0) * 8 + C.wave, ngw = C.cv_nb * 8;
    int first = (gw - (base % ngw) + ngw) % ngw;
    for (int it = first; it < nitems; it += ngw) {
        const int kb = it / nblk, nb = it % nblk, n0 = 32 * nb;
        const int drow0 = mode == 0 ? n0 : ((n0 >> 7) * 256 + (n0 & 127) + (mode == 2 ? 128 : 0));
        tr_item(W, K, N, WT, gain, 64 * kb, n0, drow0, scr, C.lane);
    }
    base += nitems;
}
__device__ __forceinline__ void convert_weights(const Ctx& C, int layer, int which) {
    int base = 0; unsigned char* ws = C.ws;
    if (which & 1) {
        tr_matrix(C, C.in[2] + (size_t)layer * D * FF, D, FF, (bf16_t*)(ws + WS_WGU1), C.in[1] + layer * D, 1, base);
        tr_matrix(C, C.in[3] + (size_t)layer * D * FF, D, FF, (bf16_t*)(ws + WS_WGU1), C.in[1] + layer * D, 2, base);
        tr_matrix(C, C.in[4] + (size_t)layer * D * FF, FF, D, (bf16_t*)(ws + WS_WD1), nullptr, 0, base);
    }
    if (which & 2) {
        if (layer == 0) { tr_matrix(C, C.in[10], D, 3336, (bf16_t*)(ws + WS_WIN), C.in[5], 0, base); tr_matrix(C, C.in[11], D, D, (bf16_t*)(ws + WS_WOUT), nullptr, 0, base); }
        else            { tr_matrix(C, C.in[18], D, 2848, (bf16_t*)(ws + WS_WIN), C.in[5] + D, 0, base); tr_matrix(C, C.in[19], D, D, (bf16_t*)(ws + WS_WOUT), nullptr, 0, base); }
    }
    if (which & 4) {
        tr_matrix(C, C.in[7] + (size_t)layer * D * FF, D, FF, (bf16_t*)(ws + WS_WGU2), C.in[6] + layer * D, 1, base);
        tr_matrix(C, C.in[8] + (size_t)layer * D * FF, D, FF, (bf16_t*)(ws + WS_WGU2), C.in[6] + layer * D, 2, base);
        tr_matrix(C, C.in[9] + (size_t)layer * D * FF, FF, D, (bf16_t*)(ws + WS_WD2), nullptr, 0, base);
    }
}
__device__ __forceinline__ void tr_small(const Ctx& C, const float* W, int K, int N, bf16_t* WT) {
    for (int idx = C.bid * 512 + C.tid; idx < K * N; idx += C.G * 512) { const int n = idx / K, k = idx % K; WT[idx] = f2bf(W[(size_t)k * N + n]); }
}

__device__ __forceinline__ void panel_rscale(const float* ssq, LAS float* rs, int pm) {
    asm volatile("s_waitcnt lgkmcnt(0)" ::: "memory"); __builtin_amdgcn_s_barrier(); asm volatile("" ::: "memory");
    if (threadIdx.x < 256) rs[threadIdx.x] = rsqrtf(ssq_row(ssq, pm * 256 + (int)threadIdx.x) * (1.f / D) + 1e-6f);
    asm volatile("s_waitcnt lgkmcnt(0)" ::: "memory"); __builtin_amdgcn_s_barrier(); asm volatile("" ::: "memory");
}

struct EpiSwiglu {
    static constexpr bool PERM = true, AFTER_DRAIN = false;
    bf16_t* H; const float* ssq; LAS float* rs;
    __device__ __forceinline__ void operator()(const f32x4 (&acc)[2][2][4][2], const pg8::Unit& u, int wr, int wc, int fr, int fq) const {
        panel_rscale(ssq, rs, u.pm);
        const int row0 = u.pm * 256 + wr * 64 + fr, col0 = u.pn * 128 + wc * 32 + 8 * fq;
#pragma unroll
        for (int ai = 0; ai < 2; ++ai)
#pragma unroll
            for (int m = 0; m < 4; ++m) {
                const int row = row0 + ai * 128 + m * 16; const float r = rs[wr * 64 + fr + ai * 128 + m * 16];
                float h[8];
#pragma unroll
                for (int n = 0; n < 2; ++n)
#pragma unroll
                    for (int v = 0; v < 4; ++v) { const float g = acc[ai][0][m][n][v] * r, up = acc[ai][1][m][n][v] * r; h[4 * n + v] = siluf_(g) * up; }
                u32x4 w; w.x = pk2(h[0], h[1]); w.y = pk2(h[2], h[3]); w.z = pk2(h[4], h[5]); w.w = pk2(h[6], h[7]);
                *(u32x4*)(H + (size_t)row * FF + col0) = w;
            }
    }
};
struct EpiResid {
    static constexpr bool PERM = true, AFTER_DRAIN = false;
    bf16_t* XB; float* ssq_out; float alpha;
    __device__ __forceinline__ void operator()(const f32x4 (&acc)[2][2][4][2], const pg8::Unit& u, int wr, int wc, int fr, int fq) const {
        const int row0 = u.pm * 256 + wr * 64 + fr, col0 = u.pn * 256 + wc * 32 + 8 * fq;
#pragma unroll
        for (int ai = 0; ai < 2; ++ai)
#pragma unroll
            for (int m = 0; m < 4; ++m) {
                const int row = row0 + ai * 128 + m * 16; float s = 0.f;
#pragma unroll
                for (int bj = 0; bj < 2; ++bj) {
                    const size_t off = (size_t)row * D + col0 + bj * 128;
                    const u32x4 xo = *(const u32x4*)(XB + off);
                    const f32x4 a0 = acc[ai][bj][m][0] * alpha, a1 = acc[ai][bj][m][1] * alpha;
                    u32x4 bq; bq.x = pk2(bflo(xo.x) + a0[0], bfhi(xo.x) + a0[1]); bq.y = pk2(bflo(xo.y) + a0[2], bfhi(xo.y) + a0[3]);
                    bq.z = pk2(bflo(xo.z) + a1[0], bfhi(xo.z) + a1[1]); bq.w = pk2(bflo(xo.w) + a1[2], bfhi(xo.w) + a1[3]);
                    *(u32x4*)(XB + off) = bq;
#pragma unroll
                    for (int q = 0; q < 4; ++q) { const float x0 = bflo(bq[q]), x1 = bfhi(bq[q]); s += x0 * x0 + x1 * x1; }
                }
                s += __shfl_xor(s, 16); s += __shfl_xor(s, 32);
                if (fq == 0) ssq_out[(size_t)(u.pn * 4 + wc) * T + row] = s;
            }
    }
};
struct EpiProj {
    static constexpr bool PERM = true, AFTER_DRAIN = false;
    bf16_t* P; int ldp, ncols; const float* ssq; float* DT; int dt_col0; LAS float* rs;
    __device__ __forceinline__ void operator()(const f32x4 (&acc)[2][2][4][2], const pg8::Unit& u, int wr, int wc, int fr, int fq) const {
        panel_rscale(ssq, rs, u.pm);
        const int row0 = u.pm * 256 + wr * 64 + fr, col0 = u.pn * 256 + wc * 32 + 8 * fq;
#pragma unroll
        for (int ai = 0; ai < 2; ++ai)
#pragma unroll
            for (int m = 0; m < 4; ++m) {
                const int row = row0 + ai * 128 + m * 16; const float r = rs[wr * 64 + fr + ai * 128 + m * 16];
#pragma unroll
                for (int bj = 0; bj < 2; ++bj) {
                    const int c = col0 + bj * 128; const f32x4 v0 = acc[ai][bj][m][0] * r, v1 = acc[ai][bj][m][1] * r;
                    if (c + 8 <= ncols) { u32x4 w; w.x = pk2(v0[0], v0[1]); w.y = pk2(v0[2], v0[3]); w.z = pk2(v1[0], v1[1]); w.w = pk2(v1[2], v1[3]); *(u32x4*)(P + (size_t)row * ldp + c) = w; }
                    else if (DT && c == dt_col0) { *(f32x4*)(DT + (size_t)row * 8) = v0; *(f32x4*)(DT + (size_t)row * 8 + 4) = v1; }
                }
            }
    }
};

__device__ __forceinline__ void prologue_x(const Ctx& C) {
    const float* x = C.in[0]; bf16_t* XB = (bf16_t*)(C.ws + WS_XB); float* ssq = (float*)(C.ws + WS_SSQ);
    const int gw = C.bid * 8 + C.wave, ngw = C.G * 8;
#pragma unroll 4
    for (int m = gw; m < T; m += ngw) {
        const f32x4* xr = (const f32x4*)(x + (size_t)m * D) + C.lane; u32x2* brow = (u32x2*)(XB + (size_t)m * D) + C.lane;
        float s = 0.f;
#pragma unroll
        for (int j = 0; j < 4; ++j) { const f32x4 v = xr[64 * j]; u32x2 q; q.x = pk2(v[0], v[1]); q.y = pk2(v[2], v[3]); brow[64 * j] = q; const float x0 = bflo(q.x), x1 = bfhi(q.x), x2 = bflo(q.y), x3 = bfhi(q.y); s += (x0 * x0 + x1 * x1) + (x2 * x2 + x3 * x3); }
        s = wave_sum(s);
        if (C.lane == 0) ssq[m] = s;
    }
    for (int i = C.bid * 512 + C.tid; i < 15 * T; i += C.G * 512) ssq[T + i] = 0.f;
}
__device__ __forceinline__ void final_norm(const Ctx& C) {
    const float* ssq = (const float*)(C.ws + WS_SSQ) + (size_t)6 * T * 16; const float* g = C.in[38];
    const int gw = C.bid * 8 + C.wave, ngw = C.G * 8;
    f32x4 gv[4];
#pragma unroll
    for (int j = 0; j < 4; ++j) gv[j] = ((const f32x4*)g)[C.lane + 64 * j];
    const bf16_t* XB = (const bf16_t*)(C.ws + WS_XB);
#pragma unroll 4
    for (int m = gw; m < T; m += ngw) {
        const u32x2* br = (const u32x2*)(XB + (size_t)m * D) + C.lane; f32x4* orow = (f32x4*)(C.X + (size_t)m * D) + C.lane; const float r = rsqrtf(ssq_row(ssq, m) * (1.f / D) + 1e-6f);
#pragma unroll
        for (int j = 0; j < 4; ++j) { const u32x2 q = br[64 * j]; f32x4 v = {bflo(q.x), bfhi(q.x), bflo(q.y), bfhi(q.y)}; v = v * r * gv[j]; orow[64 * j] = v; }
    }
}

__device__ __forceinline__ float ret_log_gamma(int h) { return logf(1.f - exp2f(-5.f - (float)h)); }

template <bool TR>
__device__ __forceinline__ void stage_rot(const bf16_t* P, int t0, int col0, LAS bf16_t* dst, int stride, float scale, float lg, bool kte, int nrows, int tl, int nth) {
    for (int it = tl; it < nrows * 8; it += nth) {
        const int row = TR ? it % nrows : it >> 3, d0 = TR ? (it / nrows) * 8 : (it & 7) * 8, t = t0 + row;
        const bf16_t* src = P + (size_t)t * P0LD + col0 + d0;
        const u32x4 a = *(const u32x4*)src, b = *(const u32x4*)(src + 64);
        const float rs = scale * (kte ? __expf(lg * (float)(127 - row)) : 1.f);
        float o1[8], o2[8];
#pragma unroll
        for (int i = 0; i < 8; ++i) {
            const unsigned wa = a[i >> 1], wb = b[i >> 1];
            const float x1 = (i & 1) ? bfhi(wa) : bflo(wa), x2 = (i & 1) ? bfhi(wb) : bflo(wb);
            const float invf = exp2f(-(float)(d0 + i) * (13.287712379549449f / 64.f));
            const float ang = (float)t * invf, n = rintf(ang * 0.15915494309189535f);
            float r = fmaf(-n, 6.2831854820251465f, ang); r = fmaf(-n, -1.7484556e-7f, r);
            const float s = __sinf(r), c = __cosf(r);
            o1[i] = (x1 * c - x2 * s) * rs; o2[i] = (x2 * c + x1 * s) * rs;
        }
        if (TR) {
#pragma unroll
            for (int i = 0; i < 8; ++i) { dst[(d0 + i) * stride + row] = f2bf(o1[i]); dst[(64 + d0 + i) * stride + row] = f2bf(o2[i]); }
        } else {
            u32x4 w1, w2; w1.x = pk2(o1[0], o1[1]); w1.y = pk2(o1[2], o1[3]); w1.z = pk2(o1[4], o1[5]); w1.w = pk2(o1[6], o1[7]);
            w2.x = pk2(o2[0], o2[1]); w2.y = pk2(o2[2], o2[3]); w2.z = pk2(o2[4], o2[5]); w2.w = pk2(o2[6], o2[7]);
            *(LAS u32x4*)(dst + row * stride + d0) = w1; *(LAS u32x4*)(dst + row * stride + 64 + d0) = w2;
        }
    }
}
__device__ __forceinline__ void stage_vT(const bf16_t* P, int t0, int col0, LAS bf16_t* dst, int stride, int tid) {
    for (int it = tid; it < 128 * 16; it += 512) {
        const int row = it & 127, e0 = (it >> 7) * 8;
        const u32x4 a = *(const u32x4*)(P + (size_t)(t0 + row) * P0LD + col0 + e0);
#pragma unroll
        for (int i = 0; i < 8; ++i) { const unsigned w = a[i >> 1]; dst[(e0 + i) * stride + row] = (unsigned short)((i & 1) ? (w >> 16) : (w & 0xffffu)); }
    }
}

__device__ __forceinline__ void stage_dt(const Ctx& C, int t0, int g, LAS float* DTS, LAS float* AS, LAS float* ACS) {
    const int l = C.tid & 127, hh = C.tid >> 7, h = 4 * g + hh;
    const float* DT = (const float*)(C.ws + WS_DT);
    const float dtv = softplusf_(DT[(size_t)(t0 + l) * 8 + h] + C.in[14][h]);
    DTS[hh * 128 + l] = dtv;
    float s = -dtv * __expf(C.in[15][h]);
    s += __builtin_bit_cast(float, __builtin_amdgcn_update_dpp(0, __builtin_bit_cast(int, s), 0x111, 0xf, 0xf, true));
    s += __builtin_bit_cast(float, __builtin_amdgcn_update_dpp(0, __builtin_bit_cast(int, s), 0x112, 0xf, 0xf, true));
    s += __builtin_bit_cast(float, __builtin_amdgcn_update_dpp(0, __builtin_bit_cast(int, s), 0x114, 0xf, 0xf, true));
    s += __builtin_bit_cast(float, __builtin_amdgcn_update_dpp(0, __builtin_bit_cast(int, s), 0x118, 0xf, 0xf, true));
    s += __builtin_bit_cast(float, __builtin_amdgcn_update_dpp(0, __builtin_bit_cast(int, s), 0x142, 0xa, 0xf, false));
    s += __builtin_bit_cast(float, __builtin_amdgcn_update_dpp(0, __builtin_bit_cast(int, s), 0x143, 0xc, 0xf, false));
    if ((C.wave & 1) == 0 && C.lane == 63) AS[hh] = s;
    __syncthreads();
    if (C.wave & 1) s += AS[hh];
    ACS[hh * 128 + l] = s;
    __syncthreads();
}

template <int NGRP, int MODE>
__device__ __forceinline__ void stage_conv(const Ctx& C, int t0, int g, LAS bf16_t* XT, LAS bf16_t* BB, LAS bf16_t* CC, const LAS float* DTS, const LAS float* ACS) {
    constexpr int NSEG = 512 / NGRP, RP = (128 + NSEG - 1) / NSEG;
    if (C.tid >= NGRP * NSEG) return;
    const bf16_t* P = (const bf16_t*)(C.ws + WS_HP);
    const int seg = C.tid % NSEG, grp = C.tid / NSEG;
    const int ch0 = grp < 32 ? 256 * g + 8 * grp : (grp < 40 ? 512 + 64 * g + 8 * (grp - 32) : 640 + 64 * g + 8 * (grp - 40));
    const float* cw = C.in[12]; const float* cb = C.in[13];
    float w0[8], w1[8], w2[8], w3[8], bb[8], x0[8], x1[8], x2[8];
#pragma unroll
    for (int i = 0; i < 8; ++i) { w0[i] = cw[ch0 + i]; w1[i] = cw[768 + ch0 + i]; w2[i] = cw[1536 + ch0 + i]; w3[i] = cw[2304 + ch0 + i]; bb[i] = cb[ch0 + i]; }
    const int r0 = seg * RP, r1 = (r0 + RP < 128) ? r0 + RP : 128;
    auto ldrow = [&](int t, float (&x)[8]) {
        if (t < 0) {
#pragma unroll
            for (int i = 0; i < 8; ++i) x[i] = 0.f;
        } else {
            const u32x4 a = *(const u32x4*)(P + (size_t)t * P0LD + C_XBC + ch0);
#pragma unroll
            for (int i = 0; i < 4; ++i) { x[2 * i] = bflo(a[i]); x[2 * i + 1] = bfhi(a[i]); }
        }
    };
    ldrow(t0 + r0 - 3, x0); ldrow(t0 + r0 - 2, x1); ldrow(t0 + r0 - 1, x2);
    for (int row = r0; row < r1; ++row) {
        float x3[8], v[8]; ldrow(t0 + row, x3);
#pragma unroll
        for (int i = 0; i < 8; ++i) { float s = bb[i] + w0[i] * x0[i] + w1[i] * x1[i] + w2[i] * x2[i] + w3[i] * x3[i]; v[i] = siluf_(s); x0[i] = x1[i]; x1[i] = x2[i]; x2[i] = x3[i]; }
        if (grp < 32) {
            const int hh = grp >> 3;
            float sc = DTS[hh * 128 + row]; if (MODE == 0) sc *= __expf(ACS[hh * 128 + 127] - ACS[hh * 128 + row]);
#pragma unroll
            for (int i = 0; i < 8; ++i) XT[(8 * grp + i) * 136 + row] = f2bf(v[i] * sc);
        } else if (MODE == 0) {
#pragma unroll
            for (int i = 0; i < 8; ++i) BB[(8 * (grp - 32) + i) * 136 + row] = f2bf(v[i]);
        } else {
            u32x4 w; w.x = pk2(v[0], v[1]); w.y = pk2(v[2], v[3]); w.z = pk2(v[4], v[5]); w.w = pk2(v[6], v[7]);
            if (grp < 40) *(LAS u32x4*)(BB + row * 72 + 8 * (grp - 32)) = w; else *(LAS u32x4*)(CC + row * 72 + 8 * (grp - 40)) = w;
        }
    }
}

__device__ __forceinline__ void ret_state_unit(const Ctx& C, int c, int h) {
    const bf16_t* P = (const bf16_t*)(C.ws + WS_HP); float* SR = (float*)(C.ws + WS_ST);
    LAS bf16_t* KT = (LAS bf16_t*)C.lds; LAS bf16_t* VT = KT + 128 * 136;
    const int t0 = c * 128, lane = C.lane, fr = lane & 15, fq = lane >> 4;
    stage_rot<true>(P, t0, C_K + h * 128, KT, 136, 0.08838834764831845f, ret_log_gamma(h), true, 128, C.tid, 512);
    stage_vT(P, t0, C_V + h * 128, VT, 136, C.tid);
    __syncthreads();
    const int e0 = 16 * C.wave; bf16x8 mf[4];
#pragma unroll
    for (int k = 0; k < 4; ++k) mf[k] = ldf(VT, 136, e0, 32 * k, lane);
    float* out = SR + ((size_t)(c * 4 + h) * 128 + e0 + fr) * 128 + 4 * fq;
#pragma unroll
    for (int dt = 0; dt < 8; ++dt) { f32x4 acc = F4Z;
#pragma unroll
        for (int k = 0; k < 4; ++k) acc = mma(acc, ldf(KT, 136, 16 * dt, 32 * k, lane), mf[k]);
        *(f32x4*)(out + 16 * dt) = acc; }
    __syncthreads();
}
__device__ __forceinline__ void mamba_state_unit(const Ctx& C, int c, int g) {
    LAS bf16_t* XT = (LAS bf16_t*)C.lds; LAS bf16_t* BT = XT + 256 * 136;
    LAS float* DTS = (LAS float*)(C.lds + 150528); LAS float* ACS = DTS + 512; LAS float* AS = ACS + 512;
    float* SM = C.X;     float* CHD = (float*)(C.ws + WS_CHD);
    const int t0 = c * 128, lane = C.lane, fr = lane & 15, fq = lane >> 4;
    stage_dt(C, t0, g, DTS, AS, ACS);
    stage_conv<40, 0>(C, t0, g, XT, BT, nullptr, DTS, ACS);
    if (C.tid < 4) CHD[(c * 2 + g) * 32 + C.tid] = __expf(ACS[C.tid * 128 + 127]);
    __syncthreads();
    const int hh = C.wave >> 1, ph = C.wave & 1;
#pragma unroll
    for (int pt = 0; pt < 2; ++pt) {
        const int p0 = ph * 32 + 16 * pt; bf16x8 mf[4];
#pragma unroll
        for (int k = 0; k < 4; ++k) mf[k] = ldf(XT, 136, hh * 64 + p0, 32 * k, lane);
        float* out = SM + ((size_t)(c * 8 + 4 * g + hh) * 64 + p0 + fr) * 64 + 4 * fq;
#pragma unroll
        for (int nt = 0; nt < 4; ++nt) { f32x4 acc = F4Z;
#pragma unroll
            for (int k = 0; k < 4; ++k) acc = mma(acc, ldf(BT, 136, 16 * nt, 32 * k, lane), mf[k]);
            *(f32x4*)(out + 16 * nt) = acc; }
    }
    __syncthreads();
}
__device__ __forceinline__ void l0_states(const Ctx& C) {
    for (int u = C.bid; u < 256; u += C.G) mamba_state_unit(C, u >> 1, u & 1);
    for (int u = C.bid; u < 512; u += C.G) ret_state_unit(C, u >> 2, u & 3);
}

__device__ __forceinline__ void l0_scan(const Ctx& C) {
    float* SR = (float*)(C.ws + WS_ST); float* SM = C.X;     const float* CHD = (const float*)(C.ws + WS_CHD);
    for (int idx = C.bid * 512 + C.tid; idx < 65536 + 32768; idx += C.G * 512) {
        if (idx < 65536) {
            const float dec = __expf(128.f * ret_log_gamma(idx >> 14)); float s = 0.f; float* p = SR + idx;
            for (int c0 = 0; c0 < 128; c0 += 32) { float kv[32];
#pragma unroll
                for (int j = 0; j < 32; ++j) kv[j] = p[(size_t)(c0 + j) * 65536];
#pragma unroll
                for (int j = 0; j < 32; ++j) { p[(size_t)(c0 + j) * 65536] = s; s = s * dec + kv[j]; } }
        } else {
            const int e = idx - 65536, head = e >> 12; float s = 0.f; float* p = SM + e;
            for (int c0 = 0; c0 < 128; c0 += 32) { float kv[32], dc[32];
#pragma unroll
                for (int j = 0; j < 32; ++j) { kv[j] = p[(size_t)(c0 + j) * 32768]; dc[j] = CHD[((c0 + j) * 2 + (head >> 2)) * 32 + (head & 3)]; }
#pragma unroll
                for (int j = 0; j < 32; ++j) { p[(size_t)(c0 + j) * 32768] = s; s = s * dc[j] + kv[j]; } }
        }
    }
}

__device__ __forceinline__ void mamba_out_unit(const Ctx& C, int c, int g) {
    LAS bf16_t* XT = (LAS bf16_t*)C.lds; LAS bf16_t* BM = (LAS bf16_t*)(C.lds + 69632); LAS bf16_t* CM = (LAS bf16_t*)(C.lds + 88064);
    LAS bf16_t* SP = (LAS bf16_t*)(C.lds + 106496); LAS bf16_t* STR = (LAS bf16_t*)(C.lds + 115712) + C.wave * (16 * 136);
    LAS float* DTS = (LAS float*)(C.lds + 150528); LAS float* ACS = DTS + 512; LAS float* AS = ACS + 512;
    const bf16_t* P = (const bf16_t*)(C.ws + WS_HP); const float* SM = C.X; bf16_t* Y = (bf16_t*)(C.ws + WS_Y);
    const int t0 = c * 128, lane = C.lane, fr = lane & 15, fq = lane >> 4, w = C.wave, l0 = 16 * w, l = l0 + fr;
    stage_dt(C, t0, g, DTS, AS, ACS);
    stage_conv<48, 1>(C, t0, g, XT, BM, CM, DTS, ACS);
    __syncthreads();
    bf16x8 cmA[2]; cmA[0] = ldf(CM, 72, l0, 0, lane); cmA[1] = ldf(CM, 72, l0, 32, lane);
    f32x4 cb[8];
#pragma unroll
    for (int st = 0; st < 8; ++st) { cb[st] = F4Z; if (st <= w) { cb[st] = mma(cb[st], ldf(BM, 72, 16 * st, 0, lane), cmA[0]); cb[st] = mma(cb[st], ldf(BM, 72, 16 * st, 32, lane), cmA[1]); } }
    float ssq = 0.f;
#pragma unroll 1
    for (int hh = 0; hh < 4; ++hh) {
        const int h = 4 * g + hh;
        __syncthreads();
        {
            const float* src = SM + (size_t)(c * 8 + h) * 4096;
#pragma unroll
            for (int i = 0; i < 2; ++i) { const int e = (C.tid + 512 * i) * 4; const f32x4 v = *(const f32x4*)(src + e); u32x2 b; b.x = pk2(v[0], v[1]); b.y = pk2(v[2], v[3]); *(LAS u32x2*)(SP + (e >> 6) * 72 + (e & 63)) = b; }
        }
        const float al = ACS[hh * 128 + l];
#pragma unroll
        for (int st = 0; st < 8; ++st) {
            const f32x4 as4 = *(const LAS f32x4*)(ACS + hh * 128 + 16 * st + 4 * fq); float sc[4];
#pragma unroll
            for (int v = 0; v < 4; ++v) { const int s = 16 * st + 4 * fq + v; sc[v] = (st <= w && s <= l) ? cb[st][v] * __expf(al - as4[v]) : 0.f; }
            u32x2 b; b.x = pk2(sc[0], sc[1]); b.y = pk2(sc[2], sc[3]); *(LAS u32x2*)(STR + fr * 136 + 16 * st + 4 * fq) = b;
        }
        __syncthreads();
        bf16x8 sA[4];
#pragma unroll
        for (int k = 0; k < 4; ++k) sA[k] = ldf(STR, 136, 0, 32 * k, lane);
        const float eal = __expf(al), dsk = C.in[16][h], dtl = DTS[hh * 128 + l], rdt = dtl > 1e-30f ? frcp(dtl) : 0.f;
#pragma unroll
        for (int pt = 0; pt < 4; ++pt) {
            f32x4 ya = F4Z, yo = F4Z;
#pragma unroll
            for (int k = 0; k < 4; ++k) ya = mma(ya, ldf(XT, 136, hh * 64 + 16 * pt, 32 * k, lane), sA[k]);
#pragma unroll
            for (int k = 0; k < 2; ++k) yo = mma(yo, ldf(SP, 72, 16 * pt, 32 * k, lane), cmA[k]);
            const int p = 16 * pt + 4 * fq;
            const u32x2 zz = *(const u32x2*)(P + (size_t)(t0 + l) * P0LD + C_Z + 256 * g + hh * 64 + p);
            const float z[4] = {bflo(zz.x), bfhi(zz.x), bflo(zz.y), bfhi(zz.y)};
            float y[4];
#pragma unroll
            for (int v = 0; v < 4; ++v) {
                const float xs = bf2f(XT[(hh * 64 + p + v) * 136 + l]) * rdt;
                y[v] = (ya[v] + yo[v] * eal + dsk * xs) * siluf_(z[v]); ssq += y[v] * y[v];
            }
            u32x2 b; b.x = pk2(y[0], y[1]); b.y = pk2(y[2], y[3]);
            *(u32x2*)(Y + (size_t)(t0 + l) * D + 512 + 256 * g + hh * 64 + p) = b;
        }
    }
    ssq += __shfl_xor(ssq, 16); ssq += __shfl_xor(ssq, 32);
    const float rinv = rsqrtf(ssq * (1.f / 256.f) + 1e-5f);
#pragma unroll 4
    for (int q = 0; q < 16; ++q) {
        const int ch = 256 * g + 16 * q + 4 * fq; const f32x4 ng = *(const f32x4*)(C.in[17] + ch);
        u32x2* yp = (u32x2*)(Y + (size_t)(t0 + l) * D + 512 + ch); const u32x2 yy = *yp;
        u32x2 b; b.x = pk2(bflo(yy.x) * rinv * ng[0], bfhi(yy.x) * rinv * ng[1]); b.y = pk2(bflo(yy.y) * rinv * ng[2], bfhi(yy.y) * rinv * ng[3]);
        *yp = b;
    }
    __syncthreads();
}
__device__ __forceinline__ void ret_out_unit(const Ctx& C, int c, int h) {
    LAS bf16_t* KN = (LAS bf16_t*)C.lds; LAS bf16_t* VT = KN + 128 * 136; LAS bf16_t* ST = VT + 128 * 136; LAS bf16_t* STR = ST + 128 * 136 + C.wave * (16 * 136);
    const bf16_t* P = (const bf16_t*)(C.ws + WS_HP); const float* SR = (const float*)(C.ws + WS_ST); bf16_t* Y = (bf16_t*)(C.ws + WS_Y);
    const int t0 = c * 128, lane = C.lane, fr = lane & 15, fq = lane >> 4, w = C.wave, i0 = 16 * w, ii = i0 + fr;
    const float lg = ret_log_gamma(h);
    stage_rot<false>(P, t0, C_K + h * 128, KN, 136, 0.08838834764831845f, 0.f, false, 128, C.tid, 512);
    stage_vT(P, t0, C_V + h * 128, VT, 136, C.tid);
    {
        const float* src = SR + (size_t)(c * 4 + h) * 16384;
#pragma unroll
        for (int i = 0; i < 8; ++i) { const int e = (C.tid + 512 * i) * 4; const f32x4 v = *(const f32x4*)(src + e); u32x2 b; b.x = pk2(v[0], v[1]); b.y = pk2(v[2], v[3]); *(LAS u32x2*)(ST + (e >> 7) * 136 + (e & 127)) = b; }
    }
    stage_rot<false>(P, t0 + i0, C_Q + h * 128, STR, 136, 1.f, 0.f, false, 16, lane, 64);
    __syncthreads();
    bf16x8 qA[4];
#pragma unroll
    for (int k = 0; k < 4; ++k) qA[k] = ldf(STR, 136, 0, 32 * k, lane);
    __syncthreads();
#pragma unroll
    for (int jt = 0; jt < 8; ++jt) {
        f32x4 sa = F4Z;
        if (jt <= w) {
#pragma unroll
            for (int k = 0; k < 4; ++k) sa = mma(sa, ldf(KN, 136, 16 * jt, 32 * k, lane), qA[k]);
        }
        float sc[4];
#pragma unroll
        for (int v = 0; v < 4; ++v) { const int j = 16 * jt + 4 * fq + v; sc[v] = (jt <= w && j <= ii) ? sa[v] * __expf(lg * (float)(ii - j)) : 0.f; }
        u32x2 b; b.x = pk2(sc[0], sc[1]); b.y = pk2(sc[2], sc[3]); *(LAS u32x2*)(STR + fr * 136 + 16 * jt + 4 * fq) = b;
    }
    __syncthreads();
    bf16x8 sA[4];
#pragma unroll
    for (int k = 0; k < 4; ++k) sA[k] = ldf(STR, 136, 0, 32 * k, lane);
    const float qfs = __expf(lg * (float)(ii + 1));
    f32x4 o[8]; float ssq = 0.f;
#pragma unroll
    for (int et = 0; et < 8; ++et) {
        f32x4 a = F4Z, a2 = F4Z;
#pragma unroll
        for (int k = 0; k < 4; ++k) { a = mma(a, ldf(VT, 136, 16 * et, 32 * k, lane), sA[k]); a2 = mma(a2, ldf(ST, 136, 16 * et, 32 * k, lane), qA[k]); }
        o[et] = a + a2 * qfs;
        ssq += (o[et][0] * o[et][0] + o[et][1] * o[et][1]) + (o[et][2] * o[et][2] + o[et][3] * o[et][3]);
    }
    ssq += __shfl_xor(ssq, 16); ssq += __shfl_xor(ssq, 32);
    const float rinv = rsqrtf(ssq * (1.f / 128.f) + 1e-6f);
#pragma unroll
    for (int et = 0; et < 8; ++et) {
        const int ch = h * 128 + 16 * et + 4 * fq;
        const u32x2 gg = *(const u32x2*)(P + (size_t)(t0 + ii) * P0LD + C_G + ch);
        u32x2 b; b.x = pk2(o[et][0] * rinv * siluf_(bflo(gg.x)), o[et][1] * rinv * siluf_(bfhi(gg.x))); b.y = pk2(o[et][2] * rinv * siluf_(bflo(gg.y)), o[et][3] * rinv * siluf_(bfhi(gg.y)));
        *(u32x2*)(Y + (size_t)(t0 + ii) * D + ch) = b;
    }
    __syncthreads();
}
__device__ __forceinline__ void l0_output(const Ctx& C) {
    for (int u = C.bid; u < 256; u += C.G) mamba_out_unit(C, u >> 1, u & 1);
    for (int u = C.bid; u < 512; u += C.G) ret_out_unit(C, u >> 2, u & 3);
}

constexpr size_t WS_WLOG = WS_ST, WS_AA = WS_ST + 16 * MiB, WS_GG = WS_WGU1, WS_PC = WS_Y;
constexpr size_t WS_LA = WS_LRUC, WS_HC = WS_LRUC + 512 * 1024, WS_HIN = WS_LRUC + 1024 * 1024;
constexpr int SW_WAT = 0, SW_WXT = 65536, SW_W2T = 131072, SW_A2T = 163840, SW_G2T = 196608;
__device__ __forceinline__ bf16_t* gg_row(unsigned char* ws, int t) { return (bf16_t*)(ws + WS_GG) + (size_t)t * 512; }
__device__ __forceinline__ float tanhf_(float x) { return 1.f - 2.f * frcp(1.f + __expf(2.f * x)); }

__device__ __forceinline__ void rwkv_prep(const Ctx& C, int c) {
    const bf16_t* P = (const bf16_t*)(C.ws + WS_HP); const bf16_t* SW = (const bf16_t*)(C.ws + WS_SMALLW);
    bf16_t* WLOG = (bf16_t*)(C.ws + WS_WLOG); bf16_t* AA = (bf16_t*)(C.ws + WS_AA);
    LAS bf16_t* TW = (LAS bf16_t*)C.lds; LAS bf16_t* AL = TW + 64 * 72; LAS bf16_t* SG = AL + 64 * 72;
    const float* mu = C.in[27];
    const int t0 = 64 * c, lane = C.lane, fr = lane & 15, fq = lane >> 4;
#pragma unroll 12
    for (int idx = C.tid; idx < 64 * 288; idx += 512) {
        const int tok = idx / 288, cc = idx % 288, col = 2560 + cc, t = t0 + tok;
        const float cur = bf2f(P[(size_t)t * P1LD + col]), prev = t > 0 ? bf2f(P[(size_t)(t - 1) * P1LD + col]) : 0.f;
        const float s = cur + (prev - cur) * mu[col - 1024];
        if (cc < 64) TW[tok * 72 + cc] = f2bf(tanhf_(s)); else if (cc < 128) AL[tok * 72 + cc - 64] = f2bf(s); else SG[tok * 168 + cc - 128] = f2bf(sigmoidf_(s));
    }
    __syncthreads();
    const int n0 = 64 * C.wave;
#pragma unroll 1
    for (int which = 0; which < 2; ++which) {
        const bf16_t* BT = SW + (which == 0 ? SW_W2T : SW_A2T); const LAS bf16_t* AM = which == 0 ? TW : AL;
        const float* bias = which == 0 ? C.in[28] : C.in[30]; bf16_t* O = which == 0 ? WLOG : AA;
#pragma unroll
        for (int nt = 0; nt < 4; ++nt) {
            const bf16x8 nf0 = ldfg(BT, 64, n0 + 16 * nt, 0, lane), nf1 = ldfg(BT, 64, n0 + 16 * nt, 32, lane);
            const int n = n0 + 16 * nt + 4 * fq; const f32x4 bv = *(const f32x4*)(bias + n);
#pragma unroll
            for (int mt = 0; mt < 4; ++mt) {
                f32x4 acc = F4Z; acc = mma(acc, nf0, ldf(AM, 72, 16 * mt, 0, lane)); acc = mma(acc, nf1, ldf(AM, 72, 16 * mt, 32, lane));
                float o[4];
#pragma unroll
                for (int v = 0; v < 4; ++v) { const float x = acc[v] + bv[v]; o[v] = which == 0 ? -__expf(-softplus_fast(-x) - 0.5f) : sigmoidf_(x); }
                u32x2 b; b.x = pk2(o[0], o[1]); b.y = pk2(o[2], o[3]);
                *(u32x2*)(O + (size_t)(t0 + 16 * mt + fr) * 512 + n) = b;
            }
        }
    }
#pragma unroll 2
    for (int nt = 0; nt < 4; ++nt) {
        bf16x8 nf[5];
#pragma unroll
        for (int k = 0; k < 5; ++k) nf[k] = ldfg(SW + SW_G2T, 160, n0 + 16 * nt, 32 * k, lane);
        const int n = n0 + 16 * nt + 4 * fq;
#pragma unroll
        for (int mt = 0; mt < 4; ++mt) {
            f32x4 acc = F4Z;
#pragma unroll
            for (int k = 0; k < 5; ++k) acc = mma(acc, nf[k], ldf(SG, 168, 16 * mt, 32 * k, lane));
#ifdef GG_CONSTVAL
            acc = (f32x4){0.5f, 0.25f, -0.5f, 1.f};
#endif
            u32x2 b; b.x = pk2(acc[0], acc[1]); b.y = pk2(acc[2], acc[3]);
            *(u32x2*)(gg_row(C.ws, t0 + 16 * mt + fr) + n) = b;
        }
    }
    asm volatile("s_waitcnt vmcnt(0)" ::: "memory");
    __threadfence_block();
    __syncthreads();
}

#ifndef RW1_SB_SK
#define RW1_SB_SK 0
#endif
#ifndef RW1_SB_MAIN
#define RW1_SB_MAIN 2
#endif
template <int PASS>
__device__ __forceinline__ void rwkv_chunk(const Ctx& C, int c) {
    const bf16_t* P = (const bf16_t*)(C.ws + WS_HP);
    const bf16_t* WLOG = (const bf16_t*)(C.ws + WS_WLOG); const bf16_t* AA = (const bf16_t*)(C.ws + WS_AA);
    float* PC = (float*)(C.ws + WS_PC); float* UC = C.X; bf16_t* Y = (bf16_t*)(C.ws + WS_Y);
    LAS float* VW = (LAS float*)(C.lds + 40960); LAS float* VKK = VW + 4096; LAS float* VB = VKK + 4096; LAS float* VK = VB + 4096; LAS float* VR = VK + 4096; LAS float* VV = VR + 4096; LAS float* VG = VV + 4096; LAS float* VBON = VG + 4096;
    const int t0 = 64 * c, lane = C.lane, head = C.wave, ch = C.tid;
    const float* mu = C.in[27];
    f32x2 SU[32], SP[32];
    if (PASS == 1) {
#pragma unroll
        for (int k = 0; k < 32; ++k) { SU[k] = (f32x2){0.f, 0.f}; SP[k] = (f32x2){(2 * k == lane) ? 1.f : 0.f, (2 * k + 1 == lane) ? 1.f : 0.f}; }
    } else {
        const f32x4* src = (const f32x4*)(UC + ((size_t)(c * 8 + head) * 64 + lane) * 64);
#pragma unroll
        for (int k4 = 0; k4 < 16; ++k4) { f32x4 v = src[k4];
#ifdef RW3_ZERO
            v = F4Z;
#endif
            SU[2 * k4] = (f32x2){v[0], v[1]}; SU[2 * k4 + 1] = (f32x2){v[2], v[3]}; }
    }
    float pr = 0.f, pk = 0.f, pv = 0.f;
    if (t0 > 0) { const bf16_t* row = P + (size_t)(t0 - 1) * P1LD; pr = bf2f(row[1024 + ch]); pk = bf2f(row[1536 + ch]); pv = bf2f(row[2048 + ch]); }
#pragma unroll 1
    for (int sb = 0; sb < 8; ++sb) {
        const float mu_r = mu[ch], mu_k = mu[512 + ch], mu_v = mu[1024 + ch], kkc = C.in[33][ch], kac = C.in[34][ch], rkc = C.in[35][ch];
        constexpr int UF = PASS == 3 ? 8 : 4;
#pragma unroll 1
        for (int j0 = 0; j0 < 8; j0 += UF) {
            float cr[UF], ck[UF], cv[UF], aa[UF], wl[UF], gg[UF];
#pragma unroll
            for (int u = 0; u < UF; ++u) {
                const int t = t0 + 8 * sb + j0 + u; const bf16_t* row = P + (size_t)t * P1LD;
                ck[u] = bf2f(row[1536 + ch]); cv[u] = bf2f(row[2048 + ch]); aa[u] = bf2f(AA[(size_t)t * 512 + ch]); wl[u] = bf2f(WLOG[(size_t)t * 512 + ch]);
                if (PASS == 3) { cr[u] = bf2f(row[1024 + ch]); gg[u] = bf2f(gg_row(C.ws, t)[ch]); }
            }
            float kkr[UF], kp[UF], nrm[UF], bon[UF], rsv[UF];
#pragma unroll
            for (int u = 0; u < UF; ++u) {
                const float ks = ck[u] + (pk - ck[u]) * mu_k, vs = cv[u] + (pv - cv[u]) * mu_v; pk = ck[u]; pv = cv[u];
                kkr[u] = ks * kkc; nrm[u] = kkr[u] * kkr[u]; kp[u] = ks * (1.f + (aa[u] - 1.f) * kac);
                VV[(j0 + u) * 512 + ch] = vs; VK[(j0 + u) * 512 + ch] = kp[u]; VW[(j0 + u) * 512 + ch] = __expf(wl[u]);
                if (PASS == 3) { rsv[u] = cr[u] + (pr - cr[u]) * mu_r; pr = cr[u]; bon[u] = rsv[u] * kp[u] * rkc; VR[(j0 + u) * 512 + ch] = rsv[u]; VG[(j0 + u) * 512 + ch] = gg[u]; }
            }
#pragma unroll
            for (int u = 0; u < UF; ++u) { nrm[u] = wave_sum_dpp(nrm[u]); if (PASS == 3) bon[u] = wave_sum_dpp(bon[u]); }
#pragma unroll
            for (int u = 0; u < UF; ++u) {
                const float kk = kkr[u] * rsqrtf(fmaxf(nrm[u], 1e-24f));
                VKK[(j0 + u) * 512 + ch] = kk; VB[(j0 + u) * 512 + ch] = kk * aa[u];
                if (PASS == 3) { if (lane == 0) VBON[(j0 + u) * 8 + head] = bon[u]; }
            }
        }
        __syncthreads();
#pragma unroll 1
        for (int j = 0; j < 8; ++j) {
            const LAS f32x4* pw = (const LAS f32x4*)(VW + j * 512 + head * 64); const LAS f32x4* pkk = (const LAS f32x4*)(VKK + j * 512 + head * 64);
            const LAS f32x4* pb = (const LAS f32x4*)(VB + j * 512 + head * 64); const LAS f32x4* pkp = (const LAS f32x4*)(VK + j * 512 + head * 64);
            const LAS f32x4* prr = (const LAS f32x4*)(VR + j * 512 + head * 64);
#define LO2(v) __builtin_shufflevector(v, v, 0, 1)
#define HI2(v) __builtin_shufflevector(v, v, 2, 3)
#define FMA2(a, b, c) __builtin_elementwise_fma(a, b, c)
            f32x2 aU0 = {0.f, 0.f}, aU1 = {0.f, 0.f}, aP0 = {0.f, 0.f}, aP1 = {0.f, 0.f};
            {
                f32x4 q = pkk[0];
#pragma unroll
                for (int g = 0; g < 16; ++g) {
                    f32x4 qn = q; if (g + 1 < 16) qn = pkk[g + 1];
                    aU0 = FMA2(SU[2 * g], LO2(q), aU0); aU1 = FMA2(SU[2 * g + 1], HI2(q), aU1);
                    if (PASS == 1) { aP0 = FMA2(SP[2 * g], LO2(q), aP0); aP1 = FMA2(SP[2 * g + 1], HI2(q), aP1); }
                    q = qn;
#if RW1_SB_SK == 1
                    if (PASS == 1) __builtin_amdgcn_sched_barrier(0);
#elif RW1_SB_SK == 4
                    if (PASS == 1 && (g & 3) == 3) __builtin_amdgcn_sched_barrier(0);
#endif
                }
            }
            float skU = (aU0[0] + aU0[1]) + (aU1[0] + aU1[1]); const float skP = (aP0[0] + aP0[1]) + (aP1[0] + aP1[1]);
#ifdef PROBE_VALU
            if (PASS == 3) { f32x2 d0 = {0.f, 0.f}, d1 = {0.f, 0.f}; const f32x2 cc = {1.0001f, 0.9999f};
#pragma unroll
                for (int g = 0; g < 32; ++g) { d0 = FMA2(SU[g], cc, d0); d1 = FMA2(SU[g], d0, d1); }
                skU += 1e-37f * ((d0[0] + d0[1]) + (d1[0] + d1[1])); }
#endif
#ifdef PROBE_LDS
            if (PASS == 3) { f32x4 d0 = F4Z;
#pragma unroll
                for (int g = 0; g < 16; ++g) d0 += pkp[g];
                skU += 1e-37f * ((d0[0] + d0[1]) + (d0[2] + d0[3])); }
#endif
            const float vv = VV[j * 512 + ch];
            const f32x2 nsU = {-skU, -skU}, nsP = {-skP, -skP}, vv2 = {vv, vv};
            f32x2 y0 = {0.f, 0.f}, y1 = {0.f, 0.f};
            {
                f32x4 w4 = pw[0], b4 = pb[0], k4 = pkp[0], r4 = F4Z; if (PASS == 3) r4 = prr[0];
#pragma unroll
                for (int g = 0; g < 16; ++g) {
                    f32x4 nw = w4, nb = b4, nk = k4, nr = r4;
                    if (g + 1 < 16) { nw = pw[g + 1]; nb = pb[g + 1]; nk = pkp[g + 1]; if (PASS == 3) nr = prr[g + 1]; }
                    SU[2 * g] = FMA2(SU[2 * g], LO2(w4), FMA2(nsU, LO2(b4), vv2 * LO2(k4)));
                    SU[2 * g + 1] = FMA2(SU[2 * g + 1], HI2(w4), FMA2(nsU, HI2(b4), vv2 * HI2(k4)));
                    if (PASS == 1) { SP[2 * g] = FMA2(SP[2 * g], LO2(w4), nsP * LO2(b4)); SP[2 * g + 1] = FMA2(SP[2 * g + 1], HI2(w4), nsP * HI2(b4)); }
                    if (PASS == 3) { y0 = FMA2(SU[2 * g], LO2(r4), y0); y1 = FMA2(SU[2 * g + 1], HI2(r4), y1); }
                    w4 = nw; b4 = nb; k4 = nk; r4 = nr;
#if RW1_SB_MAIN == 1
                    if (PASS == 1) __builtin_amdgcn_sched_barrier(0);
#elif RW1_SB_MAIN == 4
                    if (PASS == 1 && (g & 3) == 3) __builtin_amdgcn_sched_barrier(0);
#elif RW1_SB_MAIN == 2
                    if (PASS == 1 && (g & 1) == 1) __builtin_amdgcn_sched_barrier(0);
#endif
                }
            }
            const float y = (y0[0] + y0[1]) + (y1[0] + y1[1]);
            if (PASS == 3) VKK[j * 512 + ch] = y;
        }
        if (PASS == 3) {
            const float lng = C.in[36][ch], lnb = C.in[37][ch];
            float y[8], s1[8], s2[8];
#pragma unroll
            for (int u = 0; u < 8; ++u) { y[u] = VKK[u * 512 + ch]; s1[u] = y[u]; }
#pragma unroll
            for (int u = 0; u < 8; ++u) s1[u] = wave_sum_dpp(s1[u]);
#pragma unroll
            for (int u = 0; u < 8; ++u) { y[u] -= s1[u] * (1.f / 64.f); s2[u] = y[u] * y[u]; }
#pragma unroll
            for (int u = 0; u < 8; ++u) s2[u] = wave_sum_dpp(s2[u]);
#pragma unroll
            for (int u = 0; u < 8; ++u) {
                const float yn = y[u] * rsqrtf(s2[u] * (1.f / 64.f) + 64e-5f) * lng + lnb;
                Y[(size_t)(t0 + 8 * sb + u) * D + 512 + ch] = f2bf((yn + VBON[u * 8 + head] * VV[u * 512 + ch]) * VG[u * 512 + ch]);
            }
        }
        __syncthreads();
    }
    if (PASS == 1) {
        f32x4* du = (f32x4*)(UC + ((size_t)(c * 8 + head) * 64 + lane) * 64); f32x4* dp = (f32x4*)(PC + ((size_t)(c * 8 + head) * 64 + lane) * 64);
#pragma unroll
        for (int k4 = 0; k4 < 16; ++k4) { du[k4] = (f32x4){SU[2 * k4][0], SU[2 * k4][1], SU[2 * k4 + 1][0], SU[2 * k4 + 1][1]}; dp[k4] = (f32x4){SP[2 * k4][0], SP[2 * k4][1], SP[2 * k4 + 1][0], SP[2 * k4 + 1][1]}; }
    }
}

template <int PASS>
__device__ __forceinline__ void lru_chunk(const Ctx& C, int c) {
    const bf16_t* P = (const bf16_t*)(C.ws + WS_HP); const bf16_t* SW = (const bf16_t*)(C.ws + WS_SMALLW); bf16_t* Y = (bf16_t*)(C.ws + WS_Y);
    LAS bf16_t* XC = (LAS bf16_t*)C.lds; LAS bf16_t* LAB = (LAS bf16_t*)(C.lds + 66560);
    const int t0 = 64 * c, lane = C.lane, fr = lane & 15, fq = lane >> 4;
    {
        const int grp = C.tid & 63, seg = C.tid >> 6, ch0 = 8 * grp, r0 = 8 * seg;
        const float* cw = C.in[20]; const float* cb = C.in[21];
        float w0[8], w1[8], w2[8], w3[8], bb[8], x0[8], x1[8], x2[8];
#pragma unroll
        for (int i = 0; i < 8; ++i) { w0[i] = cw[ch0 + i]; w1[i] = cw[512 + ch0 + i]; w2[i] = cw[1024 + ch0 + i]; w3[i] = cw[1536 + ch0 + i]; bb[i] = cb[ch0 + i]; }
        auto ldrow = [&](int t, float (&x)[8]) {
            if (t < 0) {
#pragma unroll
                for (int i = 0; i < 8; ++i) x[i] = 0.f;
            } else {
                const u32x4 a = *(const u32x4*)(P + (size_t)t * P1LD + ch0);
#pragma unroll
                for (int i = 0; i < 4; ++i) { x[2 * i] = bflo(a[i]); x[2 * i + 1] = bfhi(a[i]); }
            }
        };
        ldrow(t0 + r0 - 3, x0); ldrow(t0 + r0 - 2, x1); ldrow(t0 + r0 - 1, x2);
#pragma unroll
        for (int row = r0; row < r0 + 8; ++row) {
            float x3[8], v[8]; ldrow(t0 + row, x3);
#pragma unroll
            for (int i = 0; i < 8; ++i) { v[i] = bb[i] + w0[i] * x0[i] + w1[i] * x1[i] + w2[i] * x2[i] + w3[i] * x3[i]; x0[i] = x1[i]; x1[i] = x2[i]; x2[i] = x3[i]; }
            u32x4 w; w.x = pk2(v[0], v[1]); w.y = pk2(v[2], v[3]); w.z = pk2(v[4], v[5]); w.w = pk2(v[6], v[7]);
            *(LAS u32x4*)(XC + row * 520 + ch0) = w;
        }
    }
    __syncthreads();
    const int nb = C.wave >> 1, eh = C.wave & 1, cbase = nb * 128 + 64 * eh;
    unsigned ur[4][4][2];
#pragma unroll
    for (int nth = 0; nth < 2; ++nth) {
        bf16x8 wfa[2][4], wfx[2][4];
#pragma unroll
        for (int n2 = 0; n2 < 2; ++n2)
#pragma unroll
            for (int k = 0; k < 4; ++k) { wfa[n2][k] = ldfg(SW + SW_WAT + nb * 16384, 128, 64 * eh + 16 * (2 * nth + n2), 32 * k, lane); wfx[n2][k] = ldfg(SW + SW_WXT + nb * 16384, 128, 64 * eh + 16 * (2 * nth + n2), 32 * k, lane); }
        f32x4 bav[2], bxv[2], sp8[2];
#pragma unroll
        for (int n2 = 0; n2 < 2; ++n2) { const int chn = cbase + 16 * (2 * nth + n2) + 4 * fq; bav[n2] = *(const f32x4*)(C.in[23] + chn); bxv[n2] = *(const f32x4*)(C.in[25] + chn); const f32x4 lam = *(const f32x4*)(C.in[26] + chn);
#pragma unroll
            for (int v = 0; v < 4; ++v) sp8[n2][v] = -8.f * softplusf_(-lam[v]); }
#pragma unroll
        for (int mt = 0; mt < 4; ++mt) {
            bf16x8 mf[4];
#pragma unroll
            for (int k = 0; k < 4; ++k) mf[k] = ldf(XC, 520, 16 * mt, nb * 128 + 32 * k, lane);
#pragma unroll
            for (int n2 = 0; n2 < 2; ++n2) {
                const int nt = 2 * nth + n2, chn = cbase + 16 * nt + 4 * fq;
                f32x4 aa = F4Z, ax = F4Z;
#pragma unroll
                for (int k = 0; k < 4; ++k) { aa = mma(aa, wfa[n2][k], mf[k]); ax = mma(ax, wfx[n2][k], mf[k]); }
                const u32x2 xw = *(const LAS u32x2*)(XC + (16 * mt + fr) * 520 + chn);
                const float xc[4] = {bflo(xw.x), bfhi(xw.x), bflo(xw.y), bfhi(xw.y)};
                float la[4], uu[4];
#pragma unroll
                for (int v = 0; v < 4; ++v) { const float r = sigmoidf_(aa[v] + bav[n2][v]), ig = sigmoidf_(ax[v] + bxv[n2][v]); la[v] = sp8[n2][v] * r; uu[v] = __builtin_amdgcn_sqrtf(fmaxf(1.f - __expf(2.f * la[v]), 0.f)) * ig * xc[v];     }
                *(LAS u32x2*)(LAB + (16 * mt + fr) * 512 + chn) = (u32x2){pk2(la[0], la[1]), pk2(la[2], la[3])};
                ur[mt][nt][0] = pk2(uu[0], uu[1]); ur[mt][nt][1] = pk2(uu[2], uu[3]);
            }
            __builtin_amdgcn_sched_barrier(0);
        }
    }
    __syncthreads();
#pragma unroll
    for (int mt = 0; mt < 4; ++mt)
#pragma unroll
        for (int nt = 0; nt < 4; ++nt) *(LAS u32x2*)(XC + (16 * mt + fr) * 520 + cbase + 16 * nt + 4 * fq) = (u32x2){ur[mt][nt][0], ur[mt][nt][1]};
    __syncthreads();
    {
        const int ch = C.tid;
        float* LA = (float*)(C.ws + WS_LA); float* HC = (float*)(C.ws + WS_HC); const float* HIN = (const float*)(C.ws + WS_HIN);
        float h = PASS == 3 ? HIN[c * 512 + ch] : 0.f, sla = 0.f;
        if (PASS == 3) {
            float gbv[64];
#pragma unroll
            for (int tok = 0; tok < 64; ++tok) gbv[tok] = bf2f(P[(size_t)(t0 + tok) * P1LD + 512 + ch]);
#pragma unroll
            for (int tok = 0; tok < 64; ++tok) {
                const float la = bf2f(LAB[tok * 512 + ch]), u = bf2f(XC[tok * 520 + ch]);
                h = fmaf(__expf(la), h, u);
                const float gb = gbv[tok], ge = 0.5f * gb * (1.f + tanhf_(0.7978845608028654f * (gb + 0.044715f * gb * gb * gb)));
                Y[(size_t)(t0 + tok) * D + ch] = f2bf(h * ge);
            }
        } else {
#pragma unroll 8
            for (int tok = 0; tok < 64; ++tok) {
                const float la = bf2f(LAB[tok * 512 + ch]), u = bf2f(XC[tok * 520 + ch]);
                h = fmaf(__expf(la), h, u); sla += la;
            }
        }
        if (PASS == 1) { LA[c * 512 + ch] = sla; HC[c * 512 + ch] = h; }
    }
    __syncthreads();
}

__device__ __forceinline__ void l1_pass_a(const Ctx& C) {
#ifndef SKIP_PREP
    for (int c = C.bid; c < 256; c += C.G) rwkv_prep(C, c);
#endif
#ifndef SKIP_RW1
    for (int c = C.bid; c < 256; c += C.G) rwkv_chunk<1>(C, c);
#ifdef PROBE_RW1X2
    for (int c = C.bid; c < 256; c += C.G) rwkv_chunk<1>(C, c);
#endif
#endif
#ifndef SKIP_LRU1
    for (int c = C.bid; c < 256; c += C.G) lru_chunk<1>(C, c);
#endif
}
__device__ __forceinline__ void l1_pass_c(const Ctx& C) {
#ifndef SKIP_RW3
    for (int c = C.bid; c < 256; c += C.G) rwkv_chunk<3>(C, c);
#ifdef PROBE_RW3X2
    for (int c = C.bid; c < 256; c += C.G) rwkv_chunk<3>(C, c);
#endif
#endif
#ifndef SKIP_LRU3
    for (int c = C.bid; c < 256; c += C.G) lru_chunk<3>(C, c);
#ifdef PROBE_LRU3X2
    for (int c = C.bid; c < 256; c += C.G) lru_chunk<3>(C, c);
#endif
#endif
}

__device__ __forceinline__ void l1_middle(const Ctx& C) {
    const float* PC = (const float*)(C.ws + WS_PC); float* UC = C.X;
    const int lane = C.lane;
#ifndef SKIP_MID
    if (C.bid < 128 && C.G >= 128) {
        const int head = C.bid >> 4, row = (C.bid & 15) * 4 + (C.wave & 3); const bool rowwave = C.wave < 4;
        LAS float* SR = (LAS float*)(C.lds + C.wave * 256); LAS float* RING = (LAS float*)(C.lds + 4096);
        const float* pcb = PC + (size_t)head * 4096 + C.tid * 8;
        float* ub = UC + ((size_t)head * 64 + row) * 64 + lane;
        float s = 0.f; SR[lane] = 0.f;
        f32x4 qa0, qb0, qa1, qb1, qa2, qb2, qa3, qb3; float u0, u1, u2, u3;
#define MID_LD(qa, qb, cc) do { const f32x4* p_ = (const f32x4*)(pcb + (size_t)(cc) * 32768); qa = p_[0]; qb = p_[1]; } while (0)
#define MID_ST(qa, qb, cc) do { LAS f32x4* d_ = (LAS f32x4*)(RING + ((cc) & 7) * 4096 + C.tid * 8); d_[0] = qa; d_[1] = qb; } while (0)
        MID_LD(qa0, qb0, 0); MID_LD(qa1, qb1, 1); MID_LD(qa2, qb2, 2); MID_LD(qa3, qb3, 3);
        MID_ST(qa0, qb0, 0); MID_ST(qa1, qb1, 1); MID_ST(qa2, qb2, 2); MID_ST(qa3, qb3, 3);
        MID_LD(qa0, qb0, 4); MID_LD(qa1, qb1, 5); MID_LD(qa2, qb2, 6); MID_LD(qa3, qb3, 7);
        u0 = ub[0]; u1 = ub[32768]; u2 = ub[2 * 32768]; u3 = ub[3 * 32768];
        __syncthreads();
#define MID_STEP(cc, qa, qb, uu) do { \
            if (rowwave) { const LAS float* P_ = RING + ((cc) & 7) * 4096 + lane; \
            float a0 = 0.f, a1 = 0.f, a2 = 0.f, a3 = 0.f; \
            _Pragma("unroll") for (int i4 = 0; i4 < 16; ++i4) { const f32x4 s4 = *(const LAS f32x4*)(SR + 4 * i4); \
                a0 = fmaf(s4[0], P_[(4 * i4) * 64], a0); a1 = fmaf(s4[1], P_[(4 * i4 + 1) * 64], a1); a2 = fmaf(s4[2], P_[(4 * i4 + 2) * 64], a2); a3 = fmaf(s4[3], P_[(4 * i4 + 3) * 64], a3); } \
            ub[(size_t)(cc) * 32768] = s;                      \
            s = uu + ((a0 + a1) + (a2 + a3)); SR[lane] = s; } \
            if ((cc) + 4 < 256) { MID_ST(qa, qb, (cc) + 4); if (rowwave) uu = ub[(size_t)((cc) + 4) * 32768]; } \
            if ((cc) + 8 < 256) MID_LD(qa, qb, (cc) + 8); } while (0)
#pragma unroll 1
        for (int c = 0; c < 256; c += 4) { MID_STEP(c, qa0, qb0, u0); MID_STEP(c + 1, qa1, qb1, u1); MID_STEP(c + 2, qa2, qb2, u2); MID_STEP(c + 3, qa3, qb3, u3); __syncthreads(); }
#undef MID_LD
#undef MID_ST
#undef MID_STEP
    }
#endif
    if (C.bid == (C.G > 128 ? 128 : 0)) {
        const float* LA = (const float*)(C.ws + WS_LA); const float* HC = (const float*)(C.ws + WS_HC); float* HIN = (float*)(C.ws + WS_HIN);
        const int ch = C.tid; float h = 0.f;
        for (int c0 = 0; c0 < 256; c0 += 32) { float la[32], hc[32];
#pragma unroll
            for (int j = 0; j < 32; ++j) { la[j] = LA[(c0 + j) * 512 + ch]; hc[j] = HC[(c0 + j) * 512 + ch]; }
#pragma unroll
            for (int j = 0; j < 32; ++j) { HIN[(c0 + j) * 512 + ch] = h; h = fmaf(__expf(la[j]), h, hc[j]); } }
    }
}

#define XB_TMO      128
#define XB_XCNT(j)  (256  + 64 * (j))
#define XB_XSUB(j)  (1280 + 64 * (j))
#define XB_XGEN(j)  (2304 + 64 * (j))
#define XB_TOP      3328
#define XB_TOPGEN   3392
#define XCD_BAR_WORDS 3456
#define XB_SPIN_CAP (1u << 18)

__device__ __forceinline__ unsigned xb_ld(unsigned* p)              { return __hip_atomic_load(p, __ATOMIC_RELAXED, __HIP_MEMORY_SCOPE_AGENT); }
__device__ __forceinline__ unsigned xb_add(unsigned* p, unsigned v) { return __hip_atomic_fetch_add(p, v, __ATOMIC_RELAXED, __HIP_MEMORY_SCOPE_AGENT); }
__device__ __forceinline__ unsigned xb_xcc_id() { return (unsigned)__builtin_amdgcn_s_getreg((3 << 11) | 20) & 0xFu; }
#define XB_SPIN(cond, bar) do { unsigned _sp = 0; while (cond) { __builtin_amdgcn_s_sleep(1); \
    if ((++_sp & 255u) == 0u) { if (xb_ld(&(bar)[XB_TMO])) break; if (_sp > XB_SPIN_CAP) { atomicAdd(&(bar)[XB_TMO], 1u); break; } } } } while (0)

struct XcdBarrier {
    unsigned* bar; unsigned x;
    volatile LAS unsigned* st;
};

__device__ __forceinline__ XcdBarrier xcd_barrier_post(unsigned* bar, volatile LAS unsigned* st) {
    XcdBarrier b; b.bar = bar; b.x = xb_xcc_id(); b.st = st;
    if (threadIdx.x == 0) (void)xb_add(&bar[XB_XCNT(b.x)], 1u);
    return b;
}
__device__ __forceinline__ void xcd_barrier_complete(unsigned* bar, unsigned x, unsigned& nloc, unsigned& nx) {
    const unsigned G = gridDim.x * gridDim.y * gridDim.z;
    unsigned sum, cnt, mine, sp = 0u;
    for (;;) {
        sum = 0u; cnt = 0u; mine = 0u;
#pragma unroll
        for (unsigned j = 0; j < 16; ++j) { const unsigned c = xb_ld(&bar[XB_XCNT(j)]); sum += c; cnt += (c > 0u) ? 1u : 0u; mine = (j == x) ? c : mine; }
        if (sum == G) break;
        __builtin_amdgcn_s_sleep(1);
        if ((++sp & 255u) == 0u) { if (xb_ld(&bar[XB_TMO])) break; if (sp > XB_SPIN_CAP) { atomicAdd(&bar[XB_TMO], 1u); break; } }
    }
    nloc = mine > 0u ? mine : 1u; nx = cnt > 0u ? cnt : 1u;
}

__device__ __forceinline__ void xcd_barrier(const XcdBarrier& b) {
    asm volatile("s_waitcnt vmcnt(0)" ::: "memory");
    __syncthreads();
    if (threadIdx.x == 0) {
        unsigned* bar = b.bar;
        __builtin_amdgcn_s_waitcnt(0);
        unsigned nloc = b.st[0], nx = b.st[1];
        if (nloc == 0u) { xcd_barrier_complete(bar, b.x, nloc, nx); b.st[0] = nloc; b.st[1] = nx; }
        const unsigned old = xb_add(&bar[XB_XSUB(b.x)], 1u);
        const unsigned gen = old / nloc;
        if (old + 1u == (gen + 1u) * nloc) {
            __builtin_amdgcn_fence(__ATOMIC_RELEASE, "agent");
            asm volatile("s_waitcnt vmcnt(0)" ::: "memory");
            const unsigned og = xb_add(&bar[XB_TOP], 1u);
            const unsigned tg = og / nx;
            if (og + 1u == (tg + 1u) * nx) xb_add(&bar[XB_TOPGEN], 1u);
            else XB_SPIN(xb_ld(&bar[XB_TOPGEN]) == tg, bar);
            __builtin_amdgcn_fence(__ATOMIC_ACQUIRE, "agent");
            xb_add(&bar[XB_XGEN(b.x)], 1u);
            asm volatile("s_waitcnt vmcnt(0)" ::: "memory");
        } else {
            XB_SPIN(xb_ld(&bar[XB_XGEN(b.x)]) == gen, bar);
            __builtin_amdgcn_fence(__ATOMIC_ACQUIRE, "agent");
            asm volatile("s_waitcnt vmcnt(0)" ::: "memory");
        }
    }
    __syncthreads();
}

struct Args { const float* in[39]; float* out; unsigned char* ws; int ph_lo, ph_hi; };
constexpr int N_PHASES = 20;

__device__ __forceinline__ void ffn_gu(const Ctx& C, LAS unsigned char* lds, size_t wgu, int site) {
    pg8::Gemm g{(const bf16_t*)(C.ws + WS_XB), (const bf16_t*)(C.ws + wgu), T, 2 * FF, D}; pg8::StaticOrder S; S.init(T, 2 * FF, C.G, C.bid);
    EpiSwiglu E{(bf16_t*)(C.ws + WS_HP), (const float*)(C.ws + WS_SSQ) + (size_t)site * T * 16, (LAS float*)(C.lds + 131072)};
    pg8::gemm_phase<EpiSwiglu, pg8::StaticOrder, true, true>(lds, g, S, E);
}
__device__ __forceinline__ void ffn_down(const Ctx& C, LAS unsigned char* lds, size_t wd, int site_out, float alpha = 0.5f) {
    pg8::Gemm g{(const bf16_t*)(C.ws + WS_HP), (const bf16_t*)(C.ws + wd), T, D, FF}; pg8::StaticOrder S; S.init(T, D, C.G, C.bid);
    EpiResid E{(bf16_t*)(C.ws + WS_XB), (float*)(C.ws + WS_SSQ) + (size_t)site_out * T * 16, alpha};
    pg8::gemm_phase<EpiResid, pg8::StaticOrder, true, true>(lds, g, S, E);
}
__device__ __forceinline__ void out_proj(const Ctx& C, LAS unsigned char* lds, int site_out) {
    pg8::Gemm g{(const bf16_t*)(C.ws + WS_Y), (const bf16_t*)(C.ws + WS_WOUT), T, D, D}; pg8::StaticOrder S; S.init(T, D, C.G, C.bid);
    EpiResid E{(bf16_t*)(C.ws + WS_XB), (float*)(C.ws + WS_SSQ) + (size_t)site_out * T * 16, 1.0f};
    pg8::gemm_phase<EpiResid, pg8::StaticOrder, true, true>(lds, g, S, E);
}


__device__ __forceinline__ void grid_bar(unsigned* ctr, unsigned target, int tid) {
    asm volatile("s_waitcnt vmcnt(0)" ::: "memory");
    __syncthreads();
    if (tid == 0) {
        __builtin_amdgcn_fence(__ATOMIC_RELEASE, "agent");
        asm volatile("s_waitcnt vmcnt(0)" ::: "memory");
        __hip_atomic_fetch_add(ctr, 1u, __ATOMIC_RELAXED, __HIP_MEMORY_SCOPE_AGENT);
        const unsigned long long t0 = __builtin_amdgcn_s_memrealtime();
        while (__hip_atomic_load(ctr, __ATOMIC_RELAXED, __HIP_MEMORY_SCOPE_AGENT) < target) {
            __builtin_amdgcn_s_sleep(2);
            if (__builtin_amdgcn_s_memrealtime() - t0 > 50000000ull) break;
        }
        __builtin_amdgcn_fence(__ATOMIC_ACQUIRE, "agent");
        asm volatile("s_waitcnt vmcnt(0)" ::: "memory");
    }
    __syncthreads();
}

__global__ void __launch_bounds__(512) mk_fwd(Args args) {
    extern __shared__ __attribute__((aligned(16))) unsigned char lds_raw[];
    cg::grid_group grid = cg::this_grid();
    Ctx C; C.in = args.in; C.X = args.out; C.ws = args.ws; C.lds = (LAS unsigned char*)lds_raw;
    C.tid = threadIdx.x; C.lane = C.tid & 63; C.wave = __builtin_amdgcn_readfirstlane(C.tid >> 6); C.G = gridDim.x; C.bid = blockIdx.x; C.cv_b0 = 0; C.cv_nb = C.G;
    LAS unsigned char* lds = C.lds;
    const int lo = args.ph_lo, hi = args.ph_hi;
#define IN(k) (lo <= (k) && (k) < hi)
#ifndef REP_MASK
#define REP_MASK 0
#endif
#define REPS(k) (((REP_MASK >> (k)) & 1) ? 2 : 1)
#ifdef PROBE_SEAMX2
#define SEAM_EXTRA grid.sync(); if (C.wave == 0) { __builtin_amdgcn_fence(__ATOMIC_ACQUIRE, "agent"); asm volatile("s_waitcnt vmcnt(0)" ::: "memory"); } __syncthreads();
#else
#define SEAM_EXTRA
#endif
#define SEAM(k) do { if (IN(k) && IN((k) + 1)) xcd_barrier(xbar); } while (0)
    if (lo < 0) grid.sync();
    volatile LAS unsigned* xst = (volatile LAS unsigned*)(C.lds + 163824);
    if (C.tid == 0) { xst[0] = 0u; xst[1] = 0u; }
    __syncthreads();
    const XcdBarrier xbar = xcd_barrier_post((unsigned*)C.ws, xst);

#define TAIL_CONVERT(layer, which) do { if (C.G == 256) { if (C.bid >= 128) { __syncthreads(); C.cv_b0 = 128; C.cv_nb = 128; convert_weights(C, (layer), (which)); C.cv_b0 = 0; C.cv_nb = C.G; } } \
    else { __syncthreads(); convert_weights(C, (layer), (which)); } } while (0)

    if (IN(0)) {
#define PROLOGUE_BODY convert_weights(C, 0, 1); bf16_t* sw = (bf16_t*)(C.ws + WS_SMALLW); for (int n = 0; n < 4; ++n) { tr_small(C, C.in[22] + n * 16384, 128, 128, sw + n * 16384); tr_small(C, C.in[24] + n * 16384, 128, 128, sw + 65536 + n * 16384); } tr_small(C, C.in[29], 64, 512, sw + 131072); tr_small(C, C.in[31], 64, 512, sw + 163840); tr_small(C, C.in[32], 160, 512, sw + 196608); prologue_x(C);
        PROLOGUE_BODY
        if (REPS(0) == 2) { PROLOGUE_BODY }
    }
    SEAM(0);
    if (IN(1)) { ffn_gu(C, lds, WS_WGU1, 0); if (REPS(1) == 2) ffn_gu(C, lds, WS_WGU1, 0); TAIL_CONVERT(0, 6); }
    SEAM(1);
    if (IN(2)) { ffn_down(C, lds, WS_WD1, 1, 0.5f); if (REPS(2) == 2) ffn_down(C, lds, WS_WD1, 1, 0.f); }
    SEAM(2);
    if (IN(3)) {
        pg8::Gemm g{(const bf16_t*)(C.ws + WS_XB), (const bf16_t*)(C.ws + WS_WIN), T, 3584, D}; pg8::StaticOrder S; S.init(T, 3584, C.G, C.bid);
        EpiProj E{(bf16_t*)(C.ws + WS_HP), P0LD, 3328, (const float*)(C.ws + WS_SSQ) + (size_t)1 * T * 16, (float*)(C.ws + WS_DT), 3328, (LAS float*)(C.lds + 131072)};
        pg8::gemm_phase<EpiProj, pg8::StaticOrder, true, true>(lds, g, S, E);
        if (REPS(3) == 2) pg8::gemm_phase<EpiProj, pg8::StaticOrder, true, true>(lds, g, S, E);
    }
    SEAM(3);
    #ifndef SKIP4
    if (IN(4)) { l0_states(C); if (REPS(4) == 2) l0_states(C); }
#endif
    SEAM(4);
    #ifndef SKIP5
    if (IN(5)) l0_scan(C);
#endif
    SEAM(5);
    #ifndef SKIP6
    if (IN(6)) { l0_output(C); if (REPS(6) == 2) l0_output(C); }
#endif
    SEAM(6);
    if (IN(7)) out_proj(C, lds, 2);
    SEAM(7);
    if (IN(8)) { ffn_gu(C, lds, WS_WGU2, 2); TAIL_CONVERT(1, 1); }
    SEAM(8);
    if (IN(9)) ffn_down(C, lds, WS_WD2, 3);
    SEAM(9);
    if (IN(10)) { ffn_gu(C, lds, WS_WGU1, 3); TAIL_CONVERT(1, 6); }
    SEAM(10);
    if (IN(11)) ffn_down(C, lds, WS_WD1, 4);
    SEAM(11);
    if (IN(12)) {
        pg8::Gemm g{(const bf16_t*)(C.ws + WS_XB), (const bf16_t*)(C.ws + WS_WIN), T, 3072, D}; pg8::StaticOrder S; S.init(T, 3072, C.G, C.bid);
        EpiProj E{(bf16_t*)(C.ws + WS_HP), P1LD, 2848, (const float*)(C.ws + WS_SSQ) + (size_t)4 * T * 16, nullptr, -1, (LAS float*)(C.lds + 131072)};
        pg8::gemm_phase<EpiProj, pg8::StaticOrder, true, true>(lds, g, S, E);
    }
    SEAM(12);
    if (IN(13)) { l1_pass_a(C); if (REPS(13) == 2) l1_pass_a(C); }
    SEAM(13);
    if (IN(14)) l1_middle(C);
    SEAM(14);
    if (IN(15)) { l1_pass_c(C); if (REPS(15) == 2) l1_pass_c(C); }
    SEAM(15);
    if (IN(16)) out_proj(C, lds, 5);
    SEAM(16);
    if (IN(17)) ffn_gu(C, lds, WS_WGU2, 5);
    SEAM(17);
    if (IN(18)) ffn_down(C, lds, WS_WD2, 6);
    SEAM(18);
    if (IN(19)) final_norm(C);
#undef IN
#undef SEAM
}

extern "C" void kernel_launch(void* const* d_in, const int* in_sizes, int n_in, void* d_out, int out_size, void* d_ws, size_t ws_size, hipStream_t stream) {
    static int grid = 0;
    if (grid == 0) {
        if (n_in != 39 || out_size != T * D || ws_size < WS_END) { fprintf(stderr, "kernel_launch: unexpected problem: n_in %d out %d ws %zu\n", n_in, out_size, ws_size); grid = -1; return; }
        int dev = 0, cus = 0, per_cu = 0;
        hipGetDevice(&dev); hipDeviceGetAttribute(&cus, hipDeviceAttributeMultiprocessorCount, dev);
        if (hipFuncSetAttribute((const void*)mk_fwd, hipFuncAttributeMaxDynamicSharedMemorySize, LDS_BYTES) != hipSuccess) { fprintf(stderr, "kernel_launch: hipFuncSetAttribute failed\n"); grid = -1; return; }
        if (hipOccupancyMaxActiveBlocksPerMultiprocessor(&per_cu, (const void*)mk_fwd, 512, LDS_BYTES) != hipSuccess || per_cu < 1) { fprintf(stderr, "kernel_launch: occupancy query says %d\n", per_cu); per_cu = 1; (void)hipGetLastError(); }
        grid = cus * (per_cu > 1 ? 1 : per_cu);
    }
    if (grid < 0) return;
    if (hipMemsetAsync(d_ws, 0, 16384, stream) != hipSuccess) { fprintf(stderr, "kernel_launch: memset of the barrier word failed\n"); return; }
    Args a{};
    for (int i = 0; i < 39; ++i) a.in[i] = (const float*)d_in[i];
    a.out = (float*)d_out; a.ws = (unsigned char*)d_ws; a.ph_lo = 0; a.ph_hi = N_PHASES;
    void* kargs[] = {&a};
    hipError_t e = hipLaunchCooperativeKernel((const void*)mk_fwd, dim3(grid), dim3(512), kargs, LDS_BYTES, stream);
    if (e != hipSuccess) fprintf(stderr, "kernel_launch: cooperative launch failed: %s (grid %d)\n", hipGetErrorString(e), grid);
}
```

```cpp
#include <hip/hip_runtime.h>
#include <hip/hip_cooperative_groups.h>
#include <cstdio>
#include <cstdint>
namespace cg = cooperative_groups;
namespace pg8 {
#define PG8_LAS __attribute__((address_space(3)))
typedef unsigned short bf16_t;
typedef short bf16x8 __attribute__((ext_vector_type(8)));
typedef float f32x4 __attribute__((ext_vector_type(4)));
typedef unsigned u32x4 __attribute__((ext_vector_type(4)));
constexpr int BM = 256, BK = 64, HALF = 128, HTB = HALF * BK * 2  , STAGE_BYTES = 8 * HTB, NXCD = 8, WGM = 8;

__host__ __device__ __forceinline__ int lds_byte(int r, int c) { const int st = (r >> 4) * 2 + (c >> 5), rr = r & 15, cc = c & 31, ob = rr * 64 + cc * 2; return st * 1024 + (ob ^ (((ob >> 9) & 1) << 5)); }
__host__ __device__ __forceinline__ void stage_rc(int b, int& R, int& C) { const int st = b / 1024, sb = b % 1024, swz = sb ^ (((sb >> 9) & 1) << 5); R = (st >> 1) * 16 + swz / 64; C = (st & 1) * 32 + (swz % 64) / 2; }
__host__ __device__ __forceinline__ int perm32(int rho) { const int n = rho >> 4, i = rho & 15; return 8 * (i >> 2) + 4 * n + (i & 3); }

struct Unit { int pm, pn; };
struct Gemm { const bf16_t* A; const bf16_t* Bt; int M, N, K; };

struct StaticOrder {
    int nM, nN, nwg, G, c;
    __host__ __device__ void init(int M, int N, int G_, int c_) { nM = M / BM; nN = N / BM; nwg = nM * nN; G = G_; c = c_; }
    __host__ __device__ bool next(int i, Unit& u) const {
        const long L = (long)i * G + c; if (L >= nwg) return false;
        int wgid = (int)L; { const int q = nwg / NXCD, r = nwg % NXCD, xcd = wgid % NXCD, off = wgid / NXCD; wgid = (xcd < r ? xcd * (q + 1) : r * (q + 1) + (xcd - r) * q) + off; }
        const int nig = WGM * nN, gid = wgid / nig, fm = gid * WGM, gsz = (nM - fm) < WGM ? (nM - fm) : WGM;
        u.pm = fm + ((wgid % nig) % gsz); u.pn = (wgid % nig) / gsz; return true;
    }
    __device__ __forceinline__ void a_ready(const Unit&) const {}
    __device__ __forceinline__ void done(const Unit&) const {}
};
__device__ __forceinline__ unsigned cvt_pk_bf16(float lo, float hi) { unsigned r; asm volatile("v_cvt_pk_bf16_f32 %0, %1, %2" : "=v"(r) : "v"(lo), "v"(hi)); return r; }
template <class Epi, class Sched, bool ALIGN_EPI = false, bool SP2 = false>
__device__ __forceinline__ void gemm_phase(PG8_LAS unsigned char* lds, const Gemm g, const Sched& S, const Epi& E) {
    const int tid = threadIdx.x, wid = __builtin_amdgcn_readfirstlane(tid >> 6), lane = tid & 63, wr = wid >> 2, wc = wid & 3, fr = lane & 15, fq = lane >> 4;
    const int K = g.K, nt = K / BK;
    unsigned voffA[2], voffB[2];
#pragma unroll
    for (int i = 0; i < 2; ++i) { int R, C; stage_rc(tid * 16 + i * 8192, R, C); const int Rb = Epi::PERM ? ((R & ~31) + perm32(R & 31)) : R;
        voffA[i] = (unsigned)(R * K + C) * 2u; voffB[i] = (unsigned)(Rb * K + C) * 2u; }
    const size_t kstep = (size_t)(BK * 2);
    const size_t hstep = (size_t)HALF * K * 2;
    const size_t tstep = 2 * hstep;
    const unsigned ldsw = (unsigned)wid * 1024u;
    const int aoff = lds_byte(wr * 64 + fr, fq * 8), boff = lds_byte(wc * 32 + fr, fq * 8);
#define PG8_SA(b, h) (((b) * 2 + (h)) * HTB)
#define PG8_SB(b, h) ((4 + (b) * 2 + (h)) * HTB)
#define PG8_STAGE(bufoff, gbase, voff) do { _Pragma("unroll") for (int _i = 0; _i < 2; ++_i) \
        __builtin_amdgcn_global_load_lds((const unsigned*)((const char*)(gbase) + (voff)[_i]), (PG8_LAS unsigned*)(lds + (bufoff) + ldsw + _i * 8192), 16, 0, 0); } while (0)
#define PG8_LDA(dst, b, h) do { _Pragma("unroll") for (int m = 0; m < 4; ++m) _Pragma("unroll") for (int k = 0; k < 2; ++k) dst[m][k] = *(const PG8_LAS bf16x8*)(lds + PG8_SA(b, h) + aoff + m * 2048 + k * 1024); } while (0)
#define PG8_LDB(dst, b, h) do { _Pragma("unroll") for (int n = 0; n < 2; ++n) _Pragma("unroll") for (int k = 0; k < 2; ++k) dst[n][k] = *(const PG8_LAS bf16x8*)(lds + PG8_SB(b, h) + boff + n * 2048 + k * 1024); } while (0)
#define PG8_MMA(ai, bj, At, Bt) do { __builtin_amdgcn_s_setprio(1); _Pragma("unroll") for (int m = 0; m < 4; ++m) _Pragma("unroll") for (int n = 0; n < 2; ++n) _Pragma("unroll") for (int k = 0; k < 2; ++k) \
        acc[ai][bj][m][n] = __builtin_amdgcn_mfma_f32_16x16x32_bf16(Bt[n][k], At[m][k], acc[ai][bj][m][n], 0, 0, 0); __builtin_amdgcn_s_setprio(0); } while (0)
#define PG8_WAIT_V(n) asm volatile("s_waitcnt vmcnt(" #n ")" ::: "memory")
#define PG8_WAIT_L(n) asm volatile("s_waitcnt lgkmcnt(" #n ")" ::: "memory")
#define PG8_BAR __builtin_amdgcn_s_barrier()
#define PG8_SCHED __builtin_amdgcn_sched_barrier(0)
    Unit cur, nxt; int ui = 0;
    if (!S.next(0, cur)) return;
    f32x4 acc[2][2][4][2];
#pragma unroll
    for (int a = 0; a < 2; ++a)
#pragma unroll
        for (int b = 0; b < 2; ++b)
#pragma unroll
            for (int m = 0; m < 4; ++m)
#pragma unroll
                for (int n = 0; n < 2; ++n) acc[a][b][m][n] = (f32x4){0.f, 0.f, 0.f, 0.f};
    bf16x8 At[4][2], B0[2][2], B1[2][2];
    const char* cA = (const char*)g.A + (size_t)cur.pm * tstep; const char* cB = (const char*)g.Bt + (size_t)cur.pn * tstep;
    S.a_ready(cur);
    if constexpr (SP2) {
        PG8_STAGE(PG8_SB(0, 0), cB, voffB); PG8_STAGE(PG8_SB(0, 1), cB + hstep, voffB); PG8_STAGE(PG8_SA(0, 0), cA, voffA); PG8_STAGE(PG8_SA(0, 1), cA + hstep, voffA);
        if (wr == 1) PG8_BAR;
        PG8_WAIT_V(2); PG8_BAR;
        PG8_STAGE(PG8_SB(1, 0), cB + kstep, voffB); PG8_STAGE(PG8_SA(1, 0), cA + kstep, voffA); PG8_STAGE(PG8_SB(1, 1), cB + hstep + kstep, voffB);
        PG8_WAIT_V(6); PG8_BAR;
    } else {
        PG8_STAGE(PG8_SB(0, 0), cB, voffB); PG8_STAGE(PG8_SA(0, 0), cA, voffA); PG8_STAGE(PG8_SB(0, 1), cB + hstep, voffB); PG8_STAGE(PG8_SA(0, 1), cA + hstep, voffA);
        if (wr == 1) PG8_BAR;
        PG8_WAIT_V(4); PG8_BAR;
        PG8_STAGE(PG8_SB(1, 0), cB + kstep, voffB); PG8_STAGE(PG8_SA(1, 0), cA + kstep, voffA); PG8_STAGE(PG8_SB(1, 1), cB + hstep + kstep, voffB);
        PG8_WAIT_V(6); PG8_BAR;
    }
    for (;;) {
        const bool has_next = S.next(ui + 1, nxt);
        const char* nA = has_next ? (const char*)g.A + (size_t)nxt.pm * tstep : cA; const char* nB = has_next ? (const char*)g.Bt + (size_t)nxt.pn * tstep : cB;
        for (int t = 0; t < nt; t += 2) {
            const bool last = (t == nt - 2);
            const char* a1 = cA + (size_t)(t + 1) * kstep;
            const char* a2 = last ? nA : cA + (size_t)(t + 2) * kstep; const char* b2 = last ? nB : cB + (size_t)(t + 2) * kstep;
            const char* a3 = a2 + kstep; const char* b3 = b2 + kstep;
            if (last && has_next) S.a_ready(nxt);
            if constexpr (SP2) {
            PG8_LDB(B0, 0, 0); PG8_LDB(B1, 0, 1); PG8_SCHED; PG8_LDA(At, 0, 0); PG8_STAGE(PG8_SA(1, 1), a1 + hstep, voffA);
            PG8_WAIT_V(8); PG8_WAIT_L(0); PG8_BAR; PG8_MMA(0, 0, At, B0); PG8_MMA(0, 1, At, B1); PG8_BAR; PG8_SCHED;
            PG8_LDA(At, 0, 1); PG8_STAGE(PG8_SB(0, 0), b2, voffB); PG8_STAGE(PG8_SB(0, 1), b2 + hstep, voffB); PG8_STAGE(PG8_SA(0, 0), a2, voffA);
            PG8_WAIT_V(8); PG8_WAIT_L(0); PG8_BAR; PG8_MMA(1, 0, At, B0); PG8_MMA(1, 1, At, B1); PG8_BAR; PG8_SCHED;
            PG8_LDB(B0, 1, 0); PG8_LDB(B1, 1, 1); PG8_SCHED; PG8_LDA(At, 1, 0); PG8_STAGE(PG8_SA(0, 1), a2 + hstep, voffA);
            PG8_WAIT_V(8); PG8_WAIT_L(0); PG8_BAR; PG8_MMA(0, 0, At, B0); PG8_MMA(0, 1, At, B1); PG8_BAR; PG8_SCHED;
            PG8_LDA(At, 1, 1); PG8_STAGE(PG8_SB(1, 0), b3, voffB); PG8_STAGE(PG8_SB(1, 1), b3 + hstep, voffB); PG8_STAGE(PG8_SA(1, 0), a3, voffA);
            PG8_WAIT_V(8); PG8_WAIT_L(0); PG8_BAR; PG8_MMA(1, 0, At, B0); PG8_MMA(1, 1, At, B1); PG8_BAR; PG8_SCHED;
            } else {
            PG8_LDB(B0, 0, 0); PG8_SCHED; PG8_LDA(At, 0, 0); PG8_STAGE(PG8_SA(1, 1), a1 + hstep, voffA);
            PG8_WAIT_L(8); PG8_BAR; PG8_WAIT_L(0); PG8_MMA(0, 0, At, B0); PG8_BAR; PG8_SCHED;
            PG8_LDB(B1, 0, 1); PG8_STAGE(PG8_SB(0, 0), b2, voffB);
            PG8_BAR; PG8_WAIT_L(0); PG8_MMA(0, 1, At, B1); PG8_BAR;
            PG8_LDA(At, 0, 1); PG8_STAGE(PG8_SA(0, 0), a2, voffA);
            PG8_BAR; PG8_WAIT_L(0); PG8_MMA(1, 0, At, B0); PG8_BAR; PG8_SCHED;
            PG8_STAGE(PG8_SB(0, 1), b2 + hstep, voffB);
            PG8_WAIT_V(6); PG8_BAR; PG8_MMA(1, 1, At, B1); PG8_BAR;
            PG8_LDB(B0, 1, 0); PG8_SCHED; PG8_LDA(At, 1, 0); PG8_STAGE(PG8_SA(0, 1), a2 + hstep, voffA);
            PG8_WAIT_L(8); PG8_BAR; PG8_WAIT_L(0); PG8_MMA(0, 0, At, B0); PG8_BAR; PG8_SCHED;
            PG8_LDB(B1, 1, 1); PG8_STAGE(PG8_SB(1, 0), b3, voffB);
            PG8_BAR; PG8_WAIT_L(0); PG8_MMA(0, 1, At, B1); PG8_BAR;
            PG8_LDA(At, 1, 1); PG8_STAGE(PG8_SA(1, 0), a3, voffA);
            PG8_BAR; PG8_WAIT_L(0); PG8_MMA(1, 0, At, B0); PG8_BAR; PG8_SCHED;
            PG8_STAGE(PG8_SB(1, 1), b3 + hstep, voffB);
            PG8_WAIT_V(6); PG8_BAR; PG8_MMA(1, 1, At, B1); PG8_BAR;
            }
        }
        if constexpr (ALIGN_EPI) { if (wr == 0) PG8_BAR; }
        if constexpr (!Epi::AFTER_DRAIN) { E(acc, cur, wr, wc, fr, fq); S.done(cur); }
        if (!has_next) break;
#pragma unroll
        for (int a = 0; a < 2; ++a)
#pragma unroll
            for (int b = 0; b < 2; ++b)
#pragma unroll
                for (int m = 0; m < 4; ++m)
#pragma unroll
                    for (int n = 0; n < 2; ++n) acc[a][b][m][n] = (f32x4){0.f, 0.f, 0.f, 0.f};
        cur = nxt; cA = nA; cB = nB; ++ui;
        if constexpr (ALIGN_EPI) { if (wr == 1) PG8_BAR; }
    }
    PG8_WAIT_V(0);
    if constexpr (!ALIGN_EPI) { if (wr == 0) PG8_BAR; }
    PG8_BAR;
    if constexpr (Epi::AFTER_DRAIN) { E.fused(acc, cur, wr, wc, fr, fq, lds, wid, lane); S.done(cur); }
#undef PG8_SA
#undef PG8_SB
#undef PG8_STAGE
#undef PG8_LDA
#undef PG8_LDB
#undef PG8_MMA
#undef PG8_WAIT_V
#undef PG8_WAIT_L
#undef PG8_BAR
#undef PG8_SCHED
}
}

#define LAS __attribute__((address_space(3)))
typedef unsigned short bf16_t;
typedef short bf16x8 __attribute__((ext_vector_type(8)));
typedef float f32x4 __attribute__((ext_vector_type(4)));
typedef float f32x2 __attribute__((ext_vector_type(2)));
typedef unsigned u32x4 __attribute__((ext_vector_type(4)));
typedef unsigned u32x2 __attribute__((ext_vector_type(2)));

constexpr int T = 16384, D = 1024, FF = 2816;
constexpr int P0LD = 3328, P1LD = 2880;
constexpr int C_Q = 0, C_K = 512, C_V = 1024, C_G = 1536, C_Z = 2048, C_XBC = 2560;
constexpr size_t MiB = 1u << 20;
constexpr size_t WS_SSQ = 247 * MiB, WS_DT = 512 * 1024, WS_LRUC = 1 * MiB, WS_CHD = 2 * MiB + 512 * 1024, WS_SMALLW = 3 * MiB;
constexpr size_t WS_WGU1 = 4 * MiB, WS_WD1 = 15 * MiB, WS_WIN = 21 * MiB, WS_WOUT = 28 * MiB, WS_WGU2 = 30 * MiB, WS_WD2 = 41 * MiB;
constexpr size_t WS_XB = 47 * MiB, WS_Y = 79 * MiB, WS_HP = 111 * MiB, WS_ST = 215 * MiB, WS_END = 255 * MiB;
constexpr int LDS_BYTES = 163840;

typedef float f32x2_t __attribute__((ext_vector_type(2)));
typedef __bf16 bf16x2_t __attribute__((ext_vector_type(2)));
__device__ __forceinline__ unsigned pk2(float lo, float hi) { f32x2_t v = {lo, hi}; bf16x2_t b = __builtin_convertvector(v, bf16x2_t); return __builtin_bit_cast(unsigned, b); }
__device__ __forceinline__ unsigned short f2bf(float f) { return (unsigned short)(pk2(f, 0.f) & 0xffffu); }
__device__ __forceinline__ float bflo(unsigned w) { return __uint_as_float(w << 16); }
__device__ __forceinline__ float bfhi(unsigned w) { return __uint_as_float(w & 0xffff0000u); }
__device__ __forceinline__ float bf2f(unsigned short h) { return __uint_as_float(((unsigned)h) << 16); }
__device__ __forceinline__ float frcp(float x) { return __builtin_amdgcn_rcpf(x); }
__device__ __forceinline__ float sigmoidf_(float x) { return frcp(1.f + __expf(-x)); }
__device__ __forceinline__ float siluf_(float x) { return x * frcp(1.f + __expf(-x)); }
__device__ __forceinline__ float softplusf_(float x) { return x > 20.f ? x : log1pf(__expf(x)); }
__device__ __forceinline__ float softplus_fast(float x) { return x > 20.f ? x : __logf(1.f + __expf(x)); }
__device__ __forceinline__ float wave_sum(float v) {
#pragma unroll
    for (int o = 1; o < 64; o <<= 1) v += __shfl_xor(v, o);
    return v;
}
__device__ __forceinline__ float wave_sum_dpp(float v) {
    v += __builtin_bit_cast(float, __builtin_amdgcn_update_dpp(0, __builtin_bit_cast(int, v), 0x111, 0xf, 0xf, true));
    v += __builtin_bit_cast(float, __builtin_amdgcn_update_dpp(0, __builtin_bit_cast(int, v), 0x112, 0xf, 0xf, true));
    v += __builtin_bit_cast(float, __builtin_amdgcn_update_dpp(0, __builtin_bit_cast(int, v), 0x114, 0xf, 0xf, true));
    v += __builtin_bit_cast(float, __builtin_amdgcn_update_dpp(0, __builtin_bit_cast(int, v), 0x118, 0xf, 0xf, true));
    v += __builtin_bit_cast(float, __builtin_amdgcn_update_dpp(0, __builtin_bit_cast(int, v), 0x142, 0xa, 0xf, false));
    v += __builtin_bit_cast(float, __builtin_amdgcn_update_dpp(0, __builtin_bit_cast(int, v), 0x143, 0xc, 0xf, false));
    return __builtin_bit_cast(float, __builtin_amdgcn_readlane(__builtin_bit_cast(int, v), 63));
}
__device__ __forceinline__ f32x4 mma(f32x4 acc, bf16x8 nfrag, bf16x8 mfrag) { return __builtin_amdgcn_mfma_f32_16x16x32_bf16(nfrag, mfrag, acc, 0, 0, 0); }
__device__ __forceinline__ bf16x8 ldf(const LAS bf16_t* base, int stride, int row0, int k0, int lane) { return *(const LAS bf16x8*)(base + (row0 + (lane & 15)) * stride + k0 + 8 * (lane >> 4)); }
__device__ __forceinline__ bf16x8 ldfg(const bf16_t* base, int stride, int row0, int k0, int lane) { return *(const bf16x8*)(base + (size_t)(row0 + (lane & 15)) * stride + k0 + 8 * (lane >> 4)); }
#define F4Z ((f32x4){0.f, 0.f, 0.f, 0.f})
__device__ __forceinline__ float ssq_row(const float* ssq, int row) {
    float s = 0.f;
#pragma unroll
    for (int k = 0; k < 16; ++k) s += ssq[(size_t)k * T + row];
    return s;
}

struct Ctx {
    const float* const* in; float* X; unsigned char* ws; LAS unsigned char* lds;
    int tid, lane, wave, G, bid;
    int cv_b0, cv_nb;
};

__device__ __forceinline__ void tr_item(const float* W, int K, int N, bf16_t* WT, const float* gain, int k0, int n0, int drow0, LAS float* scr, int lane) {
    const int nn = n0 + (lane & 31);
    float wv[32];
#pragma unroll
    for (int i = 0; i < 32; ++i) { const int kk = 2 * i + (lane >> 5); wv[i] = (nn < N) ? W[(size_t)(k0 + kk) * N + nn] : 0.f; }
#pragma unroll
    for (int i = 0; i < 32; ++i) { const int kk = 2 * i + (lane >> 5); float v = wv[i]; if (gain) v *= gain[k0 + kk]; scr[kk * 33 + (lane & 31)] = v; }
    asm volatile("s_waitcnt lgkmcnt(0)" ::: "memory");
    const int c = lane & 7;
#pragma unroll
    for (int j = 0; j < 4; ++j) { const int n = (lane >> 3) + 8 * j; const LAS float* s = scr + (8 * c) * 33 + n;
        u32x4 o; o.x = pk2(s[0 * 33], s[1 * 33]); o.y = pk2(s[2 * 33], s[3 * 33]); o.z = pk2(s[4 * 33], s[5 * 33]); o.w = pk2(s[6 * 33], s[7 * 33]);
        if (n0 + n < N) *(u32x4*)(WT + (size_t)(drow0 + n) * K + k0 + 8 * c) = o; }
    asm volatile("s_waitcnt lgkmcnt(0)" ::: "memory");
}
__device__ __forceinline__ void tr_matrix(const Ctx& C, const float* W, int K, int N, bf16_t* WT, const float* gain, int mode, int& base) {
    LAS float* scr = (LAS float*)(C.lds + C.wave * 8448);
    const int nblk = (N + 31) / 32, nitems = (K / 64) * nblk, gw = (C.bid - C.cv_b0) * 8 + C.wave, ngw = C.cv_nb * 8;
    int first = (gw - (base % ngw) + ngw) % ngw;
    for (int it = first; it < nitems; it += ngw) {
        const int kb = it / nblk, nb = it % nblk, n0 = 32 * nb;
        const int drow0 = mode == 0 ? n0 : ((n0 >> 7) * 256 + (n0 & 127) + (mode == 2 ? 128 : 0));
        tr_item(W, K, N, WT, gain, 64 * kb, n0, drow0, scr, C.lane);
    }
    base += nitems;
}
__device__ __forceinline__ void convert_weights(const Ctx& C, int layer, int which) {
    int base = 0; unsigned char* ws = C.ws;
    if (which & 1) {
        tr_matrix(C, C.in[2] + (size_t)layer * D * FF, D, FF, (bf16_t*)(ws + WS_WGU1), C.in[1] + layer * D, 1, base);
        tr_matrix(C, C.in[3] + (size_t)layer * D * FF, D, FF, (bf16_t*)(ws + WS_WGU1), C.in[1] + layer * D, 2, base);
        tr_matrix(C, C.in[4] + (size_t)layer * D * FF, FF, D, (bf16_t*)(ws + WS_WD1), nullptr, 0, base);
    }
    if (which & 2) {
        if (layer == 0) { tr_matrix(C, C.in[10], D, 3336, (bf16_t*)(ws + WS_WIN), C.in[5], 0, base); tr_matrix(C, C.in[11], D, D, (bf16_t*)(ws + WS_WOUT), nullptr, 0, base); }
        else            { tr_matrix(C, C.in[18], D, 2848, (bf16_t*)(ws + WS_WIN), C.in[5] + D, 0, base); tr_matrix(C, C.in[19], D, D, (bf16_t*)(ws + WS_WOUT), nullptr, 0, base); }
    }
    if (which & 4) {
        tr_matrix(C, C.in[7] + (size_t)layer * D * FF, D, FF, (bf16_t*)(ws + WS_WGU2), C.in[6] + layer * D, 1, base);
        tr_matrix(C, C.in[8] + (size_t)layer * D * FF, D, FF, (bf16_t*)(ws + WS_WGU2), C.in[6] + layer * D, 2, base);
        tr_matrix(C, C.in[9] + (size_t)layer * D * FF, FF, D, (bf16_t*)(ws + WS_WD2), nullptr, 0, base);
    }
}
__device__ __forceinline__ void tr_small(const Ctx& C, const float* W, int K, int N, bf16_t* WT) {
    for (int idx = C.bid * 512 + C.tid; idx < K * N; idx += C.G * 512) { const int n = idx / K, k = idx % K; WT[idx] = f2bf(W[(size_t)k * N + n]); }
}

__device__ __forceinline__ void panel_rscale(const float* ssq, LAS float* rs, int pm) {
    asm volatile("s_waitcnt lgkmcnt(0)" ::: "memory"); __builtin_amdgcn_s_barrier(); asm volatile("" ::: "memory");
    if (threadIdx.x < 256) rs[threadIdx.x] = rsqrtf(ssq_row(ssq, pm * 256 + (int)threadIdx.x) * (1.f / D) + 1e-6f);
    asm volatile("s_waitcnt lgkmcnt(0)" ::: "memory"); __builtin_amdgcn_s_barrier(); asm volatile("" ::: "memory");
}

struct EpiSwiglu {
    static constexpr bool PERM = true, AFTER_DRAIN = false;
    bf16_t* H; const float* ssq; LAS float* rs;
    __device__ __forceinline__ void operator()(const f32x4 (&acc)[2][2][4][2], const pg8::Unit& u, int wr, int wc, int fr, int fq) const {
        panel_rscale(ssq, rs, u.pm);
        const int row0 = u.pm * 256 + wr * 64 + fr, col0 = u.pn * 128 + wc * 32 + 8 * fq;
#pragma unroll
        for (int ai = 0; ai < 2; ++ai)
#pragma unroll
            for (int m = 0; m < 4; ++m) {
                const int row = row0 + ai * 128 + m * 16; const float r = rs[wr * 64 + fr + ai * 128 + m * 16];
                float h[8];
#pragma unroll
                for (int n = 0; n < 2; ++n)
#pragma unroll
                    for (int v = 0; v < 4; ++v) { const float g = acc[ai][0][m][n][v] * r, up = acc[ai][1][m][n][v] * r; h[4 * n + v] = siluf_(g) * up; }
                u32x4 w; w.x = pk2(h[0], h[1]); w.y = pk2(h[2], h[3]); w.z = pk2(h[4], h[5]); w.w = pk2(h[6], h[7]);
                *(u32x4*)(H + (size_t)row * FF + col0) = w;
            }
    }
};
struct EpiResid {
    static constexpr bool PERM = true, AFTER_DRAIN = false;
    bf16_t* XB; float* ssq_out; float alpha;
    __device__ __forceinline__ void operator()(const f32x4 (&acc)[2][2][4][2], const pg8::Unit& u, int wr, int wc, int fr, int fq) const {
        const int row0 = u.pm * 256 + wr * 64 + fr, col0 = u.pn * 256 + wc * 32 + 8 * fq;
#pragma unroll
        for (int ai = 0; ai < 2; ++ai)
#pragma unroll
            for (int m = 0; m < 4; ++m) {
                const int row = row0 + ai * 128 + m * 16; float s = 0.f;
#pragma unroll
                for (int bj = 0; bj < 2; ++bj) {
                    const size_t off = (size_t)row * D + col0 + bj * 128;
                    const u32x4 xo = *(const u32x4*)(XB + off);
                    const f32x4 a0 = acc[ai][bj][m][0] * alpha, a1 = acc[ai][bj][m][1] * alpha;
                    u32x4 bq; bq.x = pk2(bflo(xo.x) + a0[0], bfhi(xo.x) + a0[1]); bq.y = pk2(bflo(xo.y) + a0[2], bfhi(xo.y) + a0[3]);
                    bq.z = pk2(bflo(xo.z) + a1[0], bfhi(xo.z) + a1[1]); bq.w = pk2(bflo(xo.w) + a1[2], bfhi(xo.w) + a1[3]);
                    *(u32x4*)(XB + off) = bq;
#pragma unroll
                    for (int q = 0; q < 4; ++q) { const float x0 = bflo(bq[q]), x1 = bfhi(bq[q]); s += x0 * x0 + x1 * x1; }
                }
                s += __shfl_xor(s, 16); s += __shfl_xor(s, 32);
                if (fq == 0) ssq_out[(size_t)(u.pn * 4 + wc) * T + row] = s;
            }
    }
};
struct EpiProj {
    static constexpr bool PERM = true, AFTER_DRAIN = false;
    bf16_t* P; int ldp, ncols; const float* ssq; float* DT; int dt_col0; LAS float* rs;
    __device__ __forceinline__ void operator()(const f32x4 (&acc)[2][2][4][2], const pg8::Unit& u, int wr, int wc, int fr, int fq) const {
        panel_rscale(ssq, rs, u.pm);
        const int row0 = u.pm * 256 + wr * 64 + fr, col0 = u.pn * 256 + wc * 32 + 8 * fq;
#pragma unroll
        for (int ai = 0; ai < 2; ++ai)
#pragma unroll
            for (int m = 0; m < 4; ++m) {
                const int row = row0 + ai * 128 + m * 16; const float r = rs[wr * 64 + fr + ai * 128 + m * 16];
#pragma unroll
                for (int bj = 0; bj < 2; ++bj) {
                    const int c = col0 + bj * 128; const f32x4 v0 = acc[ai][bj][m][0] * r, v1 = acc[ai][bj][m][1] * r;
                    if (c + 8 <= ncols) { u32x4 w; w.x = pk2(v0[0], v0[1]); w.y = pk2(v0[2], v0[3]); w.z = pk2(v1[0], v1[1]); w.w = pk2(v1[2], v1[3]); *(u32x4*)(P + (size_t)row * ldp + c) = w; }
                    else if (DT && c == dt_col0) { *(f32x4*)(DT + (size_t)row * 8) = v0; *(f32x4*)(DT + (size_t)row * 8 + 4) = v1; }
                }
            }
    }
};

__device__ __forceinline__ void prologue_x(const Ctx& C) {
    const float* x = C.in[0]; bf16_t* XB = (bf16_t*)(C.ws + WS_XB); float* ssq = (float*)(C.ws + WS_SSQ);
    const int gw = C.bid * 8 + C.wave, ngw = C.G * 8;
#pragma unroll 4
    for (int m = gw; m < T; m += ngw) {
        const f32x4* xr = (const f32x4*)(x + (size_t)m * D) + C.lane; u32x2* brow = (u32x2*)(XB + (size_t)m * D) + C.lane;
        float s = 0.f;
#pragma unroll
        for (int j = 0; j < 4; ++j) { const f32x4 v = xr[64 * j]; u32x2 q; q.x = pk2(v[0], v[1]); q.y = pk2(v[2], v[3]); brow[64 * j] = q; const float x0 = bflo(q.x), x1 = bfhi(q.x), x2 = bflo(q.y), x3 = bfhi(q.y); s += (x0 * x0 + x1 * x1) + (x2 * x2 + x3 * x3); }
        s = wave_sum(s);
        if (C.lane == 0) ssq[m] = s;
    }
    for (int i = C.bid * 512 + C.tid; i < 15 * T; i += C.G * 512) ssq[T + i] = 0.f;
}
__device__ __forceinline__ void final_norm(const Ctx& C) {
    const float* ssq = (const float*)(C.ws + WS_SSQ) + (size_t)6 * T * 16; const float* g = C.in[38];
    const int gw = C.bid * 8 + C.wave, ngw = C.G * 8;
    f32x4 gv[4];
#pragma unroll
    for (int j = 0; j < 4; ++j) gv[j] = ((const f32x4*)g)[C.lane + 64 * j];
    const bf16_t* XB = (const bf16_t*)(C.ws + WS_XB);
#pragma unroll 4
    for (int m = gw; m < T; m += ngw) {
        const u32x2* br = (const u32x2*)(XB + (size_t)m * D) + C.lane; f32x4* orow = (f32x4*)(C.X + (size_t)m * D) + C.lane; const float r = rsqrtf(ssq_row(ssq, m) * (1.f / D) + 1e-6f);
#pragma unroll
        for (int j = 0; j < 4; ++j) { const u32x2 q = br[64 * j]; f32x4 v = {bflo(q.x), bfhi(q.x), bflo(q.y), bfhi(q.y)}; v = v * r * gv[j]; orow[64 * j] = v; }
    }
}

__device__ __forceinline__ float ret_log_gamma(int h) { return logf(1.f - exp2f(-5.f - (float)h)); }

template <bool TR>
__device__ __forceinline__ void stage_rot(const bf16_t* P, int t0, int col0, LAS bf16_t* dst, int stride, float scale, float lg, bool kte, int nrows, int tl, int nth) {
    for (int it = tl; it < nrows * 8; it += nth) {
        const int row = TR ? it % nrows : it >> 3, d0 = TR ? (it / nrows) * 8 : (it & 7) * 8, t = t0 + row;
        const bf16_t* src = P + (size_t)t * P0LD + col0 + d0;
        const u32x4 a = *(const u32x4*)src, b = *(const u32x4*)(src + 64);
        const float rs = scale * (kte ? __expf(lg * (float)(127 - row)) : 1.f);
        float o1[8], o2[8];
#pragma unroll
        for (int i = 0; i < 8; ++i) {
            const unsigned wa = a[i >> 1], wb = b[i >> 1];
            const float x1 = (i & 1) ? bfhi(wa) : bflo(wa), x2 = (i & 1) ? bfhi(wb) : bflo(wb);
            const float invf = exp2f(-(float)(d0 + i) * (13.287712379549449f / 64.f));
            const float ang = (float)t * invf, n = rintf(ang * 0.15915494309189535f);
            float r = fmaf(-n, 6.2831854820251465f, ang); r = fmaf(-n, -1.7484556e-7f, r);
            const float s = __sinf(r), c = __cosf(r);
            o1[i] = (x1 * c - x2 * s) * rs; o2[i] = (x2 * c + x1 * s) * rs;
        }
        if (TR) {
#pragma unroll
            for (int i = 0; i < 8; ++i) { dst[(d0 + i) * stride + row] = f2bf(o1[i]); dst[(64 + d0 + i) * stride + row] = f2bf(o2[i]); }
        } else {
            u32x4 w1, w2; w1.x = pk2(o1[0], o1[1]); w1.y = pk2(o1[2], o1[3]); w1.z = pk2(o1[4], o1[5]); w1.w = pk2(o1[6], o1[7]);
            w2.x = pk2(o2[0], o2[1]); w2.y = pk2(o2[2], o2[3]); w2.z = pk2(o2[4], o2[5]); w2.w = pk2(o2[6], o2[7]);
            *(LAS u32x4*)(dst + row * stride + d0) = w1; *(LAS u32x4*)(dst + row * stride + 64 + d0) = w2;
        }
    }
}
__device__ __forceinline__ void stage_vT(const bf16_t* P, int t0, int col0, LAS bf16_t* dst, int stride, int tid) {
    for (int it = tid; it < 128 * 16; it += 512) {
        const int row = it & 127, e0 = (it >> 7) * 8;
        const u32x4 a = *(const u32x4*)(P + (size_t)(t0 + row) * P0LD + col0 + e0);
#pragma unroll
        for (int i = 0; i < 8; ++i) { const unsigned w = a[i >> 1]; dst[(e0 + i) * stride + row] = (unsigned short)((i & 1) ? (w >> 16) : (w & 0xffffu)); }
    }
}

__device__ __forceinline__ void stage_dt(const Ctx& C, int t0, int g, LAS float* DTS, LAS float* AS, LAS float* ACS) {
    const int l = C.tid & 127, hh = C.tid >> 7, h = 4 * g + hh;
    const float* DT = (const float*)(C.ws + WS_DT);
    const float dtv = softplusf_(DT[(size_t)(t0 + l) * 8 + h] + C.in[14][h]);
    DTS[hh * 128 + l] = dtv;
    float s = -dtv * __expf(C.in[15][h]);
    s += __builtin_bit_cast(float, __builtin_amdgcn_update_dpp(0, __builtin_bit_cast(int, s), 0x111, 0xf, 0xf, true));
    s += __builtin_bit_cast(float, __builtin_amdgcn_update_dpp(0, __builtin_bit_cast(int, s), 0x112, 0xf, 0xf, true));
    s += __builtin_bit_cast(float, __builtin_amdgcn_update_dpp(0, __builtin_bit_cast(int, s), 0x114, 0xf, 0xf, true));
    s += __builtin_bit_cast(float, __builtin_amdgcn_update_dpp(0, __builtin_bit_cast(int, s), 0x118, 0xf, 0xf, true));
    s += __builtin_bit_cast(float, __builtin_amdgcn_update_dpp(0, __builtin_bit_cast(int, s), 0x142, 0xa, 0xf, false));
    s += __builtin_bit_cast(float, __builtin_amdgcn_update_dpp(0, __builtin_bit_cast(int, s), 0x143, 0xc, 0xf, false));
    if ((C.wave & 1) == 0 && C.lane == 63) AS[hh] = s;
    __syncthreads();
    if (C.wave & 1) s += AS[hh];
    ACS[hh * 128 + l] = s;
    __syncthreads();
}

template <int NGRP, int MODE>
__device__ __forceinline__ void stage_conv(const Ctx& C, int t0, int g, LAS bf16_t* XT, LAS bf16_t* BB, LAS bf16_t* CC, const LAS float* DTS, const LAS float* ACS) {
    constexpr int NSEG = 512 / NGRP, RP = (128 + NSEG - 1) / NSEG;
    if (C.tid >= NGRP * NSEG) return;
    const bf16_t* P = (const bf16_t*)(C.ws + WS_HP);
    const int seg = C.tid % NSEG, grp = C.tid / NSEG;
    const int ch0 = grp < 32 ? 256 * g + 8 * grp : (grp < 40 ? 512 + 64 * g + 8 * (grp - 32) : 640 + 64 * g + 8 * (grp - 40));
    const float* cw = C.in[12]; const float* cb = C.in[13];
    float w0[8], w1[8], w2[8], w3[8], bb[8], x0[8], x1[8], x2[8];
#pragma unroll
    for (int i = 0; i < 8; ++i) { w0[i] = cw[ch0 + i]; w1[i] = cw[768 + ch0 + i]; w2[i] = cw[1536 + ch0 + i]; w3[i] = cw[2304 + ch0 + i]; bb[i] = cb[ch0 + i]; }
    const int r0 = seg * RP, r1 = (r0 + RP < 128) ? r0 + RP : 128;
    auto ldrow = [&](int t, float (&x)[8]) {
        if (t < 0) {
#pragma unroll
            for (int i = 0; i < 8; ++i) x[i] = 0.f;
        } else {
            const u32x4 a = *(const u32x4*)(P + (size_t)t * P0LD + C_XBC + ch0);
#pragma unroll
            for (int i = 0; i < 4; ++i) { x[2 * i] = bflo(a[i]); x[2 * i + 1] = bfhi(a[i]); }
        }
    };
    ldrow(t0 + r0 - 3, x0); ldrow(t0 + r0 - 2, x1); ldrow(t0 + r0 - 1, x2);
    for (int row = r0; row < r1; ++row) {
        float x3[8], v[8]; ldrow(t0 + row, x3);
#pragma unroll
        for (int i = 0; i < 8; ++i) { float s = bb[i] + w0[i] * x0[i] + w1[i] * x1[i] + w2[i] * x2[i] + w3[i] * x3[i]; v[i] = siluf_(s); x0[i] = x1[i]; x1[i] = x2[i]; x2[i] = x3[i]; }
        if (grp < 32) {
            const int hh = grp >> 3;
            float sc = DTS[hh * 128 + row]; if (MODE == 0) sc *= __expf(ACS[hh * 128 + 127] - ACS[hh * 128 + row]);
#pragma unroll
            for (int i = 0; i < 8; ++i) XT[(8 * grp + i) * 136 + row] = f2bf(v[i] * sc);
        } else if (MODE == 0) {
#pragma unroll
            for (int i = 0; i < 8; ++i) BB[(8 * (grp - 32) + i) * 136 + row] = f2bf(v[i]);
        } else {
            u32x4 w; w.x = pk2(v[0], v[1]); w.y = pk2(v[2], v[3]); w.z = pk2(v[4], v[5]); w.w = pk2(v[6], v[7]);
            if (grp < 40) *(LAS u32x4*)(BB + row * 72 + 8 * (grp - 32)) = w; else *(LAS u32x4*)(CC + row * 72 + 8 * (grp - 40)) = w;
        }
    }
}

__device__ __forceinline__ void ret_state_unit(const Ctx& C, int c, int h) {
    const bf16_t* P = (const bf16_t*)(C.ws + WS_HP); float* SR = (float*)(C.ws + WS_ST);
    LAS bf16_t* KT = (LAS bf16_t*)C.lds; LAS bf16_t* VT = KT + 128 * 136;
    const int t0 = c * 128, lane = C.lane, fr = lane & 15, fq = lane >> 4;
    stage_rot<true>(P, t0, C_K + h * 128, KT, 136, 0.08838834764831845f, ret_log_gamma(h), true, 128, C.tid, 512);
    stage_vT(P, t0, C_V + h * 128, VT, 136, C.tid);
    __syncthreads();
    const int e0 = 16 * C.wave; bf16x8 mf[4];
#pragma unroll
    for (int k = 0; k < 4; ++k) mf[k] = ldf(VT, 136, e0, 32 * k, lane);
    float* out = SR + ((size_t)(c * 4 + h) * 128 + e0 + fr) * 128 + 4 * fq;
#pragma unroll
    for (int dt = 0; dt < 8; ++dt) { f32x4 acc = F4Z;
#pragma unroll
        for (int k = 0; k < 4; ++k) acc = mma(acc, ldf(KT, 136, 16 * dt, 32 * k, lane), mf[k]);
        *(f32x4*)(out + 16 * dt) = acc; }
    __syncthreads();
}
__device__ __forceinline__ void mamba_state_unit(const Ctx& C, int c, int g) {
    LAS bf16_t* XT = (LAS bf16_t*)C.lds; LAS bf16_t* BT = XT + 256 * 136;
    LAS float* DTS = (LAS float*)(C.lds + 150528); LAS float* ACS = DTS + 512; LAS float* AS = ACS + 512;
    float* SM = C.X;     float* CHD = (float*)(C.ws + WS_CHD);
    const int t0 = c * 128, lane = C.lane, fr = lane & 15, fq = lane >> 4;
    stage_dt(C, t0, g, DTS, AS, ACS);
    stage_conv<40, 0>(C, t0, g, XT, BT, nullptr, DTS, ACS);
    if (C.tid < 4) CHD[(c * 2 + g) * 32 + C.tid] = __expf(ACS[C.tid * 128 + 127]);
    __syncthreads();
    const int hh = C.wave >> 1, ph = C.wave & 1;
#pragma unroll
    for (int pt = 0; pt < 2; ++pt) {
        const int p0 = ph * 32 + 16 * pt; bf16x8 mf[4];
#pragma unroll
        for (int k = 0; k < 4; ++k) mf[k] = ldf(XT, 136, hh * 64 + p0, 32 * k, lane);
        float* out = SM + ((size_t)(c * 8 + 4 * g + hh) * 64 + p0 + fr) * 64 + 4 * fq;
#pragma unroll
        for (int nt = 0; nt < 4; ++nt) { f32x4 acc = F4Z;
#pragma unroll
            for (int k = 0; k < 4; ++k) acc = mma(acc, ldf(BT, 136, 16 * nt, 32 * k, lane), mf[k]);
            *(f32x4*)(out + 16 * nt) = acc; }
    }
    __syncthreads();
}
__device__ __forceinline__ void l0_states(const Ctx& C) {
    for (int u = C.bid; u < 256; u += C.G) mamba_state_unit(C, u >> 1, u & 1);
    for (int u = C.bid; u < 512; u += C.G) ret_state_unit(C, u >> 2, u & 3);
}

__device__ __forceinline__ void l0_scan(const Ctx& C) {
    float* SR = (float*)(C.ws + WS_ST); float* SM = C.X;     const float* CHD = (const float*)(C.ws + WS_CHD);
    for (int idx = C.bid * 512 + C.tid; idx < 65536 + 32768; idx += C.G * 512) {
        if (idx < 65536) {
            const float dec = __expf(128.f * ret_log_gamma(idx >> 14)); float s = 0.f; float* p = SR + idx;
            for (int c0 = 0; c0 < 128; c0 += 32) { float kv[32];
#pragma unroll
                for (int j = 0; j < 32; ++j) kv[j] = p[(size_t)(c0 + j) * 65536];
#pragma unroll
                for (int j = 0; j < 32; ++j) { p[(size_t)(c0 + j) * 65536] = s; s = s * dec + kv[j]; } }
        } else {
            const int e = idx - 65536, head = e >> 12; float s = 0.f; float* p = SM + e;
            for (int c0 = 0; c0 < 128; c0 += 32) { float kv[32], dc[32];
#pragma unroll
                for (int j = 0; j < 32; ++j) { kv[j] = p[(size_t)(c0 + j) * 32768]; dc[j] = CHD[((c0 + j) * 2 + (head >> 2)) * 32 + (head & 3)]; }
#pragma unroll
                for (int j = 0; j < 32; ++j) { p[(size_t)(c0 + j) * 32768] = s; s = s * dc[j] + kv[j]; } }
        }
    }
}

__device__ __forceinline__ void mamba_out_unit(const Ctx& C, int c, int g) {
    LAS bf16_t* XT = (LAS bf16_t*)C.lds; LAS bf16_t* BM = (LAS bf16_t*)(C.lds + 69632); LAS bf16_t* CM = (LAS bf16_t*)(C.lds + 88064);
    LAS bf16_t* SP = (LAS bf16_t*)(C.lds + 106496); LAS bf16_t* STR = (LAS bf16_t*)(C.lds + 115712) + C.wave * (16 * 136);
    LAS float* DTS = (LAS float*)(C.lds + 150528); LAS float* ACS = DTS + 512; LAS float* AS = ACS + 512;
    const bf16_t* P = (const bf16_t*)(C.ws + WS_HP); const float* SM = C.X; bf16_t* Y = (bf16_t*)(C.ws + WS_Y);
    const int t0 = c * 128, lane = C.lane, fr = lane & 15, fq = lane >> 4, w = C.wave, l0 = 16 * w, l = l0 + fr;
    stage_dt(C, t0, g, DTS, AS, ACS);
    stage_conv<48, 1>(C, t0, g, XT, BM, CM, DTS, ACS);
    __syncthreads();
    bf16x8 cmA[2]; cmA[0] = ldf(CM, 72, l0, 0, lane); cmA[1] = ldf(CM, 72, l0, 32, lane);
    f32x4 cb[8];
#pragma unroll
    for (int st = 0; st < 8; ++st) { cb[st] = F4Z; if (st <= w) { cb[st] = mma(cb[st], ldf(BM, 72, 16 * st, 0, lane), cmA[0]); cb[st] = mma(cb[st], ldf(BM, 72, 16 * st, 32, lane), cmA[1]); } }
    float ssq = 0.f;
#pragma unroll 1
    for (int hh = 0; hh < 4; ++hh) {
        const int h = 4 * g + hh;
        __syncthreads();
        {
            const float* src = SM + (size_t)(c * 8 + h) * 4096;
#pragma unroll
            for (int i = 0; i < 2; ++i) { const int e = (C.tid + 512 * i) * 4; const f32x4 v = *(const f32x4*)(src + e); u32x2 b; b.x = pk2(v[0], v[1]); b.y = pk2(v[2], v[3]); *(LAS u32x2*)(SP + (e >> 6) * 72 + (e & 63)) = b; }
        }
        const float al = ACS[hh * 128 + l];
#pragma unroll
        for (int st = 0; st < 8; ++st) {
            const f32x4 as4 = *(const LAS f32x4*)(ACS + hh * 128 + 16 * st + 4 * fq); float sc[4];
#pragma unroll
            for (int v = 0; v < 4; ++v) { const int s = 16 * st + 4 * fq + v; sc[v] = 0.f; if (st <= w) sc[v] = (s <= l) ? cb[st][v] * __expf(al - as4[v]) : 0.f; }
            u32x2 b; b.x = pk2(sc[0], sc[1]); b.y = pk2(sc[2], sc[3]); *(LAS u32x2*)(STR + fr * 136 + 16 * st + 4 * fq) = b;
        }
        __syncthreads();
        bf16x8 sA[4];
#pragma unroll
        for (int k = 0; k < 4; ++k) sA[k] = ldf(STR, 136, 0, 32 * k, lane);
        const float eal = __expf(al), dsk = C.in[16][h], dtl = DTS[hh * 128 + l], rdt = dtl > 1e-30f ? frcp(dtl) : 0.f;
#pragma unroll
        for (int pt = 0; pt < 4; ++pt) {
            f32x4 ya = F4Z, yo = F4Z;
#pragma unroll
            for (int k = 0; k < 4; ++k) ya = mma(ya, ldf(XT, 136, hh * 64 + 16 * pt, 32 * k, lane), sA[k]);
#pragma unroll
            for (int k = 0; k < 2; ++k) yo = mma(yo, ldf(SP, 72, 16 * pt, 32 * k, lane), cmA[k]);
            const int p = 16 * pt + 4 * fq;
            const u32x2 zz = *(const u32x2*)(P + (size_t)(t0 + l) * P0LD + C_Z + 256 * g + hh * 64 + p);
            const float z[4] = {bflo(zz.x), bfhi(zz.x), bflo(zz.y), bfhi(zz.y)};
            float y[4];
#pragma unroll
            for (int v = 0; v < 4; ++v) {
                const float xs = bf2f(XT[(hh * 64 + p + v) * 136 + l]) * rdt;
                y[v] = (ya[v] + yo[v] * eal + dsk * xs) * siluf_(z[v]); ssq += y[v] * y[v];
            }
            u32x2 b; b.x = pk2(y[0], y[1]); b.y = pk2(y[2], y[3]);
            *(u32x2*)(Y + (size_t)(t0 + l) * D + 512 + 256 * g + hh * 64 + p) = b;
        }
    }
    ssq += __shfl_xor(ssq, 16); ssq += __shfl_xor(ssq, 32);
    const float rinv = rsqrtf(ssq * (1.f / 256.f) + 1e-5f);
#pragma unroll 4
    for (int q = 0; q < 16; ++q) {
        const int ch = 256 * g + 16 * q + 4 * fq; const f32x4 ng = *(const f32x4*)(C.in[17] + ch);
        u32x2* yp = (u32x2*)(Y + (size_t)(t0 + l) * D + 512 + ch); const u32x2 yy = *yp;
        u32x2 b; b.x = pk2(bflo(yy.x) * rinv * ng[0], bfhi(yy.x) * rinv * ng[1]); b.y = pk2(bflo(yy.y) * rinv * ng[2], bfhi(yy.y) * rinv * ng[3]);
        *yp = b;
    }
    __syncthreads();
}
__device__ __forceinline__ void ret_out_unit(const Ctx& C, int c, int h) {
    LAS bf16_t* KN = (LAS bf16_t*)C.lds; LAS bf16_t* VT = KN + 128 * 136; LAS bf16_t* ST = VT + 128 * 136; LAS bf16_t* STR = ST + 128 * 136 + C.wave * (16 * 136);
    const bf16_t* P = (const bf16_t*)(C.ws + WS_HP); const float* SR = (const float*)(C.ws + WS_ST); bf16_t* Y = (bf16_t*)(C.ws + WS_Y);
    const int t0 = c * 128, lane = C.lane, fr = lane & 15, fq = lane >> 4, w = C.wave, i0 = 16 * w, ii = i0 + fr;
    const float lg = ret_log_gamma(h);
    stage_rot<false>(P, t0, C_K + h * 128, KN, 136, 0.08838834764831845f, 0.f, false, 128, C.tid, 512);
    stage_vT(P, t0, C_V + h * 128, VT, 136, C.tid);
    {
        const float* src = SR + (size_t)(c * 4 + h) * 16384;
#pragma unroll
        for (int i = 0; i < 8; ++i) { const int e = (C.tid + 512 * i) * 4; const f32x4 v = *(const f32x4*)(src + e); u32x2 b; b.x = pk2(v[0], v[1]); b.y = pk2(v[2], v[3]); *(LAS u32x2*)(ST + (e >> 7) * 136 + (e & 127)) = b; }
    }
    stage_rot<false>(P, t0 + i0, C_Q + h * 128, STR, 136, 1.f, 0.f, false, 16, lane, 64);
    __syncthreads();
    bf16x8 qA[4];
#pragma unroll
    for (int k = 0; k < 4; ++k) qA[k] = ldf(STR, 136, 0, 32 * k, lane);
    __syncthreads();
#pragma unroll
    for (int jt = 0; jt < 8; ++jt) {
        f32x4 sa = F4Z;
        if (jt <= w) {
#pragma unroll
            for (int k = 0; k < 4; ++k) sa = mma(sa, ldf(KN, 136, 16 * jt, 32 * k, lane), qA[k]);
        }
        float sc[4];
#pragma unroll
        for (int v = 0; v < 4; ++v) { const int j = 16 * jt + 4 * fq + v; sc[v] = 0.f; if (jt <= w) sc[v] = (j <= ii) ? sa[v] * __expf(lg * (float)(ii - j)) : 0.f; }
        u32x2 b; b.x = pk2(sc[0], sc[1]); b.y = pk2(sc[2], sc[3]); *(LAS u32x2*)(STR + fr * 136 + 16 * jt + 4 * fq) = b;
    }
    __syncthreads();
    bf16x8 sA[4];
#pragma unroll
    for (int k = 0; k < 4; ++k) sA[k] = ldf(STR, 136, 0, 32 * k, lane);
    const float qfs = __expf(lg * (float)(ii + 1));
    f32x4 o[8]; float ssq = 0.f;
#pragma unroll
    for (int et = 0; et < 8; ++et) {
        f32x4 a = F4Z, a2 = F4Z;
#pragma unroll
        for (int k = 0; k < 4; ++k) { a = mma(a, ldf(VT, 136, 16 * et, 32 * k, lane), sA[k]); a2 = mma(a2, ldf(ST, 136, 16 * et, 32 * k, lane), qA[k]); }
        o[et] = a + a2 * qfs;
        ssq += (o[et][0] * o[et][0] + o[et][1] * o[et][1]) + (o[et][2] * o[et][2] + o[et][3] * o[et][3]);
    }
    ssq += __shfl_xor(ssq, 16); ssq += __shfl_xor(ssq, 32);
    const float rinv = rsqrtf(ssq * (1.f / 128.f) + 1e-6f);
#pragma unroll
    for (int et = 0; et < 8; ++et) {
        const int ch = h * 128 + 16 * et + 4 * fq;
        const u32x2 gg = *(const u32x2*)(P + (size_t)(t0 + ii) * P0LD + C_G + ch);
        u32x2 b; b.x = pk2(o[et][0] * rinv * siluf_(bflo(gg.x)), o[et][1] * rinv * siluf_(bfhi(gg.x))); b.y = pk2(o[et][2] * rinv * siluf_(bflo(gg.y)), o[et][3] * rinv * siluf_(bfhi(gg.y)));
        *(u32x2*)(Y + (size_t)(t0 + ii) * D + ch) = b;
    }
    __syncthreads();
}
__device__ __forceinline__ void l0_output(const Ctx& C) {
    for (int u = C.bid; u < 256; u += C.G) mamba_out_unit(C, u >> 1, u & 1);
    for (int u = C.bid; u < 512; u += C.G) ret_out_unit(C, u >> 2, u & 3);
}

constexpr size_t WS_WLOG = WS_ST, WS_AA = WS_ST + 16 * MiB, WS_GG = WS_WGU1, WS_PC = WS_Y;
constexpr size_t WS_LA = WS_LRUC, WS_HC = WS_LRUC + 512 * 1024, WS_HIN = WS_LRUC + 1024 * 1024;
constexpr int SW_WAT = 0, SW_WXT = 65536, SW_W2T = 131072, SW_A2T = 163840, SW_G2T = 196608;
__device__ __forceinline__ bf16_t* gg_row(unsigned char* ws, int t) { return (bf16_t*)(ws + WS_GG) + (size_t)t * 512; }
__device__ __forceinline__ float tanhf_(float x) { return 1.f - 2.f * frcp(1.f + __expf(2.f * x)); }

__device__ __forceinline__ void rwkv_prep(const Ctx& C, int c) {
    const bf16_t* P = (const bf16_t*)(C.ws + WS_HP); const bf16_t* SW = (const bf16_t*)(C.ws + WS_SMALLW);
    bf16_t* WLOG = (bf16_t*)(C.ws + WS_WLOG); bf16_t* AA = (bf16_t*)(C.ws + WS_AA);
    LAS bf16_t* TW = (LAS bf16_t*)C.lds; LAS bf16_t* AL = TW + 64 * 72; LAS bf16_t* SG = AL + 64 * 72;
    const float* mu = C.in[27];
    const int t0 = 64 * c, lane = C.lane, fr = lane & 15, fq = lane >> 4;
#pragma unroll 12
    for (int idx = C.tid; idx < 64 * 288; idx += 512) {
        const int tok = idx / 288, cc = idx % 288, col = 2560 + cc, t = t0 + tok;
        const float cur = bf2f(P[(size_t)t * P1LD + col]), prev = t > 0 ? bf2f(P[(size_t)(t - 1) * P1LD + col]) : 0.f;
        const float s = cur + (prev - cur) * mu[col - 1024];
        if (cc < 64) TW[tok * 72 + cc] = f2bf(tanhf_(s)); else if (cc < 128) AL[tok * 72 + cc - 64] = f2bf(s); else SG[tok * 168 + cc - 128] = f2bf(sigmoidf_(s));
    }
    __syncthreads();
    const int n0 = 64 * C.wave;
#pragma unroll 1
    for (int which = 0; which < 2; ++which) {
        const bf16_t* BT = SW + (which == 0 ? SW_W2T : SW_A2T); const LAS bf16_t* AM = which == 0 ? TW : AL;
        const float* bias = which == 0 ? C.in[28] : C.in[30]; bf16_t* O = which == 0 ? WLOG : AA;
#pragma unroll
        for (int nt = 0; nt < 4; ++nt) {
            const bf16x8 nf0 = ldfg(BT, 64, n0 + 16 * nt, 0, lane), nf1 = ldfg(BT, 64, n0 + 16 * nt, 32, lane);
            const int n = n0 + 16 * nt + 4 * fq; const f32x4 bv = *(const f32x4*)(bias + n);
#pragma unroll
            for (int mt = 0; mt < 4; ++mt) {
                f32x4 acc = F4Z; acc = mma(acc, nf0, ldf(AM, 72, 16 * mt, 0, lane)); acc = mma(acc, nf1, ldf(AM, 72, 16 * mt, 32, lane));
                float o[4];
#pragma unroll
                for (int v = 0; v < 4; ++v) { const float x = acc[v] + bv[v]; o[v] = which == 0 ? -__expf(-softplus_fast(-x) - 0.5f) : sigmoidf_(x); }
                u32x2 b; b.x = pk2(o[0], o[1]); b.y = pk2(o[2], o[3]);
                *(u32x2*)(O + (size_t)(t0 + 16 * mt + fr) * 512 + n) = b;
            }
        }
    }
#pragma unroll 2
    for (int nt = 0; nt < 4; ++nt) {
        bf16x8 nf[5];
#pragma unroll
        for (int k = 0; k < 5; ++k) nf[k] = ldfg(SW + SW_G2T, 160, n0 + 16 * nt, 32 * k, lane);
        const int n = n0 + 16 * nt + 4 * fq;
#pragma unroll
        for (int mt = 0; mt < 4; ++mt) {
            f32x4 acc = F4Z;
#pragma unroll
            for (int k = 0; k < 5; ++k) acc = mma(acc, nf[k], ldf(SG, 168, 16 * mt, 32 * k, lane));
#ifdef GG_CONSTVAL
            acc = (f32x4){0.5f, 0.25f, -0.5f, 1.f};
#endif
            u32x2 b; b.x = pk2(acc[0], acc[1]); b.y = pk2(acc[2], acc[3]);
            *(u32x2*)(gg_row(C.ws, t0 + 16 * mt + fr) + n) = b;
        }
    }
    asm volatile("s_waitcnt vmcnt(0)" ::: "memory");
    __threadfence_block();
    __syncthreads();
}

#ifndef RW1_SB_SK
#define RW1_SB_SK 0
#endif
#ifndef RW1_SB_MAIN
#define RW1_SB_MAIN 2
#endif
template <int PASS>
__device__ __forceinline__ void rwkv_chunk(const Ctx& C, int c) {
    const bf16_t* P = (const bf16_t*)(C.ws + WS_HP);
    const bf16_t* WLOG = (const bf16_t*)(C.ws + WS_WLOG); const bf16_t* AA = (const bf16_t*)(C.ws + WS_AA);
    float* PC = (float*)(C.ws + WS_PC); float* UC = C.X; bf16_t* Y = (bf16_t*)(C.ws + WS_Y);
    LAS float* VW = (LAS float*)(C.lds + 40960); LAS float* VKK = VW + 4096; LAS float* VB = VKK + 4096; LAS float* VK = VB + 4096; LAS float* VR = VK + 4096; LAS float* VV = VR + 4096; LAS float* VG = VV + 4096; LAS float* VBON = VG + 4096;
    const int t0 = 64 * c, lane = C.lane, head = C.wave, ch = C.tid;
    const float* mu = C.in[27];
    f32x2 SU[32], SP[32];
    if (PASS == 1) {
#pragma unroll
        for (int k = 0; k < 32; ++k) { SU[k] = (f32x2){0.f, 0.f}; SP[k] = (f32x2){(2 * k == lane) ? 1.f : 0.f, (2 * k + 1 == lane) ? 1.f : 0.f}; }
    } else {
        const f32x4* src = (const f32x4*)(UC + ((size_t)(c * 8 + head) * 64 + lane) * 64);
#pragma unroll
        for (int k4 = 0; k4 < 16; ++k4) { f32x4 v = src[k4];
#ifdef RW3_ZERO
            v = F4Z;
#endif
            SU[2 * k4] = (f32x2){v[0], v[1]}; SU[2 * k4 + 1] = (f32x2){v[2], v[3]}; }
    }
    float pr = 0.f, pk = 0.f, pv = 0.f;
    if (t0 > 0) { const bf16_t* row = P + (size_t)(t0 - 1) * P1LD; pr = bf2f(row[1024 + ch]); pk = bf2f(row[1536 + ch]); pv = bf2f(row[2048 + ch]); }
#pragma unroll 1
    for (int sb = 0; sb < 8; ++sb) {
        const float mu_r = mu[ch], mu_k = mu[512 + ch], mu_v = mu[1024 + ch], kkc = C.in[33][ch], kac = C.in[34][ch], rkc = C.in[35][ch];
        constexpr int UF = PASS == 3 ? 8 : 4;
#pragma unroll 1
        for (int j0 = 0; j0 < 8; j0 += UF) {
            float cr[UF], ck[UF], cv[UF], aa[UF], wl[UF], gg[UF];
#pragma unroll
            for (int u = 0; u < UF; ++u) {
                const int t = t0 + 8 * sb + j0 + u; const bf16_t* row = P + (size_t)t * P1LD;
                ck[u] = bf2f(row[1536 + ch]); cv[u] = bf2f(row[2048 + ch]); aa[u] = bf2f(AA[(size_t)t * 512 + ch]); wl[u] = bf2f(WLOG[(size_t)t * 512 + ch]);
                if (PASS == 3) { cr[u] = bf2f(row[1024 + ch]); gg[u] = bf2f(gg_row(C.ws, t)[ch]); }
            }
            float kkr[UF], kp[UF], nrm[UF], bon[UF], rsv[UF];
#pragma unroll
            for (int u = 0; u < UF; ++u) {
                const float ks = ck[u] + (pk - ck[u]) * mu_k, vs = cv[u] + (pv - cv[u]) * mu_v; pk = ck[u]; pv = cv[u];
                kkr[u] = ks * kkc; nrm[u] = kkr[u] * kkr[u]; kp[u] = ks * (1.f + (aa[u] - 1.f) * kac);
                VV[(j0 + u) * 512 + ch] = vs; VK[(j0 + u) * 512 + ch] = kp[u]; VW[(j0 + u) * 512 + ch] = __expf(wl[u]);
                if (PASS == 3) { rsv[u] = cr[u] + (pr - cr[u]) * mu_r; pr = cr[u]; bon[u] = rsv[u] * kp[u] * rkc; VR[(j0 + u) * 512 + ch] = rsv[u]; VG[(j0 + u) * 512 + ch] = gg[u]; }
            }
#pragma unroll
            for (int u = 0; u < UF; ++u) { nrm[u] = wave_sum_dpp(nrm[u]); if (PASS == 3) bon[u] = wave_sum_dpp(bon[u]); }
#pragma unroll
            for (int u = 0; u < UF; ++u) {
                const float kk = kkr[u] * rsqrtf(fmaxf(nrm[u], 1e-24f));
                VKK[(j0 + u) * 512 + ch] = kk; VB[(j0 + u) * 512 + ch] = kk * aa[u];
                if (PASS == 3) { if (lane == 0) VBON[(j0 + u) * 8 + head] = bon[u]; }
            }
        }
        __syncthreads();
#pragma unroll 1
        for (int j = 0; j < 8; ++j) {
            const LAS f32x4* pw = (const LAS f32x4*)(VW + j * 512 + head * 64); const LAS f32x4* pkk = (const LAS f32x4*)(VKK + j * 512 + head * 64);
            const LAS f32x4* pb = (const LAS f32x4*)(VB + j * 512 + head * 64); const LAS f32x4* pkp = (const LAS f32x4*)(VK + j * 512 + head * 64);
            const LAS f32x4* prr = (const LAS f32x4*)(VR + j * 512 + head * 64);
#define LO2(v) __builtin_shufflevector(v, v, 0, 1)
#define HI2(v) __builtin_shufflevector(v, v, 2, 3)
#define FMA2(a, b, c) __builtin_elementwise_fma(a, b, c)
            f32x2 aU0 = {0.f, 0.f}, aU1 = {0.f, 0.f}, aP0 = {0.f, 0.f}, aP1 = {0.f, 0.f};
            {
                f32x4 q = pkk[0];
#pragma unroll
                for (int g = 0; g < 16; ++g) {
                    f32x4 qn = q; if (g + 1 < 16) qn = pkk[g + 1];
                    aU0 = FMA2(SU[2 * g], LO2(q), aU0); aU1 = FMA2(SU[2 * g + 1], HI2(q), aU1);
                    if (PASS == 1) { aP0 = FMA2(SP[2 * g], LO2(q), aP0); aP1 = FMA2(SP[2 * g + 1], HI2(q), aP1); }
                    q = qn;
#if RW1_SB_SK == 1
                    if (PASS == 1) __builtin_amdgcn_sched_barrier(0);
#elif RW1_SB_SK == 4
                    if (PASS == 1 && (g & 3) == 3) __builtin_amdgcn_sched_barrier(0);
#endif
                }
            }
            float skU = (aU0[0] + aU0[1]) + (aU1[0] + aU1[1]); const float skP = (aP0[0] + aP0[1]) + (aP1[0] + aP1[1]);
#ifdef PROBE_VALU
            if (PASS == 3) { f32x2 d0 = {0.f, 0.f}, d1 = {0.f, 0.f}; const f32x2 cc = {1.0001f, 0.9999f};
#pragma unroll
                for (int g = 0; g < 32; ++g) { d0 = FMA2(SU[g], cc, d0); d1 = FMA2(SU[g], d0, d1); }
                skU += 1e-37f * ((d0[0] + d0[1]) + (d1[0] + d1[1])); }
#endif
#ifdef PROBE_LDS
            if (PASS == 3) { f32x4 d0 = F4Z;
#pragma unroll
                for (int g = 0; g < 16; ++g) d0 += pkp[g];
                skU += 1e-37f * ((d0[0] + d0[1]) + (d0[2] + d0[3])); }
#endif
            const float vv = VV[j * 512 + ch];
            const f32x2 nsU = {-skU, -skU}, nsP = {-skP, -skP}, vv2 = {vv, vv};
            f32x2 y0 = {0.f, 0.f}, y1 = {0.f, 0.f};
            {
                f32x4 w4 = pw[0], b4 = pb[0], k4 = pkp[0], r4 = F4Z; if (PASS == 3) r4 = prr[0];
#pragma unroll
                for (int g = 0; g < 16; ++g) {
                    f32x4 nw = w4, nb = b4, nk = k4, nr = r4;
                    if (g + 1 < 16) { nw = pw[g + 1]; nb = pb[g + 1]; nk = pkp[g + 1]; if (PASS == 3) nr = prr[g + 1]; }
                    SU[2 * g] = FMA2(SU[2 * g], LO2(w4), FMA2(nsU, LO2(b4), vv2 * LO2(k4)));
                    SU[2 * g + 1] = FMA2(SU[2 * g + 1], HI2(w4), FMA2(nsU, HI2(b4), vv2 * HI2(k4)));
                    if (PASS == 1) { SP[2 * g] = FMA2(SP[2 * g], LO2(w4), nsP * LO2(b4)); SP[2 * g + 1] = FMA2(SP[2 * g + 1], HI2(w4), nsP * HI2(b4)); }
                    if (PASS == 3) { y0 = FMA2(SU[2 * g], LO2(r4), y0); y1 = FMA2(SU[2 * g + 1], HI2(r4), y1); }
                    w4 = nw; b4 = nb; k4 = nk; r4 = nr;
#if RW1_SB_MAIN == 1
                    if (PASS == 1) __builtin_amdgcn_sched_barrier(0);
#elif RW1_SB_MAIN == 4
                    if (PASS == 1 && (g & 3) == 3) __builtin_amdgcn_sched_barrier(0);
#elif RW1_SB_MAIN == 2
                    if (PASS == 1 && (g & 1) == 1) __builtin_amdgcn_sched_barrier(0);
#endif
                }
            }
            const float y = (y0[0] + y0[1]) + (y1[0] + y1[1]);
            if (PASS == 3) VKK[j * 512 + ch] = y;
        }
        if (PASS == 3) {
            const float lng = C.in[36][ch], lnb = C.in[37][ch];
            float y[8], s1[8], s2[8];
#pragma unroll
            for (int u = 0; u < 8; ++u) { y[u] = VKK[u * 512 + ch]; s1[u] = y[u]; }
#pragma unroll
            for (int u = 0; u < 8; ++u) s1[u] = wave_sum_dpp(s1[u]);
#pragma unroll
            for (int u = 0; u < 8; ++u) { y[u] -= s1[u] * (1.f / 64.f); s2[u] = y[u] * y[u]; }
#pragma unroll
            for (int u = 0; u < 8; ++u) s2[u] = wave_sum_dpp(s2[u]);
#pragma unroll
            for (int u = 0; u < 8; ++u) {
                const float yn = y[u] * rsqrtf(s2[u] * (1.f / 64.f) + 64e-5f) * lng + lnb;
                Y[(size_t)(t0 + 8 * sb + u) * D + 512 + ch] = f2bf((yn + VBON[u * 8 + head] * VV[u * 512 + ch]) * VG[u * 512 + ch]);
            }
        }
        __syncthreads();
    }
    if (PASS == 1) {
        f32x4* du = (f32x4*)(UC + ((size_t)(c * 8 + head) * 64 + lane) * 64); f32x4* dp = (f32x4*)(PC + ((size_t)(c * 8 + head) * 64 + lane) * 64);
#pragma unroll
        for (int k4 = 0; k4 < 16; ++k4) { du[k4] = (f32x4){SU[2 * k4][0], SU[2 * k4][1], SU[2 * k4 + 1][0], SU[2 * k4 + 1][1]}; dp[k4] = (f32x4){SP[2 * k4][0], SP[2 * k4][1], SP[2 * k4 + 1][0], SP[2 * k4 + 1][1]}; }
    }
}

template <int PASS>
__device__ __forceinline__ void lru_chunk(const Ctx& C, int c) {
    const bf16_t* P = (const bf16_t*)(C.ws + WS_HP); const bf16_t* SW = (const bf16_t*)(C.ws + WS_SMALLW); bf16_t* Y = (bf16_t*)(C.ws + WS_Y);
    LAS bf16_t* XC = (LAS bf16_t*)C.lds; LAS bf16_t* LAB = (LAS bf16_t*)(C.lds + 66560);
    const int t0 = 64 * c, lane = C.lane, fr = lane & 15, fq = lane >> 4;
    {
        const int grp = C.tid & 63, seg = C.tid >> 6, ch0 = 8 * grp, r0 = 8 * seg;
        const float* cw = C.in[20]; const float* cb = C.in[21];
        float w0[8], w1[8], w2[8], w3[8], bb[8], x0[8], x1[8], x2[8];
#pragma unroll
        for (int i = 0; i < 8; ++i) { w0[i] = cw[ch0 + i]; w1[i] = cw[512 + ch0 + i]; w2[i] = cw[1024 + ch0 + i]; w3[i] = cw[1536 + ch0 + i]; bb[i] = cb[ch0 + i]; }
        auto ldrow = [&](int t, float (&x)[8]) {
            if (t < 0) {
#pragma unroll
                for (int i = 0; i < 8; ++i) x[i] = 0.f;
            } else {
                const u32x4 a = *(const u32x4*)(P + (size_t)t * P1LD + ch0);
#pragma unroll
                for (int i = 0; i < 4; ++i) { x[2 * i] = bflo(a[i]); x[2 * i + 1] = bfhi(a[i]); }
            }
        };
        ldrow(t0 + r0 - 3, x0); ldrow(t0 + r0 - 2, x1); ldrow(t0 + r0 - 1, x2);
#pragma unroll
        for (int row = r0; row < r0 + 8; ++row) {
            float x3[8], v[8]; ldrow(t0 + row, x3);
#pragma unroll
            for (int i = 0; i < 8; ++i) { v[i] = bb[i] + w0[i] * x0[i] + w1[i] * x1[i] + w2[i] * x2[i] + w3[i] * x3[i]; x0[i] = x1[i]; x1[i] = x2[i]; x2[i] = x3[i]; }
            u32x4 w; w.x = pk2(v[0], v[1]); w.y = pk2(v[2], v[3]); w.z = pk2(v[4], v[5]); w.w = pk2(v[6], v[7]);
            *(LAS u32x4*)(XC + row * 520 + ch0) = w;
        }
    }
    __syncthreads();
    const int nb = C.wave >> 1, eh = C.wave & 1, cbase = nb * 128 + 64 * eh;
    unsigned ur[4][4][2];
#pragma unroll
    for (int nth = 0; nth < 2; ++nth) {
        bf16x8 wfa[2][4], wfx[2][4];
#pragma unroll
        for (int n2 = 0; n2 < 2; ++n2)
#pragma unroll
            for (int k = 0; k < 4; ++k) { wfa[n2][k] = ldfg(SW + SW_WAT + nb * 16384, 128, 64 * eh + 16 * (2 * nth + n2), 32 * k, lane); wfx[n2][k] = ldfg(SW + SW_WXT + nb * 16384, 128, 64 * eh + 16 * (2 * nth + n2), 32 * k, lane); }
        f32x4 bav[2], bxv[2], sp8[2];
#pragma unroll
        for (int n2 = 0; n2 < 2; ++n2) { const int chn = cbase + 16 * (2 * nth + n2) + 4 * fq; bav[n2] = *(const f32x4*)(C.in[23] + chn); bxv[n2] = *(const f32x4*)(C.in[25] + chn); const f32x4 lam = *(const f32x4*)(C.in[26] + chn);
#pragma unroll
            for (int v = 0; v < 4; ++v) sp8[n2][v] = -8.f * softplusf_(-lam[v]); }
#pragma unroll
        for (int mt = 0; mt < 4; ++mt) {
            bf16x8 mf[4];
#pragma unroll
            for (int k = 0; k < 4; ++k) mf[k] = ldf(XC, 520, 16 * mt, nb * 128 + 32 * k, lane);
#pragma unroll
            for (int n2 = 0; n2 < 2; ++n2) {
                const int nt = 2 * nth + n2, chn = cbase + 16 * nt + 4 * fq;
                f32x4 aa = F4Z, ax = F4Z;
#pragma unroll
                for (int k = 0; k < 4; ++k) { aa = mma(aa, wfa[n2][k], mf[k]); ax = mma(ax, wfx[n2][k], mf[k]); }
                const u32x2 xw = *(const LAS u32x2*)(XC + (16 * mt + fr) * 520 + chn);
                const float xc[4] = {bflo(xw.x), bfhi(xw.x), bflo(xw.y), bfhi(xw.y)};
                float la[4], uu[4];
#pragma unroll
                for (int v = 0; v < 4; ++v) { const float r = sigmoidf_(aa[v] + bav[n2][v]), ig = sigmoidf_(ax[v] + bxv[n2][v]); la[v] = sp8[n2][v] * r; uu[v] = __builtin_amdgcn_sqrtf(fmaxf(1.f - __expf(2.f * la[v]), 0.f)) * ig * xc[v];     }
                *(LAS u32x2*)(LAB + (16 * mt + fr) * 512 + chn) = (u32x2){pk2(la[0], la[1]), pk2(la[2], la[3])};
                ur[mt][nt][0] = pk2(uu[0], uu[1]); ur[mt][nt][1] = pk2(uu[2], uu[3]);
            }
            __builtin_amdgcn_sched_barrier(0);
        }
    }
    __syncthreads();
#pragma unroll
    for (int mt = 0; mt < 4; ++mt)
#pragma unroll
        for (int nt = 0; nt < 4; ++nt) *(LAS u32x2*)(XC + (16 * mt + fr) * 520 + cbase + 16 * nt + 4 * fq) = (u32x2){ur[mt][nt][0], ur[mt][nt][1]};
    __syncthreads();
    {
        const int ch = C.tid;
        float* LA = (float*)(C.ws + WS_LA); float* HC = (float*)(C.ws + WS_HC); const float* HIN = (const float*)(C.ws + WS_HIN);
        float h = PASS == 3 ? HIN[c * 512 + ch] : 0.f, sla = 0.f;
        if (PASS == 3) {
            float gbv[64];
#pragma unroll
            for (int tok = 0; tok < 64; ++tok) gbv[tok] = bf2f(P[(size_t)(t0 + tok) * P1LD + 512 + ch]);
#pragma unroll
            for (int tok = 0; tok < 64; ++tok) {
                const float la = bf2f(LAB[tok * 512 + ch]), u = bf2f(XC[tok * 520 + ch]);
                h = fmaf(__expf(la), h, u);
                const float gb = gbv[tok], ge = 0.5f * gb * (1.f + tanhf_(0.7978845608028654f * (gb + 0.044715f * gb * gb * gb)));
                Y[(size_t)(t0 + tok) * D + ch] = f2bf(h * ge);
            }
        } else {
#pragma unroll 8
            for (int tok = 0; tok < 64; ++tok) {
                const float la = bf2f(LAB[tok * 512 + ch]), u = bf2f(XC[tok * 520 + ch]);
                h = fmaf(__expf(la), h, u); sla += la;
            }
        }
        if (PASS == 1) { LA[c * 512 + ch] = sla; HC[c * 512 + ch] = h; }
    }
    __syncthreads();
}

__device__ __forceinline__ void l1_pass_a(const Ctx& C) {
#ifndef SKIP_PREP
    for (int c = C.bid; c < 256; c += C.G) rwkv_prep(C, c);
#endif
#ifndef SKIP_RW1
    for (int c = C.bid; c < 256; c += C.G) rwkv_chunk<1>(C, c);
#ifdef PROBE_RW1X2
    for (int c = C.bid; c < 256; c += C.G) rwkv_chunk<1>(C, c);
#endif
#endif
#ifndef SKIP_LRU1
    for (int c = C.bid; c < 256; c += C.G) lru_chunk<1>(C, c);
#endif
}
__device__ __forceinline__ void l1_pass_c(const Ctx& C) {
#ifndef SKIP_RW3
    for (int c = C.bid; c < 256; c += C.G) rwkv_chunk<3>(C, c);
#ifdef PROBE_RW3X2
    for (int c = C.bid; c < 256; c += C.G) rwkv_chunk<3>(C, c);
#endif
#endif
#ifndef SKIP_LRU3
    for (int c = C.bid; c < 256; c += C.G) lru_chunk<3>(C, c);
#ifdef PROBE_LRU3X2
    for (int c = C.bid; c < 256; c += C.G) lru_chunk<3>(C, c);
#endif
#endif
}

__device__ __forceinline__ void l1_middle(const Ctx& C) {
    const float* PC = (const float*)(C.ws + WS_PC); float* UC = C.X;
    const int lane = C.lane;
#ifndef SKIP_MID
    if (C.bid < 128 && C.G >= 128) {
        const int head = C.bid >> 4, row = (C.bid & 15) * 4 + (C.wave & 3); const bool rowwave = C.wave < 4;
        LAS float* SR = (LAS float*)(C.lds + C.wave * 256); LAS float* RING = (LAS float*)(C.lds + 4096);
        const float* pcb = PC + (size_t)head * 4096 + C.tid * 8;
        float* ub = UC + ((size_t)head * 64 + row) * 64 + lane;
        float s = 0.f; SR[lane] = 0.f;
        f32x4 qa0, qb0, qa1, qb1, qa2, qb2, qa3, qb3; float u0, u1, u2, u3;
#define MID_LD(qa, qb, cc) do { const f32x4* p_ = (const f32x4*)(pcb + (size_t)(cc) * 32768); qa = p_[0]; qb = p_[1]; } while (0)
#define MID_ST(qa, qb, cc) do { LAS f32x4* d_ = (LAS f32x4*)(RING + ((cc) & 7) * 4096 + C.tid * 8); d_[0] = qa; d_[1] = qb; } while (0)
        MID_LD(qa0, qb0, 0); MID_LD(qa1, qb1, 1); MID_LD(qa2, qb2, 2); MID_LD(qa3, qb3, 3);
        MID_ST(qa0, qb0, 0); MID_ST(qa1, qb1, 1); MID_ST(qa2, qb2, 2); MID_ST(qa3, qb3, 3);
        MID_LD(qa0, qb0, 4); MID_LD(qa1, qb1, 5); MID_LD(qa2, qb2, 6); MID_LD(qa3, qb3, 7);
        u0 = ub[0]; u1 = ub[32768]; u2 = ub[2 * 32768]; u3 = ub[3 * 32768];
        __syncthreads();
#define MID_STEP(cc, qa, qb, uu) do { \
            if (rowwave) { const LAS float* P_ = RING + ((cc) & 7) * 4096 + lane; \
            float a0 = 0.f, a1 = 0.f, a2 = 0.f, a3 = 0.f; \
            _Pragma("unroll") for (int i4 = 0; i4 < 16; ++i4) { const f32x4 s4 = *(const LAS f32x4*)(SR + 4 * i4); \
                a0 = fmaf(s4[0], P_[(4 * i4) * 64], a0); a1 = fmaf(s4[1], P_[(4 * i4 + 1) * 64], a1); a2 = fmaf(s4[2], P_[(4 * i4 + 2) * 64], a2); a3 = fmaf(s4[3], P_[(4 * i4 + 3) * 64], a3); } \
            ub[(size_t)(cc) * 32768] = s;                      \
            s = uu + ((a0 + a1) + (a2 + a3)); SR[lane] = s; } \
            if ((cc) + 4 < 256) { MID_ST(qa, qb, (cc) + 4); if (rowwave) uu = ub[(size_t)((cc) + 4) * 32768]; } \
            if ((cc) + 8 < 256) MID_LD(qa, qb, (cc) + 8); } while (0)
#pragma unroll 1
        for (int c = 0; c < 256; c += 4) { MID_STEP(c, qa0, qb0, u0); MID_STEP(c + 1, qa1, qb1, u1); MID_STEP(c + 2, qa2, qb2, u2); MID_STEP(c + 3, qa3, qb3, u3); __syncthreads(); }
#undef MID_LD
#undef MID_ST
#undef MID_STEP
    }
#endif
    if (C.bid == (C.G > 128 ? 128 : 0)) {
        const float* LA = (const float*)(C.ws + WS_LA); const float* HC = (const float*)(C.ws + WS_HC); float* HIN = (float*)(C.ws + WS_HIN);
        const int ch = C.tid; float h = 0.f;
        for (int c0 = 0; c0 < 256; c0 += 32) { float la[32], hc[32];
#pragma unroll
            for (int j = 0; j < 32; ++j) { la[j] = LA[(c0 + j) * 512 + ch]; hc[j] = HC[(c0 + j) * 512 + ch]; }
#pragma unroll
            for (int j = 0; j < 32; ++j) { HIN[(c0 + j) * 512 + ch] = h; h = fmaf(__expf(la[j]), h, hc[j]); } }
    }
}

#define XB_TMO      128
#define XB_XCNT(j)  (256  + 64 * (j))
#define XB_XSUB(j)  (1280 + 64 * (j))
#define XB_XGEN(j)  (2304 + 64 * (j))
#define XB_TOP      3328
#define XB_TOPGEN   3392
#define XCD_BAR_WORDS 3456
#define XB_SPIN_CAP (1u << 18)

__device__ __forceinline__ unsigned xb_ld(unsigned* p)              { return __hip_atomic_load(p, __ATOMIC_RELAXED, __HIP_MEMORY_SCOPE_AGENT); }
__device__ __forceinline__ unsigned xb_add(unsigned* p, unsigned v) { return __hip_atomic_fetch_add(p, v, __ATOMIC_RELAXED, __HIP_MEMORY_SCOPE_AGENT); }
__device__ __forceinline__ unsigned xb_xcc_id() { return (unsigned)__builtin_amdgcn_s_getreg((3 << 11) | 20) & 0xFu; }
#define XB_SPIN(cond, bar) do { unsigned _sp = 0; while (cond) { __builtin_amdgcn_s_sleep(1); \
    if ((++_sp & 255u) == 0u) { if (xb_ld(&(bar)[XB_TMO])) break; if (_sp > XB_SPIN_CAP) { atomicAdd(&(bar)[XB_TMO], 1u); break; } } } } while (0)

struct XcdBarrier {
    unsigned* bar; unsigned x;
    volatile LAS unsigned* st;
};

__device__ __forceinline__ XcdBarrier xcd_barrier_post(unsigned* bar, volatile LAS unsigned* st) {
    XcdBarrier b; b.bar = bar; b.x = xb_xcc_id(); b.st = st;
    if (threadIdx.x == 0) (void)xb_add(&bar[XB_XCNT(b.x)], 1u);
    return b;
}
__device__ __forceinline__ void xcd_barrier_complete(unsigned* bar, unsigned x, unsigned& nloc, unsigned& nx) {
    const unsigned G = gridDim.x * gridDim.y * gridDim.z;
    unsigned sum, cnt, mine, sp = 0u;
    for (;;) {
        sum = 0u; cnt = 0u; mine = 0u;
#pragma unroll
        for (unsigned j = 0; j < 16; ++j) { const unsigned c = xb_ld(&bar[XB_XCNT(j)]); sum += c; cnt += (c > 0u) ? 1u : 0u; mine = (j == x) ? c : mine; }
        if (sum == G) break;
        __builtin_amdgcn_s_sleep(1);
        if ((++sp & 255u) == 0u) { if (xb_ld(&bar[XB_TMO])) break; if (sp > XB_SPIN_CAP) { atomicAdd(&bar[XB_TMO], 1u); break; } }
    }
    nloc = mine > 0u ? mine : 1u; nx = cnt > 0u ? cnt : 1u;
}

__device__ __forceinline__ void xcd_barrier(const XcdBarrier& b) {
    asm volatile("s_waitcnt vmcnt(0)" ::: "memory");
    __syncthreads();
    if (threadIdx.x == 0) {
        unsigned* bar = b.bar;
        __builtin_amdgcn_s_waitcnt(0);
        unsigned nloc = b.st[0], nx = b.st[1];
        if (nloc == 0u) { xcd_barrier_complete(bar, b.x, nloc, nx); b.st[0] = nloc; b.st[1] = nx; }
        const unsigned old = xb_add(&bar[XB_XSUB(b.x)], 1u);
        const unsigned gen = old / nloc;
        if (old + 1u == (gen + 1u) * nloc) {
            __builtin_amdgcn_fence(__ATOMIC_RELEASE, "agent");
            asm volatile("s_waitcnt vmcnt(0)" ::: "memory");
            const unsigned og = xb_add(&bar[XB_TOP], 1u);
            const unsigned tg = og / nx;
            if (og + 1u == (tg + 1u) * nx) xb_add(&bar[XB_TOPGEN], 1u);
            else XB_SPIN(xb_ld(&bar[XB_TOPGEN]) == tg, bar);
            __builtin_amdgcn_fence(__ATOMIC_ACQUIRE, "agent");
            xb_add(&bar[XB_XGEN(b.x)], 1u);
            asm volatile("s_waitcnt vmcnt(0)" ::: "memory");
        } else {
            XB_SPIN(xb_ld(&bar[XB_XGEN(b.x)]) == gen, bar);
            __builtin_amdgcn_fence(__ATOMIC_ACQUIRE, "agent");
            asm volatile("s_waitcnt vmcnt(0)" ::: "memory");
        }
    }
    __syncthreads();
}

struct Args { const float* in[39]; float* out; unsigned char* ws; int ph_lo, ph_hi; };
constexpr int N_PHASES = 20;

__device__ __forceinline__ void ffn_gu(const Ctx& C, LAS unsigned char* lds, size_t wgu, int site) {
    pg8::Gemm g{(const bf16_t*)(C.ws + WS_XB), (const bf16_t*)(C.ws + wgu), T, 2 * FF, D}; pg8::StaticOrder S; S.init(T, 2 * FF, C.G, C.bid);
    EpiSwiglu E{(bf16_t*)(C.ws + WS_HP), (const float*)(C.ws + WS_SSQ) + (size_t)site * T * 16, (LAS float*)(C.lds + 131072)};
    pg8::gemm_phase<EpiSwiglu, pg8::StaticOrder, true, true>(lds, g, S, E);
}
__device__ __forceinline__ void ffn_down(const Ctx& C, LAS unsigned char* lds, size_t wd, int site_out, float alpha = 0.5f) {
    pg8::Gemm g{(const bf16_t*)(C.ws + WS_HP), (const bf16_t*)(C.ws + wd), T, D, FF}; pg8::StaticOrder S; S.init(T, D, C.G, C.bid);
    EpiResid E{(bf16_t*)(C.ws + WS_XB), (float*)(C.ws + WS_SSQ) + (size_t)site_out * T * 16, alpha};
    pg8::gemm_phase<EpiResid, pg8::StaticOrder, true, true>(lds, g, S, E);
}
__device__ __forceinline__ void out_proj(const Ctx& C, LAS unsigned char* lds, int site_out) {
    pg8::Gemm g{(const bf16_t*)(C.ws + WS_Y), (const bf16_t*)(C.ws + WS_WOUT), T, D, D}; pg8::StaticOrder S; S.init(T, D, C.G, C.bid);
    EpiResid E{(bf16_t*)(C.ws + WS_XB), (float*)(C.ws + WS_SSQ) + (size_t)site_out * T * 16, 1.0f};
    pg8::gemm_phase<EpiResid, pg8::StaticOrder, true, true>(lds, g, S, E);
}


__device__ __forceinline__ void grid_bar(unsigned* ctr, unsigned target, int tid) {
    asm volatile("s_waitcnt vmcnt(0)" ::: "memory");
    __syncthreads();
    if (tid == 0) {
        __builtin_amdgcn_fence(__ATOMIC_RELEASE, "agent");
        asm volatile("s_waitcnt vmcnt(0)" ::: "memory");
        __hip_atomic_fetch_add(ctr, 1u, __ATOMIC_RELAXED, __HIP_MEMORY_SCOPE_AGENT);
        const unsigned long long t0 = __builtin_amdgcn_s_memrealtime();
        while (__hip_atomic_load(ctr, __ATOMIC_RELAXED, __HIP_MEMORY_SCOPE_AGENT) < target) {
            __builtin_amdgcn_s_sleep(2);
            if (__builtin_amdgcn_s_memrealtime() - t0 > 50000000ull) break;
        }
        __builtin_amdgcn_fence(__ATOMIC_ACQUIRE, "agent");
        asm volatile("s_waitcnt vmcnt(0)" ::: "memory");
    }
    __syncthreads();
}

__global__ void __launch_bounds__(512) mk_fwd(Args args) {
    extern __shared__ __attribute__((aligned(16))) unsigned char lds_raw[];
    cg::grid_group grid = cg::this_grid();
    Ctx C; C.in = args.in; C.X = args.out; C.ws = args.ws; C.lds = (LAS unsigned char*)lds_raw;
    C.tid = threadIdx.x; C.lane = C.tid & 63; C.wave = __builtin_amdgcn_readfirstlane(C.tid >> 6); C.G = gridDim.x; C.bid = blockIdx.x; C.cv_b0 = 0; C.cv_nb = C.G;
    LAS unsigned char* lds = C.lds;
    const int lo = args.ph_lo, hi = args.ph_hi;
#define IN(k) (lo <= (k) && (k) < hi)
#ifndef REP_MASK
#define REP_MASK 0
#endif
#define REPS(k) (((REP_MASK >> (k)) & 1) ? 2 : 1)
#ifdef PROBE_SEAMX2
#define SEAM_EXTRA grid.sync(); if (C.wave == 0) { __builtin_amdgcn_fence(__ATOMIC_ACQUIRE, "agent"); asm volatile("s_waitcnt vmcnt(0)" ::: "memory"); } __syncthreads();
#else
#define SEAM_EXTRA
#endif
#define SEAM(k) do { if (IN(k) && IN((k) + 1)) xcd_barrier(xbar); } while (0)
    if (lo < 0) grid.sync();
    volatile LAS unsigned* xst = (volatile LAS unsigned*)(C.lds + 163824);
    if (C.tid == 0) { xst[0] = 0u; xst[1] = 0u; }
    __syncthreads();
    const XcdBarrier xbar = xcd_barrier_post((unsigned*)C.ws, xst);

#define TAIL_CONVERT(layer, which) do { if (C.G == 256) { if (C.bid >= 128) { __syncthreads(); C.cv_b0 = 128; C.cv_nb = 128; convert_weights(C, (layer), (which)); C.cv_b0 = 0; C.cv_nb = C.G; } } \
    else { __syncthreads(); convert_weights(C, (layer), (which)); } } while (0)

    if (IN(0)) {
#define PROLOGUE_BODY convert_weights(C, 0, 1); bf16_t* sw = (bf16_t*)(C.ws + WS_SMALLW); for (int n = 0; n < 4; ++n) { tr_small(C, C.in[22] + n * 16384, 128, 128, sw + n * 16384); tr_small(C, C.in[24] + n * 16384, 128, 128, sw + 65536 + n * 16384); } tr_small(C, C.in[29], 64, 512, sw + 131072); tr_small(C, C.in[31], 64, 512, sw + 163840); tr_small(C, C.in[32], 160, 512, sw + 196608); prologue_x(C);
        PROLOGUE_BODY
        if (REPS(0) == 2) { PROLOGUE_BODY }
    }
    SEAM(0);
    if (IN(1)) { ffn_gu(C, lds, WS_WGU1, 0); if (REPS(1) == 2) ffn_gu(C, lds, WS_WGU1, 0); TAIL_CONVERT(0, 6); }
    SEAM(1);
    if (IN(2)) { ffn_down(C, lds, WS_WD1, 1, 0.5f); if (REPS(2) == 2) ffn_down(C, lds, WS_WD1, 1, 0.f); }
    SEAM(2);
    if (IN(3)) {
        pg8::Gemm g{(const bf16_t*)(C.ws + WS_XB), (const bf16_t*)(C.ws + WS_WIN), T, 3584, D}; pg8::StaticOrder S; S.init(T, 3584, C.G, C.bid);
        EpiProj E{(bf16_t*)(C.ws + WS_HP), P0LD, 3328, (const float*)(C.ws + WS_SSQ) + (size_t)1 * T * 16, (float*)(C.ws + WS_DT), 3328, (LAS float*)(C.lds + 131072)};
        pg8::gemm_phase<EpiProj, pg8::StaticOrder, true, true>(lds, g, S, E);
        if (REPS(3) == 2) pg8::gemm_phase<EpiProj, pg8::StaticOrder, true, true>(lds, g, S, E);
    }
    SEAM(3);
    #ifndef SKIP4
    if (IN(4)) { l0_states(C); if (REPS(4) == 2) l0_states(C); }
#endif
    SEAM(4);
    #ifndef SKIP5
    if (IN(5)) l0_scan(C);
#endif
    SEAM(5);
    #ifndef SKIP6
    if (IN(6)) { l0_output(C); if (REPS(6) == 2) l0_output(C); }
#endif
    SEAM(6);
    if (IN(7)) out_proj(C, lds, 2);
    SEAM(7);
    if (IN(8)) { ffn_gu(C, lds, WS_WGU2, 2); TAIL_CONVERT(1, 1); }
    SEAM(8);
    if (IN(9)) ffn_down(C, lds, WS_WD2, 3);
    SEAM(9);
    if (IN(10)) { ffn_gu(C, lds, WS_WGU1, 3); TAIL_CONVERT(1, 6); }
    SEAM(10);
    if (IN(11)) ffn_down(C, lds, WS_WD1, 4);
    SEAM(11);
    if (IN(12)) {
        pg8::Gemm g{(const bf16_t*)(C.ws + WS_XB), (const bf16_t*)(C.ws + WS_WIN), T, 3072, D}; pg8::StaticOrder S; S.init(T, 3072, C.G, C.bid);
        EpiProj E{(bf16_t*)(C.ws + WS_HP), P1LD, 2848, (const float*)(C.ws + WS_SSQ) + (size_t)4 * T * 16, nullptr, -1, (LAS float*)(C.lds + 131072)};
        pg8::gemm_phase<EpiProj, pg8::StaticOrder, true, true>(lds, g, S, E);
    }
    SEAM(12);
    if (IN(13)) { l1_pass_a(C); if (REPS(13) == 2) l1_pass_a(C); }
    SEAM(13);
    if (IN(14)) l1_middle(C);
    SEAM(14);
    if (IN(15)) { l1_pass_c(C); if (REPS(15) == 2) l1_pass_c(C); }
    SEAM(15);
    if (IN(16)) out_proj(C, lds, 5);
    SEAM(16);
    if (IN(17)) ffn_gu(C, lds, WS_WGU2, 5);
    SEAM(17);
    if (IN(18)) ffn_down(C, lds, WS_WD2, 6);
    SEAM(18);
    if (IN(19)) final_norm(C);
#undef IN
#undef SEAM
}

extern "C" void kernel_launch(void* const* d_in, const int* in_sizes, int n_in, void* d_out, int out_size, void* d_ws, size_t ws_size, hipStream_t stream) {
    static int grid = 0;
    if (grid == 0) {
        if (n_in != 39 || out_size != T * D || ws_size < WS_END) { fprintf(stderr, "kernel_launch: unexpected problem: n_in %d out %d ws %zu\n", n_in, out_size, ws_size); grid = -1; return; }
        int dev = 0, cus = 0, per_cu = 0;
        hipGetDevice(&dev); hipDeviceGetAttribute(&cus, hipDeviceAttributeMultiprocessorCount, dev);
        if (hipFuncSetAttribute((const void*)mk_fwd, hipFuncAttributeMaxDynamicSharedMemorySize, LDS_BYTES) != hipSuccess) { fprintf(stderr, "kernel_launch: hipFuncSetAttribute failed\n"); grid = -1; return; }
        if (hipOccupancyMaxActiveBlocksPerMultiprocessor(&per_cu, (const void*)mk_fwd, 512, LDS_BYTES) != hipSuccess || per_cu < 1) { fprintf(stderr, "kernel_launch: occupancy query says %d\n", per_cu); per_cu = 1; (void)hipGetLastError(); }
        grid = cus * (per_cu > 1 ? 1 : per_cu);
    }
    if (grid < 0) return;
    if (hipMemsetAsync(d_ws, 0, 16384, stream) != hipSuccess) { fprintf(stderr, "kernel_launch: memset of the barrier word failed\n"); return; }
    Args a{};
    for (int i = 0; i < 39; ++i) a.in[i] = (const float*)d_in[i];
    a.out = (float*)d_out; a.ws = (unsigned char*)d_ws; a.ph_lo = 0; a.ph_hi = N_PHASES;
    void* kargs[] = {&a};
    hipError_t e = hipLaunchCooperativeKernel((const void*)mk_fwd, dim3(grid), dim3(512), kargs, LDS_BYTES, stream);
    if (e != hipSuccess) fprintf(stderr, "kernel_launch: cooperative launch failed: %s (grid %d)\n", hipGetErrorString(e), grid);
}
```

```cpp
#include <hip/hip_runtime.h>
#include <hip/hip_cooperative_groups.h>
#include <cstdio>
#include <cstdint>
namespace cg = cooperative_groups;
namespace pg8 {
#define PG8_LAS __attribute__((address_space(3)))
typedef unsigned short bf16_t;
typedef short bf16x8 __attribute__((ext_vector_type(8)));
typedef float f32x4 __attribute__((ext_vector_type(4)));
typedef unsigned u32x4 __attribute__((ext_vector_type(4)));
constexpr int BM = 256, BK = 64, HALF = 128, HTB = HALF * BK * 2  , STAGE_BYTES = 8 * HTB, NXCD = 8, WGM = 8;

__host__ __device__ __forceinline__ int lds_byte(int r, int c) { const int st = (r >> 4) * 2 + (c >> 5), rr = r & 15, cc = c & 31, ob = rr * 64 + cc * 2; return st * 1024 + (ob ^ (((ob >> 9) & 1) << 5)); }
__host__ __device__ __forceinline__ void stage_rc(int b, int& R, int& C) { const int st = b / 1024, sb = b % 1024, swz = sb ^ (((sb >> 9) & 1) << 5); R = (st >> 1) * 16 + swz / 64; C = (st & 1) * 32 + (swz % 64) / 2; }
__host__ __device__ __forceinline__ int perm32(int rho) { const int n = rho >> 4, i = rho & 15; return 8 * (i >> 2) + 4 * n + (i & 3); }

struct Unit { int pm, pn; };
struct Gemm { const bf16_t* A; const bf16_t* Bt; int M, N, K; };

struct StaticOrder {
    int nM, nN, nwg, G, c;
    __host__ __device__ void init(int M, int N, int G_, int c_) { nM = M / BM; nN = N / BM; nwg = nM * nN; G = G_; c = c_; }
    __host__ __device__ bool next(int i, Unit& u) const {
        const long L = (long)i * G + c; if (L >= nwg) return false;
        int wgid = (int)L; { const int q = nwg / NXCD, r = nwg % NXCD, xcd = wgid % NXCD, off = wgid / NXCD; wgid = (xcd < r ? xcd * (q + 1) : r * (q + 1) + (xcd - r) * q) + off; }
        const int nig = WGM * nN, gid = wgid / nig, fm = gid * WGM, gsz = (nM - fm) < WGM ? (nM - fm) : WGM;
        u.pm = fm + ((wgid % nig) % gsz); u.pn = (wgid % nig) / gsz; return true;
    }
    __device__ __forceinline__ void a_ready(const Unit&) const {}
    __device__ __forceinline__ void done(const Unit&) const {}
};
__device__ __forceinline__ unsigned cvt_pk_bf16(float lo, float hi) { unsigned r; asm volatile("v_cvt_pk_bf16_f32 %0, %1, %2" : "=v"(r) : "v"(lo), "v"(hi)); return r; }
template <class Epi, class Sched, bool ALIGN_EPI = false, bool SP2 = false>
__device__ __forceinline__ void gemm_phase(PG8_LAS unsigned char* lds, const Gemm g, const Sched& S, const Epi& E) {
    const int tid = threadIdx.x, wid = __builtin_amdgcn_readfirstlane(tid >> 6), lane = tid & 63, wr = wid >> 2, wc = wid & 3, fr = lane & 15, fq = lane >> 4;
    const int K = g.K, nt = K / BK;
    unsigned voffA[2], voffB[2];
#pragma unroll
    for (int i = 0; i < 2; ++i) { int R, C; stage_rc(tid * 16 + i * 8192, R, C); const int Rb = Epi::PERM ? ((R & ~31) + perm32(R & 31)) : R;
        voffA[i] = (unsigned)(R * K + C) * 2u; voffB[i] = (unsigned)(Rb * K + C) * 2u; }
    const size_t kstep = (size_t)(BK * 2);
    const size_t hstep = (size_t)HALF * K * 2;
    const size_t tstep = 2 * hstep;
    const unsigned ldsw = (unsigned)wid * 1024u;
    const int aoff = lds_byte(wr * 64 + fr, fq * 8), boff = lds_byte(wc * 32 + fr, fq * 8);
#define PG8_SA(b, h) (((b) * 2 + (h)) * HTB)
#define PG8_SB(b, h) ((4 + (b) * 2 + (h)) * HTB)
#define PG8_STAGE(bufoff, gbase, voff) do { _Pragma("unroll") for (int _i = 0; _i < 2; ++_i) \
        __builtin_amdgcn_global_load_lds((const unsigned*)((const char*)(gbase) + (voff)[_i]), (PG8_LAS unsigned*)(lds + (bufoff) + ldsw + _i * 8192), 16, 0, 0); } while (0)
#define PG8_LDA(dst, b, h) do { _Pragma("unroll") for (int m = 0; m < 4; ++m) _Pragma("unroll") for (int k = 0; k < 2; ++k) dst[m][k] = *(const PG8_LAS bf16x8*)(lds + PG8_SA(b, h) + aoff + m * 2048 + k * 1024); } while (0)
#define PG8_LDB(dst, b, h) do { _Pragma("unroll") for (int n = 0; n < 2; ++n) _Pragma("unroll") for (int k = 0; k < 2; ++k) dst[n][k] = *(const PG8_LAS bf16x8*)(lds + PG8_SB(b, h) + boff + n * 2048 + k * 1024); } while (0)
#define PG8_MMA(ai, bj, At, Bt) do { __builtin_amdgcn_s_setprio(1); _Pragma("unroll") for (int m = 0; m < 4; ++m) _Pragma("unroll") for (int n = 0; n < 2; ++n) _Pragma("unroll") for (int k = 0; k < 2; ++k) \
        acc[ai][bj][m][n] = __builtin_amdgcn_mfma_f32_16x16x32_bf16(Bt[n][k], At[m][k], acc[ai][bj][m][n], 0, 0, 0); __builtin_amdgcn_s_setprio(0); } while (0)
#define PG8_WAIT_V(n) asm volatile("s_waitcnt vmcnt(" #n ")" ::: "memory")
#define PG8_WAIT_L(n) asm volatile("s_waitcnt lgkmcnt(" #n ")" ::: "memory")
#define PG8_BAR __builtin_amdgcn_s_barrier()
#define PG8_SCHED __builtin_amdgcn_sched_barrier(0)
    Unit cur, nxt; int ui = 0;
    if (!S.next(0, cur)) return;
    f32x4 acc[2][2][4][2];
#pragma unroll
    for (int a = 0; a < 2; ++a)
#pragma unroll
        for (int b = 0; b < 2; ++b)
#pragma unroll
            for (int m = 0; m < 4; ++m)
#pragma unroll
                for (int n = 0; n < 2; ++n) acc[a][b][m][n] = (f32x4){0.f, 0.f, 0.f, 0.f};
    bf16x8 At[4][2], B0[2][2], B1[2][2];
    const char* cA = (const char*)g.A + (size_t)cur.pm * tstep; const char* cB = (const char*)g.Bt + (size_t)cur.pn * tstep;
    S.a_ready(cur);
    if constexpr (SP2) {
        PG8_STAGE(PG8_SB(0, 0), cB, voffB); PG8_STAGE(PG8_SB(0, 1), cB + hstep, voffB); PG8_STAGE(PG8_SA(0, 0), cA, voffA); PG8_STAGE(PG8_SA(0, 1), cA + hstep, voffA);
        if (wr == 1) PG8_BAR;
        PG8_WAIT_V(2); PG8_BAR;
        PG8_STAGE(PG8_SB(1, 0), cB + kstep, voffB); PG8_STAGE(PG8_SA(1, 0), cA + kstep, voffA); PG8_STAGE(PG8_SB(1, 1), cB + hstep + kstep, voffB);
        PG8_WAIT_V(6); PG8_BAR;
    } else {
        PG8_STAGE(PG8_SB(0, 0), cB, voffB); PG8_STAGE(PG8_SA(0, 0), cA, voffA); PG8_STAGE(PG8_SB(0, 1), cB + hstep, voffB); PG8_STAGE(PG8_SA(0, 1), cA + hstep, voffA);
        if (wr == 1) PG8_BAR;
        PG8_WAIT_V(4); PG8_BAR;
        PG8_STAGE(PG8_SB(1, 0), cB + kstep, voffB); PG8_STAGE(PG8_SA(1, 0), cA + kstep, voffA); PG8_STAGE(PG8_SB(1, 1), cB + hstep + kstep, voffB);
        PG8_WAIT_V(6); PG8_BAR;
    }
    for (;;) {
        const bool has_next = S.next(ui + 1, nxt);
        const char* nA = has_next ? (const char*)g.A + (size_t)nxt.pm * tstep : cA; const char* nB = has_next ? (const char*)g.Bt + (size_t)nxt.pn * tstep : cB;
        for (int t = 0; t < nt; t += 2) {
            const bool last = (t == nt - 2);
            const char* a1 = cA + (size_t)(t + 1) * kstep;
            const char* a2 = last ? nA : cA + (size_t)(t + 2) * kstep; const char* b2 = last ? nB : cB + (size_t)(t + 2) * kstep;
            const char* a3 = a2 + kstep; const char* b3 = b2 + kstep;
            if (last && has_next) S.a_ready(nxt);
            if constexpr (SP2) {
            PG8_LDB(B0, 0, 0); PG8_LDB(B1, 0, 1); PG8_SCHED; PG8_LDA(At, 0, 0); PG8_STAGE(PG8_SA(1, 1), a1 + hstep, voffA);
            PG8_WAIT_V(8); PG8_WAIT_L(0); PG8_BAR; PG8_MMA(0, 0, At, B0); PG8_MMA(0, 1, At, B1); PG8_BAR; PG8_SCHED;
            PG8_LDA(At, 0, 1); PG8_STAGE(PG8_SB(0, 0), b2, voffB); PG8_STAGE(PG8_SB(0, 1), b2 + hstep, voffB); PG8_STAGE(PG8_SA(0, 0), a2, voffA);
            PG8_WAIT_V(8); PG8_WAIT_L(0); PG8_BAR; PG8_MMA(1, 0, At, B0); PG8_MMA(1, 1, At, B1); PG8_BAR; PG8_SCHED;
            PG8_LDB(B0, 1, 0); PG8_LDB(B1, 1, 1); PG8_SCHED; PG8_LDA(At, 1, 0); PG8_STAGE(PG8_SA(0, 1), a2 + hstep, voffA);
            PG8_WAIT_V(8); PG8_WAIT_L(0); PG8_BAR; PG8_MMA(0, 0, At, B0); PG8_MMA(0, 1, At, B1); PG8_BAR; PG8_SCHED;
            PG8_LDA(At, 1, 1); PG8_STAGE(PG8_SB(1, 0), b3, voffB); PG8_STAGE(PG8_SB(1, 1), b3 + hstep, voffB); PG8_STAGE(PG8_SA(1, 0), a3, voffA);
            PG8_WAIT_V(8); PG8_WAIT_L(0); PG8_BAR; PG8_MMA(1, 0, At, B0); PG8_MMA(1, 1, At, B1); PG8_BAR; PG8_SCHED;
            } else {
            PG8_LDB(B0, 0, 0); PG8_SCHED; PG8_LDA(At, 0, 0); PG8_STAGE(PG8_SA(1, 1), a1 + hstep, voffA);
            PG8_WAIT_L(8); PG8_BAR; PG8_WAIT_L(0); PG8_MMA(0, 0, At, B0); PG8_BAR; PG8_SCHED;
            PG8_LDB(B1, 0, 1); PG8_STAGE(PG8_SB(0, 0), b2, voffB);
            PG8_BAR; PG8_WAIT_L(0); PG8_MMA(0, 1, At, B1); PG8_BAR;
            PG8_LDA(At, 0, 1); PG8_STAGE(PG8_SA(0, 0), a2, voffA);
            PG8_BAR; PG8_WAIT_L(0); PG8_MMA(1, 0, At, B0); PG8_BAR; PG8_SCHED;
            PG8_STAGE(PG8_SB(0, 1), b2 + hstep, voffB);
            PG8_WAIT_V(6); PG8_BAR; PG8_MMA(1, 1, At, B1); PG8_BAR;
            PG8_LDB(B0, 1, 0); PG8_SCHED; PG8_LDA(At, 1, 0); PG8_STAGE(PG8_SA(0, 1), a2 + hstep, voffA);
            PG8_WAIT_L(8); PG8_BAR; PG8_WAIT_L(0); PG8_MMA(0, 0, At, B0); PG8_BAR; PG8_SCHED;
            PG8_LDB(B1, 1, 1); PG8_STAGE(PG8_SB(1, 0), b3, voffB);
            PG8_BAR; PG8_WAIT_L(0); PG8_MMA(0, 1, At, B1); PG8_BAR;
            PG8_LDA(At, 1, 1); PG8_STAGE(PG8_SA(1, 0), a3, voffA);
            PG8_BAR; PG8_WAIT_L(0); PG8_MMA(1, 0, At, B0); PG8_BAR; PG8_SCHED;
            PG8_STAGE(PG8_SB(1, 1), b3 + hstep, voffB);
            PG8_WAIT_V(6); PG8_BAR; PG8_MMA(1, 1, At, B1); PG8_BAR;
            }
        }
        if constexpr (ALIGN_EPI) { if (wr == 0) PG8_BAR; }
        if constexpr (!Epi::AFTER_DRAIN) { E(acc, cur, wr, wc, fr, fq); S.done(cur); }
        if (!has_next) break;
#pragma unroll
        for (int a = 0; a < 2; ++a)
#pragma unroll
            for (int b = 0; b < 2; ++b)
#pragma unroll
                for (int m = 0; m < 4; ++m)
#pragma unroll
                    for (int n = 0; n < 2; ++n) acc[a][b][m][n] = (f32x4){0.f, 0.f, 0.f, 0.f};
        cur = nxt; cA = nA; cB = nB; ++ui;
        if constexpr (ALIGN_EPI) { if (wr == 1) PG8_BAR; }
    }
    PG8_WAIT_V(0);
    if constexpr (!ALIGN_EPI) { if (wr == 0) PG8_BAR; }
    PG8_BAR;
    if constexpr (Epi::AFTER_DRAIN) { E.fused(acc, cur, wr, wc, fr, fq, lds, wid, lane); S.done(cur); }
#undef PG8_SA
#undef PG8_SB
#undef PG8_STAGE
#undef PG8_LDA
#undef PG8_LDB
#undef PG8_MMA
#undef PG8_WAIT_V
#undef PG8_WAIT_L
#undef PG8_BAR
#undef PG8_SCHED
}
}

#define LAS __attribute__((address_space(3)))
typedef unsigned short bf16_t;
typedef short bf16x8 __attribute__((ext_vector_type(8)));
typedef float f32x4 __attribute__((ext_vector_type(4)));
typedef float f32x2 __attribute__((ext_vector_type(2)));
typedef unsigned u32x4 __attribute__((ext_vector_type(4)));
typedef unsigned u32x2 __attribute__((ext_vector_type(2)));

constexpr int T = 16384, D = 1024, FF = 2816;
constexpr int P0LD = 3328, P1LD = 2880;
constexpr int C_Q = 0, C_K = 512, C_V = 1024, C_G = 1536, C_Z = 2048, C_XBC = 2560;
constexpr size_t MiB = 1u << 20;
constexpr size_t WS_SSQ = 247 * MiB, WS_DT = 512 * 1024, WS_LRUC = 1 * MiB, WS_CHD = 2 * MiB + 512 * 1024, WS_SMALLW = 3 * MiB;
constexpr size_t WS_WGU1 = 4 * MiB, WS_WD1 = 15 * MiB, WS_WIN = 21 * MiB, WS_WOUT = 28 * MiB, WS_WGU2 = 30 * MiB, WS_WD2 = 41 * MiB;
constexpr size_t WS_XB = 47 * MiB, WS_Y = 79 * MiB, WS_HP = 111 * MiB, WS_ST = 215 * MiB, WS_END = 255 * MiB;
constexpr int LDS_BYTES = 163840;

typedef float f32x2_t __attribute__((ext_vector_type(2)));
typedef __bf16 bf16x2_t __attribute__((ext_vector_type(2)));
__device__ __forceinline__ unsigned pk2(float lo, float hi) { f32x2_t v = {lo, hi}; bf16x2_t b = __builtin_convertvector(v, bf16x2_t); return __builtin_bit_cast(unsigned, b); }
__device__ __forceinline__ unsigned short f2bf(float f) { return (unsigned short)(pk2(f, 0.f) & 0xffffu); }
__device__ __forceinline__ float bflo(unsigned w) { return __uint_as_float(w << 16); }
__device__ __forceinline__ float bfhi(unsigned w) { return __uint_as_float(w & 0xffff0000u); }
__device__ __forceinline__ float bf2f(unsigned short h) { return __uint_as_float(((unsigned)h) << 16); }
__device__ __forceinline__ float frcp(float x) { return __builtin_amdgcn_rcpf(x); }
__device__ __forceinline__ float sigmoidf_(float x) { return frcp(1.f + __expf(-x)); }
__device__ __forceinline__ float siluf_(float x) { return x * frcp(1.f + __expf(-x)); }
__device__ __forceinline__ float softplusf_(float x) { return x > 20.f ? x : log1pf(__expf(x)); }
__device__ __forceinline__ float softplus_fast(float x) { return x > 20.f ? x : __logf(1.f + __expf(x)); }
__device__ __forceinline__ float wave_sum(float v) {
#pragma unroll
    for (int o = 1; o < 64; o <<= 1) v += __shfl_xor(v, o);
    return v;
}
__device__ __forceinline__ float wave_sum_dpp(float v) {
    v += __builtin_bit_cast(float, __builtin_amdgcn_update_dpp(0, __builtin_bit_cast(int, v), 0x111, 0xf, 0xf, true));
    v += __builtin_bit_cast(float, __builtin_amdgcn_update_dpp(0, __builtin_bit_cast(int, v), 0x112, 0xf, 0xf, true));
    v += __builtin_bit_cast(float, __builtin_amdgcn_update_dpp(0, __builtin_bit_cast(int, v), 0x114, 0xf, 0xf, true));
    v += __builtin_bit_cast(float, __builtin_amdgcn_update_dpp(0, __builtin_bit_cast(int, v), 0x118, 0xf, 0xf, true));
    v += __builtin_bit_cast(float, __builtin_amdgcn_update_dpp(0, __builtin_bit_cast(int, v), 0x142, 0xa, 0xf, false));
    v += __builtin_bit_cast(float, __builtin_amdgcn_update_dpp(0, __builtin_bit_cast(int, v), 0x143, 0xc, 0xf, false));
    return __builtin_bit_cast(float, __builtin_amdgcn_readlane(__builtin_bit_cast(int, v), 63));
}
__device__ __forceinline__ f32x4 mma(f32x4 acc, bf16x8 nfrag, bf16x8 mfrag) { return __builtin_amdgcn_mfma_f32_16x16x32_bf16(nfrag, mfrag, acc, 0, 0, 0); }
__device__ __forceinline__ bf16x8 ldf(const LAS bf16_t* base, int stride, int row0, int k0, int lane) { return *(const LAS bf16x8*)(base + (row0 + (lane & 15)) * stride + k0 + 8 * (lane >> 4)); }
__device__ __forceinline__ bf16x8 ldfg(const bf16_t* base, int stride, int row0, int k0, int lane) { return *(const bf16x8*)(base + (size_t)(row0 + (lane & 15)) * stride + k0 + 8 * (lane >> 4)); }
#define F4Z ((f32x4){0.f, 0.f, 0.f, 0.f})
__device__ __forceinline__ float ssq_row(const float* ssq, int row) {
    float s = 0.f;
#pragma unroll
    for (int k = 0; k < 16; ++k) s += ssq[(size_t)k * T + row];
    return s;
}

struct Ctx {
    const float* const* in; float* X; unsigned char* ws; LAS unsigned char* lds;
    int tid, lane, wave, G, bid;
    int cv_b0, cv_nb;
};

__device__ __forceinline__ void tr_item(const float* W, int K, int N, bf16_t* WT, const float* gain, int k0, int n0, int drow0, LAS float* scr, int lane) {
    const int nn = n0 + (lane & 31);
    float wv[32];
#pragma unroll
    for (int i = 0; i < 32; ++i) { const int kk = 2 * i + (lane >> 5); wv[i] = (nn < N) ? W[(size_t)(k0 + kk) * N + nn] : 0.f; }
#pragma unroll
    for (int i = 0; i < 32; ++i) { const int kk = 2 * i + (lane >> 5); float v = wv[i]; if (gain) v *= gain[k0 + kk]; scr[kk * 33 + (lane & 31)] = v; }
    asm volatile("s_waitcnt lgkmcnt(0)" ::: "memory");
    const int c = lane & 7;
#pragma unroll
    for (int j = 0; j < 4; ++j) { const int n = (lane >> 3) + 8 * j; const LAS float* s = scr + (8 * c) * 33 + n;
        u32x4 o; o.x = pk2(s[0 * 33], s[1 * 33]); o.y = pk2(s[2 * 33], s[3 * 33]); o.z = pk2(s[4 * 33], s[5 * 33]); o.w = pk2(s[6 * 33], s[7 * 33]);
        if (n0 + n < N) *(u32x4*)(WT + (size_t)(drow0 + n) * K + k0 + 8 * c) = o; }
    asm volatile("s_waitcnt lgkmcnt(0)" ::: "memory");
}
__device__ __forceinline__ void tr_matrix(const Ctx& C, const float* W, int K, int N, bf16_t* WT, const float* gain, int mode, int& base) {
    LAS float* scr = (LAS float*)(C.lds + C.wave * 8448);
    const int nblk = (N + 31) / 32, nitems = (K / 64) * nblk, gw = (C.bid - C.cv_b0) * 8 + C.wave, ngw = C.cv_nb * 8;
    int first = (gw - (base % ngw) + ngw) % ngw;
    for (int it = first; it < nitems; it += ngw) {
        const int kb = it / nblk, nb = it % nblk, n0 = 32 * nb;
        const int drow0 = mode == 0 ? n0 : ((n0 >> 7) * 256 + (n0 & 127) + (mode == 2 ? 128 : 0));
        tr_item(W, K, N, WT, gain, 64 * kb, n0, drow0, scr, C.lane);
    }
    base += nitems;
}
__device__ __forceinline__ void convert_weights(const Ctx& C, int layer, int which) {
    int base = 0; unsigned char* ws = C.ws;
    if (which & 1) {
        tr_matrix(C, C.in[2] + (size_t)layer * D * FF, D, FF, (bf16_t*)(ws + WS_WGU1), C.in[1] + layer * D, 1, base);
        tr_matrix(C, C.in[3] + (size_t)layer * D * FF, D, FF, (bf16_t*)(ws + WS_WGU1), C.in[1] + layer * D, 2, base);
        tr_matrix(C, C.in[4] + (size_t)layer * D * FF, FF, D, (bf16_t*)(ws + WS_WD1), nullptr, 0, base);
    }
    if (which & 2) {
        if (layer == 0) { tr_matrix(C, C.in[10], D, 3336, (bf16_t*)(ws + WS_WIN), C.in[5], 0, base); tr_matrix(C, C.in[11], D, D, (bf16_t*)(ws + WS_WOUT), nullptr, 0, base); }
        else            { tr_matrix(C, C.in[18], D, 2848, (bf16_t*)(ws + WS_WIN), C.in[5] + D, 0, base); tr_matrix(C, C.in[19], D, D, (bf16_t*)(ws + WS_WOUT), nullptr, 0, base); }
    }
    if (which & 4) {
        tr_matrix(C, C.in[7] + (size_t)layer * D * FF, D, FF, (bf16_t*)(ws + WS_WGU2), C.in[6] + layer * D, 1, base);
        tr_matrix(C, C.in[8] + (size_t)layer * D * FF, D, FF, (bf16_t*)(ws + WS_WGU2), C.in[6] + layer * D, 2, base);
        tr_matrix(C, C.in[9] + (size_t)layer * D * FF, FF, D, (bf16_t*)(ws + WS_WD2), nullptr, 0, base);
    }
}
__device__ __forceinline__ void tr_small(const Ctx& C, const float* W, int K, int N, bf16_t* WT) {
    for (int idx = C.bid * 512 + C.tid; idx < K * N; idx += C.G * 512) { const int n = idx / K, k = idx % K; WT[idx] = f2bf(W[(size_t)k * N + n]); }
}

__device__ __forceinline__ void panel_rscale(const float* ssq, LAS float* rs, int pm) {
    asm volatile("s_waitcnt lgkmcnt(0)" ::: "memory"); __builtin_amdgcn_s_barrier(); asm volatile("" ::: "memory");
    if (threadIdx.x < 256) rs[threadIdx.x] = rsqrtf(ssq_row(ssq, pm * 256 + (int)threadIdx.x) * (1.f / D) + 1e-6f);
    asm volatile("s_waitcnt lgkmcnt(0)" ::: "memory"); __builtin_amdgcn_s_barrier(); asm volatile("" ::: "memory");
}

struct EpiSwiglu {
    static constexpr bool PERM = true, AFTER_DRAIN = false;
    bf16_t* H; const float* ssq; LAS float* rs;
    __device__ __forceinline__ void operator()(const f32x4 (&acc)[2][2][4][2], const pg8::Unit& u, int wr, int wc, int fr, int fq) const {
        panel_rscale(ssq, rs, u.pm);
        const int row0 = u.pm * 256 + wr * 64 + fr, col0 = u.pn * 128 + wc * 32 + 8 * fq;
#pragma unroll
        for (int ai = 0; ai < 2; ++ai)
#pragma unroll
            for (int m = 0; m < 4; ++m) {
                const int row = row0 + ai * 128 + m * 16; const float r = rs[wr * 64 + fr + ai * 128 + m * 16];
                float h[8];
#pragma unroll
                for (int n = 0; n < 2; ++n)
#pragma unroll
                    for (int v = 0; v < 4; ++v) { const float g = acc[ai][0][m][n][v] * r, up = acc[ai][1][m][n][v] * r; h[4 * n + v] = siluf_(g) * up; }
                u32x4 w; w.x = pk2(h[0], h[1]); w.y = pk2(h[2], h[3]); w.z = pk2(h[4], h[5]); w.w = pk2(h[6], h[7]);
                *(u32x4*)(H + (size_t)row * FF + col0) = w;
            }
    }
};
struct EpiResid {
    static constexpr bool PERM = true, AFTER_DRAIN = false;
    bf16_t* XB; float* ssq_out; float alpha;
    __device__ __forceinline__ void operator()(const f32x4 (&acc)[2][2][4][2], const pg8::Unit& u, int wr, int wc, int fr, int fq) const {
        const int row0 = u.pm * 256 + wr * 64 + fr, col0 = u.pn * 256 + wc * 32 + 8 * fq;
#pragma unroll
        for (int ai = 0; ai < 2; ++ai)
#pragma unroll
            for (int m = 0; m < 4; ++m) {
                const int row = row0 + ai * 128 + m * 16; float s = 0.f;
#pragma unroll
                for (int bj = 0; bj < 2; ++bj) {
                    const size_t off = (size_t)row * D + col0 + bj * 128;
                    const u32x4 xo = *(const u32x4*)(XB + off);
                    const f32x4 a0 = acc[ai][bj][m][0] * alpha, a1 = acc[ai][bj][m][1] * alpha;
                    u32x4 bq; bq.x = pk2(bflo(xo.x) + a0[0], bfhi(xo.x) + a0[1]); bq.y = pk2(bflo(xo.y) + a0[2], bfhi(xo.y) + a0[3]);
                    bq.z = pk2(bflo(xo.z) + a1[0], bfhi(xo.z) + a1[1]); bq.w = pk2(bflo(xo.w) + a1[2], bfhi(xo.w) + a1[3]);
                    *(u32x4*)(XB + off) = bq;
#pragma unroll
                    for (int q = 0; q < 4; ++q) { const float x0 = bflo(bq[q]), x1 = bfhi(bq[q]); s += x0 * x0 + x1 * x1; }
                }
                s += __shfl_xor(s, 16); s += __shfl_xor(s, 32);
                if (fq == 0) ssq_out[(size_t)(u.pn * 4 + wc) * T + row] = s;
            }
    }
};
struct EpiProj {
    static constexpr bool PERM = true, AFTER_DRAIN = false;
    bf16_t* P; int ldp, ncols; const float* ssq; float* DT; int dt_col0; LAS float* rs;
    __device__ __forceinline__ void operator()(const f32x4 (&acc)[2][2][4][2], const pg8::Unit& u, int wr, int wc, int fr, int fq) const {
        panel_rscale(ssq, rs, u.pm);
        const int row0 = u.pm * 256 + wr * 64 + fr, col0 = u.pn * 256 + wc * 32 + 8 * fq;
#pragma unroll
        for (int ai = 0; ai < 2; ++ai)
#pragma unroll
            for (int m = 0; m < 4; ++m) {
                const int row = row0 + ai * 128 + m * 16; const float r = rs[wr * 64 + fr + ai * 128 + m * 16];
#pragma unroll
                for (int bj = 0; bj < 2; ++bj) {
                    const int c = col0 + bj * 128; const f32x4 v0 = acc[ai][bj][m][0] * r, v1 = acc[ai][bj][m][1] * r;
                    if (c + 8 <= ncols) { u32x4 w; w.x = pk2(v0[0], v0[1]); w.y = pk2(v0[2], v0[3]); w.z = pk2(v1[0], v1[1]); w.w = pk2(v1[2], v1[3]); *(u32x4*)(P + (size_t)row * ldp + c) = w; }
                    else if (DT && c == dt_col0) { *(f32x4*)(DT + (size_t)row * 8) = v0; *(f32x4*)(DT + (size_t)row * 8 + 4) = v1; }
                }
            }
    }
};

__device__ __forceinline__ void prologue_x(const Ctx& C) {
    const float* x = C.in[0]; bf16_t* XB = (bf16_t*)(C.ws + WS_XB); float* ssq = (float*)(C.ws + WS_SSQ);
    const int gw = C.bid * 8 + C.wave, ngw = C.G * 8;
#pragma unroll 4
    for (int m = gw; m < T; m += ngw) {
        const f32x4* xr = (const f32x4*)(x + (size_t)m * D) + C.lane; u32x2* brow = (u32x2*)(XB + (size_t)m * D) + C.lane;
        float s = 0.f;
#pragma unroll
        for (int j = 0; j < 4; ++j) { const f32x4 v = xr[64 * j]; u32x2 q; q.x = pk2(v[0], v[1]); q.y = pk2(v[2], v[3]); brow[64 * j] = q; const float x0 = bflo(q.x), x1 = bfhi(q.x), x2 = bflo(q.y), x3 = bfhi(q.y); s += (x0 * x0 + x1 * x1) + (x2 * x2 + x3 * x3); }
        s = wave_sum(s);
        if (C.lane == 0) ssq[m] = s;
    }
    for (int i = C.bid * 512 + C.tid; i < 15 * T; i += C.G * 512) ssq[T + i] = 0.f;
}
__device__ __forceinline__ void final_norm(const Ctx& C) {
    const float* ssq = (const float*)(C.ws + WS_SSQ) + (size_t)6 * T * 16; const float* g = C.in[38];
    const int gw = C.bid * 8 + C.wave, ngw = C.G * 8;
    f32x4 gv[4];
#pragma unroll
    for (int j = 0; j < 4; ++j) gv[j] = ((const f32x4*)g)[C.lane + 64 * j];
    const bf16_t* XB = (const bf16_t*)(C.ws + WS_XB);
#pragma unroll 4
    for (int m = gw; m < T; m += ngw) {
        const u32x2* br = (const u32x2*)(XB + (size_t)m * D) + C.lane; f32x4* orow = (f32x4*)(C.X + (size_t)m * D) + C.lane; const float r = rsqrtf(ssq_row(ssq, m) * (1.f / D) + 1e-6f);
#pragma unroll
        for (int j = 0; j < 4; ++j) { const u32x2 q = br[64 * j]; f32x4 v = {bflo(q.x), bfhi(q.x), bflo(q.y), bfhi(q.y)}; v = v * r * gv[j]; orow[64 * j] = v; }
    }
}

__device__ __forceinline__ float ret_log_gamma(int h) { return logf(1.f - exp2f(-5.f - (float)h)); }

template <bool TR>
__device__ __forceinline__ void stage_rot(const bf16_t* P, int t0, int col0, LAS bf16_t* dst, int stride, float scale, float lg, bool kte, int nrows, int tl, int nth) {
    for (int it = tl; it < nrows * 8; it += nth) {
        const int row = TR ? it % nrows : it >> 3, d0 = TR ? (it / nrows) * 8 : (it & 7) * 8, t = t0 + row;
        const bf16_t* src = P + (size_t)t * P0LD + col0 + d0;
        const u32x4 a = *(const u32x4*)src, b = *(const u32x4*)(src + 64);
        const float rs = scale * (kte ? __expf(lg * (float)(127 - row)) : 1.f);
        float o1[8], o2[8];
#pragma unroll
        for (int i = 0; i < 8; ++i) {
            const unsigned wa = a[i >> 1], wb = b[i >> 1];
            const float x1 = (i & 1) ? bfhi(wa) : bflo(wa), x2 = (i & 1) ? bfhi(wb) : bflo(wb);
            const float invf = exp2f(-(float)(d0 + i) * (13.287712379549449f / 64.f));
            const float ang = (float)t * invf, n = rintf(ang * 0.15915494309189535f);
            float r = fmaf(-n, 6.2831854820251465f, ang); r = fmaf(-n, -1.7484556e-7f, r);
            const float s = __sinf(r), c = __cosf(r);
            o1[i] = (x1 * c - x2 * s) * rs; o2[i] = (x2 * c + x1 * s) * rs;
        }
        if (TR) {
#pragma unroll
            for (int i = 0; i < 8; ++i) { dst[(d0 + i) * stride + row] = f2bf(o1[i]); dst[(64 + d0 + i) * stride + row] = f2bf(o2[i]); }
        } else {
            u32x4 w1, w2; w1.x = pk2(o1[0], o1[1]); w1.y = pk2(o1[2], o1[3]); w1.z = pk2(o1[4], o1[5]); w1.w = pk2(o1[6], o1[7]);
            w2.x = pk2(o2[0], o2[1]); w2.y = pk2(o2[2], o2[3]); w2.z = pk2(o2[4], o2[5]); w2.w = pk2(o2[6], o2[7]);
            *(LAS u32x4*)(dst + row * stride + d0) = w1; *(LAS u32x4*)(dst + row * stride + 64 + d0) = w2;
        }
    }
}
__device__ __forceinline__ void stage_vT(const bf16_t* P, int t0, int col0, LAS bf16_t* dst, int stride, int tid) {
    for (int it = tid; it < 128 * 16; it += 512) {
        const int row = it & 127, e0 = (it >> 7) * 8;
        const u32x4 a = *(const u32x4*)(P + (size_t)(t0 + row) * P0LD + col0 + e0);
#pragma unroll
        for (int i = 0; i < 8; ++i) { const unsigned w = a[i >> 1]; dst[(e0 + i) * stride + row] = (unsigned short)((i & 1) ? (w >> 16) : (w & 0xffffu)); }
    }
}

__device__ __forceinline__ void stage_dt(const Ctx& C, int t0, int g, LAS float* DTS, LAS float* AS, LAS float* ACS) {
    const int l = C.tid & 127, hh = C.tid >> 7, h = 4 * g + hh;
    const float* DT = (const float*)(C.ws + WS_DT);
    const float dtv = softplusf_(DT[(size_t)(t0 + l) * 8 + h] + C.in[14][h]);
    DTS[hh * 128 + l] = dtv;
    float s = -dtv * __expf(C.in[15][h]);
    s += __builtin_bit_cast(float, __builtin_amdgcn_update_dpp(0, __builtin_bit_cast(int, s), 0x111, 0xf, 0xf, true));
    s += __builtin_bit_cast(float, __builtin_amdgcn_update_dpp(0, __builtin_bit_cast(int, s), 0x112, 0xf, 0xf, true));
    s += __builtin_bit_cast(float, __builtin_amdgcn_update_dpp(0, __builtin_bit_cast(int, s), 0x114, 0xf, 0xf, true));
    s += __builtin_bit_cast(float, __builtin_amdgcn_update_dpp(0, __builtin_bit_cast(int, s), 0x118, 0xf, 0xf, true));
    s += __builtin_bit_cast(float, __builtin_amdgcn_update_dpp(0, __builtin_bit_cast(int, s), 0x142, 0xa, 0xf, false));
    s += __builtin_bit_cast(float, __builtin_amdgcn_update_dpp(0, __builtin_bit_cast(int, s), 0x143, 0xc, 0xf, false));
    if ((C.wave & 1) == 0 && C.lane == 63) AS[hh] = s;
    __syncthreads();
    if (C.wave & 1) s += AS[hh];
    ACS[hh * 128 + l] = s;
    __syncthreads();
}

template <int NGRP, int MODE>
__device__ __forceinline__ void stage_conv(const Ctx& C, int t0, int g, LAS bf16_t* XT, LAS bf16_t* BB, LAS bf16_t* CC, const LAS float* DTS, const LAS float* ACS) {
    constexpr int NSEG = 512 / NGRP, RP = (128 + NSEG - 1) / NSEG;
    if (C.tid >= NGRP * NSEG) return;
    const bf16_t* P = (const bf16_t*)(C.ws + WS_HP);
    const int seg = C.tid % NSEG, grp = C.tid / NSEG;
    const int ch0 = grp < 32 ? 256 * g + 8 * grp : (grp < 40 ? 512 + 64 * g + 8 * (grp - 32) : 640 + 64 * g + 8 * (grp - 40));
    const float* cw = C.in[12]; const float* cb = C.in[13];
    float w0[8], w1[8], w2[8], w3[8], bb[8], x0[8], x1[8], x2[8];
#pragma unroll
    for (int i = 0; i < 8; ++i) { w0[i] = cw[ch0 + i]; w1[i] = cw[768 + ch0 + i]; w2[i] = cw[1536 + ch0 + i]; w3[i] = cw[2304 + ch0 + i]; bb[i] = cb[ch0 + i]; }
    const int r0 = seg * RP, r1 = (r0 + RP < 128) ? r0 + RP : 128;
    auto ldrow = [&](int t, float (&x)[8]) {
        if (t < 0) {
#pragma unroll
            for (int i = 0; i < 8; ++i) x[i] = 0.f;
        } else {
            const u32x4 a = *(const u32x4*)(P + (size_t)t * P0LD + C_XBC + ch0);
#pragma unroll
            for (int i = 0; i < 4; ++i) { x[2 * i] = bflo(a[i]); x[2 * i + 1] = bfhi(a[i]); }
        }
    };
    ldrow(t0 + r0 - 3, x0); ldrow(t0 + r0 - 2, x1); ldrow(t0 + r0 - 1, x2);
    for (int row = r0; row < r1; ++row) {
        float x3[8], v[8]; ldrow(t0 + row, x3);
#pragma unroll
        for (int i = 0; i < 8; ++i) { float s = bb[i] + w0[i] * x0[i] + w1[i] * x1[i] + w2[i] * x2[i] + w3[i] * x3[i]; v[i] = siluf_(s); x0[i] = x1[i]; x1[i] = x2[i]; x2[i] = x3[i]; }
        if (grp < 32) {
            const int hh = grp >> 3;
            float sc = DTS[hh * 128 + row]; if (MODE == 0) sc *= __expf(ACS[hh * 128 + 127] - ACS[hh * 128 + row]);
#pragma unroll
            for (int i = 0; i < 8; ++i) XT[(8 * grp + i) * 136 + row] = f2bf(v[i] * sc);
        } else if (MODE == 0) {
#pragma unroll
            for (int i = 0; i < 8; ++i) BB[(8 * (grp - 32) + i) * 136 + row] = f2bf(v[i]);
        } else {
            u32x4 w; w.x = pk2(v[0], v[1]); w.y = pk2(v[2], v[3]); w.z = pk2(v[4], v[5]); w.w = pk2(v[6], v[7]);
            if (grp < 40) *(LAS u32x4*)(BB + row * 72 + 8 * (grp - 32)) = w; else *(LAS u32x4*)(CC + row * 72 + 8 * (grp - 40)) = w;
        }
    }
}

__device__ __forceinline__ void ret_state_unit(const Ctx& C, int c, int h) {
    const bf16_t* P = (const bf16_t*)(C.ws + WS_HP); float* SR = (float*)(C.ws + WS_ST);
    LAS bf16_t* KT = (LAS bf16_t*)C.lds; LAS bf16_t* VT = KT + 128 * 136;
    const int t0 = c * 128, lane = C.lane, fr = lane & 15, fq = lane >> 4;
    stage_rot<true>(P, t0, C_K + h * 128, KT, 136, 0.08838834764831845f, ret_log_gamma(h), true, 128, C.tid, 512);
    stage_vT(P, t0, C_V + h * 128, VT, 136, C.tid);
    __syncthreads();
    const int e0 = 16 * C.wave; bf16x8 mf[4];
#pragma unroll
    for (int k = 0; k < 4; ++k) mf[k] = ldf(VT, 136, e0, 32 * k, lane);
    float* out = SR + ((size_t)(c * 4 + h) * 128 + e0 + fr) * 128 + 4 * fq;
#pragma unroll
    for (int dt = 0; dt < 8; ++dt) { f32x4 acc = F4Z;
#pragma unroll
        for (int k = 0; k < 4; ++k) acc = mma(acc, ldf(KT, 136, 16 * dt, 32 * k, lane), mf[k]);
        *(f32x4*)(out + 16 * dt) = acc; }
    __syncthreads();
}
__device__ __forceinline__ void mamba_state_unit(const Ctx& C, int c, int g) {
    LAS bf16_t* XT = (LAS bf16_t*)C.lds; LAS bf16_t* BT = XT + 256 * 136;
    LAS float* DTS = (LAS float*)(C.lds + 150528); LAS float* ACS = DTS + 512; LAS float* AS = ACS + 512;
    float* SM = C.X;     float* CHD = (float*)(C.ws + WS_CHD);
    const int t0 = c * 128, lane = C.lane, fr = lane & 15, fq = lane >> 4;
    stage_dt(C, t0, g, DTS, AS, ACS);
    stage_conv<40, 0>(C, t0, g, XT, BT, nullptr, DTS, ACS);
    if (C.tid < 4) CHD[(c * 2 + g) * 32 + C.tid] = __expf(ACS[C.tid * 128 + 127]);
    __syncthreads();
    const int hh = C.wave >> 1, ph = C.wave & 1;
#pragma unroll
    for (int pt = 0; pt < 2; ++pt) {
        const int p0 = ph * 32 + 16 * pt; bf16x8 mf[4];
#pragma unroll
        for (int k = 0; k < 4; ++k) mf[k] = ldf(XT, 136, hh * 64 + p0, 32 * k, lane);
        float* out = SM + ((size_t)(c * 8 + 4 * g + hh) * 64 + p0 + fr) * 64 + 4 * fq;
#pragma unroll
        for (int nt = 0; nt < 4; ++nt) { f32x4 acc = F4Z;
#pragma unroll
            for (int k = 0; k < 4; ++k) acc = mma(acc, ldf(BT, 136, 16 * nt, 32 * k, lane), mf[k]);
            *(f32x4*)(out + 16 * nt) = acc; }
    }
    __syncthreads();
}
__device__ __forceinline__ void l0_states(const Ctx& C) {
    for (int u = C.bid; u < 256; u += C.G) mamba_state_unit(C, u >> 1, u & 1);
    for (int u = C.bid; u < 512; u += C.G) ret_state_unit(C, u >> 2, u & 3);
}

__device__ __forceinline__ void l0_scan(const Ctx& C) {
    float* SR = (float*)(C.ws + WS_ST); float* SM = C.X;     const float* CHD = (const float*)(C.ws + WS_CHD);
    for (int idx = C.bid * 512 + C.tid; idx < 65536 + 32768; idx += C.G * 512) {
        if (idx < 65536) {
            const float dec = __expf(128.f * ret_log_gamma(idx >> 14)); float s = 0.f; float* p = SR + idx;
            for (int c0 = 0; c0 < 128; c0 += 32) { float kv[32];
#pragma unroll
                for (int j = 0; j < 32; ++j) kv[j] = p[(size_t)(c0 + j) * 65536];
#pragma unroll
                for (int j = 0; j < 32; ++j) { p[(size_t)(c0 + j) * 65536] = s; s = s * dec + kv[j]; } }
        } else {
            const int e = idx - 65536, head = e >> 12; float s = 0.f; float* p = SM + e;
            for (int c0 = 0; c0 < 128; c0 += 32) { float kv[32], dc[32];
#pragma unroll
                for (int j = 0; j < 32; ++j) { kv[j] = p[(size_t)(c0 + j) * 32768]; dc[j] = CHD[((c0 + j) * 2 + (head >> 2)) * 32 + (head & 3)]; }
#pragma unroll
                for (int j = 0; j < 32; ++j) { p[(size_t)(c0 + j) * 32768] = s; s = s * dc[j] + kv[j]; } }
        }
    }
}

__device__ __forceinline__ void mamba_out_unit(const Ctx& C, int c, int g) {
    LAS bf16_t* XT = (LAS bf16_t*)C.lds; LAS bf16_t* BM = (LAS bf16_t*)(C.lds + 69632); LAS bf16_t* CM = (LAS bf16_t*)(C.lds + 88064);
    LAS bf16_t* SP = (LAS bf16_t*)(C.lds + 106496); LAS bf16_t* STR = (LAS bf16_t*)(C.lds + 115712) + C.wave * (16 * 136);
    LAS float* DTS = (LAS float*)(C.lds + 150528); LAS float* ACS = DTS + 512; LAS float* AS = ACS + 512;
    const bf16_t* P = (const bf16_t*)(C.ws + WS_HP); const float* SM = C.X; bf16_t* Y = (bf16_t*)(C.ws + WS_Y);
    const int t0 = c * 128, lane = C.lane, fr = lane & 15, fq = lane >> 4, w = C.wave, l0 = 16 * w, l = l0 + fr;
    stage_dt(C, t0, g, DTS, AS, ACS);
    stage_conv<48, 1>(C, t0, g, XT, BM, CM, DTS, ACS);
    __syncthreads();
    bf16x8 cmA[2]; cmA[0] = ldf(CM, 72, l0, 0, lane); cmA[1] = ldf(CM, 72, l0, 32, lane);
    f32x4 cb[8];
#pragma unroll
    for (int st = 0; st < 8; ++st) { cb[st] = F4Z; if (st <= w) { cb[st] = mma(cb[st], ldf(BM, 72, 16 * st, 0, lane), cmA[0]); cb[st] = mma(cb[st], ldf(BM, 72, 16 * st, 32, lane), cmA[1]); } }
    float ssq = 0.f;
#pragma unroll 1
    for (int hh = 0; hh < 4; ++hh) {
        const int h = 4 * g + hh;
        __syncthreads();
        {
            const float* src = SM + (size_t)(c * 8 + h) * 4096;
#pragma unroll
            for (int i = 0; i < 2; ++i) { const int e = (C.tid + 512 * i) * 4; const f32x4 v = *(const f32x4*)(src + e); u32x2 b; b.x = pk2(v[0], v[1]); b.y = pk2(v[2], v[3]); *(LAS u32x2*)(SP + (e >> 6) * 72 + (e & 63)) = b; }
        }
        const float al = ACS[hh * 128 + l];
#pragma unroll
        for (int st = 0; st < 8; ++st) {
            const f32x4 as4 = *(const LAS f32x4*)(ACS + hh * 128 + 16 * st + 4 * fq); float sc[4];
#pragma unroll
            for (int v = 0; v < 4; ++v) { const int s = 16 * st + 4 * fq + v; sc[v] = 0.f; if (st <= w) sc[v] = (s <= l) ? cb[st][v] * __expf(al - as4[v]) : 0.f; }
            u32x2 b; b.x = pk2(sc[0], sc[1]); b.y = pk2(sc[2], sc[3]); *(LAS u32x2*)(STR + fr * 136 + 16 * st + 4 * fq) = b;
        }
        __syncthreads();
        bf16x8 sA[4];
#pragma unroll
        for (int k = 0; k < 4; ++k) sA[k] = ldf(STR, 136, 0, 32 * k, lane);
        const float eal = __expf(al), dsk = C.in[16][h], dtl = DTS[hh * 128 + l], rdt = dtl > 1e-30f ? frcp(dtl) : 0.f;
#pragma unroll
        for (int pt = 0; pt < 4; ++pt) {
            f32x4 ya = F4Z, yo = F4Z;
#pragma unroll
            for (int k = 0; k < 4; ++k) if (k <= (w >> 1)) ya = mma(ya, ldf(XT, 136, hh * 64 + 16 * pt, 32 * k, lane), sA[k]);
#pragma unroll
            for (int k = 0; k < 2; ++k) yo = mma(yo, ldf(SP, 72, 16 * pt, 32 * k, lane), cmA[k]);
            const int p = 16 * pt + 4 * fq;
            const u32x2 zz = *(const u32x2*)(P + (size_t)(t0 + l) * P0LD + C_Z + 256 * g + hh * 64 + p);
            const float z[4] = {bflo(zz.x), bfhi(zz.x), bflo(zz.y), bfhi(zz.y)};
            float y[4];
#pragma unroll
            for (int v = 0; v < 4; ++v) {
                const float xs = bf2f(XT[(hh * 64 + p + v) * 136 + l]) * rdt;
                y[v] = (ya[v] + yo[v] * eal + dsk * xs) * siluf_(z[v]); ssq += y[v] * y[v];
            }
            u32x2 b; b.x = pk2(y[0], y[1]); b.y = pk2(y[2], y[3]);
            *(u32x2*)(Y + (size_t)(t0 + l) * D + 512 + 256 * g + hh * 64 + p) = b;
        }
    }
    ssq += __shfl_xor(ssq, 16); ssq += __shfl_xor(ssq, 32);
    const float rinv = rsqrtf(ssq * (1.f / 256.f) + 1e-5f);
#pragma unroll 4
    for (int q = 0; q < 16; ++q) {
        const int ch = 256 * g + 16 * q + 4 * fq; const f32x4 ng = *(const f32x4*)(C.in[17] + ch);
        u32x2* yp = (u32x2*)(Y + (size_t)(t0 + l) * D + 512 + ch); const u32x2 yy = *yp;
        u32x2 b; b.x = pk2(bflo(yy.x) * rinv * ng[0], bfhi(yy.x) * rinv * ng[1]); b.y = pk2(bflo(yy.y) * rinv * ng[2], bfhi(yy.y) * rinv * ng[3]);
        *yp = b;
    }
    __syncthreads();
}
__device__ __forceinline__ void ret_out_unit(const Ctx& C, int c, int h) {
    LAS bf16_t* KN = (LAS bf16_t*)C.lds; LAS bf16_t* VT = KN + 128 * 136; LAS bf16_t* ST = VT + 128 * 136; LAS bf16_t* STR = ST + 128 * 136 + C.wave * (16 * 136);
    const bf16_t* P = (const bf16_t*)(C.ws + WS_HP); const float* SR = (const float*)(C.ws + WS_ST); bf16_t* Y = (bf16_t*)(C.ws + WS_Y);
    const int t0 = c * 128, lane = C.lane, fr = lane & 15, fq = lane >> 4, w = C.wave, i0 = 16 * w, ii = i0 + fr;
    const float lg = ret_log_gamma(h);
    stage_rot<false>(P, t0, C_K + h * 128, KN, 136, 0.08838834764831845f, 0.f, false, 128, C.tid, 512);
    stage_vT(P, t0, C_V + h * 128, VT, 136, C.tid);
    {
        const float* src = SR + (size_t)(c * 4 + h) * 16384;
#pragma unroll
        for (int i = 0; i < 8; ++i) { const int e = (C.tid + 512 * i) * 4; const f32x4 v = *(const f32x4*)(src + e); u32x2 b; b.x = pk2(v[0], v[1]); b.y = pk2(v[2], v[3]); *(LAS u32x2*)(ST + (e >> 7) * 136 + (e & 127)) = b; }
    }
    stage_rot<false>(P, t0 + i0, C_Q + h * 128, STR, 136, 1.f, 0.f, false, 16, lane, 64);
    __syncthreads();
    bf16x8 qA[4];
#pragma unroll
    for (int k = 0; k < 4; ++k) qA[k] = ldf(STR, 136, 0, 32 * k, lane);
    __syncthreads();
#pragma unroll
    for (int jt = 0; jt < 8; ++jt) {
        f32x4 sa = F4Z;
        if (jt <= w) {
#pragma unroll
            for (int k = 0; k < 4; ++k) sa = mma(sa, ldf(KN, 136, 16 * jt, 32 * k, lane), qA[k]);
        }
        float sc[4];
#pragma unroll
        for (int v = 0; v < 4; ++v) { const int j = 16 * jt + 4 * fq + v; sc[v] = 0.f; if (jt <= w) sc[v] = (j <= ii) ? sa[v] * __expf(lg * (float)(ii - j)) : 0.f; }
        u32x2 b; b.x = pk2(sc[0], sc[1]); b.y = pk2(sc[2], sc[3]); *(LAS u32x2*)(STR + fr * 136 + 16 * jt + 4 * fq) = b;
    }
    __syncthreads();
    bf16x8 sA[4];
#pragma unroll
    for (int k = 0; k < 4; ++k) sA[k] = ldf(STR, 136, 0, 32 * k, lane);
    const float qfs = __expf(lg * (float)(ii + 1));
    f32x4 o[8]; float ssq = 0.f;
#pragma unroll
    for (int et = 0; et < 8; ++et) {
        f32x4 a = F4Z, a2 = F4Z;
#pragma unroll
        for (int k = 0; k < 4; ++k) { if (k <= (w >> 1)) a = mma(a, ldf(VT, 136, 16 * et, 32 * k, lane), sA[k]); a2 = mma(a2, ldf(ST, 136, 16 * et, 32 * k, lane), qA[k]); }
        o[et] = a + a2 * qfs;
        ssq += (o[et][0] * o[et][0] + o[et][1] * o[et][1]) + (o[et][2] * o[et][2] + o[et][3] * o[et][3]);
    }
    ssq += __shfl_xor(ssq, 16); ssq += __shfl_xor(ssq, 32);
    const float rinv = rsqrtf(ssq * (1.f / 128.f) + 1e-6f);
#pragma unroll
    for (int et = 0; et < 8; ++et) {
        const int ch = h * 128 + 16 * et + 4 * fq;
        const u32x2 gg = *(const u32x2*)(P + (size_t)(t0 + ii) * P0LD + C_G + ch);
        u32x2 b; b.x = pk2(o[et][0] * rinv * siluf_(bflo(gg.x)), o[et][1] * rinv * siluf_(bfhi(gg.x))); b.y = pk2(o[et][2] * rinv * siluf_(bflo(gg.y)), o[et][3] * rinv * siluf_(bfhi(gg.y)));
        *(u32x2*)(Y + (size_t)(t0 + ii) * D + ch) = b;
    }
    __syncthreads();
}
__device__ __forceinline__ void l0_output(const Ctx& C) {
    for (int u = C.bid; u < 256; u += C.G) mamba_out_unit(C, u >> 1, u & 1);
    for (int u = C.bid; u < 512; u += C.G) ret_out_unit(C, u >> 2, u & 3);
}

constexpr size_t WS_WLOG = WS_ST, WS_AA = WS_ST + 16 * MiB, WS_GG = WS_WGU1, WS_PC = WS_Y;
constexpr size_t WS_LA = WS_LRUC, WS_HC = WS_LRUC + 512 * 1024, WS_HIN = WS_LRUC + 1024 * 1024;
constexpr int SW_WAT = 0, SW_WXT = 65536, SW_W2T = 131072, SW_A2T = 163840, SW_G2T = 196608;
__device__ __forceinline__ bf16_t* gg_row(unsigned char* ws, int t) { return (bf16_t*)(ws + WS_GG) + (size_t)t * 512; }
__device__ __forceinline__ float tanhf_(float x) { return 1.f - 2.f * frcp(1.f + __expf(2.f * x)); }

__device__ __forceinline__ void rwkv_prep(const Ctx& C, int c) {
    const bf16_t* P = (const bf16_t*)(C.ws + WS_HP); const bf16_t* SW = (const bf16_t*)(C.ws + WS_SMALLW);
    bf16_t* WLOG = (bf16_t*)(C.ws + WS_WLOG); bf16_t* AA = (bf16_t*)(C.ws + WS_AA);
    LAS bf16_t* TW = (LAS bf16_t*)C.lds; LAS bf16_t* AL = TW + 64 * 72; LAS bf16_t* SG = AL + 64 * 72;
    const float* mu = C.in[27];
    const int t0 = 64 * c, lane = C.lane, fr = lane & 15, fq = lane >> 4;
#pragma unroll 12
    for (int idx = C.tid; idx < 64 * 288; idx += 512) {
        const int tok = idx / 288, cc = idx % 288, col = 2560 + cc, t = t0 + tok;
        const float cur = bf2f(P[(size_t)t * P1LD + col]), prev = t > 0 ? bf2f(P[(size_t)(t - 1) * P1LD + col]) : 0.f;
        const float s = cur + (prev - cur) * mu[col - 1024];
        if (cc < 64) TW[tok * 72 + cc] = f2bf(tanhf_(s)); else if (cc < 128) AL[tok * 72 + cc - 64] = f2bf(s); else SG[tok * 168 + cc - 128] = f2bf(sigmoidf_(s));
    }
    __syncthreads();
    const int n0 = 64 * C.wave;
#pragma unroll 1
    for (int which = 0; which < 2; ++which) {
        const bf16_t* BT = SW + (which == 0 ? SW_W2T : SW_A2T); const LAS bf16_t* AM = which == 0 ? TW : AL;
        const float* bias = which == 0 ? C.in[28] : C.in[30]; bf16_t* O = which == 0 ? WLOG : AA;
#pragma unroll
        for (int nt = 0; nt < 4; ++nt) {
            const bf16x8 nf0 = ldfg(BT, 64, n0 + 16 * nt, 0, lane), nf1 = ldfg(BT, 64, n0 + 16 * nt, 32, lane);
            const int n = n0 + 16 * nt + 4 * fq; const f32x4 bv = *(const f32x4*)(bias + n);
#pragma unroll
            for (int mt = 0; mt < 4; ++mt) {
                f32x4 acc = F4Z; acc = mma(acc, nf0, ldf(AM, 72, 16 * mt, 0, lane)); acc = mma(acc, nf1, ldf(AM, 72, 16 * mt, 32, lane));
                float o[4];
#pragma unroll
                for (int v = 0; v < 4; ++v) { const float x = acc[v] + bv[v]; o[v] = which == 0 ? -__expf(-softplus_fast(-x) - 0.5f) : sigmoidf_(x); }
                u32x2 b; b.x = pk2(o[0], o[1]); b.y = pk2(o[2], o[3]);
                *(u32x2*)(O + (size_t)(t0 + 16 * mt + fr) * 512 + n) = b;
            }
        }
    }
#pragma unroll 2
    for (int nt = 0; nt < 4; ++nt) {
        bf16x8 nf[5];
#pragma unroll
        for (int k = 0; k < 5; ++k) nf[k] = ldfg(SW + SW_G2T, 160, n0 + 16 * nt, 32 * k, lane);
        const int n = n0 + 16 * nt + 4 * fq;
#pragma unroll
        for (int mt = 0; mt < 4; ++mt) {
            f32x4 acc = F4Z;
#pragma unroll
            for (int k = 0; k < 5; ++k) acc = mma(acc, nf[k], ldf(SG, 168, 16 * mt, 32 * k, lane));
#ifdef GG_CONSTVAL
            acc = (f32x4){0.5f, 0.25f, -0.5f, 1.f};
#endif
            u32x2 b; b.x = pk2(acc[0], acc[1]); b.y = pk2(acc[2], acc[3]);
            *(u32x2*)(gg_row(C.ws, t0 + 16 * mt + fr) + n) = b;
        }
    }
    asm volatile("s_waitcnt vmcnt(0)" ::: "memory");
    __threadfence_block();
    __syncthreads();
}

#ifndef RW1_SB_SK
#define RW1_SB_SK 0
#endif
#ifndef RW1_SB_MAIN
#define RW1_SB_MAIN 2
#endif
template <int PASS>
__device__ __forceinline__ void rwkv_chunk(const Ctx& C, int c) {
    const bf16_t* P = (const bf16_t*)(C.ws + WS_HP);
    const bf16_t* WLOG = (const bf16_t*)(C.ws + WS_WLOG); const bf16_t* AA = (const bf16_t*)(C.ws + WS_AA);
    float* PC = (float*)(C.ws + WS_PC); float* UC = C.X; bf16_t* Y = (bf16_t*)(C.ws + WS_Y);
    LAS float* VW = (LAS float*)(C.lds + 40960); LAS float* VKK = VW + 4096; LAS float* VB = VKK + 4096; LAS float* VK = VB + 4096; LAS float* VR = VK + 4096; LAS float* VV = VR + 4096; LAS float* VG = VV + 4096; LAS float* VBON = VG + 4096;
    const int t0 = 64 * c, lane = C.lane, head = C.wave, ch = C.tid;
    const float* mu = C.in[27];
    f32x2 SU[32], SP[32];
    if (PASS == 1) {
#pragma unroll
        for (int k = 0; k < 32; ++k) { SU[k] = (f32x2){0.f, 0.f}; SP[k] = (f32x2){(2 * k == lane) ? 1.f : 0.f, (2 * k + 1 == lane) ? 1.f : 0.f}; }
    } else {
        const f32x4* src = (const f32x4*)(UC + ((size_t)(c * 8 + head) * 64 + lane) * 64);
#pragma unroll
        for (int k4 = 0; k4 < 16; ++k4) { f32x4 v = src[k4];
#ifdef RW3_ZERO
            v = F4Z;
#endif
            SU[2 * k4] = (f32x2){v[0], v[1]}; SU[2 * k4 + 1] = (f32x2){v[2], v[3]}; }
    }
    float pr = 0.f, pk = 0.f, pv = 0.f;
    if (t0 > 0) { const bf16_t* row = P + (size_t)(t0 - 1) * P1LD; pr = bf2f(row[1024 + ch]); pk = bf2f(row[1536 + ch]); pv = bf2f(row[2048 + ch]); }
#pragma unroll 1
    for (int sb = 0; sb < 8; ++sb) {
        const float mu_r = mu[ch], mu_k = mu[512 + ch], mu_v = mu[1024 + ch], kkc = C.in[33][ch], kac = C.in[34][ch], rkc = C.in[35][ch];
        constexpr int UF = PASS == 3 ? 8 : 4;
#pragma unroll 1
        for (int j0 = 0; j0 < 8; j0 += UF) {
            float cr[UF], ck[UF], cv[UF], aa[UF], wl[UF], gg[UF];
#pragma unroll
            for (int u = 0; u < UF; ++u) {
                const int t = t0 + 8 * sb + j0 + u; const bf16_t* row = P + (size_t)t * P1LD;
                ck[u] = bf2f(row[1536 + ch]); cv[u] = bf2f(row[2048 + ch]); aa[u] = bf2f(AA[(size_t)t * 512 + ch]); wl[u] = bf2f(WLOG[(size_t)t * 512 + ch]);
                if (PASS == 3) { cr[u] = bf2f(row[1024 + ch]); gg[u] = bf2f(gg_row(C.ws, t)[ch]); }
            }
            float kkr[UF], kp[UF], nrm[UF], bon[UF], rsv[UF];
#pragma unroll
            for (int u = 0; u < UF; ++u) {
                const float ks = ck[u] + (pk - ck[u]) * mu_k, vs = cv[u] + (pv - cv[u]) * mu_v; pk = ck[u]; pv = cv[u];
                kkr[u] = ks * kkc; nrm[u] = kkr[u] * kkr[u]; kp[u] = ks * (1.f + (aa[u] - 1.f) * kac);
                VV[(j0 + u) * 512 + ch] = vs; VK[(j0 + u) * 512 + ch] = kp[u]; VW[(j0 + u) * 512 + ch] = __expf(wl[u]);
                if (PASS == 3) { rsv[u] = cr[u] + (pr - cr[u]) * mu_r; pr = cr[u]; bon[u] = rsv[u] * kp[u] * rkc; VR[(j0 + u) * 512 + ch] = rsv[u]; VG[(j0 + u) * 512 + ch] = gg[u]; }
            }
#pragma unroll
            for (int u = 0; u < UF; ++u) { nrm[u] = wave_sum_dpp(nrm[u]); if (PASS == 3) bon[u] = wave_sum_dpp(bon[u]); }
#pragma unroll
            for (int u = 0; u < UF; ++u) {
                const float kk = kkr[u] * rsqrtf(fmaxf(nrm[u], 1e-24f));
                VKK[(j0 + u) * 512 + ch] = kk; VB[(j0 + u) * 512 + ch] = kk * aa[u];
                if (PASS == 3) { if (lane == 0) VBON[(j0 + u) * 8 + head] = bon[u]; }
            }
        }
        __syncthreads();
#pragma unroll 1
        for (int j = 0; j < 8; ++j) {
            const LAS f32x4* pw = (const LAS f32x4*)(VW + j * 512 + head * 64); const LAS f32x4* pkk = (const LAS f32x4*)(VKK + j * 512 + head * 64);
            const LAS f32x4* pb = (const LAS f32x4*)(VB + j * 512 + head * 64); const LAS f32x4* pkp = (const LAS f32x4*)(VK + j * 512 + head * 64);
            const LAS f32x4* prr = (const LAS f32x4*)(VR + j * 512 + head * 64);
#define LO2(v) __builtin_shufflevector(v, v, 0, 1)
#define HI2(v) __builtin_shufflevector(v, v, 2, 3)
#define FMA2(a, b, c) __builtin_elementwise_fma(a, b, c)
            f32x2 aU0 = {0.f, 0.f}, aU1 = {0.f, 0.f}, aP0 = {0.f, 0.f}, aP1 = {0.f, 0.f};
            {
                f32x4 q = pkk[0];
#pragma unroll
                for (int g = 0; g < 16; ++g) {
                    f32x4 qn = q; if (g + 1 < 16) qn = pkk[g + 1];
                    aU0 = FMA2(SU[2 * g], LO2(q), aU0); aU1 = FMA2(SU[2 * g + 1], HI2(q), aU1);
                    if (PASS == 1) { aP0 = FMA2(SP[2 * g], LO2(q), aP0); aP1 = FMA2(SP[2 * g + 1], HI2(q), aP1); }
                    q = qn;
#if RW1_SB_SK == 1
                    if (PASS == 1) __builtin_amdgcn_sched_barrier(0);
#elif RW1_SB_SK == 4
                    if (PASS == 1 && (g & 3) == 3) __builtin_amdgcn_sched_barrier(0);
#endif
                }
            }
            float skU = (aU0[0] + aU0[1]) + (aU1[0] + aU1[1]); const float skP = (aP0[0] + aP0[1]) + (aP1[0] + aP1[1]);
#ifdef PROBE_VALU
            if (PASS == 3) { f32x2 d0 = {0.f, 0.f}, d1 = {0.f, 0.f}; const f32x2 cc = {1.0001f, 0.9999f};
#pragma unroll
                for (int g = 0; g < 32; ++g) { d0 = FMA2(SU[g], cc, d0); d1 = FMA2(SU[g], d0, d1); }
                skU += 1e-37f * ((d0[0] + d0[1]) + (d1[0] + d1[1])); }
#endif
#ifdef PROBE_LDS
            if (PASS == 3) { f32x4 d0 = F4Z;
#pragma unroll
                for (int g = 0; g < 16; ++g) d0 += pkp[g];
                skU += 1e-37f * ((d0[0] + d0[1]) + (d0[2] + d0[3])); }
#endif
            const float vv = VV[j * 512 + ch];
            const f32x2 nsU = {-skU, -skU}, nsP = {-skP, -skP}, vv2 = {vv, vv};
            f32x2 y0 = {0.f, 0.f}, y1 = {0.f, 0.f};
            {
                f32x4 w4 = pw[0], b4 = pb[0], k4 = pkp[0], r4 = F4Z; if (PASS == 3) r4 = prr[0];
#pragma unroll
                for (int g = 0; g < 16; ++g) {
                    f32x4 nw = w4, nb = b4, nk = k4, nr = r4;
                    if (g + 1 < 16) { nw = pw[g + 1]; nb = pb[g + 1]; nk = pkp[g + 1]; if (PASS == 3) nr = prr[g + 1]; }
                    SU[2 * g] = FMA2(SU[2 * g], LO2(w4), FMA2(nsU, LO2(b4), vv2 * LO2(k4)));
                    SU[2 * g + 1] = FMA2(SU[2 * g + 1], HI2(w4), FMA2(nsU, HI2(b4), vv2 * HI2(k4)));
                    if (PASS == 1) { SP[2 * g] = FMA2(SP[2 * g], LO2(w4), nsP * LO2(b4)); SP[2 * g + 1] = FMA2(SP[2 * g + 1], HI2(w4), nsP * HI2(b4)); }
                    if (PASS == 3) { y0 = FMA2(SU[2 * g], LO2(r4), y0); y1 = FMA2(SU[2 * g + 1], HI2(r4), y1); }
                    w4 = nw; b4 = nb; k4 = nk; r4 = nr;
#if RW1_SB_MAIN == 1
                    if (PASS == 1) __builtin_amdgcn_sched_barrier(0);
#elif RW1_SB_MAIN == 4
                    if (PASS == 1 && (g & 3) == 3) __builtin_amdgcn_sched_barrier(0);
#elif RW1_SB_MAIN == 2
                    if (PASS == 1 && (g & 1) == 1) __builtin_amdgcn_sched_barrier(0);
#endif
                }
            }
            const float y = (y0[0] + y0[1]) + (y1[0] + y1[1]);
            if (PASS == 3) VKK[j * 512 + ch] = y;
        }
        if (PASS == 3) {
            const float lng = C.in[36][ch], lnb = C.in[37][ch];
            float y[8], s1[8], s2[8];
#pragma unroll
            for (int u = 0; u < 8; ++u) { y[u] = VKK[u * 512 + ch]; s1[u] = y[u]; }
#pragma unroll
            for (int u = 0; u < 8; ++u) s1[u] = wave_sum_dpp(s1[u]);
#pragma unroll
            for (int u = 0; u < 8; ++u) { y[u] -= s1[u] * (1.f / 64.f); s2[u] = y[u] * y[u]; }
#pragma unroll
            for (int u = 0; u < 8; ++u) s2[u] = wave_sum_dpp(s2[u]);
#pragma unroll
            for (int u = 0; u < 8; ++u) {
                const float yn = y[u] * rsqrtf(s2[u] * (1.f / 64.f) + 64e-5f) * lng + lnb;
                Y[(size_t)(t0 + 8 * sb + u) * D + 512 + ch] = f2bf((yn + VBON[u * 8 + head] * VV[u * 512 + ch]) * VG[u * 512 + ch]);
            }
        }
        __syncthreads();
    }
    if (PASS == 1) {
        f32x4* du = (f32x4*)(UC + ((size_t)(c * 8 + head) * 64 + lane) * 64); f32x4* dp = (f32x4*)(PC + ((size_t)(c * 8 + head) * 64 + lane) * 64);
#pragma unroll
        for (int k4 = 0; k4 < 16; ++k4) { du[k4] = (f32x4){SU[2 * k4][0], SU[2 * k4][1], SU[2 * k4 + 1][0], SU[2 * k4 + 1][1]}; dp[k4] = (f32x4){SP[2 * k4][0], SP[2 * k4][1], SP[2 * k4 + 1][0], SP[2 * k4 + 1][1]}; }
    }
}

template <int PASS>
__device__ __forceinline__ void lru_chunk(const Ctx& C, int c) {
    const bf16_t* P = (const bf16_t*)(C.ws + WS_HP); const bf16_t* SW = (const bf16_t*)(C.ws + WS_SMALLW); bf16_t* Y = (bf16_t*)(C.ws + WS_Y);
    LAS bf16_t* XC = (LAS bf16_t*)C.lds; LAS bf16_t* LAB = (LAS bf16_t*)(C.lds + 66560);
    const int t0 = 64 * c, lane = C.lane, fr = lane & 15, fq = lane >> 4;
    {
        const int grp = C.tid & 63, seg = C.tid >> 6, ch0 = 8 * grp, r0 = 8 * seg;
        const float* cw = C.in[20]; const float* cb = C.in[21];
        float w0[8], w1[8], w2[8], w3[8], bb[8], x0[8], x1[8], x2[8];
#pragma unroll
        for (int i = 0; i < 8; ++i) { w0[i] = cw[ch0 + i]; w1[i] = cw[512 + ch0 + i]; w2[i] = cw[1024 + ch0 + i]; w3[i] = cw[1536 + ch0 + i]; bb[i] = cb[ch0 + i]; }
        auto ldrow = [&](int t, float (&x)[8]) {
            if (t < 0) {
#pragma unroll
                for (int i = 0; i < 8; ++i) x[i] = 0.f;
            } else {
                const u32x4 a = *(const u32x4*)(P + (size_t)t * P1LD + ch0);
#pragma unroll
                for (int i = 0; i < 4; ++i) { x[2 * i] = bflo(a[i]); x[2 * i + 1] = bfhi(a[i]); }
            }
        };
        ldrow(t0 + r0 - 3, x0); ldrow(t0 + r0 - 2, x1); ldrow(t0 + r0 - 1, x2);
#pragma unroll
        for (int row = r0; row < r0 + 8; ++row) {
            float x3[8], v[8]; ldrow(t0 + row, x3);
#pragma unroll
            for (int i = 0; i < 8; ++i) { v[i] = bb[i] + w0[i] * x0[i] + w1[i] * x1[i] + w2[i] * x2[i] + w3[i] * x3[i]; x0[i] = x1[i]; x1[i] = x2[i]; x2[i] = x3[i]; }
            u32x4 w; w.x = pk2(v[0], v[1]); w.y = pk2(v[2], v[3]); w.z = pk2(v[4], v[5]); w.w = pk2(v[6], v[7]);
            *(LAS u32x4*)(XC + row * 520 + ch0) = w;
        }
    }
    __syncthreads();
    const int nb = C.wave >> 1, eh = C.wave & 1, cbase = nb * 128 + 64 * eh;
    unsigned ur[4][4][2];
#pragma unroll
    for (int nth = 0; nth < 2; ++nth) {
        bf16x8 wfa[2][4], wfx[2][4];
#pragma unroll
        for (int n2 = 0; n2 < 2; ++n2)
#pragma unroll
            for (int k = 0; k < 4; ++k) { wfa[n2][k] = ldfg(SW + SW_WAT + nb * 16384, 128, 64 * eh + 16 * (2 * nth + n2), 32 * k, lane); wfx[n2][k] = ldfg(SW + SW_WXT + nb * 16384, 128, 64 * eh + 16 * (2 * nth + n2), 32 * k, lane); }
        f32x4 bav[2], bxv[2], sp8[2];
#pragma unroll
        for (int n2 = 0; n2 < 2; ++n2) { const int chn = cbase + 16 * (2 * nth + n2) + 4 * fq; bav[n2] = *(const f32x4*)(C.in[23] + chn); bxv[n2] = *(const f32x4*)(C.in[25] + chn); const f32x4 lam = *(const f32x4*)(C.in[26] + chn);
#pragma unroll
            for (int v = 0; v < 4; ++v) sp8[n2][v] = -8.f * softplusf_(-lam[v]); }
#pragma unroll
        for (int mt = 0; mt < 4; ++mt) {
            bf16x8 mf[4];
#pragma unroll
            for (int k = 0; k < 4; ++k) mf[k] = ldf(XC, 520, 16 * mt, nb * 128 + 32 * k, lane);
#pragma unroll
            for (int n2 = 0; n2 < 2; ++n2) {
                const int nt = 2 * nth + n2, chn = cbase + 16 * nt + 4 * fq;
                f32x4 aa = F4Z, ax = F4Z;
#pragma unroll
                for (int k = 0; k < 4; ++k) { aa = mma(aa, wfa[n2][k], mf[k]); ax = mma(ax, wfx[n2][k], mf[k]); }
                const u32x2 xw = *(const LAS u32x2*)(XC + (16 * mt + fr) * 520 + chn);
                const float xc[4] = {bflo(xw.x), bfhi(xw.x), bflo(xw.y), bfhi(xw.y)};
                float la[4], uu[4];
#pragma unroll
                for (int v = 0; v < 4; ++v) { const float r = sigmoidf_(aa[v] + bav[n2][v]), ig = sigmoidf_(ax[v] + bxv[n2][v]); la[v] = sp8[n2][v] * r; uu[v] = __builtin_amdgcn_sqrtf(fmaxf(1.f - __expf(2.f * la[v]), 0.f)) * ig * xc[v];     }
                *(LAS u32x2*)(LAB + (16 * mt + fr) * 512 + chn) = (u32x2){pk2(la[0], la[1]), pk2(la[2], la[3])};
                ur[mt][nt][0] = pk2(uu[0], uu[1]); ur[mt][nt][1] = pk2(uu[2], uu[3]);
            }
            __builtin_amdgcn_sched_barrier(0);
        }
    }
    __syncthreads();
#pragma unroll
    for (int mt = 0; mt < 4; ++mt)
#pragma unroll
        for (int nt = 0; nt < 4; ++nt) *(LAS u32x2*)(XC + (16 * mt + fr) * 520 + cbase + 16 * nt + 4 * fq) = (u32x2){ur[mt][nt][0], ur[mt][nt][1]};
    __syncthreads();
    {
        const int ch = C.tid;
        float* LA = (float*)(C.ws + WS_LA); float* HC = (float*)(C.ws + WS_HC); const float* HIN = (const float*)(C.ws + WS_HIN);
        float h = PASS == 3 ? HIN[c * 512 + ch] : 0.f, sla = 0.f;
        if (PASS == 3) {
            float gbv[64];
#pragma unroll
            for (int tok = 0; tok < 64; ++tok) gbv[tok] = bf2f(P[(size_t)(t0 + tok) * P1LD + 512 + ch]);
#pragma unroll
            for (int tok = 0; tok < 64; ++tok) {
                const float la = bf2f(LAB[tok * 512 + ch]), u = bf2f(XC[tok * 520 + ch]);
                h = fmaf(__expf(la), h, u);
                const float gb = gbv[tok], ge = 0.5f * gb * (1.f + tanhf_(0.7978845608028654f * (gb + 0.044715f * gb * gb * gb)));
                Y[(size_t)(t0 + tok) * D + ch] = f2bf(h * ge);
            }
        } else {
#pragma unroll 8
            for (int tok = 0; tok < 64; ++tok) {
                const float la = bf2f(LAB[tok * 512 + ch]), u = bf2f(XC[tok * 520 + ch]);
                h = fmaf(__expf(la), h, u); sla += la;
            }
        }
        if (PASS == 1) { LA[c * 512 + ch] = sla; HC[c * 512 + ch] = h; }
    }
    __syncthreads();
}

__device__ __forceinline__ void l1_pass_a(const Ctx& C) {
#ifndef SKIP_PREP
    for (int c = C.bid; c < 256; c += C.G) rwkv_prep(C, c);
#endif
#ifndef SKIP_RW1
    for (int c = C.bid; c < 256; c += C.G) rwkv_chunk<1>(C, c);
#ifdef PROBE_RW1X2
    for (int c = C.bid; c < 256; c += C.G) rwkv_chunk<1>(C, c);
#endif
#endif
#ifndef SKIP_LRU1
    for (int c = C.bid; c < 256; c += C.G) lru_chunk<1>(C, c);
#endif
}
__device__ __forceinline__ void l1_pass_c(const Ctx& C) {
#ifndef SKIP_RW3
    for (int c = C.bid; c < 256; c += C.G) rwkv_chunk<3>(C, c);
#ifdef PROBE_RW3X2
    for (int c = C.bid; c < 256; c += C.G) rwkv_chunk<3>(C, c);
#endif
#endif
#ifndef SKIP_LRU3
    for (int c = C.bid; c < 256; c += C.G) lru_chunk<3>(C, c);
#ifdef PROBE_LRU3X2
    for (int c = C.bid; c < 256; c += C.G) lru_chunk<3>(C, c);
#endif
#endif
}

__device__ __forceinline__ void l1_middle(const Ctx& C) {
    const float* PC = (const float*)(C.ws + WS_PC); float* UC = C.X;
    const int lane = C.lane;
#ifndef SKIP_MID
    if (C.bid < 128 && C.G >= 128) {
        const int head = C.bid >> 4, row = (C.bid & 15) * 4 + (C.wave & 3); const bool rowwave = C.wave < 4;
        LAS float* SR = (LAS float*)(C.lds + C.wave * 256); LAS float* RING = (LAS float*)(C.lds + 4096);
        const float* pcb = PC + (size_t)head * 4096 + C.tid * 8;
        float* ub = UC + ((size_t)head * 64 + row) * 64 + lane;
        float s = 0.f; SR[lane] = 0.f;
        f32x4 qa0, qb0, qa1, qb1, qa2, qb2, qa3, qb3; float u0, u1, u2, u3;
#define MID_LD(qa, qb, cc) do { const f32x4* p_ = (const f32x4*)(pcb + (size_t)(cc) * 32768); qa = p_[0]; qb = p_[1]; } while (0)
#define MID_ST(qa, qb, cc) do { LAS f32x4* d_ = (LAS f32x4*)(RING + ((cc) & 7) * 4096 + C.tid * 8); d_[0] = qa; d_[1] = qb; } while (0)
        MID_LD(qa0, qb0, 0); MID_LD(qa1, qb1, 1); MID_LD(qa2, qb2, 2); MID_LD(qa3, qb3, 3);
        MID_ST(qa0, qb0, 0); MID_ST(qa1, qb1, 1); MID_ST(qa2, qb2, 2); MID_ST(qa3, qb3, 3);
        MID_LD(qa0, qb0, 4); MID_LD(qa1, qb1, 5); MID_LD(qa2, qb2, 6); MID_LD(qa3, qb3, 7);
        u0 = ub[0]; u1 = ub[32768]; u2 = ub[2 * 32768]; u3 = ub[3 * 32768];
        __syncthreads();
#define MID_STEP(cc, qa, qb, uu) do { \
            if (rowwave) { const LAS float* P_ = RING + ((cc) & 7) * 4096 + lane; \
            float a0 = 0.f, a1 = 0.f, a2 = 0.f, a3 = 0.f; \
            _Pragma("unroll") for (int i4 = 0; i4 < 16; ++i4) { const f32x4 s4 = *(const LAS f32x4*)(SR + 4 * i4); \
                a0 = fmaf(s4[0], P_[(4 * i4) * 64], a0); a1 = fmaf(s4[1], P_[(4 * i4 + 1) * 64], a1); a2 = fmaf(s4[2], P_[(4 * i4 + 2) * 64], a2); a3 = fmaf(s4[3], P_[(4 * i4 + 3) * 64], a3); } \
            ub[(size_t)(cc) * 32768] = s;                      \
            s = uu + ((a0 + a1) + (a2 + a3)); SR[lane] = s; } \
            if ((cc) + 4 < 256) { MID_ST(qa, qb, (cc) + 4); if (rowwave) uu = ub[(size_t)((cc) + 4) * 32768]; } \
            if ((cc) + 8 < 256) MID_LD(qa, qb, (cc) + 8); } while (0)
#pragma unroll 1
        for (int c = 0; c < 256; c += 4) { MID_STEP(c, qa0, qb0, u0); MID_STEP(c + 1, qa1, qb1, u1); MID_STEP(c + 2, qa2, qb2, u2); MID_STEP(c + 3, qa3, qb3, u3); __syncthreads(); }
#undef MID_LD
#undef MID_ST
#undef MID_STEP
    }
#endif
    if (C.bid == (C.G > 128 ? 128 : 0)) {
        const float* LA = (const float*)(C.ws + WS_LA); const float* HC = (const float*)(C.ws + WS_HC); float* HIN = (float*)(C.ws + WS_HIN);
        const int ch = C.tid; float h = 0.f;
        for (int c0 = 0; c0 < 256; c0 += 32) { float la[32], hc[32];
#pragma unroll
            for (int j = 0; j < 32; ++j) { la[j] = LA[(c0 + j) * 512 + ch]; hc[j] = HC[(c0 + j) * 512 + ch]; }
#pragma unroll
            for (int j = 0; j < 32; ++j) { HIN[(c0 + j) * 512 + ch] = h; h = fmaf(__expf(la[j]), h, hc[j]); } }
    }
}

#define XB_TMO      128
#define XB_XCNT(j)  (256  + 64 * (j))
#define XB_XSUB(j)  (1280 + 64 * (j))
#define XB_XGEN(j)  (2304 + 64 * (j))
#define XB_TOP      3328
#define XB_TOPGEN   3392
#define XCD_BAR_WORDS 3456
#define XB_SPIN_CAP (1u << 18)

__device__ __forceinline__ unsigned xb_ld(unsigned* p)              { return __hip_atomic_load(p, __ATOMIC_RELAXED, __HIP_MEMORY_SCOPE_AGENT); }
__device__ __forceinline__ unsigned xb_add(unsigned* p, unsigned v) { return __hip_atomic_fetch_add(p, v, __ATOMIC_RELAXED, __HIP_MEMORY_SCOPE_AGENT); }
__device__ __forceinline__ unsigned xb_xcc_id() { return (unsigned)__builtin_amdgcn_s_getreg((3 << 11) | 20) & 0xFu; }
#define XB_SPIN(cond, bar) do { unsigned _sp = 0; while (cond) { __builtin_amdgcn_s_sleep(1); \
    if ((++_sp & 255u) == 0u) { if (xb_ld(&(bar)[XB_TMO])) break; if (_sp > XB_SPIN_CAP) { atomicAdd(&(bar)[XB_TMO], 1u); break; } } } } while (0)

struct XcdBarrier {
    unsigned* bar; unsigned x;
    volatile LAS unsigned* st;
};

__device__ __forceinline__ XcdBarrier xcd_barrier_post(unsigned* bar, volatile LAS unsigned* st) {
    XcdBarrier b; b.bar = bar; b.x = xb_xcc_id(); b.st = st;
    if (threadIdx.x == 0) (void)xb_add(&bar[XB_XCNT(b.x)], 1u);
    return b;
}
__device__ __forceinline__ void xcd_barrier_complete(unsigned* bar, unsigned x, unsigned& nloc, unsigned& nx) {
    const unsigned G = gridDim.x * gridDim.y * gridDim.z;
    unsigned sum, cnt, mine, sp = 0u;
    for (;;) {
        sum = 0u; cnt = 0u; mine = 0u;
#pragma unroll
        for (unsigned j = 0; j < 16; ++j) { const unsigned c = xb_ld(&bar[XB_XCNT(j)]); sum += c; cnt += (c > 0u) ? 1u : 0u; mine = (j == x) ? c : mine; }
        if (sum == G) break;
        __builtin_amdgcn_s_sleep(1);
        if ((++sp & 255u) == 0u) { if (xb_ld(&bar[XB_TMO])) break; if (sp > XB_SPIN_CAP) { atomicAdd(&bar[XB_TMO], 1u); break; } }
    }
    nloc = mine > 0u ? mine : 1u; nx = cnt > 0u ? cnt : 1u;
}

__device__ __forceinline__ void xcd_barrier(const XcdBarrier& b) {
    asm volatile("s_waitcnt vmcnt(0)" ::: "memory");
    __syncthreads();
    if (threadIdx.x == 0) {
        unsigned* bar = b.bar;
        __builtin_amdgcn_s_waitcnt(0);
        unsigned nloc = b.st[0], nx = b.st[1];
        if (nloc == 0u) { xcd_barrier_complete(bar, b.x, nloc, nx); b.st[0] = nloc; b.st[1] = nx; }
        const unsigned old = xb_add(&bar[XB_XSUB(b.x)], 1u);
        const unsigned gen = old / nloc;
        if (old + 1u == (gen + 1u) * nloc) {
            __builtin_amdgcn_fence(__ATOMIC_RELEASE, "agent");
            asm volatile("s_waitcnt vmcnt(0)" ::: "memory");
            const unsigned og = xb_add(&bar[XB_TOP], 1u);
            const unsigned tg = og / nx;
            if (og + 1u == (tg + 1u) * nx) xb_add(&bar[XB_TOPGEN], 1u);
            else XB_SPIN(xb_ld(&bar[XB_TOPGEN]) == tg, bar);
            __builtin_amdgcn_fence(__ATOMIC_ACQUIRE, "agent");
            xb_add(&bar[XB_XGEN(b.x)], 1u);
            asm volatile("s_waitcnt vmcnt(0)" ::: "memory");
        } else {
            XB_SPIN(xb_ld(&bar[XB_XGEN(b.x)]) == gen, bar);
            __builtin_amdgcn_fence(__ATOMIC_ACQUIRE, "agent");
            asm volatile("s_waitcnt vmcnt(0)" ::: "memory");
        }
    }
    __syncthreads();
}

struct Args { const float* in[39]; float* out; unsigned char* ws; int ph_lo, ph_hi; };
constexpr int N_PHASES = 20;

__device__ __forceinline__ void ffn_gu(const Ctx& C, LAS unsigned char* lds, size_t wgu, int site) {
    pg8::Gemm g{(const bf16_t*)(C.ws + WS_XB), (const bf16_t*)(C.ws + wgu), T, 2 * FF, D}; pg8::StaticOrder S; S.init(T, 2 * FF, C.G, C.bid);
    EpiSwiglu E{(bf16_t*)(C.ws + WS_HP), (const float*)(C.ws + WS_SSQ) + (size_t)site * T * 16, (LAS float*)(C.lds + 131072)};
    pg8::gemm_phase<EpiSwiglu, pg8::StaticOrder, true, true>(lds, g, S, E);
}
__device__ __forceinline__ void ffn_down(const Ctx& C, LAS unsigned char* lds, size_t wd, int site_out, float alpha = 0.5f) {
    pg8::Gemm g{(const bf16_t*)(C.ws + WS_HP), (const bf16_t*)(C.ws + wd), T, D, FF}; pg8::StaticOrder S; S.init(T, D, C.G, C.bid);
    EpiResid E{(bf16_t*)(C.ws + WS_XB), (float*)(C.ws + WS_SSQ) + (size_t)site_out * T * 16, alpha};
    pg8::gemm_phase<EpiResid, pg8::StaticOrder, true, true>(lds, g, S, E);
}
__device__ __forceinline__ void out_proj(const Ctx& C, LAS unsigned char* lds, int site_out) {
    pg8::Gemm g{(const bf16_t*)(C.ws + WS_Y), (const bf16_t*)(C.ws + WS_WOUT), T, D, D}; pg8::StaticOrder S; S.init(T, D, C.G, C.bid);
    EpiResid E{(bf16_t*)(C.ws + WS_XB), (float*)(C.ws + WS_SSQ) + (size_t)site_out * T * 16, 1.0f};
    pg8::gemm_phase<EpiResid, pg8::StaticOrder, true, true>(lds, g, S, E);
}


__device__ __forceinline__ void grid_bar(unsigned* ctr, unsigned target, int tid) {
    asm volatile("s_waitcnt vmcnt(0)" ::: "memory");
    __syncthreads();
    if (tid == 0) {
        __builtin_amdgcn_fence(__ATOMIC_RELEASE, "agent");
        asm volatile("s_waitcnt vmcnt(0)" ::: "memory");
        __hip_atomic_fetch_add(ctr, 1u, __ATOMIC_RELAXED, __HIP_MEMORY_SCOPE_AGENT);
        const unsigned long long t0 = __builtin_amdgcn_s_memrealtime();
        while (__hip_atomic_load(ctr, __ATOMIC_RELAXED, __HIP_MEMORY_SCOPE_AGENT) < target) {
            __builtin_amdgcn_s_sleep(2);
            if (__builtin_amdgcn_s_memrealtime() - t0 > 50000000ull) break;
        }
        __builtin_amdgcn_fence(__ATOMIC_ACQUIRE, "agent");
        asm volatile("s_waitcnt vmcnt(0)" ::: "memory");
    }
    __syncthreads();
}

__global__ void __launch_bounds__(512) mk_fwd(Args args) {
    extern __shared__ __attribute__((aligned(16))) unsigned char lds_raw[];
    cg::grid_group grid = cg::this_grid();
    Ctx C; C.in = args.in; C.X = args.out; C.ws = args.ws; C.lds = (LAS unsigned char*)lds_raw;
    C.tid = threadIdx.x; C.lane = C.tid & 63; C.wave = __builtin_amdgcn_readfirstlane(C.tid >> 6); C.G = gridDim.x; C.bid = blockIdx.x; C.cv_b0 = 0; C.cv_nb = C.G;
    LAS unsigned char* lds = C.lds;
    const int lo = args.ph_lo, hi = args.ph_hi;
#define IN(k) (lo <= (k) && (k) < hi)
#ifndef REP_MASK
#define REP_MASK 0
#endif
#define REPS(k) (((REP_MASK >> (k)) & 1) ? 2 : 1)
#ifdef PROBE_SEAMX2
#define SEAM_EXTRA grid.sync(); if (C.wave == 0) { __builtin_amdgcn_fence(__ATOMIC_ACQUIRE, "agent"); asm volatile("s_waitcnt vmcnt(0)" ::: "memory"); } __syncthreads();
#else
#define SEAM_EXTRA
#endif
#define SEAM(k) do { if (IN(k) && IN((k) + 1)) xcd_barrier(xbar); } while (0)
    if (lo < 0) grid.sync();
    volatile LAS unsigned* xst = (volatile LAS unsigned*)(C.lds + 163824);
    if (C.tid == 0) { xst[0] = 0u; xst[1] = 0u; }
    __syncthreads();
    const XcdBarrier xbar = xcd_barrier_post((unsigned*)C.ws, xst);

#define TAIL_CONVERT(layer, which) do { if (C.G == 256) { if (C.bid >= 128) { __syncthreads(); C.cv_b0 = 128; C.cv_nb = 128; convert_weights(C, (layer), (which)); C.cv_b0 = 0; C.cv_nb = C.G; } } \
    else { __syncthreads(); convert_weights(C, (layer), (which)); } } while (0)

    if (IN(0)) {
#define PROLOGUE_BODY convert_weights(C, 0, 1); bf16_t* sw = (bf16_t*)(C.ws + WS_SMALLW); for (int n = 0; n < 4; ++n) { tr_small(C, C.in[22] + n * 16384, 128, 128, sw + n * 16384); tr_small(C, C.in[24] + n * 16384, 128, 128, sw + 65536 + n * 16384); } tr_small(C, C.in[29], 64, 512, sw + 131072); tr_small(C, C.in[31], 64, 512, sw + 163840); tr_small(C, C.in[32], 160, 512, sw + 196608); prologue_x(C);
        PROLOGUE_BODY
        if (REPS(0) == 2) { PROLOGUE_BODY }
    }
    SEAM(0);
    if (IN(1)) { ffn_gu(C, lds, WS_WGU1, 0); if (REPS(1) == 2) ffn_gu(C, lds, WS_WGU1, 0); TAIL_CONVERT(0, 6); }
    SEAM(1);
    if (IN(2)) { ffn_down(C, lds, WS_WD1, 1, 0.5f); if (REPS(2) == 2) ffn_down(C, lds, WS_WD1, 1, 0.f); }
    SEAM(2);
    if (IN(3)) {
        pg8::Gemm g{(const bf16_t*)(C.ws + WS_XB), (const bf16_t*)(C.ws + WS_WIN), T, 3584, D}; pg8::StaticOrder S; S.init(T, 3584, C.G, C.bid);
        EpiProj E{(bf16_t*)(C.ws + WS_HP), P0LD, 3328, (const float*)(C.ws + WS_SSQ) + (size_t)1 * T * 16, (float*)(C.ws + WS_DT), 3328, (LAS float*)(C.lds + 131072)};
        pg8::gemm_phase<EpiProj, pg8::StaticOrder, true, true>(lds, g, S, E);
        if (REPS(3) == 2) pg8::gemm_phase<EpiProj, pg8::StaticOrder, true, true>(lds, g, S, E);
    }
    SEAM(3);
    #ifndef SKIP4
    if (IN(4)) { l0_states(C); if (REPS(4) == 2) l0_states(C); }
#endif
    SEAM(4);
    #ifndef SKIP5
    if (IN(5)) l0_scan(C);
#endif
    SEAM(5);
    #ifndef SKIP6
    if (IN(6)) { l0_output(C); if (REPS(6) == 2) l0_output(C); }
#endif
    SEAM(6);
    if (IN(7)) out_proj(C, lds, 2);
    SEAM(7);
    if (IN(8)) { ffn_gu(C, lds, WS_WGU2, 2); TAIL_CONVERT(1, 1); }
    SEAM(8);
    if (IN(9)) ffn_down(C, lds, WS_WD2, 3);
    SEAM(9);
    if (IN(10)) { ffn_gu(C, lds, WS_WGU1, 3); TAIL_CONVERT(1, 6); }
    SEAM(10);
    if (IN(11)) ffn_down(C, lds, WS_WD1, 4);
    SEAM(11);
    if (IN(12)) {
        pg8::Gemm g{(const bf16_t*)(C.ws + WS_XB), (const bf16_t*)(C.ws + WS_WIN), T, 3072, D}; pg8::StaticOrder S; S.init(T, 3072, C.G, C.bid);
        EpiProj E{(bf16_t*)(C.ws + WS_HP), P1LD, 2848, (const float*)(C.ws + WS_SSQ) + (size_t)4 * T * 16, nullptr, -1, (LAS float*)(C.lds + 131072)};
        pg8::gemm_phase<EpiProj, pg8::StaticOrder, true, true>(lds, g, S, E);
    }
    SEAM(12);
    if (IN(13)) { l1_pass_a(C); if (REPS(13) == 2) l1_pass_a(C); }
    SEAM(13);
    if (IN(14)) l1_middle(C);
    SEAM(14);
    if (IN(15)) { l1_pass_c(C); if (REPS(15) == 2) l1_pass_c(C); }
    SEAM(15);
    if (IN(16)) out_proj(C, lds, 5);
    SEAM(16);
    if (IN(17)) ffn_gu(C, lds, WS_WGU2, 5);
    SEAM(17);
    if (IN(18)) ffn_down(C, lds, WS_WD2, 6);
    SEAM(18);
    if (IN(19)) final_norm(C);
#undef IN
#undef SEAM
}

extern "C" void kernel_launch(void* const* d_in, const int* in_sizes, int n_in, void* d_out, int out_size, void* d_ws, size_t ws_size, hipStream_t stream) {
    static int grid = 0;
    if (grid == 0) {
        if (n_in != 39 || out_size != T * D || ws_size < WS_END) { fprintf(stderr, "kernel_launch: unexpected problem: n_in %d out %d ws %zu\n", n_in, out_size, ws_size); grid = -1; return; }
        int dev = 0, cus = 0, per_cu = 0;
        hipGetDevice(&dev); hipDeviceGetAttribute(&cus, hipDeviceAttributeMultiprocessorCount, dev);
        if (hipFuncSetAttribute((const void*)mk_fwd, hipFuncAttributeMaxDynamicSharedMemorySize, LDS_BYTES) != hipSuccess) { fprintf(stderr, "kernel_launch: hipFuncSetAttribute failed\n"); grid = -1; return; }
        if (hipOccupancyMaxActiveBlocksPerMultiprocessor(&per_cu, (const void*)mk_fwd, 512, LDS_BYTES) != hipSuccess || per_cu < 1) { fprintf(stderr, "kernel_launch: occupancy query says %d\n", per_cu); per_cu = 1; (void)hipGetLastError(); }
        grid = cus * (per_cu > 1 ? 1 : per_cu);
    }
    if (grid < 0) return;
    if (hipMemsetAsync(d_ws, 0, 16384, stream) != hipSuccess) { fprintf(stderr, "kernel_launch: memset of the barrier word failed\n"); return; }
    Args a{};
    for (int i = 0; i < 39; ++i) a.in[i] = (const float*)d_in[i];
    a.out = (float*)d_out; a.ws = (unsigned char*)d_ws; a.ph_lo = 0; a.ph_hi = N_PHASES;
    void* kargs[] = {&a};
    hipError_t e = hipLaunchCooperativeKernel((const void*)mk_fwd, dim3(grid), dim3(512), kargs, LDS_BYTES, stream);
    if (e != hipSuccess) fprintf(stderr, "kernel_launch: cooperative launch failed: %s (grid %d)\n", hipGetErrorString(e), grid);
}
```
